# Optimizing an MI355X kernel written in HIP

```python
import math
import jax, jax.numpy as jnp
from jax import lax
import numpy as np

D_MODEL = 1024
BATCH = 4
SEQ = 8192
DEPTH = 1

N_MEM = 256
EPS = 1e-6

DN_HEADS = 4
DN_DK = 128
DN_DV = 128
DN_CONV = 4
DN_CHUNK = 64
DN_QKV_W = DN_HEADS * (2 * DN_DK + DN_DV)
DN_V_W = DN_HEADS * DN_DV

DA_HEADS = 4
DA_DH = 64
DA_DV = 2 * DA_DH
DA_QK_W = DA_HEADS * 2 * DA_DH
DA_V_W = DA_HEADS * DA_DV
DA_QKV_W = 2 * DA_QK_W + DA_V_W
Q_BLOCK = 128

MX_HEADS = 4
MX_DH = 128
MX_W = MX_HEADS * MX_DH

REL_BUCKETS = 32
REL_MAX_DIST = 128

N_BRANCH = 3
BRANCH_W = 512

IN_SIZES = (DN_QKV_W, DN_V_W, DN_HEADS, DN_HEADS, DA_QKV_W, MX_W, N_BRANCH * D_MODEL)
IN_W = DN_QKV_W + DN_V_W + 2 * DN_HEADS + DA_QKV_W + MX_W + N_BRANCH * D_MODEL

N_EXPERTS = 32
TOP_K = 4
D_FF = 1024
SWIGLU_LIMIT = 7.0
SWIGLU_ALPHA = 1.702
EXPERT_BLOCK = 512

kernel_name = 'hybrid_deltanet_diffattn_memx_moe_block'


def rms_norm(x, gain):
    xf = x.astype(jnp.float32)
    return xf * lax.rsqrt(jnp.mean(xf * xf, axis=-1, keepdims=True) + EPS) * gain.astype(jnp.float32)


def l2_norm(x):
    return x * lax.rsqrt(jnp.sum(x * x, axis=-1, keepdims=True) + EPS)


def t5_bucket(rel):
    n = jnp.maximum(-rel, 0)
    max_exact = REL_BUCKETS // 2
    nf = jnp.maximum(n, 1).astype(jnp.float32)
    large = max_exact + (jnp.log(nf / max_exact) / math.log(REL_MAX_DIST / max_exact)
                         * (REL_BUCKETS - max_exact)).astype(jnp.int32)
    large = jnp.minimum(large, REL_BUCKETS - 1)
    return jnp.where(n < max_exact, n, large)


def causal_depthwise_conv(x, w):
    c = x.shape[-1]
    return lax.conv_general_dilated(x, w[:, None, :], window_strides=(1,),
                                    padding=[(w.shape[0] - 1, 0)],
                                    dimension_numbers=('NWC', 'WIO', 'NWC'),
                                    feature_group_count=c)


def chunk_gated_delta_rule(q, k, v, g, beta):
    b, h, s, dk = q.shape
    dv = v.shape[-1]
    c = DN_CHUNK
    n = s // c
    q = q.reshape(b, h, n, c, dk)
    k = k.reshape(b, h, n, c, dk)
    v = v.reshape(b, h, n, c, dv)
    beta = beta.reshape(b, h, n, c)
    g = jnp.cumsum(g.reshape(b, h, n, c), axis=-1)
    incl = jnp.tril(jnp.ones((c, c), dtype=bool))
    strict = jnp.tril(jnp.ones((c, c), dtype=bool), k=-1)
    decay = jnp.exp(jnp.where(incl, g[..., :, None] - g[..., None, :], -jnp.inf))
    kk = jnp.einsum('bhnid,bhnjd->bhnij', k, k)
    lower = jnp.where(strict, kk * decay * beta[..., :, None], 0.0)
    a_mat = lower + jnp.eye(c, dtype=lower.dtype)
    rhs = jnp.concatenate([v * beta[..., None], k * (beta * jnp.exp(g))[..., None]], axis=-1)
    sol = lax.linalg.triangular_solve(a_mat, rhs, left_side=True, lower=True, unit_diagonal=True)
    u, w = sol[..., :dv], sol[..., dv:]
    qk = jnp.where(incl, jnp.einsum('bhnid,bhnjd->bhnij', q, k) * decay, 0.0)
    g_last = g[..., -1]
    q_dec = q * jnp.exp(g)[..., None]
    k_dec = k * jnp.exp(g_last[..., None] - g)[..., None]

    def step(state, xs):
        u_c, w_c, q_c, qk_c, k_c, gl_c = xs
        v_new = u_c - jnp.einsum('bhck,bhkv->bhcv', w_c, state)
        o_c = jnp.einsum('bhck,bhkv->bhcv', q_c, state) + jnp.einsum('bhij,bhjv->bhiv', qk_c, v_new)
        state = state * jnp.exp(gl_c)[..., None, None] + jnp.einsum('bhck,bhcv->bhkv', k_c, v_new)
        return state, o_c

    xs = tuple(jnp.moveaxis(t, 2, 0) for t in (u, w, q_dec, qk, k_dec, g_last))
    state0 = jnp.zeros((b, h, dk, dv), q.dtype)
    _, o = lax.scan(step, state0, xs)
    return jnp.moveaxis(o, 0, 2).reshape(b, h, s, dv)


def diff_attention(q, k, v, lam, rel_table):
    b, h, _, s, dh = q.shape
    nb = s // Q_BLOCK
    qb = q.reshape(b, h, 2, nb, Q_BLOCK, dh).transpose(3, 0, 1, 2, 4, 5)
    k_pos = jnp.arange(s, dtype=jnp.int32)
    scale = dh ** -0.5

    def one_block(args):
        i, q_blk = args
        q_pos = i * Q_BLOCK + jnp.arange(Q_BLOCK, dtype=jnp.int32)
        rel = k_pos[None, :] - q_pos[:, None]
        bias = jnp.take(rel_table, t5_bucket(rel), axis=0)
        bias = jnp.transpose(bias, (2, 0, 1))[None, :, None]
        sc = jnp.einsum('bhmqd,bhmkd->bhmqk', q_blk, k) * scale + bias
        sc = jnp.where(rel <= 0, sc, -1e30)
        p = jax.nn.softmax(sc, axis=-1)
        p = p[:, :, 0] - lam * p[:, :, 1]
        return jnp.einsum('bhqk,bhkd->bhqd', p, v)

    o = lax.map(one_block, (jnp.arange(nb, dtype=jnp.int32), qb))
    return o.transpose(1, 2, 0, 3, 4).reshape(b, h, s, -1)


def memory_attention(q, k, v):
    sc = jnp.einsum('bhqd,bhkd->bhqk', q, k) * (q.shape[-1] ** -0.5)
    p = jax.nn.softmax(sc, axis=-1)
    return jnp.einsum('bhqk,bhkd->bhqd', p, v)


def hybrid_mixer(h, mem, rel_table, w_in, b_gate, dn_conv, dn_a_log, dn_dt_bias, dn_out_norm,
                 da_q_norm, da_k_norm, da_lambda, da_subln, mem_norm, w_mem_kv,
                 mx_q_norm, mx_k_norm, w_branch, w_out, lam_init):
    f32 = jnp.float32
    b, s, d = h.shape
    proj = jnp.einsum('bsd,dc->bsc', h, w_in)
    offs = np.cumsum(IN_SIZES)[:-1].tolist()
    dn_qkv, dn_z, dn_a, dn_b, da_qkv, mx_q, gate_logits = jnp.split(proj, offs, axis=-1)

    qkv = jax.nn.silu(causal_depthwise_conv(dn_qkv.astype(f32), dn_conv.astype(f32)))
    q_a, k_a, v_a = jnp.split(qkv, [DN_HEADS * DN_DK, 2 * DN_HEADS * DN_DK], axis=-1)
    q_a = l2_norm(q_a.reshape(b, s, DN_HEADS, DN_DK)) * (DN_DK ** -0.5)
    k_a = l2_norm(k_a.reshape(b, s, DN_HEADS, DN_DK))
    v_a = v_a.reshape(b, s, DN_HEADS, DN_DV)
    beta = jax.nn.sigmoid(dn_b.astype(f32))
    g = -jnp.exp(dn_a_log.astype(f32)) * jax.nn.softplus(dn_a.astype(f32) + dn_dt_bias.astype(f32))
    o_a = chunk_gated_delta_rule(q_a.transpose(0, 2, 1, 3), k_a.transpose(0, 2, 1, 3),
                                 v_a.transpose(0, 2, 1, 3), g.transpose(0, 2, 1),
                                 beta.transpose(0, 2, 1))
    o_a = rms_norm(o_a.transpose(0, 2, 1, 3), dn_out_norm) * jax.nn.silu(
        dn_z.astype(f32).reshape(b, s, DN_HEADS, DN_DV))
    o_dn = o_a.reshape(b, s, DN_V_W)

    da_q, da_k, da_v = jnp.split(da_qkv.astype(f32), [DA_QK_W, 2 * DA_QK_W], axis=-1)
    q_b = rms_norm(da_q.reshape(b, s, DA_HEADS, 2, DA_DH), da_q_norm).transpose(0, 2, 3, 1, 4)
    k_b = rms_norm(da_k.reshape(b, s, DA_HEADS, 2, DA_DH), da_k_norm).transpose(0, 2, 3, 1, 4)
    v_b = da_v.reshape(b, s, DA_HEADS, DA_DV).transpose(0, 2, 1, 3)
    lam_p = da_lambda.astype(f32)
    lam = (jnp.exp(jnp.sum(lam_p[0] * lam_p[1])) - jnp.exp(jnp.sum(lam_p[2] * lam_p[3]))
           + lam_init)
    o_b = diff_attention(q_b, k_b, v_b, lam, rel_table.astype(f32))
    o_b = rms_norm(o_b, da_subln) * (1.0 - lam_init)
    o_da = o_b.transpose(0, 2, 1, 3).reshape(b, s, DA_V_W)

    n_mem = mem.shape[1]
    mem_n = rms_norm(mem, mem_norm)
    mkv = jnp.einsum('bmd,dc->bmc', mem_n, w_mem_kv.astype(f32))
    mk, mv = jnp.split(mkv, [MX_W], axis=-1)
    q_c = rms_norm(mx_q.astype(f32).reshape(b, s, MX_HEADS, MX_DH), mx_q_norm).transpose(0, 2, 1, 3)
    k_c = rms_norm(mk.reshape(b, n_mem, MX_HEADS, MX_DH), mx_k_norm).transpose(0, 2, 1, 3)
    v_c = mv.reshape(b, n_mem, MX_HEADS, MX_DH).transpose(0, 2, 1, 3)
    o_mx = memory_attention(q_c, k_c, v_c).transpose(0, 2, 1, 3).reshape(b, s, MX_W)

    branches = jnp.stack([o_dn, o_da, o_mx], axis=2)
    y = jnp.einsum('bsrc,rcd->bsrd', branches, w_branch.astype(f32))
    gates = jax.nn.sigmoid(gate_logits.astype(f32).reshape(b, s, N_BRANCH, d)
                           + b_gate.astype(f32).reshape(N_BRANCH, d))
    merged = jnp.sum(gates * y, axis=2)
    return jnp.einsum('bsd,de->bse', merged, w_out.astype(f32))


def moe_ffn(h, w_router, b_router, w_gate_up, b_gate_up, w_down, b_down):
    f32 = jnp.float32
    b, s, d = h.shape
    t = b * s
    xt = h.reshape(t, d).astype(f32)
    logits = xt @ w_router.astype(f32) + b_router.astype(f32)
    top_logits, top_idx = lax.top_k(logits, TOP_K)
    top_w = jax.nn.softmax(top_logits, axis=-1)
    m = t * TOP_K
    e_flat = top_idx.reshape(m).astype(jnp.int32)
    tok_flat = jnp.repeat(jnp.arange(t, dtype=jnp.int32), TOP_K)
    w_flat = top_w.reshape(m)
    order = jnp.argsort(e_flat)
    e_sorted = e_flat[order]
    counts = jnp.bincount(e_flat, length=N_EXPERTS).astype(jnp.int32)
    starts = jnp.cumsum(counts) - counts
    padded = (counts + EXPERT_BLOCK - 1) // EXPERT_BLOCK * EXPERT_BLOCK
    pends = jnp.cumsum(padded)
    pstarts = pends - padded
    dest = pstarts[e_sorted] + jnp.arange(m, dtype=jnp.int32) - starts[e_sorted]
    n_blocks = -(-m // EXPERT_BLOCK) + N_EXPERTS
    n_slots = n_blocks * EXPERT_BLOCK
    slot_tok = jnp.full((n_slots,), t, jnp.int32).at[dest].set(tok_flat[order])
    slot_w = jnp.zeros((n_slots,), f32).at[dest].set(w_flat[order])
    block_e = jnp.minimum(jnp.searchsorted(pends, jnp.arange(n_blocks, dtype=jnp.int32) * EXPERT_BLOCK,
                                           side='right'), N_EXPERTS - 1).astype(jnp.int32)
    x_pad = jnp.concatenate([xt, jnp.zeros((1, d), f32)], axis=0)

    def expert_block(args):
        tok_b, e = args
        xb = x_pad[tok_b]
        gu = xb @ w_gate_up[e].astype(f32) + b_gate_up[e].astype(f32)
        gate, up = gu[:, :D_FF], gu[:, D_FF:]
        gate = jnp.minimum(gate, SWIGLU_LIMIT)
        up = jnp.clip(up, -SWIGLU_LIMIT, SWIGLU_LIMIT)
        act = (up + 1.0) * gate * jax.nn.sigmoid(SWIGLU_ALPHA * gate)
        return act @ w_down[e].astype(f32) + b_down[e].astype(f32)

    y = lax.map(expert_block, (slot_tok.reshape(n_blocks, EXPERT_BLOCK), block_e))
    y = y.reshape(n_slots, d) * slot_w[:, None]
    out = jax.ops.segment_sum(y, slot_tok, num_segments=t + 1)[:t]
    return out.reshape(b, s, d)


def setup_inputs(seed: int = 0) -> dict:
    key = jax.random.key(seed)
    ks = jax.random.split(key, 32)
    f32 = jnp.float32

    def dense(k, shape, fan_in):
        return jax.random.normal(k, shape, f32) * fan_in ** -0.5

    def gain(k, shape):
        return 1.0 + 0.02 * jax.random.normal(k, shape, f32)

    def small(k, shape, scale):
        return scale * jax.random.normal(k, shape, f32)

    dt = jnp.exp(jax.random.uniform(ks[7], (DEPTH, DN_HEADS), f32,
                                    math.log(1e-3), math.log(1e-1)))
    return {
        'x': jax.random.normal(ks[0], (BATCH, SEQ, D_MODEL), f32),
        'mem': jax.random.normal(ks[1], (BATCH, N_MEM, D_MODEL), f32),
        'rel_table': small(ks[2], (REL_BUCKETS, DA_HEADS), 0.1),
        'attn_norm': gain(ks[3], (DEPTH, D_MODEL)),
        'w_in': dense(ks[4], (DEPTH, D_MODEL, IN_W), D_MODEL),
        'b_gate': small(ks[5], (DEPTH, N_BRANCH * D_MODEL), 0.02),
        'dn_conv': dense(ks[6], (DEPTH, DN_CONV, DN_QKV_W), DN_CONV),
        'dn_a_log': jnp.log(jax.random.uniform(ks[8], (DEPTH, DN_HEADS), f32, 1.0, 16.0)),
        'dn_dt_bias': dt + jnp.log(-jnp.expm1(-dt)),
        'dn_out_norm': gain(ks[9], (DEPTH, DN_DV)),
        'da_q_norm': gain(ks[10], (DEPTH, DA_DH)),
        'da_k_norm': gain(ks[11], (DEPTH, DA_DH)),
        'da_lambda': small(ks[12], (DEPTH, 4, DA_DH), 0.1),
        'da_subln': gain(ks[13], (DEPTH, DA_DV)),
        'mem_norm': gain(ks[14], (DEPTH, D_MODEL)),
        'w_mem_kv': dense(ks[15], (DEPTH, D_MODEL, 2 * MX_W), D_MODEL),
        'mx_q_norm': gain(ks[16], (DEPTH, MX_DH)),
        'mx_k_norm': gain(ks[17], (DEPTH, MX_DH)),
        'w_branch': dense(ks[18], (DEPTH, N_BRANCH, BRANCH_W, D_MODEL), BRANCH_W),
        'w_out': dense(ks[19], (DEPTH, D_MODEL, D_MODEL), D_MODEL),
        'ffn_norm': gain(ks[20], (DEPTH, D_MODEL)),
        'w_router': dense(ks[21], (DEPTH, D_MODEL, N_EXPERTS), D_MODEL),
        'b_router': small(ks[22], (DEPTH, N_EXPERTS), 0.01),
        'w_gate_up': dense(ks[23], (DEPTH, N_EXPERTS, D_MODEL, 2 * D_FF), D_MODEL),
        'b_gate_up': small(ks[24], (DEPTH, N_EXPERTS, 2 * D_FF), 0.02),
        'w_down': dense(ks[25], (DEPTH, N_EXPERTS, D_FF, D_MODEL), D_FF),
        'b_down': small(ks[26], (DEPTH, N_EXPERTS, D_MODEL), 0.02),
    }


def reference(x, mem, rel_table, attn_norm, w_in, b_gate, dn_conv, dn_a_log, dn_dt_bias,
              dn_out_norm, da_q_norm, da_k_norm, da_lambda, da_subln, mem_norm, w_mem_kv,
              mx_q_norm, mx_k_norm, w_branch, w_out, ffn_norm, w_router, b_router,
              w_gate_up, b_gate_up, w_down, b_down):
    for l in range(DEPTH):
        lam_init = 0.8 - 0.6 * math.exp(-0.3 * l)
        h = rms_norm(x, attn_norm[l]).astype(x.dtype)
        mix = hybrid_mixer(h, mem, rel_table, w_in[l], b_gate[l], dn_conv[l], dn_a_log[l],
                           dn_dt_bias[l], dn_out_norm[l], da_q_norm[l], da_k_norm[l],
                           da_lambda[l], da_subln[l], mem_norm[l], w_mem_kv[l],
                           mx_q_norm[l], mx_k_norm[l], w_branch[l], w_out[l], lam_init)
        x = x + mix.astype(x.dtype)
        h = rms_norm(x, ffn_norm[l]).astype(x.dtype)
        x = x + moe_ffn(h, w_router[l], b_router[l], w_gate_up[l], b_gate_up[l],
                        w_down[l], b_down[l]).astype(x.dtype)
    return x
```

```cpp
#include <hip/hip_runtime.h>
#include <hip/hip_bf16.h>
#include <cstdio>
#include <cstdint>
#include <cmath>

#define GAS __attribute__((address_space(1)))
#define LAS __attribute__((address_space(3)))
typedef unsigned short bf16;
typedef unsigned v4u __attribute__((ext_vector_type(4)));
typedef unsigned v2u __attribute__((ext_vector_type(2)));
typedef float f32x4 __attribute__((ext_vector_type(4)));
typedef float f32x16 __attribute__((ext_vector_type(16)));
typedef short bf16x8 __attribute__((ext_vector_type(8)));
typedef short s16x4 __attribute__((ext_vector_type(4)));
typedef GAS unsigned gu32;
#define RLX_AGENT __ATOMIC_RELAXED, __HIP_MEMORY_SCOPE_AGENT
#define LDS_WAIT() asm volatile("s_waitcnt lgkmcnt(0)" ::: "memory")
#define VM_WAIT() asm volatile("s_waitcnt vmcnt(0)" ::: "memory")
#define DI __device__ __forceinline__

DI unsigned f2bf(float f) { unsigned u = __builtin_bit_cast(unsigned, f); return (u + 0x7fffu + ((u >> 16) & 1u)) >> 16; }
DI unsigned pk2(float lo, float hi) { return f2bf(lo) | (f2bf(hi) << 16); }
DI float bflo(unsigned w) { return __builtin_bit_cast(float, w << 16); }
DI float bfhi(unsigned w) { return __builtin_bit_cast(float, w & 0xffff0000u); }
DI float bf2f(bf16 b) { return __builtin_bit_cast(float, (unsigned)b << 16); }
DI float wave_sum(float v) {
#pragma unroll
    for (int o = 1; o < 64; o <<= 1) v += __shfl_xor(v, o);
    return v;
}
DI float fast_exp(float x) { return __builtin_amdgcn_exp2f(x * 1.4426950408889634f); }
DI float sigmoidf_(float x) { return __builtin_amdgcn_rcpf(1.f + fast_exp(-x)); }
DI int lds_add(LAS int* p, int v) { return __hip_atomic_fetch_add(p, v, __ATOMIC_RELAXED, __HIP_MEMORY_SCOPE_WORKGROUP); }
DI int fresh_tid() { int t; asm volatile("v_mov_b32 %0, %1" : "=v"(t) : "v"((int)threadIdx.x)); return t; }
DI int crow(int r, int hi) { return (r & 3) + 8 * (r >> 2) + 4 * hi; }

constexpr int BATCH = 4, SEQ = 8192, T = BATCH * SEQ, D = 1024, INW = 7176, PW = 7168, NMEM = 256;
constexpr float EPS = 1e-6f;
constexpr int P_DNQ = 0, P_DNK = 512, P_DNV = 1024, P_DNZ = 1536, P_DAQ = 2048, P_DAK = 2560, P_DAV = 3072, P_MXQ = 3584, P_GATE = 4096;
constexpr int NEXP = 32, DFF = 1024, NSLOT_MAX = T * 4 + NEXP * 256, NTILE_MAX = NSLOT_MAX / 256;
constexpr int NCHUNK = BATCH * 4 * (SEQ / 64);
constexpr float LOG2E = 1.4426950408889634f;

constexpr size_t MiB = 1u << 20;
constexpr size_t WS_CTL = 0, CTL_ZERO_BYTES = 1 * MiB;
constexpr size_t WS_G = 1 * MiB;
constexpr size_t WS_BETA = WS_G + 512 * 1024;
constexpr size_t WS_TOKE = 2 * MiB;
constexpr size_t WS_TOKW = WS_TOKE + 512 * 1024;
constexpr size_t WS_SDST = 3 * MiB;
constexpr size_t WS_SW = 4 * MiB;
constexpr size_t WS_EGL = 5 * MiB;
constexpr size_t WS_WB = 6 * MiB;
constexpr size_t WS_WOUT = 9 * MiB;
constexpr size_t WS_WMKV = 11 * MiB;
constexpr size_t WS_MEMN = 13 * MiB;
constexpr size_t WS_MKV = 15 * MiB;
constexpr size_t WS_WIN = 17 * MiB;
constexpr size_t WS_WGU = 32 * MiB;
constexpr size_t WS_WD = 160 * MiB;
constexpr size_t WS_H = 224 * MiB;
constexpr size_t WS_P = 288 * MiB;
constexpr size_t WS_NW = 736 * MiB;
constexpr size_t WS_QD = 768 * MiB;
constexpr size_t WS_KDT = 800 * MiB;
constexpr size_t WS_U = 832 * MiB;
constexpr size_t WS_QK = 864 * MiB;
constexpr size_t WS_ODN = 880 * MiB;
constexpr size_t WS_O1 = 912 * MiB;
constexpr size_t WS_O2 = 944 * MiB;
constexpr size_t WS_OMX = 976 * MiB;
constexpr size_t WS_ODNF = 736 * MiB;
constexpr size_t WS_ODAF = 768 * MiB;
constexpr size_t WS_MRG = 800 * MiB;
constexpr size_t WS_XS = 288 * MiB;
constexpr size_t WS_ACT = 560 * MiB;
constexpr size_t WS_END = 1024 * MiB;
static_assert(WS_OMX + (size_t)T * 512 * 2 <= WS_END && WS_ACT + (size_t)NSLOT_MAX * 1024 * 2 <= WS_END && WS_XS + (size_t)NSLOT_MAX * 1024 * 2 <= WS_ACT, "ws map");

constexpr int CW_QHEAD = 64;
constexpr int CW_CNT = 128;
constexpr int CW_CUR = 192;
constexpr int CW_BAR = 4096;

constexpr int RING_BYTES = 136 * 1024;
constexpr int LDSCTL_OFF = RING_BYTES;
constexpr int MISC_OFF = LDSCTL_OFF;
constexpr int LTAB_OFF = LDSCTL_OFF + 128;
constexpr int LCNT_OFF = LTAB_OFF + NTILE_MAX * 4;
constexpr int LWSC_OFF = LCNT_OFF + 512;
constexpr int LDS_BYTES = 144 * 1024;
static_assert(LWSC_OFF + 8 * 256 <= LDS_BYTES, "LDS map");

namespace pg8 {
constexpr int BM = 256, BK = 64, HALF = 128, HTB = HALF * BK * 2, STAGE_BYTES = 8 * HTB, NXCD = 8, WGM = 8;
DI int lds_byte(int r, int c) { const int st = (r >> 4) * 2 + (c >> 5), rr = r & 15, cc = c & 31, ob = rr * 64 + cc * 2; return st * 1024 + (ob ^ (((ob >> 9) & 1) << 5)); }
DI void stage_rc(int b, int& R, int& C) { const int st = b / 1024, sb = b % 1024, swz = sb ^ (((sb >> 9) & 1) << 5); R = (st >> 1) * 16 + swz / 64; C = (st & 1) * 32 + (swz % 64) / 2; }
DI int perm32(int rho) { const int n = rho >> 4, i = rho & 15; return 8 * (i >> 2) + 4 * n + (i & 3); }

struct Unit { int pm, pn; long aoff, boff; int tag; };
struct Gemm { const bf16* A; const bf16* Bt; int lda, ldb, K; };

struct StaticOrder {
    int nM, nN, nwg, G, c;
    DI void init(int M, int N, int G_, int c_) { nM = M / BM; nN = N / BM; nwg = nM * nN; G = G_; c = c_; }
    DI bool tile(long L, int& pm, int& pn) const {
        if (L >= nwg) return false;
        int wgid = (int)L; { const int q = nwg / NXCD, r = nwg % NXCD, xcd = wgid % NXCD, off = wgid / NXCD; wgid = (xcd < r ? xcd * (q + 1) : r * (q + 1) + (xcd - r) * q) + off; }
        const int nig = WGM * nN, gid = wgid / nig, fm = gid * WGM, gsz = (nM - fm) < WGM ? (nM - fm) : WGM;
        pm = fm + ((wgid % nig) % gsz); pn = (wgid % nig) / gsz; return true;
    }
    DI bool next(int i, Unit& u) const { u.aoff = 0; u.boff = 0; u.tag = 0; return tile((long)i * G + c, u.pm, u.pn); }
};

template <class Epi, class Sched>
DI void gemm_phase(LAS unsigned char* lds, const Gemm g, const Sched& S, const Epi& E, const int tid) {
    const int wid = __builtin_amdgcn_readfirstlane(tid >> 6), lane = tid & 63, wr = wid >> 2, wc = wid & 3, fr = lane & 15, fq = lane >> 4;
    const int K = g.K, nt = K / BK;
    unsigned voffA[2], voffB[2];
#pragma unroll
    for (int i = 0; i < 2; ++i) { int R, C; stage_rc(tid * 16 + i * 8192, R, C); const int Rb = Epi::PERM ? ((R & ~31) + perm32(R & 31)) : R;
        voffA[i] = (unsigned)(R * g.lda + C) * 2u; voffB[i] = (unsigned)(Rb * g.ldb + C) * 2u; }
    const size_t kstep = (size_t)(BK * 2);
    const size_t hstepA = (size_t)HALF * g.lda * 2, hstepB = (size_t)HALF * g.ldb * 2;
    const size_t tstepA = 2 * hstepA, tstepB = 2 * hstepB;
    const unsigned ldsw = (unsigned)wid * 1024u;
    const int aoff = lds_byte(wr * 64 + fr, fq * 8), boff = lds_byte(wc * 32 + fr, fq * 8);
#define PG8_SA(b, h) (((b) * 2 + (h)) * HTB)
#define PG8_SB(b, h) ((4 + (b) * 2 + (h)) * HTB)
#define PG8_STAGE(bufoff, gbase, voff) do { _Pragma("unroll") for (int _i = 0; _i < 2; ++_i) \
        __builtin_amdgcn_global_load_lds((const unsigned*)((const char*)(gbase) + (voff)[_i]), (LAS unsigned*)(lds + (bufoff) + ldsw + _i * 8192), 16, 0, 0); } while (0)
#define PG8_LDA(dst, b, h) do { _Pragma("unroll") for (int m = 0; m < 4; ++m) _Pragma("unroll") for (int k = 0; k < 2; ++k) dst[m][k] = *(const LAS bf16x8*)(lds + PG8_SA(b, h) + aoff + m * 2048 + k * 1024); } while (0)
#define PG8_LDB(dst, b, h) do { _Pragma("unroll") for (int n = 0; n < 2; ++n) _Pragma("unroll") for (int k = 0; k < 2; ++k) dst[n][k] = *(const LAS bf16x8*)(lds + PG8_SB(b, h) + boff + n * 2048 + k * 1024); } while (0)
#define PG8_MMA(ai, bj, At, Bt) do { __builtin_amdgcn_s_setprio(1); _Pragma("unroll") for (int m = 0; m < 4; ++m) _Pragma("unroll") for (int n = 0; n < 2; ++n) _Pragma("unroll") for (int k = 0; k < 2; ++k) \
        acc[ai][bj][m][n] = __builtin_amdgcn_mfma_f32_16x16x32_bf16(Bt[n][k], At[m][k], acc[ai][bj][m][n], 0, 0, 0); __builtin_amdgcn_s_setprio(0); } while (0)
#define PG8_WAIT_V(n) asm volatile("s_waitcnt vmcnt(" #n ")" ::: "memory")
#define PG8_WAIT_L(n) asm volatile("s_waitcnt lgkmcnt(" #n ")" ::: "memory")
#define PG8_BAR __builtin_amdgcn_s_barrier()
#define PG8_SCHED __builtin_amdgcn_sched_barrier(0)
    Unit cur, nxt; int ui = 0;
    if (!S.next(0, cur)) return;
    f32x4 acc[2][2][4][2];
#pragma unroll
    for (int a = 0; a < 2; ++a)
#pragma unroll
        for (int b = 0; b < 2; ++b)
#pragma unroll
            for (int m = 0; m < 4; ++m)
#pragma unroll
                for (int n = 0; n < 2; ++n) acc[a][b][m][n] = (f32x4){0.f, 0.f, 0.f, 0.f};
    bf16x8 At[4][2], B0[2][2], B1[2][2];
    const char* cA = (const char*)g.A + (size_t)cur.pm * tstepA + cur.aoff; const char* cB = (const char*)g.Bt + (size_t)cur.pn * tstepB + cur.boff;
    PG8_STAGE(PG8_SB(0, 0), cB, voffB); PG8_STAGE(PG8_SB(0, 1), cB + hstepB, voffB); PG8_STAGE(PG8_SA(0, 0), cA, voffA); PG8_STAGE(PG8_SA(0, 1), cA + hstepA, voffA);
    if (wr == 1) PG8_BAR;
    PG8_WAIT_V(2); PG8_BAR;
    PG8_STAGE(PG8_SB(1, 0), cB + kstep, voffB); PG8_STAGE(PG8_SA(1, 0), cA + kstep, voffA); PG8_STAGE(PG8_SB(1, 1), cB + hstepB + kstep, voffB);
    PG8_WAIT_V(6); PG8_BAR;
    for (;;) {
        const bool has_next = S.next(ui + 1, nxt);
        const char* nA = has_next ? (const char*)g.A + (size_t)nxt.pm * tstepA + nxt.aoff : cA; const char* nB = has_next ? (const char*)g.Bt + (size_t)nxt.pn * tstepB + nxt.boff : cB;
        for (int t = 0; t < nt; t += 2) {
            const bool last = (t == nt - 2);
            const char* a1 = cA + (size_t)(t + 1) * kstep;
            const char* a2 = last ? nA : cA + (size_t)(t + 2) * kstep; const char* b2 = last ? nB : cB + (size_t)(t + 2) * kstep;
            const char* a3 = a2 + kstep; const char* b3 = b2 + kstep;
            PG8_LDB(B0, 0, 0); PG8_LDB(B1, 0, 1); PG8_SCHED; PG8_LDA(At, 0, 0); PG8_STAGE(PG8_SA(1, 1), a1 + hstepA, voffA);
            PG8_WAIT_V(8); PG8_WAIT_L(0); PG8_BAR; PG8_MMA(0, 0, At, B0); PG8_MMA(0, 1, At, B1); PG8_BAR; PG8_SCHED;
            PG8_LDA(At, 0, 1); PG8_STAGE(PG8_SB(0, 0), b2, voffB); PG8_STAGE(PG8_SB(0, 1), b2 + hstepB, voffB); PG8_STAGE(PG8_SA(0, 0), a2, voffA);
            PG8_WAIT_V(8); PG8_WAIT_L(0); PG8_BAR; PG8_MMA(1, 0, At, B0); PG8_MMA(1, 1, At, B1); PG8_BAR; PG8_SCHED;
            PG8_LDB(B0, 1, 0); PG8_LDB(B1, 1, 1); PG8_SCHED; PG8_LDA(At, 1, 0); PG8_STAGE(PG8_SA(0, 1), a2 + hstepA, voffA);
            PG8_WAIT_V(8); PG8_WAIT_L(0); PG8_BAR; PG8_MMA(0, 0, At, B0); PG8_MMA(0, 1, At, B1); PG8_BAR; PG8_SCHED;
            PG8_LDA(At, 1, 1); PG8_STAGE(PG8_SB(1, 0), b3, voffB); PG8_STAGE(PG8_SB(1, 1), b3 + hstepB, voffB); PG8_STAGE(PG8_SA(1, 0), a3, voffA);
            PG8_WAIT_V(8); PG8_WAIT_L(0); PG8_BAR; PG8_MMA(1, 0, At, B0); PG8_MMA(1, 1, At, B1); PG8_BAR; PG8_SCHED;
        }
        if (wr == 0) PG8_BAR;
        E(acc, cur, wr, wc, fr, fq);
        if (!has_next) break;
#pragma unroll
        for (int a = 0; a < 2; ++a)
#pragma unroll
            for (int b = 0; b < 2; ++b)
#pragma unroll
                for (int m = 0; m < 4; ++m)
#pragma unroll
                    for (int n = 0; n < 2; ++n) acc[a][b][m][n] = (f32x4){0.f, 0.f, 0.f, 0.f};
        cur = nxt; cA = nA; cB = nB; ++ui;
        if (wr == 1) PG8_BAR;
    }
    PG8_WAIT_V(0);
    PG8_BAR;
#undef PG8_SA
#undef PG8_SB
#undef PG8_STAGE
#undef PG8_LDA
#undef PG8_LDB
#undef PG8_MMA
#undef PG8_WAIT_V
#undef PG8_WAIT_L
#undef PG8_BAR
#undef PG8_SCHED
}
}
namespace attn_body {
using bf16=__hip_bfloat16;
using bf16x8=__attribute__((ext_vector_type(8)))short;
using s16x4=__attribute__((ext_vector_type(4)))short;
using f32x16=__attribute__((ext_vector_type(16)))float;
using u32x4=__attribute__((ext_vector_type(4)))unsigned;
constexpr int SEQ=8192,D=64,DM=7168,OPITCH=512;
constexpr int NW=8,QBLK=32,QB=QBLK*NW,KVBLK=64,NQB=SEQ/QB;
constexpr int ATTN_UNIT_ROWS=QB;
__device__ __forceinline__ int crow(int r,int hi){return (r&3)+8*(r>>2)+4*hi;}
#define SBAR() __builtin_amdgcn_sched_barrier(0)
__device__ __forceinline__ void cmask(f32x16&p0,f32x16&p1,int jb,int qrel,int hi){
  const float NEG=-INFINITY; int kb=64*jb+4*hi;
  #pragma unroll
  for(int r=0;r<16;++r){int kv=kb+(r&3)+8*(r>>2); if(kv>qrel)p0[r]=NEG; if(kv+32>qrel)p1[r]=NEG;}
}

__device__ __forceinline__ void biasadd(f32x16&p0,f32x16&p1,const float*lp){
  #pragma unroll
  for(int r=0;r<16;r+=2){ const float a0=lp[59-((r&3)+8*(r>>2))],a1=lp[59-(((r+1)&3)+8*((r+1)>>2))],b0=lp[59-32-((r&3)+8*(r>>2))],b1=lp[59-32-(((r+1)&3)+8*((r+1)>>2))];
    p0[r]+=a0; p0[r+1]+=a1; p1[r]+=b0; p1[r+1]+=b1; __builtin_amdgcn_sched_barrier(0); }
}
constexpr int NSLOT=3, SLOTB=8192;
constexpr int LDS_K=0, LDS_V=NSLOT*SLOTB, LDS_WS=2*NSLOT*SLOTB, LDS_OST=LDS_WS+NW*64*4, LDS_LUT=LDS_OST+NW*4096, LDS_BYTES=LDS_LUT+640*4;
constexpr float C2=0.125f*1.4426950408889634f;
__device__ __forceinline__ void glds16(const void*gsrc,unsigned lds_dst){unsigned keep;
  asm volatile("s_mov_b32 %0, m0\n\ts_mov_b32 m0, %2\n\ts_nop 0\n\tglobal_load_lds_dwordx4 %1, off\n\ts_mov_b32 m0, %0":"=&s"(keep):"v"(gsrc),"s"(lds_dst):"memory");}
__device__ __forceinline__ float max3f(float a,float b,float c){float r;asm("v_max3_f32 %0, %1, %2, %3":"=v"(r):"v"(a),"v"(b),"v"(c));return r;}
__device__ __forceinline__ float max2f(float a,float b){float r;asm("v_max_f32_e32 %0, %1, %2":"=v"(r):"v"(a),"v"(b));return r;}
__device__ __forceinline__ float fadd_s(float a,float b){float r;asm("v_add_f32_e32 %0, %1, %2":"=v"(r):"v"(a),"v"(b));return r;}
__device__ __forceinline__ float fsub_s(float a,float b){float r;asm("v_sub_f32_e32 %0, %1, %2":"=v"(r):"v"(a),"v"(b));return r;}
typedef float f32x2_t __attribute__((ext_vector_type(2))); typedef __bf16 bf16x2_t __attribute__((ext_vector_type(2)));
__device__ __forceinline__ unsigned cvtpk_s(float lo,float hi){f32x2_t v={lo,hi};bf16x2_t b=__builtin_convertvector(v,bf16x2_t);return __builtin_bit_cast(unsigned,b);}
#define WAIT_BAR(N) asm volatile("s_waitcnt vmcnt(" #N ") lgkmcnt(0)\n\ts_barrier":::"memory")

__device__ __forceinline__ void qkt(f32x16&p0,f32x16&p1,const char*Kslot,const bf16x8*qr,const f32x16&negm,int r32,int hi){
  const char*kb=Kslot+hi*1024+r32*16;
  #pragma unroll
  for(int d0=0;d0<4;++d0){
    const bf16x8 b0=*reinterpret_cast<const bf16x8*>(kb+d0*2048);
    const bf16x8 b1=*reinterpret_cast<const bf16x8*>(kb+d0*2048+512);
    if(d0==0){p0=__builtin_amdgcn_mfma_f32_32x32x16_bf16(b0,qr[0],negm,0,0,0);p1=__builtin_amdgcn_mfma_f32_32x32x16_bf16(b1,qr[0],negm,0,0,0);}
    else{p0=__builtin_amdgcn_mfma_f32_32x32x16_bf16(b0,qr[d0],p0,0,0,0);p1=__builtin_amdgcn_mfma_f32_32x32x16_bf16(b1,qr[d0],p1,0,0,0);}}
}
typedef __attribute__((address_space(3))) const char* lds_cptr;
typedef short v4i16_t __attribute__((ext_vector_type(4)));
__device__ __forceinline__ void kload8(bf16x8*kf,lds_cptr kp){
  kf[0]=*(const __attribute__((address_space(3))) bf16x8*)(kp);      kf[1]=*(const __attribute__((address_space(3))) bf16x8*)(kp+512);
  kf[2]=*(const __attribute__((address_space(3))) bf16x8*)(kp+2048); kf[3]=*(const __attribute__((address_space(3))) bf16x8*)(kp+2560);
  kf[4]=*(const __attribute__((address_space(3))) bf16x8*)(kp+4096); kf[5]=*(const __attribute__((address_space(3))) bf16x8*)(kp+4608);
  kf[6]=*(const __attribute__((address_space(3))) bf16x8*)(kp+6144); kf[7]=*(const __attribute__((address_space(3))) bf16x8*)(kp+6656);
}
__device__ __forceinline__ void kload2(bf16x8*kf,lds_cptr kp,int j){ kf[2*j]=*(const __attribute__((address_space(3))) bf16x8*)(kp+j*2048); kf[2*j+1]=*(const __attribute__((address_space(3))) bf16x8*)(kp+j*2048+512); }
__device__ __forceinline__ s16x4 vtr(lds_cptr p){ return __builtin_bit_cast(s16x4,__builtin_amdgcn_ds_read_tr16_b64_v4i16((__attribute__((address_space(3))) v4i16_t*)p)); }
__device__ __forceinline__ float rowmax(const f32x16&p0,const f32x16&p1){
  float a=max3f(p0[0],p0[1],p1[0]),b=max3f(p0[2],p0[3],p1[1]);a=max3f(a,p1[2],p1[3]);
  #pragma unroll
  for(int r=4;r<16;r+=4){a=max3f(a,p0[r],p0[r+1]);b=max3f(b,p0[r+2],p0[r+3]);a=max3f(a,p1[r],p1[r+1]);b=max3f(b,p1[r+2],p1[r+3]);}
  const float m=max2f(a,b);
  auto rr=__builtin_amdgcn_permlane32_swap(__float_as_uint(m),__float_as_uint(m),false,false);
  return max2f(__uint_as_float(rr[0]),__uint_as_float(rr[1]));
}
__device__ __forceinline__ void pv(f32x16*o,int vb,bf16x8 pa0,bf16x8 pa1,bf16x8 pa2,bf16x8 pa3){
  #pragma unroll
  for(int d0=0;d0<2;++d0){s16x4 lo[4],hi[4];
    #pragma unroll
    for(int ks=0;ks<4;++ks){
      asm volatile("ds_read_b64_tr_b16 %0,%1 offset:%c2":"=&v"(lo[ks]):"v"(vb),"i"(d0*4096+ks*1024):"memory");
      asm volatile("ds_read_b64_tr_b16 %0,%1 offset:%c2":"=&v"(hi[ks]):"v"(vb),"i"(d0*4096+ks*1024+512):"memory");}
    asm volatile("s_waitcnt lgkmcnt(0)":::"memory");SBAR();
    #define PK(k) (bf16x8){lo[k][0],lo[k][1],lo[k][2],lo[k][3],hi[k][0],hi[k][1],hi[k][2],hi[k][3]}
    o[d0]=__builtin_amdgcn_mfma_f32_32x32x16_bf16(pa0,PK(0),o[d0],0,0,0);
    o[d0]=__builtin_amdgcn_mfma_f32_32x32x16_bf16(pa1,PK(1),o[d0],0,0,0);
    o[d0]=__builtin_amdgcn_mfma_f32_32x32x16_bf16(pa2,PK(2),o[d0],0,0,0);
    o[d0]=__builtin_amdgcn_mfma_f32_32x32x16_bf16(pa3,PK(3),o[d0],0,0,0);
    #undef PK
  }
}

#ifndef ATTN_STORE16
#define ATTN_STORE16(p,v) (*(u32x4*)(p)=(v))
#endif
template<int THRL> __device__ __forceinline__ void attn_unit(int qb,const bf16*Qh,const bf16*__restrict__ Kh,const bf16*__restrict__ Vh,bf16*Oh,const float* __restrict__ rel_table,int head,char*shm,const int tid){
  const int lane=tid&63,r32=lane&31,hi=lane>>5; const int wid=__builtin_amdgcn_readfirstlane(tid>>6);
  const int q0=qb*QB;
  const bf16*Qw=Qh+(long)(q0+wid*QBLK)*DM;
  const unsigned lds0=(unsigned)(uintptr_t)shm;
  float*wsf=(float*)(shm+LDS_WS)+wid*64;
  const bf16*ksrc=Kh+(long)lane*DM+wid*8;
  const bf16*vsrc=Vh+(long)(16*(wid&3)+(lane>>2))*DM+(wid>>2)*32+(lane&3)*8;
  const unsigned kdst=lds0+LDS_K+wid*1024, vdst=lds0+LDS_V+wid*1024;
  #define DMA_K(t,slot) glds16(ksrc+(long)(t)*KVBLK*DM,(unsigned)__builtin_amdgcn_readfirstlane(kdst+(slot)))
  #define DMA_V(t,slot) glds16(vsrc+(long)(t)*KVBLK*DM,(unsigned)__builtin_amdgcn_readfirstlane(vdst+(slot)))
  const int vb0=(int)(lds0+LDS_V)+((lane>>4)&1)*32+(lane&3)*8+(4*hi+((lane&15)>>2))*64;
  const char*Kbase=shm+LDS_K; bf16x8 kf[8];
  const lds_cptr shm3=(lds_cptr)shm; const lds_cptr kp0=shm3+LDS_K+hi*1024+r32*16; const lds_cptr vp0=shm3+LDS_V+((lane>>4)&1)*32+(lane&3)*8+(4*hi+((lane&15)>>2))*64;
  const int NT=(q0+QB)/KVBLK;
  { float*lut=(float*)(shm+LDS_LUT); const float t31=rel_table[31*4+head];
    for(int i=tid;i<640;i+=512){ const int d=i-256; float v=0.f;
      if(d>=0&&d<128){ int bk; if(d<16)bk=d; else { bk=16+(int)(logf((float)d*(1.f/16.f))/logf(8.f)*16.f); bk=bk<31?bk:31; } v=(rel_table[bk*4+head]-t31)*1.4426950408889634f; }
      lut[i]=v; } }
  const float*lutl=(const float*)(shm+LDS_LUT)+(wid*QBLK+r32-4*hi+256-59);
  DMA_K(0,0);DMA_V(0,0);DMA_K(1,SLOTB);
  bf16x8 qr[4];
  #pragma unroll
  for(int d0=0;d0<4;++d0)qr[d0]=*reinterpret_cast<const bf16x8*>(&Qw[(long)r32*DM+d0*16+hi*8]);
  float mhat=0.f,l_reg=0.f;f32x16 o[2];o[0]=f32x16{};o[1]=f32x16{};f32x16 negm=f32x16{};asm volatile("":"+v"(negm));
  const int qrel=wid*QBLK+r32;
  #define CMASK(P0,P1,t) do{int jb_=(t)-(NT-4); if(jb_>=-2)biasadd(P0,P1,lutl-64*jb_); if(jb_>=0)cmask(P0,P1,jb_,qrel,hi);}while(0)
  bool resc=false;
  #define START(P0,P1) do{ const float rm=rowmax(P0,P1); resc=false; \
    { const float dl=rm; mhat=fadd_s(mhat,dl); \
      _Pragma("unroll") for(int r=0;r<16;++r){P0[r]=fsub_s(P0[r],dl);P1[r]=fsub_s(P1[r],dl);} \
      _Pragma("unroll") for(int r=0;r<16;++r)negm[r]=-mhat; asm volatile("":"+v"(negm)); } \
    _Pragma("unroll") for(int r=0;r<16;++r)P0[r]=__builtin_amdgcn_exp2f(P0[r]); }while(0)
  #define RESC() do{ if(resc){ asm volatile("s_waitcnt lgkmcnt(0)":::"memory"); \
      _Pragma("unroll") for(int d_=0;d_<2;++d_) _Pragma("unroll") for(int r=0;r<16;++r)o[d_][r]*=wsf[crow(r,hi)]; } }while(0)
  f32x16 pA0,pA1,pB0,pB1;
  int sl_prev=0,sl_cur=0,sl_next=SLOTB;
  #define ROT() do{sl_prev=sl_cur;sl_cur=sl_next;sl_next=(sl_next==(NSLOT-1)*SLOTB)?0:sl_next+SLOTB;}while(0)
  DMA_K(2,2*SLOTB);
  WAIT_BAR(3);
  qkt(pA0,pA1,Kbase,qr,negm,r32,hi);asm volatile("s_nop 15\n\ts_nop 7":"+v"(pA0),"+v"(pA1));CMASK(pA0,pA1,0);
  START(pA0,pA1);
  _Pragma("unroll") for(int r=0;r<16;++r)pA1[r]=__builtin_amdgcn_exp2f(pA1[r]);
  WAIT_BAR(0);
  DMA_K(3,0);DMA_V(1,SLOTB);
  ROT();
  kload8(kf,kp0+sl_cur);
  WAIT_BAR(2);
  s16x4 vlo[8],vhi[8]; u32x4 pw0,pw1,pw2,pw3;
  #define PKW(P,B) cvtpk_s(P[B],P[B+1])
  #define PAF(k) __builtin_bit_cast(bf16x8,pw##k)
  #define VFR(i) (bf16x8){vlo[i][0],vlo[i][1],vlo[i][2],vlo[i][3],vhi[i][0],vhi[i][1],vhi[i][2],vhi[i][3]}
  #define PIN(x) asm volatile("":"+v"(x))
  #define MX3(a,b,c) __builtin_fmaxf(__builtin_fmaxf((a),(b)),(c))
  #define GAPA(MF,A0,A1,A2,A3,W0,W1,PW) do{ MF; sacc+=A0; sacc+=A1; sacc+=A2; sacc+=A3; PIN(sacc); W0; W1; PIN(PW); SBAR(); }while(0)
  #define EX(v) __builtin_amdgcn_exp2f(v)
  #define GAPB(MF,X,B) do{ MF; X[B]=EX(X[B]); X[B+1]=EX(X[B+1]); X[B+2]=EX(X[B+2]); X[B+3]=EX(X[B+3]); PIN(X); SBAR(); }while(0)
  #define VRD(i) do{ vlo[i]=vtr(vp_+(((i)>>2)*4096+((i)&3)*1024)); vhi[i]=vtr(vp_+(((i)>>2)*4096+((i)&3)*1024+512)); }while(0)
  #define KRD(G,j) do{ if(G){ kload2(kf,kp0+sl_next,j); SBAR(); } }while(0)
  #define STEP(C0,C1,P0,P1,t,GK,GV,GL) do{ SBAR(); \
    const lds_cptr vp_=vp0+sl_prev; \
    VRD(0); SBAR(); float sacc=(P0[0]+P0[1]); \
    GAPA(C0=__builtin_amdgcn_mfma_f32_32x32x16_bf16(kf[0],qr[0],negm,0,0,0), P0[2],P0[3],P0[4],P0[5],     pw0[0]=PKW(P0,0), pw0[1]=PKW(P0,2), pw0); \
    VRD(4); SBAR(); GAPA(C1=__builtin_amdgcn_mfma_f32_32x32x16_bf16(kf[1],qr[0],negm,0,0,0), P0[6],P0[7],P0[8],P0[9],     pw0[2]=PKW(P0,4), pw0[3]=PKW(P0,6), pw0); \
    VRD(1); SBAR(); GAPA(C0=__builtin_amdgcn_mfma_f32_32x32x16_bf16(kf[2],qr[1],C0,0,0,0),   P0[10],P0[11],P0[12],P0[13], pw1[0]=PKW(P0,8), pw1[1]=PKW(P0,10), pw1); \
    VRD(5); SBAR(); GAPA(C1=__builtin_amdgcn_mfma_f32_32x32x16_bf16(kf[3],qr[1],C1,0,0,0),   P0[14],P0[15],P1[0],P1[1],   pw1[2]=PKW(P0,12),pw1[3]=PKW(P0,14), pw1); \
    VRD(2); SBAR(); GAPA(C0=__builtin_amdgcn_mfma_f32_32x32x16_bf16(kf[4],qr[2],C0,0,0,0),   P1[2],P1[3],P1[4],P1[5],     pw2[0]=PKW(P1,0), pw2[1]=PKW(P1,2), pw2); \
    VRD(6); SBAR(); GAPA(C1=__builtin_amdgcn_mfma_f32_32x32x16_bf16(kf[5],qr[2],C1,0,0,0),   P1[6],P1[7],P1[8],P1[9],     pw2[2]=PKW(P1,4), pw2[3]=PKW(P1,6), pw2); \
    VRD(3); SBAR(); GAPA(C0=__builtin_amdgcn_mfma_f32_32x32x16_bf16(kf[6],qr[3],C0,0,0,0),   P1[10],P1[11],P1[12],P1[13], pw3[0]=PKW(P1,8), pw3[1]=PKW(P1,10), pw3); \
    VRD(7); SBAR(); GAPA(C1=__builtin_amdgcn_mfma_f32_32x32x16_bf16(kf[7],qr[3],C1,0,0,0),   P1[14],P1[15],0.f,0.f,       pw3[2]=PKW(P1,12),pw3[3]=PKW(P1,14), pw3); \
    l_reg+=sacc; \
    if(GK){DMA_K((t)+3,sl_cur);} if(GV){DMA_V((t)+1,sl_next);} \
    CMASK(C0,C1,t); \
    { float a=MX3(C0[0],C0[1],C1[0]),b=MX3(C0[2],C0[3],C1[1]); a=MX3(a,C1[2],C1[3]); \
      _Pragma("unroll") for(int r=4;r<16;r+=4){a=MX3(a,C0[r],C0[r+1]);b=MX3(b,C0[r+2],C0[r+3]);a=MX3(a,C1[r],C1[r+1]);b=MX3(b,C1[r+2],C1[r+3]);} \
      float rm=__builtin_fmaxf(a,b); { auto rr=__builtin_amdgcn_permlane32_swap(__float_as_uint(rm),__float_as_uint(rm),false,false); rm=__builtin_fmaxf(__uint_as_float(rr[0]),__uint_as_float(rr[1])); } \
      resc=false; \
      if(__builtin_expect(__any(rm>(float)THRL),0)){ const float dl=__builtin_fmaxf(rm,0.f); mhat+=dl; \
        _Pragma("unroll") for(int r=0;r<16;++r){C0[r]-=dl;C1[r]-=dl;} \
        _Pragma("unroll") for(int r=0;r<16;++r)negm[r]=-mhat; asm volatile("":"+v"(negm)); \
        const float f=__builtin_amdgcn_exp2f(-dl); l_reg*=f; if(hi==0)wsf[r32]=f; resc=true; } } \
    SBAR(); \
    GAPB(o[0]=__builtin_amdgcn_mfma_f32_32x32x16_bf16(PAF(0),VFR(0),o[0],0,0,0), C0,0); \
    GAPB(o[1]=__builtin_amdgcn_mfma_f32_32x32x16_bf16(PAF(0),VFR(4),o[1],0,0,0), C0,4); \
    KRD(GL,0); GAPB(o[0]=__builtin_amdgcn_mfma_f32_32x32x16_bf16(PAF(1),VFR(1),o[0],0,0,0), C0,8); \
    KRD(GL,1); GAPB(o[1]=__builtin_amdgcn_mfma_f32_32x32x16_bf16(PAF(1),VFR(5),o[1],0,0,0), C0,12); \
    KRD(GL,2); GAPB(o[0]=__builtin_amdgcn_mfma_f32_32x32x16_bf16(PAF(2),VFR(2),o[0],0,0,0), C1,0); \
    KRD(GL,3); GAPB(o[1]=__builtin_amdgcn_mfma_f32_32x32x16_bf16(PAF(2),VFR(6),o[1],0,0,0), C1,4); \
    GAPB(o[0]=__builtin_amdgcn_mfma_f32_32x32x16_bf16(PAF(3),VFR(3),o[0],0,0,0), C1,8); \
    GAPB(o[1]=__builtin_amdgcn_mfma_f32_32x32x16_bf16(PAF(3),VFR(7),o[1],0,0,0), C1,12); \
    }while(0)
  int t=1;
  #undef CMASK
  #define CMASK(P0,P1,t) do{}while(0)
  for(;t+7<NT;t+=2){
    STEP(pB0,pB1,pA0,pA1,t,true,true,true);     WAIT_BAR(2); RESC(); ROT();
    STEP(pA0,pA1,pB0,pB1,t+1,true,true,true);   WAIT_BAR(2); RESC(); ROT();
  }
  #undef CMASK
  #define CMASK(P0,P1,t) do{int jb_=(t)-(NT-4); if(jb_>=-2)biasadd(P0,P1,lutl-64*jb_); if(jb_>=0)cmask(P0,P1,jb_,qrel,hi);}while(0)
  #define ENDW(tt) do{ if((tt)+3<NT){WAIT_BAR(2);} else if((tt)+2<NT){WAIT_BAR(1);} else {WAIT_BAR(0);} }while(0)
  for(;t+1<NT;t+=2){
    STEP(pB0,pB1,pA0,pA1,t,(t+3<NT),(t+1<NT),(t+1<NT));       ENDW(t);   RESC(); ROT();
    STEP(pA0,pA1,pB0,pB1,t+1,(t+4<NT),(t+2<NT),(t+2<NT));     ENDW(t+1); RESC(); ROT();
  }
  STEP(pB0,pB1,pA0,pA1,NT-1,false,false,false); RESC();
  { float sacc=pB0[0]+pB0[1]; _Pragma("unroll") for(int r=2;r<16;++r)sacc+=pB0[r]; _Pragma("unroll") for(int r=0;r<16;++r)sacc+=pB1[r]; l_reg+=sacc;
    pw0=(u32x4){PKW(pB0,0),PKW(pB0,2),PKW(pB0,4),PKW(pB0,6)};pw1=(u32x4){PKW(pB0,8),PKW(pB0,10),PKW(pB0,12),PKW(pB0,14)};pw2=(u32x4){PKW(pB1,0),PKW(pB1,2),PKW(pB1,4),PKW(pB1,6)};pw3=(u32x4){PKW(pB1,8),PKW(pB1,10),PKW(pB1,12),PKW(pB1,14)};
    SBAR(); pv(o,vb0+sl_cur,PAF(0),PAF(1),PAF(2),PAF(3)); }
  #undef PKW
  #undef PAF
  #undef VFR
  #undef PIN
  #undef MX3
  #undef GAPA
  #undef GAPB
  #undef EX
  #undef VRD
  #undef KRD
  #undef STEP
  #undef ENDW
  {auto rr=__builtin_amdgcn_permlane32_swap(__float_as_uint(l_reg),__float_as_uint(l_reg),false,false);l_reg=__uint_as_float(rr[0])+__uint_as_float(rr[1]);}
  if(hi==0)wsf[32+r32]=l_reg;asm volatile("s_waitcnt lgkmcnt(0)":::"memory");
  float rli[16];
  #pragma unroll
  for(int r=0;r<16;++r)rli[r]=__builtin_amdgcn_rcpf(wsf[32+crow(r,hi)]);
  bf16*Ow=Oh+(long)(q0+wid*QBLK)*OPITCH;
  { bf16*stg=(bf16*)(shm+LDS_OST)+wid*2048;
    #pragma unroll
    for(int r=0;r<16;++r){const int orow=crow(r,hi);
      #pragma unroll
      for(int d0=0;d0<2;++d0)stg[orow*64+d0*32+r32]=__float2bfloat16(o[d0][r]*rli[r]);}
    asm volatile("s_waitcnt lgkmcnt(0)":::"memory");
    #pragma unroll
    for(int i=0;i<4;++i){const int row=i*8+(lane>>3),ch=lane&7; const u32x4 v=*(const u32x4*)(stg+row*64+ch*8); ATTN_STORE16(Ow+(long)row*OPITCH+ch*8,v);} }
  asm volatile("s_waitcnt lgkmcnt(0)\n\ts_barrier":::"memory");
  #undef DMA_K
  #undef DMA_V
  #undef CMASK
  #undef START
  #undef RESC
  #undef ROT
}
constexpr int ATTN_LDS_BYTES=LDS_BYTES;
#undef SBAR
#undef WAIT_BAR
}
#define XB_TMO      128
#define XB_XCNT(j)  (256  + 64 * (j))
#define XB_XSUB(j)  (1280 + 64 * (j))
#define XB_XGEN(j)  (2304 + 64 * (j))
#define XB_TOP      3328
#define XB_TOPGEN   3392
#define XCD_BAR_WORDS 3456
#define XB_SPIN_CAP (1u << 18)

__device__ __forceinline__ unsigned xb_ld(unsigned* p)              { return __hip_atomic_load(p, __ATOMIC_RELAXED, __HIP_MEMORY_SCOPE_AGENT); }
__device__ __forceinline__ unsigned xb_add(unsigned* p, unsigned v) { return __hip_atomic_fetch_add(p, v, __ATOMIC_RELAXED, __HIP_MEMORY_SCOPE_AGENT); }
__device__ __forceinline__ unsigned xb_xcc_id() { return (unsigned)__builtin_amdgcn_s_getreg((3 << 11) | 20) & 0xFu; }
#define XB_SPIN(cond, bar) do { unsigned _sp = 0; while (cond) { __builtin_amdgcn_s_sleep(1); \
    if ((++_sp & 255u) == 0u) { if (xb_ld(&(bar)[XB_TMO])) break; if (_sp > XB_SPIN_CAP) { atomicAdd(&(bar)[XB_TMO], 1u); break; } } } } while (0)

struct XcdBarrier {
    unsigned* bar; unsigned x;
    volatile LAS unsigned* st;
};

__device__ __forceinline__ XcdBarrier xcd_barrier_post(unsigned* bar, volatile LAS unsigned* st) {
    XcdBarrier b; b.bar = bar; b.x = xb_xcc_id(); b.st = st;
    if (threadIdx.x == 0) (void)xb_add(&bar[XB_XCNT(b.x)], 1u);
    return b;
}
__device__ __forceinline__ void xcd_barrier_complete(unsigned* bar, unsigned x, unsigned& nloc, unsigned& nx) {
    const unsigned G = gridDim.x * gridDim.y * gridDim.z;
    unsigned sum, cnt, mine, sp = 0u;
    for (;;) {
        sum = 0u; cnt = 0u; mine = 0u;
#pragma unroll
        for (unsigned j = 0; j < 16; ++j) { const unsigned c = xb_ld(&bar[XB_XCNT(j)]); sum += c; cnt += (c > 0u) ? 1u : 0u; mine = (j == x) ? c : mine; }
        if (sum == G) break;
        __builtin_amdgcn_s_sleep(1);
        if ((++sp & 255u) == 0u) { if (xb_ld(&bar[XB_TMO])) break; if (sp > XB_SPIN_CAP) { atomicAdd(&bar[XB_TMO], 1u); break; } }
    }
    nloc = mine > 0u ? mine : 1u; nx = cnt > 0u ? cnt : 1u;
}

__device__ __forceinline__ void xcd_barrier(const XcdBarrier& b) {
    asm volatile("s_waitcnt vmcnt(0)" ::: "memory");
    __syncthreads();
    if (threadIdx.x == 0) {
        unsigned* bar = b.bar;
        __builtin_amdgcn_s_waitcnt(0);
        unsigned nloc = b.st[0], nx = b.st[1];
        if (nloc == 0u) { xcd_barrier_complete(bar, b.x, nloc, nx); b.st[0] = nloc; b.st[1] = nx; }
        const unsigned old = xb_add(&bar[XB_XSUB(b.x)], 1u);
        const unsigned gen = old / nloc;
        if (old + 1u == (gen + 1u) * nloc) {
            __builtin_amdgcn_fence(__ATOMIC_RELEASE, "agent");
            asm volatile("s_waitcnt vmcnt(0)" ::: "memory");
            const unsigned og = xb_add(&bar[XB_TOP], 1u);
            const unsigned tg = og / nx;
            if (og + 1u == (tg + 1u) * nx) xb_add(&bar[XB_TOPGEN], 1u);
            else XB_SPIN(xb_ld(&bar[XB_TOPGEN]) == tg, bar);
            __builtin_amdgcn_fence(__ATOMIC_ACQUIRE, "agent");
            xb_add(&bar[XB_XGEN(b.x)], 1u);
            asm volatile("s_waitcnt vmcnt(0)" ::: "memory");
        } else {
            XB_SPIN(xb_ld(&bar[XB_XGEN(b.x)]) == gen, bar);
            __builtin_amdgcn_fence(__ATOMIC_ACQUIRE, "agent");
            asm volatile("s_waitcnt vmcnt(0)" ::: "memory");
        }
    }
    __syncthreads();
}
struct Args { const float* in[27]; float* out; unsigned char* ws; int ph_lo, ph_hi, li, pad; };
enum { I_X = 0, I_MEM, I_REL, I_ANORM, I_WIN, I_BGATE, I_CONV, I_ALOG, I_DTB, I_DNON, I_DAQN, I_DAKN, I_LAM, I_SUBLN, I_MEMNORM, I_WMKV, I_MXQN, I_MXKN, I_WBR, I_WOUT, I_FNORM,
       I_WR, I_BR, I_WGU, I_BGU, I_WD, I_BD };

DI void tr_item(const float* __restrict__ W, size_t ldw, int k0, int c0, bf16* WT, int K, size_t drow0, LAS float* scr, int lane) {
#pragma unroll 8
    for (int k = 0; k < 64; ++k) scr[k * 65 + lane] = W[(size_t)(k0 + k) * ldw + c0 + lane];
    LDS_WAIT();
    const int c = lane & 7;
#pragma unroll
    for (int j = 0; j < 8; ++j) { const int n = (lane >> 3) + 8 * j; const LAS float* s = scr + (8 * c) * 65 + n;
        v4u o; o.x = pk2(s[0 * 65], s[1 * 65]); o.y = pk2(s[2 * 65], s[3 * 65]); o.z = pk2(s[4 * 65], s[5 * 65]); o.w = pk2(s[6 * 65], s[7 * 65]);
        *(v4u*)(WT + (drow0 + n) * K + k0 + 8 * c) = o; }
    LDS_WAIT();
}

DI void p0_prologue(const Args& a, LAS unsigned char* lds, int vcu, int G, int wave, int lane) {
    unsigned char* ws = a.ws;
    LAS float* scr = (LAS float*)(lds + wave * 16640);
    const int gw = vcu * 8 + wave, NGW = G * 8;
    constexpr int I_IN = 16 * 112, I_GU = 16 * 32 * NEXP, I_DN = 16 * 16 * NEXP, I_BRI = 3 * 8 * 16, I_OUT = 16 * 16, I_MK = 16 * 16;
    constexpr int NITEMS = I_IN + I_GU + I_DN + I_BRI + I_OUT + I_MK;
    for (int it = gw; it < NITEMS; it += NGW) {
        int r = it;
        if (r < I_GU) { const int e = r / 512, q = r % 512, kb = q / 32, nb = q % 32; const int n0 = nb * 64, pn = n0 >> 8, bj = (n0 >> 7) & 1, i0 = n0 & 127;
            tr_item(a.in[I_WGU] + (size_t)e * 1024 * 2048, 2048, kb * 64, bj * 1024 + 128 * pn + i0, (bf16*)(ws + WS_WGU), 1024, (size_t)e * 2048 + n0, scr, lane); continue; } r -= I_GU;
        if (r < I_DN) { const int e = r / 256, q = r % 256, kb = q / 16, nb = q % 16;
            tr_item(a.in[I_WD] + (size_t)e * 1024 * 1024, 1024, kb * 64, nb * 64, (bf16*)(ws + WS_WD), 1024, (size_t)e * 1024 + nb * 64, scr, lane); continue; } r -= I_DN;
        if (r < I_IN) { const int kb = r / 112, nb = r % 112; const int n0 = nb * 64;
            tr_item(a.in[I_WIN], INW, kb * 64, n0 < 2048 ? n0 : n0 + 8, (bf16*)(ws + WS_WIN), 1024, (size_t)n0, scr, lane); continue; } r -= I_IN;
        if (r < I_BRI) { const int br = r / 128, q = r % 128, kb = q / 16, nb = q % 16;
            tr_item(a.in[I_WBR] + (size_t)br * 512 * 1024, 1024, kb * 64, nb * 64, (bf16*)(ws + WS_WB), 512, (size_t)br * 1024 + nb * 64, scr, lane); continue; } r -= I_BRI;
        if (r < I_OUT) { const int kb = r / 16, nb = r % 16;
            tr_item(a.in[I_WOUT], 1024, kb * 64, nb * 64, (bf16*)(ws + WS_WOUT), 1024, (size_t)nb * 64, scr, lane); continue; } r -= I_OUT;
        { const int kb = r / 16, nb = r % 16;
            tr_item(a.in[I_WMKV], 1024, kb * 64, nb * 64, (bf16*)(ws + WS_WMKV), 1024, (size_t)nb * 64, scr, lane); }
    }
    {
        const float* win = a.in[I_WIN];
        f32x4 gv[4];
#pragma unroll
        for (int j = 0; j < 4; ++j) gv[j] = ((const f32x4*)a.in[I_ANORM])[lane + 64 * j];
        f32x4 wa[4][4], wb[4][4];
#pragma unroll
        for (int j = 0; j < 4; ++j)
#pragma unroll
            for (int c = 0; c < 4; ++c) { const f32x4* p = (const f32x4*)(win + (size_t)(4 * lane + 256 * j + c) * INW + 2048); wa[j][c] = p[0]; wb[j][c] = p[1]; }
        const float alog = a.in[I_ALOG][lane & 3], dtb = a.in[I_DTB][lane & 3];
        float* G_ = (float*)(ws + WS_G); float* B_ = (float*)(ws + WS_BETA);
        bf16* H = (bf16*)(ws + WS_H);
        for (int m = gw; m < T; m += NGW) {
            const f32x4* xr = (const f32x4*)(a.in[I_X] + (size_t)m * D) + lane;
            f32x4 v[4]; float ss = 0.f;
#pragma unroll
            for (int j = 0; j < 4; ++j) { v[j] = xr[64 * j]; ss += (v[j].x * v[j].x + v[j].y * v[j].y) + (v[j].z * v[j].z + v[j].w * v[j].w); }
            const float rstd = rsqrtf(wave_sum(ss) * (1.f / D) + EPS);
            f32x4 pa = {0.f, 0.f, 0.f, 0.f}, pb = {0.f, 0.f, 0.f, 0.f};
            unsigned long long* o8 = (unsigned long long*)(H + (size_t)m * D) + lane;
#pragma unroll
            for (int j = 0; j < 4; ++j) { v[j] = v[j] * rstd * gv[j];
                o8[64 * j] = (unsigned long long)pk2(v[j].x, v[j].y) | ((unsigned long long)pk2(v[j].z, v[j].w) << 32);
                pa += wa[j][0] * v[j].x + wa[j][1] * v[j].y + wa[j][2] * v[j].z + wa[j][3] * v[j].w;
                pb += wb[j][0] * v[j].x + wb[j][1] * v[j].y + wb[j][2] * v[j].z + wb[j][3] * v[j].w; }
            pa.x = wave_sum(pa.x); pa.y = wave_sum(pa.y); pa.z = wave_sum(pa.z); pa.w = wave_sum(pa.w);
            pb.x = wave_sum(pb.x); pb.y = wave_sum(pb.y); pb.z = wave_sum(pb.z); pb.w = wave_sum(pb.w);
            if (lane < 4) {
                const float av = lane == 0 ? pa.x : lane == 1 ? pa.y : lane == 2 ? pa.z : pa.w;
                const float bv = lane == 0 ? pb.x : lane == 1 ? pb.y : lane == 2 ? pb.z : pb.w;
                const float z = av + dtb; const float sp = z > 20.f ? z : log1pf(expf(z));
                G_[(size_t)m * 4 + lane] = -expf(alog) * sp;
                B_[(size_t)m * 4 + lane] = 1.f / (1.f + expf(-bv));
            }
        }
    }
    {
        f32x4 gv[4];
#pragma unroll
        for (int j = 0; j < 4; ++j) gv[j] = ((const f32x4*)a.in[I_MEMNORM])[lane + 64 * j];
        bf16* MN = (bf16*)(ws + WS_MEMN);
        for (int m = gw; m < BATCH * NMEM; m += NGW) {
            const f32x4* xr = (const f32x4*)(a.in[I_MEM] + (size_t)m * D) + lane;
            f32x4 v[4]; float ss = 0.f;
#pragma unroll
            for (int j = 0; j < 4; ++j) { v[j] = xr[64 * j]; ss += (v[j].x * v[j].x + v[j].y * v[j].y) + (v[j].z * v[j].z + v[j].w * v[j].w); }
            const float rstd = rsqrtf(wave_sum(ss) * (1.f / D) + EPS);
            unsigned long long* o8 = (unsigned long long*)(MN + (size_t)m * D) + lane;
#pragma unroll
            for (int j = 0; j < 4; ++j) { v[j] = v[j] * rstd * gv[j]; o8[64 * j] = (unsigned long long)pk2(v[j].x, v[j].y) | ((unsigned long long)pk2(v[j].z, v[j].w) << 32); }
        }
    }
}

struct EpiP {
    static constexpr bool PERM = true;
    bf16* O; const float* b_gate;
    DI void operator()(const f32x4 (&acc)[2][2][4][2], const pg8::Unit& u, int wr, int wc, int fr, int fq) const {
        const int row0 = u.pm * 256 + wr * 64 + fr, col0 = u.pn * 256 + wc * 32 + 8 * fq;
        const bool isg = u.pn >= 16;
        f32x4 bv[2][2];
#pragma unroll
        for (int bj = 0; bj < 2; ++bj)
#pragma unroll
            for (int n = 0; n < 2; ++n) bv[bj][n] = isg ? *(const f32x4*)(b_gate + (col0 - P_GATE) + bj * 128 + 4 * n) : (f32x4){0.f, 0.f, 0.f, 0.f};
#pragma unroll
        for (int ai = 0; ai < 2; ++ai)
#pragma unroll
            for (int m = 0; m < 4; ++m) { bf16* rowp = O + (size_t)(row0 + ai * 128 + m * 16) * PW + col0;
#pragma unroll
                for (int bj = 0; bj < 2; ++bj) { f32x4 v0 = acc[ai][bj][m][0] + bv[bj][0], v1 = acc[ai][bj][m][1] + bv[bj][1];
                    if (isg) { v0.x = sigmoidf_(v0.x); v0.y = sigmoidf_(v0.y); v0.z = sigmoidf_(v0.z); v0.w = sigmoidf_(v0.w);
                               v1.x = sigmoidf_(v1.x); v1.y = sigmoidf_(v1.y); v1.z = sigmoidf_(v1.z); v1.w = sigmoidf_(v1.w); }
                    v4u w; w.x = pk2(v0.x, v0.y); w.y = pk2(v0.z, v0.w); w.z = pk2(v1.x, v1.y); w.w = pk2(v1.z, v1.w);
                    *(v4u*)(rowp + bj * 128) = w; } }
    }
};
struct EpiPlain {
    static constexpr bool PERM = true;
    bf16* O; int ldc;
    DI void operator()(const f32x4 (&acc)[2][2][4][2], const pg8::Unit& u, int wr, int wc, int fr, int fq) const {
        const int row0 = u.pm * 256 + wr * 64 + fr, col0 = u.pn * 256 + wc * 32 + 8 * fq;
#pragma unroll
        for (int ai = 0; ai < 2; ++ai)
#pragma unroll
            for (int m = 0; m < 4; ++m) { bf16* rowp = O + (size_t)(row0 + ai * 128 + m * 16) * ldc + col0;
#pragma unroll
                for (int bj = 0; bj < 2; ++bj) { const f32x4 v0 = acc[ai][bj][m][0], v1 = acc[ai][bj][m][1];
                    v4u w; w.x = pk2(v0.x, v0.y); w.y = pk2(v0.z, v0.w); w.z = pk2(v1.x, v1.y); w.w = pk2(v1.z, v1.w);
                    *(v4u*)(rowp + bj * 128) = w; } }
    }
};

DI void p2_norm_rows(const Args& a, int vcu, int G, int wave, int lane) {
    unsigned char* ws = a.ws; bf16* P = (bf16*)(ws + WS_P);
    const int gw = vcu * 8 + wave, NGW = G * 8;
    float gda[16], gmx[8], gmk[8];
    { const float* gsrc = (lane < 32 ? a.in[I_DAQN] : a.in[I_DAKN]) + 16 * (lane & 3);
#pragma unroll
      for (int i = 0; i < 16; ++i) gda[i] = gsrc[i];
#pragma unroll
      for (int i = 0; i < 8; ++i) { gmx[i] = a.in[I_MXQN][8 * (lane & 15) + i]; gmk[i] = a.in[I_MXKN][8 * (lane & 15) + i]; } }
    const float sc_da = lane < 32 ? 0.125f * LOG2E : 1.f;
    const float sc_mx = 0.08838834764831845f * LOG2E;
    for (int m = gw; m < T; m += NGW) {
        { v4u* p = (v4u*)(P + (size_t)m * PW + P_DAQ + 16 * lane); v4u w0 = p[0], w1 = p[1];
          float f[16]; f[0] = bflo(w0.x); f[1] = bfhi(w0.x); f[2] = bflo(w0.y); f[3] = bfhi(w0.y); f[4] = bflo(w0.z); f[5] = bfhi(w0.z); f[6] = bflo(w0.w); f[7] = bfhi(w0.w);
          f[8] = bflo(w1.x); f[9] = bfhi(w1.x); f[10] = bflo(w1.y); f[11] = bfhi(w1.y); f[12] = bflo(w1.z); f[13] = bfhi(w1.z); f[14] = bflo(w1.w); f[15] = bfhi(w1.w);
          float ss = 0.f;
#pragma unroll
          for (int i = 0; i < 16; ++i) ss += f[i] * f[i];
          ss += __shfl_xor(ss, 1); ss += __shfl_xor(ss, 2);
          const float r = rsqrtf(ss * (1.f / 64.f) + EPS) * sc_da;
#pragma unroll
          for (int i = 0; i < 16; ++i) f[i] = f[i] * r * gda[i];
          w0.x = pk2(f[0], f[1]); w0.y = pk2(f[2], f[3]); w0.z = pk2(f[4], f[5]); w0.w = pk2(f[6], f[7]);
          w1.x = pk2(f[8], f[9]); w1.y = pk2(f[10], f[11]); w1.z = pk2(f[12], f[13]); w1.w = pk2(f[14], f[15]);
          p[0] = w0; p[1] = w1; }
        { v4u* p = (v4u*)(P + (size_t)m * PW + P_MXQ + 8 * lane); v4u w0 = p[0];
          float f[8]; f[0] = bflo(w0.x); f[1] = bfhi(w0.x); f[2] = bflo(w0.y); f[3] = bfhi(w0.y); f[4] = bflo(w0.z); f[5] = bfhi(w0.z); f[6] = bflo(w0.w); f[7] = bfhi(w0.w);
          float ss = 0.f;
#pragma unroll
          for (int i = 0; i < 8; ++i) ss += f[i] * f[i];
          ss += __shfl_xor(ss, 1); ss += __shfl_xor(ss, 2); ss += __shfl_xor(ss, 4); ss += __shfl_xor(ss, 8);
          const float r = rsqrtf(ss * (1.f / 128.f) + EPS) * sc_mx;
#pragma unroll
          for (int i = 0; i < 8; ++i) f[i] = f[i] * r * gmx[i];
          w0.x = pk2(f[0], f[1]); w0.y = pk2(f[2], f[3]); w0.z = pk2(f[4], f[5]); w0.w = pk2(f[6], f[7]);
          p[0] = w0; }
    }
    bf16* MKV = (bf16*)(ws + WS_MKV);
    for (int m = gw; m < BATCH * NMEM; m += NGW) {
        v4u* p = (v4u*)(MKV + (size_t)m * 1024 + 8 * lane); v4u w0 = p[0];
        float f[8]; f[0] = bflo(w0.x); f[1] = bfhi(w0.x); f[2] = bflo(w0.y); f[3] = bfhi(w0.y); f[4] = bflo(w0.z); f[5] = bfhi(w0.z); f[6] = bflo(w0.w); f[7] = bfhi(w0.w);
        float ss = 0.f;
#pragma unroll
        for (int i = 0; i < 8; ++i) ss += f[i] * f[i];
        ss += __shfl_xor(ss, 1); ss += __shfl_xor(ss, 2); ss += __shfl_xor(ss, 4); ss += __shfl_xor(ss, 8);
        const float r = rsqrtf(ss * (1.f / 128.f) + EPS);
#pragma unroll
        for (int i = 0; i < 8; ++i) f[i] = f[i] * r * gmk[i];
        w0.x = pk2(f[0], f[1]); w0.y = pk2(f[2], f[3]); w0.z = pk2(f[4], f[5]); w0.w = pk2(f[6], f[7]);
        p[0] = w0;
    }
}

constexpr int PREP_GC = 0, PREP_BETA = 256, PREP_QS = 1024, PREP_KS = PREP_QS + 64 * 272, PREP_LM = PREP_KS + 64 * 272, PREP_RHS = PREP_LM + 64 * 64 * 4, PREP_END = PREP_RHS + 64 * 256 * 4;
static_assert(PREP_END <= RING_BYTES, "prep LDS");
DI void dn_prep_unit(const Args& a, LAS unsigned char* lds, int ck, int tid_in, int wave, int lane_in) {
    const int tid = fresh_tid(), lane = tid & 63; (void)tid_in; (void)lane_in;
    unsigned char* ws = a.ws; const bf16* P = (const bf16*)(ws + WS_P);
    const int n = ck & 127, h = (ck >> 7) & 3, b = ck >> 9;
    const size_t t0 = (size_t)b * SEQ + (size_t)n * 64;
    LAS float* gc = (LAS float*)(lds + PREP_GC); LAS float* bet = (LAS float*)(lds + PREP_BETA);
    LAS float* Lm = (LAS float*)(lds + PREP_LM); LAS float* RHS = (LAS float*)(lds + PREP_RHS);
    if (wave == 0) {
        float v = ((const float*)(ws + WS_G))[(t0 + lane) * 4 + h];
#pragma unroll
        for (int o = 1; o < 64; o <<= 1) { const float u = __shfl_up(v, o); if (lane >= o) v += u; }
        gc[lane] = v; bet[lane] = ((const float*)(ws + WS_BETA))[(t0 + lane) * 4 + h];
    }
    __syncthreads();
    if (wave < 6) {
        const int part = wave >> 1, rg = (tid >> 4) & 7, cg = tid & 15, i0 = rg * 8;
        const int ch0 = part * 512 + h * 128 + cg * 8;
        float w[4][8];
#pragma unroll
        for (int j = 0; j < 4; ++j) { const f32x4* p = (const f32x4*)(a.in[I_CONV] + j * 1536 + ch0); const f32x4 w0 = p[0], w1 = p[1];
            w[j][0] = w0.x; w[j][1] = w0.y; w[j][2] = w0.z; w[j][3] = w0.w; w[j][4] = w1.x; w[j][5] = w1.y; w[j][6] = w1.z; w[j][7] = w1.w; }
        v4u xin[11];
        const bf16* xp = P + ((long)b * SEQ + n * 64 + i0 - 3) * PW + ch0;
        asm volatile("" : "+v"(xp));
#pragma unroll
        for (int jj = 0; jj < 11; ++jj) { const int s = n * 64 + i0 - 3 + jj;
            xin[jj] = (s >= 0) ? *(const GAS v4u*)(xp + (long)jj * PW) : (v4u){0u, 0u, 0u, 0u}; }
        float o[8][8];
#pragma unroll
        for (int ri = 0; ri < 8; ++ri) {
            float acc[8];
#pragma unroll
            for (int c = 0; c < 8; ++c) acc[c] = 0.f;
#pragma unroll
            for (int j = 0; j < 4; ++j) { const v4u x = xin[ri + j];
                acc[0] += w[j][0] * bflo(x.x); acc[1] += w[j][1] * bfhi(x.x); acc[2] += w[j][2] * bflo(x.y); acc[3] += w[j][3] * bfhi(x.y);
                acc[4] += w[j][4] * bflo(x.z); acc[5] += w[j][5] * bfhi(x.z); acc[6] += w[j][6] * bflo(x.w); acc[7] += w[j][7] * bfhi(x.w); }
            float ss = 0.f;
#pragma unroll
            for (int c = 0; c < 8; ++c) { const float s_ = acc[c] * sigmoidf_(acc[c]); o[ri][c] = s_; ss += s_ * s_; }
            ss += __shfl_xor(ss, 1); ss += __shfl_xor(ss, 2); ss += __shfl_xor(ss, 4); ss += __shfl_xor(ss, 8);
            const float nrm = part == 0 ? rsqrtf(ss + EPS) * 0.08838834764831845f : part == 1 ? rsqrtf(ss + EPS) : 1.f;
#pragma unroll
            for (int c = 0; c < 8; ++c) o[ri][c] *= nrm;
        }
        bf16* qdp = (bf16*)(ws + WS_QD) + (t0 + i0) * 512 + h * 128 + cg * 8;
        asm volatile("" : "+v"(qdp));
#pragma unroll
        for (int ri = 0; ri < 8; ++ri) {
            const int row = i0 + ri; const float g_ = gc[row], be = bet[row];
            if (part == 0) {
                v4u wq; wq.x = pk2(o[ri][0], o[ri][1]); wq.y = pk2(o[ri][2], o[ri][3]); wq.z = pk2(o[ri][4], o[ri][5]); wq.w = pk2(o[ri][6], o[ri][7]);
                *(LAS v4u*)(lds + PREP_QS + row * 272 + cg * 16) = wq;
                const float eg = fast_exp(g_);
                v4u wd; wd.x = pk2(o[ri][0] * eg, o[ri][1] * eg); wd.y = pk2(o[ri][2] * eg, o[ri][3] * eg); wd.z = pk2(o[ri][4] * eg, o[ri][5] * eg); wd.w = pk2(o[ri][6] * eg, o[ri][7] * eg);
                *(GAS v4u*)(qdp + ri * 512) = wd;
            } else if (part == 1) {
                v4u wq; wq.x = pk2(o[ri][0], o[ri][1]); wq.y = pk2(o[ri][2], o[ri][3]); wq.z = pk2(o[ri][4], o[ri][5]); wq.w = pk2(o[ri][6], o[ri][7]);
                *(LAS v4u*)(lds + PREP_KS + row * 272 + cg * 16) = wq;
                const float f = be * fast_exp(g_);
                LAS f32x4* r4 = (LAS f32x4*)(RHS + row * 256 + 128 + cg * 8);
                r4[0] = (f32x4){o[ri][0] * f, o[ri][1] * f, o[ri][2] * f, o[ri][3] * f}; r4[1] = (f32x4){o[ri][4] * f, o[ri][5] * f, o[ri][6] * f, o[ri][7] * f};
            } else {
                LAS f32x4* r4 = (LAS f32x4*)(RHS + row * 256 + cg * 8);
                r4[0] = (f32x4){o[ri][0] * be, o[ri][1] * be, o[ri][2] * be, o[ri][3] * be}; r4[1] = (f32x4){o[ri][4] * be, o[ri][5] * be, o[ri][6] * be, o[ri][7] * be};
            }
        }
    }
    __syncthreads();
    {
        const int sel = wave >> 2, it = (wave >> 1) & 1, jt = wave & 1, r = lane & 31, hh = lane >> 5;
        const LAS unsigned char* Ab = lds + (sel ? PREP_QS : PREP_KS) + (32 * it + r) * 272 + hh * 16;
        const LAS unsigned char* Bb = lds + PREP_KS + (32 * jt + r) * 272 + hh * 16;
        f32x16 acc = {};
#pragma unroll
        for (int s = 0; s < 8; ++s) { const bf16x8 av = *(const LAS bf16x8*)(Ab + s * 32), bv = *(const LAS bf16x8*)(Bb + s * 32);
            acc = __builtin_amdgcn_mfma_f32_32x32x16_bf16(av, bv, acc, 0, 0, 0); }
        const int col = 32 * jt + r; const float gcol = gc[col];
        bf16* QKB = (bf16*)(ws + WS_QK) + (size_t)ck * 4096;
#pragma unroll
        for (int i = 0; i < 16; ++i) { const int row = 32 * it + crow(i, hh);
            const float dec = fast_exp(col <= row ? gc[row] - gcol : 0.f);
            if (sel == 0) Lm[row * 64 + col] = (col < row) ? acc[i] * dec * bet[row] : 0.f;
            else QKB[row * 64 + col] = (bf16)f2bf((col <= row) ? acc[i] * dec : 0.f); }
    }
    __syncthreads();
    if (wave < 4) {
        const int c = tid;
        for (int i = 1; i < 64; ++i) {
            float acc = RHS[i * 256 + c];
            const int nj = (i + 3) >> 2;
            for (int jq = 0; jq < nj; ++jq) { const f32x4 l4 = *(const LAS f32x4*)(Lm + i * 64 + 4 * jq);
                acc -= l4.x * RHS[(4 * jq) * 256 + c]; acc -= l4.y * RHS[(4 * jq + 1) * 256 + c]; acc -= l4.z * RHS[(4 * jq + 2) * 256 + c]; acc -= l4.w * RHS[(4 * jq + 3) * 256 + c]; }
            RHS[i * 256 + c] = acc;
        }
    } else {
        const int q = tid - 256, kd = q & 127, half = q >> 7;
        const float gl = gc[63];
        bf16* KDT = (bf16*)(ws + WS_KDT) + (size_t)ck * 8192 + kd * 64 + half * 32;
#pragma unroll
        for (int c8 = 0; c8 < 4; ++c8) { float f[8];
#pragma unroll
            for (int j = 0; j < 8; ++j) { const int c = 32 * half + 8 * c8 + j; f[j] = bf2f(*(const LAS bf16*)(lds + PREP_KS + c * 272 + kd * 2)) * fast_exp(gl - gc[c]); }
            v4u w; w.x = pk2(f[0], f[1]); w.y = pk2(f[2], f[3]); w.z = pk2(f[4], f[5]); w.w = pk2(f[6], f[7]);
            *(v4u*)(KDT + 8 * c8) = w; }
        if (q == 0) ((float*)(ws + WS_EGL))[ck] = fast_exp(gl);
    }
    __syncthreads();
    {
        const int row = tid >> 3, seg = tid & 7;
        const LAS f32x4* s4 = (const LAS f32x4*)(RHS + row * 256 + seg * 32);
        const float sg = seg < 4 ? 1.f : -1.f;
        bf16* dst = (bf16*)(ws + (seg < 4 ? WS_U : WS_NW)) + (t0 + row) * 512 + h * 128 + (seg & 3) * 32;
#pragma unroll
        for (int q = 0; q < 4; ++q) { const f32x4 x0 = s4[2 * q] * sg, x1 = s4[2 * q + 1] * sg;
            v4u w; w.x = pk2(x0.x, x0.y); w.y = pk2(x0.z, x0.w); w.z = pk2(x1.x, x1.y); w.w = pk2(x1.z, x1.w);
            *(v4u*)(dst + 8 * q) = w; }
    }
    __syncthreads();
}

constexpr int SCAN_ST = 0, SCAN_VN = 2 * 32 * 272, SCAN_END = SCAN_VN + 2 * 32 * 144;
DI void dn_scan(const Args& a, LAS unsigned char* lds, int j, int wave, int lane) {
    unsigned char* ws = a.ws;
    const int grp = wave >> 2, w4 = wave & 3, task = 2 * j + grp, bh = task >> 2, vs = task & 3, b = bh >> 2, h = bh & 3;
    const int r = lane & 31, hh = lane >> 5;
    LAS unsigned char* ST = lds + SCAN_ST + grp * (32 * 272); LAS unsigned char* VN = lds + SCAN_VN + grp * (32 * 144);
    const bf16* NW = (const bf16*)(ws + WS_NW); const bf16* QD = (const bf16*)(ws + WS_QD); const bf16* U = (const bf16*)(ws + WS_U);
    const bf16* KDT = (const bf16*)(ws + WS_KDT); const bf16* QKB = (const bf16*)(ws + WS_QK); const float* EGL = (const float*)(ws + WS_EGL);
    bf16* ODN = (bf16*)(ws + WS_ODN);
    bf16x8 bI[2];
#pragma unroll
    for (int s = 0; s < 2; ++s)
#pragma unroll
        for (int jj = 0; jj < 8; ++jj) bI[s][jj] = (16 * s + 8 * hh + jj == r) ? (short)0x3F80 : (short)0;
    f32x16 sacc = {};
    const int ct = w4 & 1;
    for (int n = 0; n < SEQ / 64; ++n) {
        const int ck = bh * 128 + n; const size_t t0 = (size_t)b * SEQ + (size_t)n * 64;
#pragma unroll
        for (int g = 0; g < 4; ++g) { v2u w; w.x = pk2(sacc[4 * g], sacc[4 * g + 1]); w.y = pk2(sacc[4 * g + 2], sacc[4 * g + 3]);
            *(LAS v2u*)(ST + r * 272 + (32 * w4 + 8 * g + 4 * hh) * 2) = w; }
        __syncthreads();
        f32x16 acc = {};
        const size_t arow = (t0 + 32 * ct + r) * 512 + h * 128;
        if (w4 < 2) {
#pragma unroll
            for (int s = 0; s < 2; ++s) { const bf16x8 av = *(const bf16x8*)(U + arow + vs * 32 + 16 * s + 8 * hh); acc = __builtin_amdgcn_mfma_f32_32x32x16_bf16(av, bI[s], acc, 0, 0, 0); }
#pragma unroll
            for (int s = 0; s < 8; ++s) { const bf16x8 av = *(const bf16x8*)(NW + arow + 16 * s + 8 * hh); const bf16x8 bv = *(const LAS bf16x8*)(ST + r * 272 + (16 * s + 8 * hh) * 2);
                acc = __builtin_amdgcn_mfma_f32_32x32x16_bf16(av, bv, acc, 0, 0, 0); }
#pragma unroll
            for (int g = 0; g < 4; ++g) { v2u w; w.x = pk2(acc[4 * g], acc[4 * g + 1]); w.y = pk2(acc[4 * g + 2], acc[4 * g + 3]);
                *(LAS v2u*)(VN + r * 144 + (32 * ct + 8 * g + 4 * hh) * 2) = w; }
        } else {
#pragma unroll
            for (int s = 0; s < 8; ++s) { const bf16x8 av = *(const bf16x8*)(QD + arow + 16 * s + 8 * hh); const bf16x8 bv = *(const LAS bf16x8*)(ST + r * 272 + (16 * s + 8 * hh) * 2);
                acc = __builtin_amdgcn_mfma_f32_32x32x16_bf16(av, bv, acc, 0, 0, 0); }
        }
        __syncthreads();
        if (w4 >= 2) {
#pragma unroll
            for (int s = 0; s < 4; ++s) { const bf16x8 av = *(const bf16x8*)(QKB + ((size_t)ck * 64 + 32 * ct + r) * 64 + 16 * s + 8 * hh); const bf16x8 bv = *(const LAS bf16x8*)(VN + r * 144 + (16 * s + 8 * hh) * 2);
                acc = __builtin_amdgcn_mfma_f32_32x32x16_bf16(av, bv, acc, 0, 0, 0); }
#pragma unroll
            for (int i = 0; i < 16; ++i) ODN[(t0 + 32 * ct + crow(i, hh)) * 512 + h * 128 + vs * 32 + r] = (bf16)f2bf(acc[i]);
        }
        const float egl = EGL[ck];
#pragma unroll
        for (int i = 0; i < 16; ++i) sacc[i] *= egl;
#pragma unroll
        for (int s = 0; s < 4; ++s) { const bf16x8 av = *(const bf16x8*)(KDT + ((size_t)ck * 128 + 32 * w4 + r) * 64 + 16 * s + 8 * hh); const bf16x8 bv = *(const LAS bf16x8*)(VN + r * 144 + (16 * s + 8 * hh) * 2);
            sacc = __builtin_amdgcn_mfma_f32_32x32x16_bf16(av, bv, sacc, 0, 0, 0); }
    }
    __syncthreads();
}
constexpr int MX_K = 0, MX_V = 65536;
DI void mx_unit(const Args& a, LAS unsigned char* lds, int bh, int qb, int tid, int wave, int lane) {
    unsigned char* ws = a.ws; const int b = bh >> 2, h = bh & 3;
    const bf16* MKV = (const bf16*)(ws + WS_MKV) + (size_t)b * NMEM * 1024 + h * 128;
#pragma unroll
    for (int i = 0; i < 8; ++i) { const int q = tid + 512 * i, row = q >> 4, ch = q & 15;
        const v4u kv = *(const v4u*)(MKV + (size_t)row * 1024 + ch * 8), vv = *(const v4u*)(MKV + (size_t)row * 1024 + 512 + ch * 8);
        *(LAS v4u*)(lds + MX_K + row * 256 + ((ch ^ (row & 7)) * 16)) = kv; *(LAS v4u*)(lds + MX_V + row * 256 + ch * 16) = vv; }
    const int r = lane & 31, hh = lane >> 5;
    const size_t qrow = (size_t)b * SEQ + (size_t)qb * 256 + wave * 32;
    const bf16* Q = (const bf16*)(ws + WS_P) + (qrow + r) * PW + P_MXQ + h * 128;
    bf16x8 qf[8];
#pragma unroll
    for (int s = 0; s < 8; ++s) qf[s] = *(const bf16x8*)(Q + 16 * s + 8 * hh);
    __syncthreads();
    float mx = -INFINITY;
#pragma unroll 1
    for (int kt = 0; kt < 8; ++kt) { f32x16 acc = {}; const int row = 32 * kt + r;
#pragma unroll
        for (int s = 0; s < 8; ++s) { const bf16x8 kf = *(const LAS bf16x8*)(lds + MX_K + row * 256 + (((2 * s + hh) ^ (row & 7)) * 16));
            acc = __builtin_amdgcn_mfma_f32_32x32x16_bf16(kf, qf[s], acc, 0, 0, 0); }
#pragma unroll
        for (int i = 0; i < 16; ++i) mx = fmaxf(mx, acc[i]); }
    mx = fmaxf(mx, __shfl_xor(mx, 32));
    float sum = 0.f;
    f32x16 o[4] = {};
    const int g16 = lane >> 4, i16 = lane & 15, qq = i16 >> 2, pp = i16 & 3;
    const LAS unsigned char* vb = lds + MX_V + (4 * hh + qq) * 256 + (16 * (g16 & 1) + 4 * pp) * 2;
#pragma unroll 1
    for (int kt = 0; kt < 8; ++kt) { f32x16 st = {}; const int row = 32 * kt + r;
#pragma unroll
        for (int s = 0; s < 8; ++s) { const bf16x8 kf = *(const LAS bf16x8*)(lds + MX_K + row * 256 + (((2 * s + hh) ^ (row & 7)) * 16));
            st = __builtin_amdgcn_mfma_f32_32x32x16_bf16(kf, qf[s], st, 0, 0, 0); }
#pragma unroll
        for (int i = 0; i < 16; ++i) { const float p = __builtin_amdgcn_exp2f(st[i] - mx); st[i] = p; sum += p; }
#pragma unroll
        for (int s2 = 0; s2 < 2; ++s2) {
            v4u pw; pw.x = pk2(st[8 * s2 + 0], st[8 * s2 + 1]); pw.y = pk2(st[8 * s2 + 2], st[8 * s2 + 3]); pw.z = pk2(st[8 * s2 + 4], st[8 * s2 + 5]); pw.w = pk2(st[8 * s2 + 6], st[8 * s2 + 7]);
            const bf16x8 pa = __builtin_bit_cast(bf16x8, pw);
#pragma unroll
            for (int dt = 0; dt < 4; ++dt) {
                const LAS unsigned char* vp = vb + (32 * kt + 16 * s2) * 256 + dt * 64;
                const s16x4 lo = __builtin_bit_cast(s16x4, __builtin_amdgcn_ds_read_tr16_b64_v4i16((LAS s16x4*)vp));
                const s16x4 hi = __builtin_bit_cast(s16x4, __builtin_amdgcn_ds_read_tr16_b64_v4i16((LAS s16x4*)(vp + 8 * 256)));
                const bf16x8 vf = {lo[0], lo[1], lo[2], lo[3], hi[0], hi[1], hi[2], hi[3]};
                o[dt] = __builtin_amdgcn_mfma_f32_32x32x16_bf16(pa, vf, o[dt], 0, 0, 0);
            }
        }
    }
    sum += __shfl_xor(sum, 32);
    LAS float* wsc = (LAS float*)(lds + LWSC_OFF + wave * 256);
    if (hh == 0) wsc[r] = __builtin_amdgcn_rcpf(sum);
    LDS_WAIT();
    bf16* O = (bf16*)(ws + WS_OMX) + qrow * 512 + h * 128;
#pragma unroll
    for (int i = 0; i < 16; ++i) { const int qr_ = crow(i, hh); const float rl = wsc[qr_];
#pragma unroll
        for (int dt = 0; dt < 4; ++dt) O[(size_t)qr_ * 512 + dt * 32 + r] = (bf16)f2bf(o[dt][i] * rl); }
    __syncthreads();
}

DI void p4_norm_rows(const Args& a, int vcu, int G, int wave, int lane) {
    unsigned char* ws = a.ws; const int gw = vcu * 8 + wave, NGW = G * 8;
    const float* lp = a.in[I_LAM];
    const float l1 = wave_sum(lp[lane] * lp[64 + lane]), l2 = wave_sum(lp[128 + lane] * lp[192 + lane]);
    const float lam_init = 0.2f, lam = expf(l1) - expf(l2) + lam_init;
    float gdn[8], gda[8];
#pragma unroll
    for (int i = 0; i < 8; ++i) { gdn[i] = a.in[I_DNON][8 * (lane & 15) + i]; gda[i] = a.in[I_SUBLN][8 * (lane & 15) + i] * (1.f - lam_init); }
    const bf16* P = (const bf16*)(ws + WS_P);
    for (int m = gw; m < T; m += NGW) {
        { const v4u w0 = *(const v4u*)((const bf16*)(ws + WS_ODN) + (size_t)m * 512 + 8 * lane), z0 = *(const v4u*)(P + (size_t)m * PW + P_DNZ + 8 * lane);
          float f[8], z[8]; f[0] = bflo(w0.x); f[1] = bfhi(w0.x); f[2] = bflo(w0.y); f[3] = bfhi(w0.y); f[4] = bflo(w0.z); f[5] = bfhi(w0.z); f[6] = bflo(w0.w); f[7] = bfhi(w0.w);
          z[0] = bflo(z0.x); z[1] = bfhi(z0.x); z[2] = bflo(z0.y); z[3] = bfhi(z0.y); z[4] = bflo(z0.z); z[5] = bfhi(z0.z); z[6] = bflo(z0.w); z[7] = bfhi(z0.w);
          float ss = 0.f;
#pragma unroll
          for (int i = 0; i < 8; ++i) ss += f[i] * f[i];
          ss += __shfl_xor(ss, 1); ss += __shfl_xor(ss, 2); ss += __shfl_xor(ss, 4); ss += __shfl_xor(ss, 8);
          const float r = rsqrtf(ss * (1.f / 128.f) + EPS);
#pragma unroll
          for (int i = 0; i < 8; ++i) f[i] = f[i] * r * gdn[i] * (z[i] * sigmoidf_(z[i]));
          v4u o; o.x = pk2(f[0], f[1]); o.y = pk2(f[2], f[3]); o.z = pk2(f[4], f[5]); o.w = pk2(f[6], f[7]);
          *(v4u*)((bf16*)(ws + WS_ODNF) + (size_t)m * 512 + 8 * lane) = o; }
        { const v4u w1 = *(const v4u*)((const bf16*)(ws + WS_O1) + (size_t)m * 512 + 8 * lane), w2 = *(const v4u*)((const bf16*)(ws + WS_O2) + (size_t)m * 512 + 8 * lane);
          float f[8]; f[0] = bflo(w1.x) - lam * bflo(w2.x); f[1] = bfhi(w1.x) - lam * bfhi(w2.x); f[2] = bflo(w1.y) - lam * bflo(w2.y); f[3] = bfhi(w1.y) - lam * bfhi(w2.y);
          f[4] = bflo(w1.z) - lam * bflo(w2.z); f[5] = bfhi(w1.z) - lam * bfhi(w2.z); f[6] = bflo(w1.w) - lam * bflo(w2.w); f[7] = bfhi(w1.w) - lam * bfhi(w2.w);
          float ss = 0.f;
#pragma unroll
          for (int i = 0; i < 8; ++i) ss += f[i] * f[i];
          ss += __shfl_xor(ss, 1); ss += __shfl_xor(ss, 2); ss += __shfl_xor(ss, 4); ss += __shfl_xor(ss, 8);
          const float r = rsqrtf(ss * (1.f / 128.f) + EPS);
#pragma unroll
          for (int i = 0; i < 8; ++i) f[i] = f[i] * r * gda[i];
          v4u o; o.x = pk2(f[0], f[1]); o.y = pk2(f[2], f[3]); o.z = pk2(f[4], f[5]); o.w = pk2(f[6], f[7]);
          *(v4u*)((bf16*)(ws + WS_ODAF) + (size_t)m * 512 + 8 * lane) = o; }
    }
}

struct BranchOrder {
    pg8::StaticOrder so; long a1, a2;
    DI bool next(int i, pg8::Unit& u) const {
        const int tl = i / 3, r = i - 3 * tl;
        if (!so.tile((long)tl * so.G + so.c, u.pm, u.pn)) return false;
        u.aoff = r == 0 ? 0 : (r == 1 ? a1 : a2); u.boff = (long)r * 1024 * 512 * 2; u.tag = r; return true;
    }
};
struct EpiMerge {
    static constexpr bool PERM = true;
    bf16* MRG; const bf16* P;
    DI void operator()(const f32x4 (&acc)[2][2][4][2], const pg8::Unit& u, int wr, int wc, int fr, int fq) const {
        const int row0 = u.pm * 256 + wr * 64 + fr, col0 = u.pn * 256 + wc * 32 + 8 * fq; const int r = u.tag;
#pragma unroll
        for (int ai = 0; ai < 2; ++ai)
#pragma unroll
            for (int m = 0; m < 4; ++m) { const size_t row = (size_t)(row0 + ai * 128 + m * 16);
#pragma unroll
                for (int bj = 0; bj < 2; ++bj) { const int col = col0 + bj * 128;
                    const v4u gw = *(const v4u*)(P + row * PW + P_GATE + r * 1024 + col);
                    f32x4 v0 = acc[ai][bj][m][0], v1 = acc[ai][bj][m][1];
                    v0.x *= bflo(gw.x); v0.y *= bfhi(gw.x); v0.z *= bflo(gw.y); v0.w *= bfhi(gw.y); v1.x *= bflo(gw.z); v1.y *= bfhi(gw.z); v1.z *= bflo(gw.w); v1.w *= bfhi(gw.w);
                    v4u* dst = (v4u*)(MRG + row * 1024 + col);
                    if (r > 0) { const v4u ow = *dst; v0.x += bflo(ow.x); v0.y += bfhi(ow.x); v0.z += bflo(ow.y); v0.w += bfhi(ow.y); v1.x += bflo(ow.z); v1.y += bfhi(ow.z); v1.z += bflo(ow.w); v1.w += bfhi(ow.w); }
                    v4u w; w.x = pk2(v0.x, v0.y); w.y = pk2(v0.z, v0.w); w.z = pk2(v1.x, v1.y); w.w = pk2(v1.z, v1.w);
                    *dst = w; } }
    }
};
struct EpiResF32 {
    static constexpr bool PERM = false;
    float* C; const float* X;
    DI void operator()(const f32x4 (&acc)[2][2][4][2], const pg8::Unit& u, int wr, int wc, int fr, int fq) const {
        const int row0 = u.pm * 256 + wr * 64 + fr, col0 = u.pn * 256 + wc * 32 + 4 * fq;
#pragma unroll
        for (int ai = 0; ai < 2; ++ai)
#pragma unroll
            for (int m = 0; m < 4; ++m) { const size_t ro = (size_t)(row0 + ai * 128 + m * 16) * 1024 + col0;
#pragma unroll
                for (int bj = 0; bj < 2; ++bj)
#pragma unroll
                    for (int n = 0; n < 2; ++n) *(f32x4*)(C + ro + bj * 128 + n * 16) = acc[ai][bj][m][n] + *(const f32x4*)(X + ro + bj * 128 + n * 16); }
    }
};

constexpr int RT_W = 0, RT_LG = 65536;
DI void p5_router(const Args& a, LAS unsigned char* lds, int vcu, int G, int tid, int wave, int lane) {
    unsigned char* ws = a.ws; const int gw = vcu * 8 + wave, NGW = G * 8;
    const float* X1 = a.out;
    {
        f32x4 gv[4];
#pragma unroll
        for (int j = 0; j < 4; ++j) gv[j] = ((const f32x4*)a.in[I_FNORM])[lane + 64 * j];
        bf16* H2 = (bf16*)(ws + WS_H);
        for (int m = gw; m < T; m += NGW) {
            const f32x4* xr = (const f32x4*)(X1 + (size_t)m * D) + lane;
            f32x4 v[4]; float ss = 0.f;
#pragma unroll
            for (int j = 0; j < 4; ++j) { v[j] = xr[64 * j]; ss += (v[j].x * v[j].x + v[j].y * v[j].y) + (v[j].z * v[j].z + v[j].w * v[j].w); }
            const float rstd = rsqrtf(wave_sum(ss) * (1.f / D) + EPS);
            unsigned long long* o8 = (unsigned long long*)(H2 + (size_t)m * D) + lane;
#pragma unroll
            for (int j = 0; j < 4; ++j) { v[j] = v[j] * rstd * gv[j]; o8[64 * j] = (unsigned long long)pk2(v[j].x, v[j].y) | ((unsigned long long)pk2(v[j].z, v[j].w) << 32); }
        }
    }
    LAS int* hist = (LAS int*)(lds + LCNT_OFF);
    if (tid < 32) hist[tid] = 0;
    const int r = lane & 31, hh = lane >> 5;
    for (int tb = vcu; tb < T / 128; tb += G) {
        const int tok0 = tb * 128 + wave * 32;
        f32x16 acc = {}; float ssq = 0.f;
        for (int kh = 0; kh < 2; ++kh) {
            __syncthreads();
#pragma unroll
            for (int i = 0; i < 8; ++i) { const int q = tid + 512 * i, k = q >> 3, e4 = (q & 7) * 4;
                const float gk = a.in[I_FNORM][kh * 512 + k]; f32x4 w = *(const f32x4*)(a.in[I_WR] + (size_t)(kh * 512 + k) * 32 + e4);
                *(LAS f32x4*)(lds + RT_W + (k * 32 + e4) * 4) = w * gk; }
            __syncthreads();
            if (wave < 4) {
                const float* xp = X1 + (size_t)(tok0 + r) * D + kh * 512 + 4 * hh;
                for (int i = 0; i < 64; ++i) { const f32x4 xv = *(const f32x4*)(xp + 8 * i);
                    ssq += (xv.x * xv.x + xv.y * xv.y) + (xv.z * xv.z + xv.w * xv.w);
                    const LAS float* wp = (const LAS float*)(lds + RT_W) + (8 * i + 4 * hh) * 32 + r;
                    acc = __builtin_amdgcn_mfma_f32_32x32x2f32(xv.x, wp[0], acc, 0, 0, 0);
                    acc = __builtin_amdgcn_mfma_f32_32x32x2f32(xv.y, wp[32], acc, 0, 0, 0);
                    acc = __builtin_amdgcn_mfma_f32_32x32x2f32(xv.z, wp[64], acc, 0, 0, 0);
                    acc = __builtin_amdgcn_mfma_f32_32x32x2f32(xv.w, wp[96], acc, 0, 0, 0); }
            }
        }
        if (wave < 4) {
            ssq += __shfl_xor(ssq, 32);
            LAS float* wsc = (LAS float*)(lds + LWSC_OFF + wave * 256);
            if (hh == 0) wsc[r] = rsqrtf(ssq * (1.f / D) + EPS);
            LDS_WAIT();
            LAS float* LG = (LAS float*)(lds + RT_LG + wave * (32 * 33 * 4));
            const float br = a.in[I_BR][r];
#pragma unroll
            for (int i = 0; i < 16; ++i) { const int tk = crow(i, hh); LG[tk * 33 + r] = acc[i] * wsc[tk] + br; }
            LDS_WAIT();
            if (lane < 32) {
                const LAS float* row = LG + lane * 33;
                float best[4]; int bi[4];
                unsigned taken = 0u;
#pragma unroll
                for (int k = 0; k < 4; ++k) { float bv = -INFINITY; int be = 0;
                    for (int e = 0; e < 32; ++e) { const float v = row[e]; const bool ok = !((taken >> e) & 1u) && v > bv; bv = ok ? v : bv; be = ok ? e : be; }
                    best[k] = bv; bi[k] = be; taken |= 1u << be; }
                const float e0 = 1.f, e1 = expf(best[1] - best[0]), e2 = expf(best[2] - best[0]), e3 = expf(best[3] - best[0]);
                const float inv = 1.f / (e0 + e1 + e2 + e3);
                int* TE = (int*)(ws + WS_TOKE) + (size_t)(tok0 + lane) * 4; float* TW = (float*)(ws + WS_TOKW) + (size_t)(tok0 + lane) * 4;
                TE[0] = bi[0]; TE[1] = bi[1]; TE[2] = bi[2]; TE[3] = bi[3];
                TW[0] = e0 * inv; TW[1] = e1 * inv; TW[2] = e2 * inv; TW[3] = e3 * inv;
                lds_add(&hist[bi[0]], 1); lds_add(&hist[bi[1]], 1); lds_add(&hist[bi[2]], 1); lds_add(&hist[bi[3]], 1);
            }
        }
    }
    __syncthreads();
    if (tid < 32) atomicAdd((unsigned*)(ws + WS_CTL) + CW_CNT + tid, (unsigned)hist[tid]);
}

DI void moe_table(const Args& a, LAS unsigned char* lds, int tid) {
    LAS int* cnt = (LAS int*)(lds + LCNT_OFF); LAS int* base = cnt + 32; LAS int* misc = cnt + 64; LAS int* tab = (LAS int*)(lds + LTAB_OFF);
    __syncthreads();
    if (tid < 32) cnt[tid] = (int)__hip_atomic_load((unsigned*)(a.ws + WS_CTL) + CW_CNT + tid, RLX_AGENT);
    __syncthreads();
    if (tid == 0) { int ti = 0; for (int e = 0; e < 32; ++e) { base[e] = ti * 256; const int nt = (cnt[e] + 255) >> 8; for (int q = 0; q < nt; ++q) tab[ti + q] = e; ti += nt; } misc[0] = ti; }
    __syncthreads();
}
DI void p6_slots(const Args& a, LAS unsigned char* lds, int vcu, int G, int tid, int wave, int lane) {
    unsigned char* ws = a.ws;
    LAS int* cnt = (LAS int*)(lds + LCNT_OFF); LAS int* base = cnt + 32;
    LAS int* lh = (LAS int*)(lds + 0); LAS int* wb = lh + 32; LAS int* pslot = lh + 64;
    moe_table(a, lds, tid);
    int* SD = (int*)(ws + WS_SDST); float* SW = (float*)(ws + WS_SW);
    for (int e = vcu; e < 32; e += G) { const int lo = base[e] + cnt[e], hi = base[e] + (((cnt[e] + 255) >> 8) << 8); for (int s = lo + tid; s < hi; s += 512) SD[s] = -1; }
    const int* TE = (const int*)(ws + WS_TOKE); const float* TW = (const float*)(ws + WS_TOKW);
    const bf16* H2 = (const bf16*)(ws + WS_H); bf16* XS = (bf16*)(ws + WS_XS);
    for (int tb = vcu; tb < T / 128; tb += G) {
        __syncthreads();
        if (tid < 32) lh[tid] = 0;
        __syncthreads();
        const int pair = tb * 512 + tid; const int e = TE[pair];
        const int rank = lds_add(&lh[e], 1);
        __syncthreads();
        if (tid < 32) wb[tid] = (int)atomicAdd((unsigned*)(ws + WS_CTL) + CW_CUR + tid, (unsigned)lh[tid]);
        __syncthreads();
        const int slot = base[e] + wb[e] + rank;
        SD[slot] = pair; SW[slot] = TW[pair]; pslot[tid] = slot;
        __syncthreads();
        for (int q = 0; q < 16; ++q) { const int tl = wave * 16 + q; const size_t tok = (size_t)tb * 128 + tl;
            const v4u* src = (const v4u*)(H2 + tok * 1024 + 16 * lane); const v4u w0 = src[0], w1 = src[1];
#pragma unroll
            for (int k = 0; k < 4; ++k) { v4u* dst = (v4u*)(XS + (size_t)pslot[tl * 4 + k] * 1024 + 16 * lane); dst[0] = w0; dst[1] = w1; } }
    }
    __syncthreads();
}

struct MoeOrder {
    const LAS int* tab; int ntiles, npn, G, c; long bstride;
    DI bool next(int i, pg8::Unit& u) const {
        const long L = (long)i * G + c; const int rt = (int)(L / npn);
        if (rt >= ntiles) return false;
        const int e = __builtin_amdgcn_readfirstlane(tab[rt]);
        u.pm = rt; u.pn = (int)(L % npn); u.aoff = 0; u.boff = (long)e * bstride; u.tag = e; return true;
    }
};
struct EpiSwiGLU {
    static constexpr bool PERM = true;
    bf16* ACT; const float* bgu;
    DI void operator()(const f32x4 (&acc)[2][2][4][2], const pg8::Unit& u, int wr, int wc, int fr, int fq) const {
        const int row0 = u.pm * 256 + wr * 64 + fr, j0 = u.pn * 128 + wc * 32 + 8 * fq;
        const float* bp = bgu + (size_t)u.tag * 2048 + j0;
        const f32x4 bg0 = *(const f32x4*)(bp), bg1 = *(const f32x4*)(bp + 4), bu0 = *(const f32x4*)(bp + 1024), bu1 = *(const f32x4*)(bp + 1028);
#pragma unroll
        for (int ai = 0; ai < 2; ++ai)
#pragma unroll
            for (int m = 0; m < 4; ++m) {
                f32x4 g0 = acc[ai][0][m][0] + bg0, g1 = acc[ai][0][m][1] + bg1, u0 = acc[ai][1][m][0] + bu0, u1 = acc[ai][1][m][1] + bu1;
                float o[8];
#pragma unroll
                for (int q = 0; q < 4; ++q) { float g = fminf(g0[q], 7.f), up = fminf(fmaxf(u0[q], -7.f), 7.f); o[q] = (up + 1.f) * g * sigmoidf_(1.702f * g);
                    g = fminf(g1[q], 7.f); up = fminf(fmaxf(u1[q], -7.f), 7.f); o[4 + q] = (up + 1.f) * g * sigmoidf_(1.702f * g); }
                v4u w; w.x = pk2(o[0], o[1]); w.y = pk2(o[2], o[3]); w.z = pk2(o[4], o[5]); w.w = pk2(o[6], o[7]);
                *(v4u*)(ACT + (size_t)(row0 + ai * 128 + m * 16) * 1024 + j0) = w; }
    }
};
struct EpiDown {
    static constexpr bool PERM = true;
    bf16* Y2; const float* bd; const int* SD; const float* SW;
    DI void operator()(const f32x4 (&acc)[2][2][4][2], const pg8::Unit& u, int wr, int wc, int fr, int fq) const {
        const int row0 = u.pm * 256 + wr * 64 + fr, col0 = u.pn * 256 + wc * 32 + 8 * fq;
        const float* bp = bd + (size_t)u.tag * 1024 + col0;
        f32x4 bv[2][2];
#pragma unroll
        for (int bj = 0; bj < 2; ++bj)
#pragma unroll
            for (int n = 0; n < 2; ++n) bv[bj][n] = *(const f32x4*)(bp + bj * 128 + 4 * n);
#pragma unroll
        for (int ai = 0; ai < 2; ++ai)
#pragma unroll
            for (int m = 0; m < 4; ++m) { const int slot = row0 + ai * 128 + m * 16; const int dst = SD[slot];
                if (dst >= 0) { const float sw = SW[slot]; bf16* rowp = Y2 + (size_t)dst * 1024 + col0;
#pragma unroll
                    for (int bj = 0; bj < 2; ++bj) { const f32x4 v0 = (acc[ai][bj][m][0] + bv[bj][0]) * sw, v1 = (acc[ai][bj][m][1] + bv[bj][1]) * sw;
                        v4u w; w.x = pk2(v0.x, v0.y); w.y = pk2(v0.z, v0.w); w.z = pk2(v1.x, v1.y); w.w = pk2(v1.z, v1.w);
                        *(v4u*)(rowp + bj * 128) = w; } } }
    }
};

DI void p9_combine(const Args& a, int vcu, int G, int wave, int lane) {
    unsigned char* ws = a.ws; const int gw = vcu * 8 + wave, NGW = G * 8;
    const bf16* Y2 = (const bf16*)(ws + WS_XS);
    for (int m = gw; m < T; m += NGW) {
        f32x4* op = (f32x4*)(a.out + (size_t)m * D + 16 * lane);
        f32x4 o0 = op[0], o1 = op[1], o2 = op[2], o3 = op[3];
#pragma unroll
        for (int k = 0; k < 4; ++k) { const v4u* yp = (const v4u*)(Y2 + ((size_t)m * 4 + k) * 1024 + 16 * lane); const v4u w0 = yp[0], w1 = yp[1];
            o0.x += bflo(w0.x); o0.y += bfhi(w0.x); o0.z += bflo(w0.y); o0.w += bfhi(w0.y); o1.x += bflo(w0.z); o1.y += bfhi(w0.z); o1.z += bflo(w0.w); o1.w += bfhi(w0.w);
            o2.x += bflo(w1.x); o2.y += bfhi(w1.x); o2.z += bflo(w1.y); o2.w += bfhi(w1.y); o3.x += bflo(w1.z); o3.y += bfhi(w1.z); o3.z += bflo(w1.w); o3.w += bfhi(w1.w); }
        op[0] = o0; op[1] = o1; op[2] = o2; op[3] = o3;
    }
}
constexpr int NPHASE = 12;
constexpr int N_ATT_ITEMS = 2048, N_MX_ITEMS = 512, N_SCAN_WG = 32;
typedef const Args __attribute__((address_space(4))) CArgs;
#if defined(__HIP_DEVICE_COMPILE__)
DI CArgs* fresh_args() { unsigned long long v = (unsigned long long)__builtin_amdgcn_kernarg_segment_ptr(); asm volatile("" : "+s"(v)); return (CArgs*)v; }
#else
__device__ CArgs* fresh_args();
#endif
DI Args load_args() { CArgs* p = fresh_args(); Args a;
#pragma unroll
    for (int i = 0; i < 27; ++i) a.in[i] = p->in[i];
    a.out = p->out; a.ws = p->ws; a.ph_lo = p->ph_lo; a.ph_hi = p->ph_hi; a.li = p->li; a.pad = 0; return a; }
#ifndef MK_N_LAUNCHES
#define MK_N_LAUNCHES 1
#endif
__global__ void __launch_bounds__(512, 2) mk_fwd(Args args_unused) {
    extern __shared__ __attribute__((aligned(16))) unsigned char lds_raw[];
    LAS unsigned char* lds = (LAS unsigned char*)lds_raw;
    volatile LAS unsigned* MISC = (volatile LAS unsigned*)(lds + MISC_OFF);
    for (int u = threadIdx.x; u < (LDS_BYTES - LDSCTL_OFF) / 4; u += 512) ((LAS unsigned*)(lds + LDSCTL_OFF))[u] = 0u;
    __syncthreads();
    { const Args A0 = load_args(); (void)xcd_barrier_post((unsigned*)(A0.ws + WS_CTL) + CW_BAR, MISC + 8); }
#ifdef ONLY_PHASE
#define IN(k) ((k) == ONLY_PHASE)
#elif MK_N_LAUNCHES == 1
#define IN(k) true
#else
#define IN(k) (fresh_args()->ph_lo <= (k) && (k) < fresh_args()->ph_hi)
#endif
#define FRESH() const Args A_ = load_args(); unsigned char* const ws = A_.ws; (void)ws; const int tid_ = fresh_tid(), lane_ = tid_ & 63, wave_ = __builtin_amdgcn_readfirstlane(tid_ >> 6); (void)lane_; (void)wave_; \
    const int G = gridDim.x, bx = blockIdx.x, vcu = (G % 8 == 0) ? (bx % 8) * (G / 8) + bx / 8 : bx; (void)vcu
#define SEAM(k) do { if (IN(k) && IN((k) + 1)) { XcdBarrier b_; b_.bar = (unsigned*)(fresh_args()->ws + WS_CTL) + CW_BAR; b_.x = xb_xcc_id(); b_.st = MISC + 8; xcd_barrier(b_); } } while (0)

    if (IN(0)) { FRESH(); p0_prologue(A_, lds, vcu, G, wave_, lane_); }
    SEAM(0);
    if (IN(1)) {
        FRESH();
        { pg8::Gemm g{(const bf16*)(ws + WS_H), (const bf16*)(ws + WS_WIN), 1024, 1024, 1024}; pg8::StaticOrder S; S.init(T, PW, G, bx);
          EpiP E{(bf16*)(ws + WS_P), A_.in[I_BGATE]};
          pg8::gemm_phase<EpiP, pg8::StaticOrder>(lds, g, S, E, tid_); }
        { pg8::Gemm g{(const bf16*)(ws + WS_MEMN), (const bf16*)(ws + WS_WMKV), 1024, 1024, 1024}; pg8::StaticOrder S; S.init(BATCH * NMEM, 1024, G, bx);
          EpiPlain E{(bf16*)(ws + WS_MKV), 1024};
          pg8::gemm_phase<EpiPlain, pg8::StaticOrder>(lds, g, S, E, tid_); }
    }
    SEAM(1);
    if (IN(2)) {
        FRESH();
#ifndef NO_PREP
        for (int ck = vcu; ck < NCHUNK; ck += G) dn_prep_unit(A_, lds, ck, tid_, wave_, lane_);
#endif
#ifndef NO_NORM
        p2_norm_rows(A_, vcu, G, wave_, lane_);
#endif
    }
    SEAM(2);
    if (IN(3)) {
#ifndef NO_SCAN
        if (blockIdx.x < N_SCAN_WG) { FRESH(); dn_scan(A_, lds, bx, wave_, lane_); }
#endif
#ifndef NO_ATT
        for (;;) {
            CArgs* ap = fresh_args(); unsigned char* ws = ap->ws; const int tid_ = fresh_tid();
            if (tid_ == 0) MISC[16] = __hip_atomic_fetch_add((unsigned*)(ws + WS_CTL) + CW_QHEAD, 1u, RLX_AGENT);
            __syncthreads();
            const int item = (int)MISC[16];
            __syncthreads();
            if (item >= N_ATT_ITEMS) break;
            const int qb = 31 - (item >> 6), rest = item & 63, b = rest >> 4, h = (rest >> 2) & 3, map = (rest >> 1) & 1, half = rest & 1;
            const attn_body::bf16* Pb = (const attn_body::bf16*)(ws + WS_P) + (size_t)b * SEQ * PW;
            attn_body::bf16* Ob = (attn_body::bf16*)(ws + (map ? WS_O2 : WS_O1)) + (size_t)b * SEQ * 512 + h * 128 + half * 64;
            attn_body::attn_unit<8>(qb, Pb + P_DAQ + h * 128 + map * 64, Pb + P_DAK + h * 128 + map * 64, Pb + P_DAV + h * 128 + half * 64, Ob, ap->in[I_REL], h, (char*)lds_raw, tid_);
        }
#endif
#ifndef NO_MX
        for (;;) {
            FRESH();
            if (tid_ == 0) MISC[16] = __hip_atomic_fetch_add((unsigned*)(ws + WS_CTL) + CW_QHEAD + 16, 1u, RLX_AGENT);
            __syncthreads();
            const int idx = (int)MISC[16];
            __syncthreads();
            if (idx >= N_MX_ITEMS) break;
            mx_unit(A_, lds, idx >> 5, idx & 31, tid_, wave_, lane_);
        }
#endif
    }
    SEAM(3);
    if (IN(4)) { FRESH(); p4_norm_rows(A_, vcu, G, wave_, lane_); }
    SEAM(4);
    if (IN(5)) {
        FRESH();
        pg8::Gemm g{(const bf16*)(ws + WS_ODNF), (const bf16*)(ws + WS_WB), 512, 512, 512};
        BranchOrder S; S.so.init(T, 1024, G, bx); S.a1 = (long)(WS_ODAF - WS_ODNF); S.a2 = (long)(WS_OMX - WS_ODNF);
        EpiMerge E{(bf16*)(ws + WS_MRG), (const bf16*)(ws + WS_P)};
        pg8::gemm_phase<EpiMerge, BranchOrder>(lds, g, S, E, tid_);
    }
    SEAM(5);
    if (IN(6)) {
        FRESH();
        pg8::Gemm g{(const bf16*)(ws + WS_MRG), (const bf16*)(ws + WS_WOUT), 1024, 1024, 1024}; pg8::StaticOrder S; S.init(T, 1024, G, bx);
        EpiResF32 E{A_.out, A_.in[I_X]};
        pg8::gemm_phase<EpiResF32, pg8::StaticOrder>(lds, g, S, E, tid_);
    }
    SEAM(6);
    if (IN(7)) { FRESH(); p5_router(A_, lds, vcu, G, tid_, wave_, lane_); }
    SEAM(7);
    if (IN(8)) { FRESH(); p6_slots(A_, lds, vcu, G, tid_, wave_, lane_); }
    SEAM(8);
    if (IN(9)) {
        FRESH();
        moe_table(A_, lds, tid_);
        pg8::Gemm g{(const bf16*)(ws + WS_XS), (const bf16*)(ws + WS_WGU), 1024, 1024, 1024};
        MoeOrder S{(const LAS int*)(lds + LTAB_OFF), ((const LAS int*)(lds + LCNT_OFF))[64], 8, G, bx, (long)2048 * 1024 * 2};
        EpiSwiGLU E{(bf16*)(ws + WS_ACT), A_.in[I_BGU]};
        pg8::gemm_phase<EpiSwiGLU, MoeOrder>(lds, g, S, E, tid_);
    }
    SEAM(9);
    if (IN(10)) {
        FRESH();
        moe_table(A_, lds, tid_);
        pg8::Gemm g{(const bf16*)(ws + WS_ACT), (const bf16*)(ws + WS_WD), 1024, 1024, 1024};
        MoeOrder S{(const LAS int*)(lds + LTAB_OFF), ((const LAS int*)(lds + LCNT_OFF))[64], 4, G, bx, (long)1024 * 1024 * 2};
        EpiDown E{(bf16*)(ws + WS_XS), A_.in[I_BD], (const int*)(ws + WS_SDST), (const float*)(ws + WS_SW)};
        pg8::gemm_phase<EpiDown, MoeOrder>(lds, g, S, E, tid_);
    }
    SEAM(10);
    if (IN(11)) {
        FRESH();
        p9_combine(A_, vcu, G, wave_, lane_);
        if (bx == 0 && tid_ == 0) { if (__hip_atomic_load((unsigned*)(ws + WS_CTL) + CW_BAR + XB_TMO, RLX_AGENT) != 0u) A_.out[0] = __builtin_nanf(""); }
    }
#undef IN
#undef SEAM
#undef FRESH
}

extern "C" void kernel_launch(void* const* d_in, const int* in_sizes, int n_in, void* d_out, int out_size, void* d_ws, size_t ws_size, hipStream_t stream) {
    static int grid = 0;
    if (grid == 0) {
        if (n_in != 27 || in_sizes[0] != T * D || out_size != T * D || ws_size < WS_END) {
            fprintf(stderr, "kernel_launch: unexpected shapes (n_in %d, in0 %d, out %d, ws %zu < %zu); nothing launched\n", n_in, n_in > 0 ? in_sizes[0] : -1, out_size, ws_size, (size_t)WS_END); grid = -1; return; }
        int dev = 0, cus = 0, per_cu = 0;
        if (hipGetDevice(&dev) != hipSuccess || hipDeviceGetAttribute(&cus, hipDeviceAttributeMultiprocessorCount, dev) != hipSuccess) { grid = -1; return; }
        if (hipFuncSetAttribute((const void*)mk_fwd, hipFuncAttributeMaxDynamicSharedMemorySize, LDS_BYTES) != hipSuccess) { fprintf(stderr, "kernel_launch: hipFuncSetAttribute failed\n"); grid = -1; return; }
        if (hipOccupancyMaxActiveBlocksPerMultiprocessor(&per_cu, (const void*)mk_fwd, 512, LDS_BYTES) != hipSuccess || per_cu < 1)
            fprintf(stderr, "kernel_launch: note: occupancy query reports %d workgroups per CU\n", per_cu);
        (void)hipGetLastError();
        grid = cus;
        if (grid > 256) grid = 256;
    }
    if (grid < 0) return;
    if (hipMemsetAsync((char*)d_ws + WS_CTL, 0, CTL_ZERO_BYTES, stream) != hipSuccess) return;
    Args a{};
    for (int i = 0; i < 27; ++i) a.in[i] = (const float*)d_in[i];
    a.out = (float*)d_out; a.ws = (unsigned char*)d_ws;
#if MK_N_LAUNCHES == 1
    a.ph_lo = 0; a.ph_hi = NPHASE; a.li = 0; a.pad = 0;
    hipLaunchKernelGGL(mk_fwd, dim3(grid), dim3(512), LDS_BYTES, stream, a);
#else
    for (int p = 0; p < NPHASE; ++p) { a.ph_lo = p; a.ph_hi = p + 1; a.li = 0; a.pad = 0; hipLaunchKernelGGL(mk_fwd, dim3(grid), dim3(512), LDS_BYTES, stream, a); }
#endif
}
```

```cpp
#include <hip/hip_runtime.h>
#include <hip/hip_bf16.h>
#include <cstdio>
#include <cstdint>
#include <cmath>

#define GAS __attribute__((address_space(1)))
#define LAS __attribute__((address_space(3)))
typedef unsigned short bf16;
typedef unsigned v4u __attribute__((ext_vector_type(4)));
typedef unsigned v2u __attribute__((ext_vector_type(2)));
typedef float f32x4 __attribute__((ext_vector_type(4)));
typedef float f32x16 __attribute__((ext_vector_type(16)));
typedef short bf16x8 __attribute__((ext_vector_type(8)));
typedef short s16x4 __attribute__((ext_vector_type(4)));
typedef GAS unsigned gu32;
#define RLX_AGENT __ATOMIC_RELAXED, __HIP_MEMORY_SCOPE_AGENT
#define LDS_WAIT() asm volatile("s_waitcnt lgkmcnt(0)" ::: "memory")
#define VM_WAIT() asm volatile("s_waitcnt vmcnt(0)" ::: "memory")
#define DI __device__ __forceinline__

DI unsigned f2bf(float f) { unsigned u = __builtin_bit_cast(unsigned, f); return (u + 0x7fffu + ((u >> 16) & 1u)) >> 16; }
DI unsigned pk2(float lo, float hi) { return f2bf(lo) | (f2bf(hi) << 16); }
DI float bflo(unsigned w) { return __builtin_bit_cast(float, w << 16); }
DI float bfhi(unsigned w) { return __builtin_bit_cast(float, w & 0xffff0000u); }
DI float bf2f(bf16 b) { return __builtin_bit_cast(float, (unsigned)b << 16); }
DI float wave_sum(float v) {
#pragma unroll
    for (int o = 1; o < 64; o <<= 1) v += __shfl_xor(v, o);
    return v;
}
DI float fast_exp(float x) { return __builtin_amdgcn_exp2f(x * 1.4426950408889634f); }
DI float sigmoidf_(float x) { return __builtin_amdgcn_rcpf(1.f + fast_exp(-x)); }
DI int lds_add(LAS int* p, int v) { return __hip_atomic_fetch_add(p, v, __ATOMIC_RELAXED, __HIP_MEMORY_SCOPE_WORKGROUP); }
DI int fresh_tid() { int t; asm volatile("v_mov_b32 %0, %1" : "=v"(t) : "v"((int)threadIdx.x)); return t; }
DI int crow(int r, int hi) { return (r & 3) + 8 * (r >> 2) + 4 * hi; }

constexpr int BATCH = 4, SEQ = 8192, T = BATCH * SEQ, D = 1024, INW = 7176, PW = 7168, NMEM = 256;
constexpr float EPS = 1e-6f;
constexpr int P_DNQ = 0, P_DNK = 512, P_DNV = 1024, P_DNZ = 1536, P_DAQ = 2048, P_DAK = 2560, P_DAV = 3072, P_MXQ = 3584, P_GATE = 4096;
constexpr int NEXP = 32, DFF = 1024, NSLOT_MAX = T * 4 + NEXP * 256, NTILE_MAX = NSLOT_MAX / 256;
constexpr int NCHUNK = BATCH * 4 * (SEQ / 64);
constexpr float LOG2E = 1.4426950408889634f;

constexpr size_t MiB = 1u << 20;
constexpr size_t WS_CTL = 0, CTL_ZERO_BYTES = 1 * MiB;
constexpr size_t WS_G = 1 * MiB;
constexpr size_t WS_BETA = WS_G + 512 * 1024;
constexpr size_t WS_TOKE = 2 * MiB;
constexpr size_t WS_TOKW = WS_TOKE + 512 * 1024;
constexpr size_t WS_SDST = 3 * MiB;
constexpr size_t WS_SW = 4 * MiB;
constexpr size_t WS_EGL = 5 * MiB;
constexpr size_t WS_WB = 6 * MiB;
constexpr size_t WS_WOUT = 9 * MiB;
constexpr size_t WS_WMKV = 11 * MiB;
constexpr size_t WS_MEMN = 13 * MiB;
constexpr size_t WS_MKV = 15 * MiB;
constexpr size_t WS_WIN = 17 * MiB;
constexpr size_t WS_WGU = 32 * MiB;
constexpr size_t WS_WD = 160 * MiB;
constexpr size_t WS_H = 224 * MiB;
constexpr size_t WS_P = 288 * MiB;
constexpr size_t WS_NW = 736 * MiB;
constexpr size_t WS_QD = 768 * MiB;
constexpr size_t WS_KDT = 800 * MiB;
constexpr size_t WS_U = 832 * MiB;
constexpr size_t WS_QK = 864 * MiB;
constexpr size_t WS_ODN = 880 * MiB;
constexpr size_t WS_O1 = 912 * MiB;
constexpr size_t WS_O2 = 944 * MiB;
constexpr size_t WS_OMX = 976 * MiB;
constexpr size_t WS_ODNF = 736 * MiB;
constexpr size_t WS_ODAF = 768 * MiB;
constexpr size_t WS_MRG = 800 * MiB;
constexpr size_t WS_XS = 288 * MiB;
constexpr size_t WS_ACT = 560 * MiB;
constexpr size_t WS_END = 1024 * MiB;
static_assert(WS_OMX + (size_t)T * 512 * 2 <= WS_END && WS_ACT + (size_t)NSLOT_MAX * 1024 * 2 <= WS_END && WS_XS + (size_t)NSLOT_MAX * 1024 * 2 <= WS_ACT, "ws map");

constexpr int CW_QHEAD = 64;
constexpr int CW_CNT = 128;
constexpr int CW_CUR = 192;
constexpr int CW_BAR = 4096;

constexpr int RING_BYTES = 136 * 1024;
constexpr int LDSCTL_OFF = RING_BYTES;
constexpr int MISC_OFF = LDSCTL_OFF;
constexpr int LTAB_OFF = LDSCTL_OFF + 128;
constexpr int LCNT_OFF = LTAB_OFF + NTILE_MAX * 4;
constexpr int LWSC_OFF = LCNT_OFF + 512;
constexpr int LDS_BYTES = 144 * 1024;
static_assert(LWSC_OFF + 8 * 256 <= LDS_BYTES, "LDS map");

namespace pg8 {
constexpr int BM = 256, BK = 64, HALF = 128, HTB = HALF * BK * 2, STAGE_BYTES = 8 * HTB, NXCD = 8, WGM = 8;
DI int lds_byte(int r, int c) { const int st = (r >> 4) * 2 + (c >> 5), rr = r & 15, cc = c & 31, ob = rr * 64 + cc * 2; return st * 1024 + (ob ^ (((ob >> 9) & 1) << 5)); }
DI void stage_rc(int b, int& R, int& C) { const int st = b / 1024, sb = b % 1024, swz = sb ^ (((sb >> 9) & 1) << 5); R = (st >> 1) * 16 + swz / 64; C = (st & 1) * 32 + (swz % 64) / 2; }
DI int perm32(int rho) { const int n = rho >> 4, i = rho & 15; return 8 * (i >> 2) + 4 * n + (i & 3); }

struct Unit { int pm, pn; long aoff, boff; int tag; };
struct Gemm { const bf16* A; const bf16* Bt; int lda, ldb, K; };

struct StaticOrder {
    int nM, nN, nwg, G, c;
    DI void init(int M, int N, int G_, int c_) { nM = M / BM; nN = N / BM; nwg = nM * nN; G = G_; c = c_; }
    DI bool tile(long L, int& pm, int& pn) const {
        if (L >= nwg) return false;
        int wgid = (int)L; { const int q = nwg / NXCD, r = nwg % NXCD, xcd = wgid % NXCD, off = wgid / NXCD; wgid = (xcd < r ? xcd * (q + 1) : r * (q + 1) + (xcd - r) * q) + off; }
        const int nig = WGM * nN, gid = wgid / nig, fm = gid * WGM, gsz = (nM - fm) < WGM ? (nM - fm) : WGM;
        pm = fm + ((wgid % nig) % gsz); pn = (wgid % nig) / gsz; return true;
    }
    DI bool next(int i, Unit& u) const { u.aoff = 0; u.boff = 0; u.tag = 0; return tile((long)i * G + c, u.pm, u.pn); }
};

template <class Epi, class Sched>
DI void gemm_phase(LAS unsigned char* lds, const Gemm g, const Sched& S, const Epi& E, const int tid) {
    const int wid = __builtin_amdgcn_readfirstlane(tid >> 6), lane = tid & 63, wr = wid >> 2, wc = wid & 3, fr = lane & 15, fq = lane >> 4;
    const int K = g.K, nt = K / BK;
    unsigned voffA[2], voffB[2];
#pragma unroll
    for (int i = 0; i < 2; ++i) { int R, C; stage_rc(tid * 16 + i * 8192, R, C); const int Rb = Epi::PERM ? ((R & ~31) + perm32(R & 31)) : R;
        voffA[i] = (unsigned)(R * g.lda + C) * 2u; voffB[i] = (unsigned)(Rb * g.ldb + C) * 2u; }
    const size_t kstep = (size_t)(BK * 2);
    const size_t hstepA = (size_t)HALF * g.lda * 2, hstepB = (size_t)HALF * g.ldb * 2;
    const size_t tstepA = 2 * hstepA, tstepB = 2 * hstepB;
    const unsigned ldsw = (unsigned)wid * 1024u;
    const int aoff = lds_byte(wr * 64 + fr, fq * 8), boff = lds_byte(wc * 32 + fr, fq * 8);
#define PG8_SA(b, h) (((b) * 2 + (h)) * HTB)
#define PG8_SB(b, h) ((4 + (b) * 2 + (h)) * HTB)
#define PG8_STAGE(bufoff, gbase, voff) do { _Pragma("unroll") for (int _i = 0; _i < 2; ++_i) \
        __builtin_amdgcn_global_load_lds((const unsigned*)((const char*)(gbase) + (voff)[_i]), (LAS unsigned*)(lds + (bufoff) + ldsw + _i * 8192), 16, 0, 0); } while (0)
#define PG8_LDA(dst, b, h) do { _Pragma("unroll") for (int m = 0; m < 4; ++m) _Pragma("unroll") for (int k = 0; k < 2; ++k) dst[m][k] = *(const LAS bf16x8*)(lds + PG8_SA(b, h) + aoff + m * 2048 + k * 1024); } while (0)
#define PG8_LDB(dst, b, h) do { _Pragma("unroll") for (int n = 0; n < 2; ++n) _Pragma("unroll") for (int k = 0; k < 2; ++k) dst[n][k] = *(const LAS bf16x8*)(lds + PG8_SB(b, h) + boff + n * 2048 + k * 1024); } while (0)
#define PG8_MMA(ai, bj, At, Bt) do { __builtin_amdgcn_s_setprio(1); _Pragma("unroll") for (int m = 0; m < 4; ++m) _Pragma("unroll") for (int n = 0; n < 2; ++n) _Pragma("unroll") for (int k = 0; k < 2; ++k) \
        acc[ai][bj][m][n] = __builtin_amdgcn_mfma_f32_16x16x32_bf16(Bt[n][k], At[m][k], acc[ai][bj][m][n], 0, 0, 0); __builtin_amdgcn_s_setprio(0); } while (0)
#define PG8_WAIT_V(n) asm volatile("s_waitcnt vmcnt(" #n ")" ::: "memory")
#define PG8_WAIT_L(n) asm volatile("s_waitcnt lgkmcnt(" #n ")" ::: "memory")
#define PG8_BAR __builtin_amdgcn_s_barrier()
#define PG8_SCHED __builtin_amdgcn_sched_barrier(0)
    Unit cur, nxt; int ui = 0;
    if (!S.next(0, cur)) return;
    f32x4 acc[2][2][4][2];
#pragma unroll
    for (int a = 0; a < 2; ++a)
#pragma unroll
        for (int b = 0; b < 2; ++b)
#pragma unroll
            for (int m = 0; m < 4; ++m)
#pragma unroll
                for (int n = 0; n < 2; ++n) acc[a][b][m][n] = (f32x4){0.f, 0.f, 0.f, 0.f};
    bf16x8 At[4][2], B0[2][2], B1[2][2];
    const char* cA = (const char*)g.A + (size_t)cur.pm * tstepA + cur.aoff; const char* cB = (const char*)g.Bt + (size_t)cur.pn * tstepB + cur.boff;
    PG8_STAGE(PG8_SB(0, 0), cB, voffB); PG8_STAGE(PG8_SB(0, 1), cB + hstepB, voffB); PG8_STAGE(PG8_SA(0, 0), cA, voffA); PG8_STAGE(PG8_SA(0, 1), cA + hstepA, voffA);
    if (wr == 1) PG8_BAR;
    PG8_WAIT_V(2); PG8_BAR;
    PG8_STAGE(PG8_SB(1, 0), cB + kstep, voffB); PG8_STAGE(PG8_SA(1, 0), cA + kstep, voffA); PG8_STAGE(PG8_SB(1, 1), cB + hstepB + kstep, voffB);
    PG8_WAIT_V(6); PG8_BAR;
    for (;;) {
        const bool has_next = S.next(ui + 1, nxt);
        const char* nA = has_next ? (const char*)g.A + (size_t)nxt.pm * tstepA + nxt.aoff : cA; const char* nB = has_next ? (const char*)g.Bt + (size_t)nxt.pn * tstepB + nxt.boff : cB;
        for (int t = 0; t < nt; t += 2) {
            const bool last = (t == nt - 2);
            const char* a1 = cA + (size_t)(t + 1) * kstep;
            const char* a2 = last ? nA : cA + (size_t)(t + 2) * kstep; const char* b2 = last ? nB : cB + (size_t)(t + 2) * kstep;
            const char* a3 = a2 + kstep; const char* b3 = b2 + kstep;
            PG8_LDB(B0, 0, 0); PG8_LDB(B1, 0, 1); PG8_SCHED; PG8_LDA(At, 0, 0); PG8_STAGE(PG8_SA(1, 1), a1 + hstepA, voffA);
            PG8_WAIT_V(8); PG8_WAIT_L(0); PG8_BAR; PG8_MMA(0, 0, At, B0); PG8_MMA(0, 1, At, B1); PG8_BAR; PG8_SCHED;
            PG8_LDA(At, 0, 1); PG8_STAGE(PG8_SB(0, 0), b2, voffB); PG8_STAGE(PG8_SB(0, 1), b2 + hstepB, voffB); PG8_STAGE(PG8_SA(0, 0), a2, voffA);
            PG8_WAIT_V(8); PG8_WAIT_L(0); PG8_BAR; PG8_MMA(1, 0, At, B0); PG8_MMA(1, 1, At, B1); PG8_BAR; PG8_SCHED;
            PG8_LDB(B0, 1, 0); PG8_LDB(B1, 1, 1); PG8_SCHED; PG8_LDA(At, 1, 0); PG8_STAGE(PG8_SA(0, 1), a2 + hstepA, voffA);
            PG8_WAIT_V(8); PG8_WAIT_L(0); PG8_BAR; PG8_MMA(0, 0, At, B0); PG8_MMA(0, 1, At, B1); PG8_BAR; PG8_SCHED;
            PG8_LDA(At, 1, 1); PG8_STAGE(PG8_SB(1, 0), b3, voffB); PG8_STAGE(PG8_SB(1, 1), b3 + hstepB, voffB); PG8_STAGE(PG8_SA(1, 0), a3, voffA);
            PG8_WAIT_V(8); PG8_WAIT_L(0); PG8_BAR; PG8_MMA(1, 0, At, B0); PG8_MMA(1, 1, At, B1); PG8_BAR; PG8_SCHED;
        }
        if (wr == 0) PG8_BAR;
        E(acc, cur, wr, wc, fr, fq);
        if (!has_next) break;
#pragma unroll
        for (int a = 0; a < 2; ++a)
#pragma unroll
            for (int b = 0; b < 2; ++b)
#pragma unroll
                for (int m = 0; m < 4; ++m)
#pragma unroll
                    for (int n = 0; n < 2; ++n) acc[a][b][m][n] = (f32x4){0.f, 0.f, 0.f, 0.f};
        cur = nxt; cA = nA; cB = nB; ++ui;
        if (wr == 1) PG8_BAR;
    }
    PG8_WAIT_V(0);
    PG8_BAR;
#undef PG8_SA
#undef PG8_SB
#undef PG8_STAGE
#undef PG8_LDA
#undef PG8_LDB
#undef PG8_MMA
#undef PG8_WAIT_V
#undef PG8_WAIT_L
#undef PG8_BAR
#undef PG8_SCHED
}
}
namespace attn_body {
using bf16=__hip_bfloat16;
using bf16x8=__attribute__((ext_vector_type(8)))short;
using s16x4=__attribute__((ext_vector_type(4)))short;
using f32x16=__attribute__((ext_vector_type(16)))float;
using u32x4=__attribute__((ext_vector_type(4)))unsigned;
constexpr int SEQ=8192,D=64,DM=7168,OPITCH=512;
constexpr int NW=8,QBLK=32,QB=QBLK*NW,KVBLK=64,NQB=SEQ/QB;
constexpr int ATTN_UNIT_ROWS=QB;
__device__ __forceinline__ int crow(int r,int hi){return (r&3)+8*(r>>2)+4*hi;}
#define SBAR() __builtin_amdgcn_sched_barrier(0)
__device__ __forceinline__ void cmask(f32x16&p0,f32x16&p1,int jb,int qrel,int hi){
  const float NEG=-INFINITY; int kb=64*jb+4*hi;
  #pragma unroll
  for(int r=0;r<16;++r){int kv=kb+(r&3)+8*(r>>2); if(kv>qrel)p0[r]=NEG; if(kv+32>qrel)p1[r]=NEG;}
}

__device__ __forceinline__ void biasadd(f32x16&p0,f32x16&p1,const float*lp){
  #pragma unroll
  for(int r=0;r<16;r+=2){ const float a0=lp[59-((r&3)+8*(r>>2))],a1=lp[59-(((r+1)&3)+8*((r+1)>>2))],b0=lp[59-32-((r&3)+8*(r>>2))],b1=lp[59-32-(((r+1)&3)+8*((r+1)>>2))];
    p0[r]+=a0; p0[r+1]+=a1; p1[r]+=b0; p1[r+1]+=b1; __builtin_amdgcn_sched_barrier(0); }
}
constexpr int NSLOT=3, SLOTB=8192;
constexpr int LDS_K=0, LDS_V=NSLOT*SLOTB, LDS_WS=2*NSLOT*SLOTB, LDS_OST=LDS_WS+NW*64*4, LDS_LUT=LDS_OST+NW*4096, LDS_BYTES=LDS_LUT+640*4;
constexpr float C2=0.125f*1.4426950408889634f;
__device__ __forceinline__ void glds16(const void*gsrc,unsigned lds_dst){unsigned keep;
  asm volatile("s_mov_b32 %0, m0\n\ts_mov_b32 m0, %2\n\ts_nop 0\n\tglobal_load_lds_dwordx4 %1, off\n\ts_mov_b32 m0, %0":"=&s"(keep):"v"(gsrc),"s"(lds_dst):"memory");}
__device__ __forceinline__ float max3f(float a,float b,float c){float r;asm("v_max3_f32 %0, %1, %2, %3":"=v"(r):"v"(a),"v"(b),"v"(c));return r;}
__device__ __forceinline__ float max2f(float a,float b){float r;asm("v_max_f32_e32 %0, %1, %2":"=v"(r):"v"(a),"v"(b));return r;}
__device__ __forceinline__ float fadd_s(float a,float b){float r;asm("v_add_f32_e32 %0, %1, %2":"=v"(r):"v"(a),"v"(b));return r;}
__device__ __forceinline__ float fsub_s(float a,float b){float r;asm("v_sub_f32_e32 %0, %1, %2":"=v"(r):"v"(a),"v"(b));return r;}
typedef float f32x2_t __attribute__((ext_vector_type(2))); typedef __bf16 bf16x2_t __attribute__((ext_vector_type(2)));
__device__ __forceinline__ unsigned cvtpk_s(float lo,float hi){f32x2_t v={lo,hi};bf16x2_t b=__builtin_convertvector(v,bf16x2_t);return __builtin_bit_cast(unsigned,b);}
#define WAIT_BAR(N) asm volatile("s_waitcnt vmcnt(" #N ") lgkmcnt(0)\n\ts_barrier":::"memory")

__device__ __forceinline__ void qkt(f32x16&p0,f32x16&p1,const char*Kslot,const bf16x8*qr,const f32x16&negm,int r32,int hi){
  const char*kb=Kslot+hi*1024+r32*16;
  #pragma unroll
  for(int d0=0;d0<4;++d0){
    const bf16x8 b0=*reinterpret_cast<const bf16x8*>(kb+d0*2048);
    const bf16x8 b1=*reinterpret_cast<const bf16x8*>(kb+d0*2048+512);
    if(d0==0){p0=__builtin_amdgcn_mfma_f32_32x32x16_bf16(b0,qr[0],negm,0,0,0);p1=__builtin_amdgcn_mfma_f32_32x32x16_bf16(b1,qr[0],negm,0,0,0);}
    else{p0=__builtin_amdgcn_mfma_f32_32x32x16_bf16(b0,qr[d0],p0,0,0,0);p1=__builtin_amdgcn_mfma_f32_32x32x16_bf16(b1,qr[d0],p1,0,0,0);}}
}
typedef __attribute__((address_space(3))) const char* lds_cptr;
typedef short v4i16_t __attribute__((ext_vector_type(4)));
__device__ __forceinline__ void kload8(bf16x8*kf,lds_cptr kp){
  kf[0]=*(const __attribute__((address_space(3))) bf16x8*)(kp);      kf[1]=*(const __attribute__((address_space(3))) bf16x8*)(kp+512);
  kf[2]=*(const __attribute__((address_space(3))) bf16x8*)(kp+2048); kf[3]=*(const __attribute__((address_space(3))) bf16x8*)(kp+2560);
  kf[4]=*(const __attribute__((address_space(3))) bf16x8*)(kp+4096); kf[5]=*(const __attribute__((address_space(3))) bf16x8*)(kp+4608);
  kf[6]=*(const __attribute__((address_space(3))) bf16x8*)(kp+6144); kf[7]=*(const __attribute__((address_space(3))) bf16x8*)(kp+6656);
}
__device__ __forceinline__ void kload2(bf16x8*kf,lds_cptr kp,int j){ kf[2*j]=*(const __attribute__((address_space(3))) bf16x8*)(kp+j*2048); kf[2*j+1]=*(const __attribute__((address_space(3))) bf16x8*)(kp+j*2048+512); }
__device__ __forceinline__ s16x4 vtr(lds_cptr p){ return __builtin_bit_cast(s16x4,__builtin_amdgcn_ds_read_tr16_b64_v4i16((__attribute__((address_space(3))) v4i16_t*)p)); }
__device__ __forceinline__ float rowmax(const f32x16&p0,const f32x16&p1){
  float a=max3f(p0[0],p0[1],p1[0]),b=max3f(p0[2],p0[3],p1[1]);a=max3f(a,p1[2],p1[3]);
  #pragma unroll
  for(int r=4;r<16;r+=4){a=max3f(a,p0[r],p0[r+1]);b=max3f(b,p0[r+2],p0[r+3]);a=max3f(a,p1[r],p1[r+1]);b=max3f(b,p1[r+2],p1[r+3]);}
  const float m=max2f(a,b);
  auto rr=__builtin_amdgcn_permlane32_swap(__float_as_uint(m),__float_as_uint(m),false,false);
  return max2f(__uint_as_float(rr[0]),__uint_as_float(rr[1]));
}
__device__ __forceinline__ void pv(f32x16*o,int vb,bf16x8 pa0,bf16x8 pa1,bf16x8 pa2,bf16x8 pa3){
  #pragma unroll
  for(int d0=0;d0<2;++d0){s16x4 lo[4],hi[4];
    #pragma unroll
    for(int ks=0;ks<4;++ks){
      asm volatile("ds_read_b64_tr_b16 %0,%1 offset:%c2":"=&v"(lo[ks]):"v"(vb),"i"(d0*4096+ks*1024):"memory");
      asm volatile("ds_read_b64_tr_b16 %0,%1 offset:%c2":"=&v"(hi[ks]):"v"(vb),"i"(d0*4096+ks*1024+512):"memory");}
    asm volatile("s_waitcnt lgkmcnt(0)":::"memory");SBAR();
    #define PK(k) (bf16x8){lo[k][0],lo[k][1],lo[k][2],lo[k][3],hi[k][0],hi[k][1],hi[k][2],hi[k][3]}
    o[d0]=__builtin_amdgcn_mfma_f32_32x32x16_bf16(pa0,PK(0),o[d0],0,0,0);
    o[d0]=__builtin_amdgcn_mfma_f32_32x32x16_bf16(pa1,PK(1),o[d0],0,0,0);
    o[d0]=__builtin_amdgcn_mfma_f32_32x32x16_bf16(pa2,PK(2),o[d0],0,0,0);
    o[d0]=__builtin_amdgcn_mfma_f32_32x32x16_bf16(pa3,PK(3),o[d0],0,0,0);
    #undef PK
  }
}

#ifndef ATTN_STORE16
#define ATTN_STORE16(p,v) (*(u32x4*)(p)=(v))
#endif
template<int THRL> __device__ __forceinline__ void attn_unit(int qb,const bf16*Qh,const bf16*__restrict__ Kh,const bf16*__restrict__ Vh,bf16*Oh,const float* __restrict__ rel_table,int head,char*shm,const int tid){
  const int lane=tid&63,r32=lane&31,hi=lane>>5; const int wid=__builtin_amdgcn_readfirstlane(tid>>6);
  const int q0=qb*QB;
  const bf16*Qw=Qh+(long)(q0+wid*QBLK)*DM;
  const unsigned lds0=(unsigned)(uintptr_t)shm;
  float*wsf=(float*)(shm+LDS_WS)+wid*64;
  const bf16*ksrc=Kh+(long)lane*DM+wid*8;
  const bf16*vsrc=Vh+(long)(16*(wid&3)+(lane>>2))*DM+(wid>>2)*32+(lane&3)*8;
  const unsigned kdst=lds0+LDS_K+wid*1024, vdst=lds0+LDS_V+wid*1024;
  #define DMA_K(t,slot) glds16(ksrc+(long)(t)*KVBLK*DM,(unsigned)__builtin_amdgcn_readfirstlane(kdst+(slot)))
  #define DMA_V(t,slot) glds16(vsrc+(long)(t)*KVBLK*DM,(unsigned)__builtin_amdgcn_readfirstlane(vdst+(slot)))
  const int vb0=(int)(lds0+LDS_V)+((lane>>4)&1)*32+(lane&3)*8+(4*hi+((lane&15)>>2))*64;
  const char*Kbase=shm+LDS_K; bf16x8 kf[8];
  const lds_cptr shm3=(lds_cptr)shm; const lds_cptr kp0=shm3+LDS_K+hi*1024+r32*16; const lds_cptr vp0=shm3+LDS_V+((lane>>4)&1)*32+(lane&3)*8+(4*hi+((lane&15)>>2))*64;
  const int NT=(q0+QB)/KVBLK;
  { float*lut=(float*)(shm+LDS_LUT); const float t31=rel_table[31*4+head];
    for(int i=tid;i<640;i+=512){ const int d=i-256; float v=0.f;
      if(d>=0&&d<128){ int bk; if(d<16)bk=d; else { bk=16+(int)(logf((float)d*(1.f/16.f))/logf(8.f)*16.f); bk=bk<31?bk:31; } v=(rel_table[bk*4+head]-t31)*1.4426950408889634f; }
      lut[i]=v; } }
  const float*lutl=(const float*)(shm+LDS_LUT)+(wid*QBLK+r32-4*hi+256-59);
  DMA_K(0,0);DMA_V(0,0);DMA_K(1,SLOTB);
  bf16x8 qr[4];
  #pragma unroll
  for(int d0=0;d0<4;++d0)qr[d0]=*reinterpret_cast<const bf16x8*>(&Qw[(long)r32*DM+d0*16+hi*8]);
  float mhat=0.f,l_reg=0.f;f32x16 o[2];o[0]=f32x16{};o[1]=f32x16{};f32x16 negm=f32x16{};asm volatile("":"+v"(negm));
  const int qrel=wid*QBLK+r32;
  #define CMASK(P0,P1,t) do{int jb_=(t)-(NT-4); if(jb_>=-2)biasadd(P0,P1,lutl-64*jb_); if(jb_>=0)cmask(P0,P1,jb_,qrel,hi);}while(0)
  bool resc=false;
  #define START(P0,P1) do{ const float rm=rowmax(P0,P1); resc=false; \
    { const float dl=rm; mhat=fadd_s(mhat,dl); \
      _Pragma("unroll") for(int r=0;r<16;++r){P0[r]=fsub_s(P0[r],dl);P1[r]=fsub_s(P1[r],dl);} \
      _Pragma("unroll") for(int r=0;r<16;++r)negm[r]=-mhat; asm volatile("":"+v"(negm)); } \
    _Pragma("unroll") for(int r=0;r<16;++r)P0[r]=__builtin_amdgcn_exp2f(P0[r]); }while(0)
  #define RESC() do{ if(resc){ asm volatile("s_waitcnt lgkmcnt(0)":::"memory"); \
      _Pragma("unroll") for(int d_=0;d_<2;++d_) _Pragma("unroll") for(int r=0;r<16;++r)o[d_][r]*=wsf[crow(r,hi)]; } }while(0)
  f32x16 pA0,pA1,pB0,pB1;
  int sl_prev=0,sl_cur=0,sl_next=SLOTB;
  #define ROT() do{sl_prev=sl_cur;sl_cur=sl_next;sl_next=(sl_next==(NSLOT-1)*SLOTB)?0:sl_next+SLOTB;}while(0)
  DMA_K(2,2*SLOTB);
  WAIT_BAR(3);
  qkt(pA0,pA1,Kbase,qr,negm,r32,hi);asm volatile("s_nop 15\n\ts_nop 7":"+v"(pA0),"+v"(pA1));CMASK(pA0,pA1,0);
  START(pA0,pA1);
  _Pragma("unroll") for(int r=0;r<16;++r)pA1[r]=__builtin_amdgcn_exp2f(pA1[r]);
  WAIT_BAR(0);
  DMA_K(3,0);DMA_V(1,SLOTB);
  ROT();
  kload8(kf,kp0+sl_cur);
  WAIT_BAR(2);
  s16x4 vlo[8],vhi[8]; u32x4 pw0,pw1,pw2,pw3;
  #define PKW(P,B) cvtpk_s(P[B],P[B+1])
  #define PAF(k) __builtin_bit_cast(bf16x8,pw##k)
  #define VFR(i) (bf16x8){vlo[i][0],vlo[i][1],vlo[i][2],vlo[i][3],vhi[i][0],vhi[i][1],vhi[i][2],vhi[i][3]}
  #define PIN(x) asm volatile("":"+v"(x))
  #define MX3(a,b,c) __builtin_fmaxf(__builtin_fmaxf((a),(b)),(c))
  #define GAPA(MF,A0,A1,A2,A3,W0,W1,PW) do{ MF; sacc+=A0; sacc+=A1; sacc+=A2; sacc+=A3; PIN(sacc); W0; W1; PIN(PW); SBAR(); }while(0)
  #define EX(v) __builtin_amdgcn_exp2f(v)
  #define GAPB(MF,X,B) do{ MF; X[B]=EX(X[B]); X[B+1]=EX(X[B+1]); X[B+2]=EX(X[B+2]); X[B+3]=EX(X[B+3]); PIN(X); SBAR(); }while(0)
  #define VRD(i) do{ vlo[i]=vtr(vp_+(((i)>>2)*4096+((i)&3)*1024)); vhi[i]=vtr(vp_+(((i)>>2)*4096+((i)&3)*1024+512)); }while(0)
  #define KRD(G,j) do{ if(G){ kload2(kf,kp0+sl_next,j); SBAR(); } }while(0)
  #define STEP(C0,C1,P0,P1,t,GK,GV,GL) do{ SBAR(); \
    const lds_cptr vp_=vp0+sl_prev; \
    VRD(0); SBAR(); float sacc=(P0[0]+P0[1]); \
    GAPA(C0=__builtin_amdgcn_mfma_f32_32x32x16_bf16(kf[0],qr[0],negm,0,0,0), P0[2],P0[3],P0[4],P0[5],     pw0[0]=PKW(P0,0), pw0[1]=PKW(P0,2), pw0); \
    VRD(4); SBAR(); GAPA(C1=__builtin_amdgcn_mfma_f32_32x32x16_bf16(kf[1],qr[0],negm,0,0,0), P0[6],P0[7],P0[8],P0[9],     pw0[2]=PKW(P0,4), pw0[3]=PKW(P0,6), pw0); \
    VRD(1); SBAR(); GAPA(C0=__builtin_amdgcn_mfma_f32_32x32x16_bf16(kf[2],qr[1],C0,0,0,0),   P0[10],P0[11],P0[12],P0[13], pw1[0]=PKW(P0,8), pw1[1]=PKW(P0,10), pw1); \
    VRD(5); SBAR(); GAPA(C1=__builtin_amdgcn_mfma_f32_32x32x16_bf16(kf[3],qr[1],C1,0,0,0),   P0[14],P0[15],P1[0],P1[1],   pw1[2]=PKW(P0,12),pw1[3]=PKW(P0,14), pw1); \
    VRD(2); SBAR(); GAPA(C0=__builtin_amdgcn_mfma_f32_32x32x16_bf16(kf[4],qr[2],C0,0,0,0),   P1[2],P1[3],P1[4],P1[5],     pw2[0]=PKW(P1,0), pw2[1]=PKW(P1,2), pw2); \
    VRD(6); SBAR(); GAPA(C1=__builtin_amdgcn_mfma_f32_32x32x16_bf16(kf[5],qr[2],C1,0,0,0),   P1[6],P1[7],P1[8],P1[9],     pw2[2]=PKW(P1,4), pw2[3]=PKW(P1,6), pw2); \
    VRD(3); SBAR(); GAPA(C0=__builtin_amdgcn_mfma_f32_32x32x16_bf16(kf[6],qr[3],C0,0,0,0),   P1[10],P1[11],P1[12],P1[13], pw3[0]=PKW(P1,8), pw3[1]=PKW(P1,10), pw3); \
    VRD(7); SBAR(); GAPA(C1=__builtin_amdgcn_mfma_f32_32x32x16_bf16(kf[7],qr[3],C1,0,0,0),   P1[14],P1[15],0.f,0.f,       pw3[2]=PKW(P1,12),pw3[3]=PKW(P1,14), pw3); \
    l_reg+=sacc; \
    if(GK){DMA_K((t)+3,sl_cur);} if(GV){DMA_V((t)+1,sl_next);} \
    CMASK(C0,C1,t); \
    { float a=MX3(C0[0],C0[1],C1[0]),b=MX3(C0[2],C0[3],C1[1]); a=MX3(a,C1[2],C1[3]); \
      _Pragma("unroll") for(int r=4;r<16;r+=4){a=MX3(a,C0[r],C0[r+1]);b=MX3(b,C0[r+2],C0[r+3]);a=MX3(a,C1[r],C1[r+1]);b=MX3(b,C1[r+2],C1[r+3]);} \
      float rm=__builtin_fmaxf(a,b); { auto rr=__builtin_amdgcn_permlane32_swap(__float_as_uint(rm),__float_as_uint(rm),false,false); rm=__builtin_fmaxf(__uint_as_float(rr[0]),__uint_as_float(rr[1])); } \
      resc=false; \
      if(__builtin_expect(__any(rm>(float)THRL),0)){ const float dl=__builtin_fmaxf(rm,0.f); mhat+=dl; \
        _Pragma("unroll") for(int r=0;r<16;++r){C0[r]-=dl;C1[r]-=dl;} \
        _Pragma("unroll") for(int r=0;r<16;++r)negm[r]=-mhat; asm volatile("":"+v"(negm)); \
        const float f=__builtin_amdgcn_exp2f(-dl); l_reg*=f; if(hi==0)wsf[r32]=f; resc=true; } } \
    SBAR(); \
    GAPB(o[0]=__builtin_amdgcn_mfma_f32_32x32x16_bf16(PAF(0),VFR(0),o[0],0,0,0), C0,0); \
    GAPB(o[1]=__builtin_amdgcn_mfma_f32_32x32x16_bf16(PAF(0),VFR(4),o[1],0,0,0), C0,4); \
    KRD(GL,0); GAPB(o[0]=__builtin_amdgcn_mfma_f32_32x32x16_bf16(PAF(1),VFR(1),o[0],0,0,0), C0,8); \
    KRD(GL,1); GAPB(o[1]=__builtin_amdgcn_mfma_f32_32x32x16_bf16(PAF(1),VFR(5),o[1],0,0,0), C0,12); \
    KRD(GL,2); GAPB(o[0]=__builtin_amdgcn_mfma_f32_32x32x16_bf16(PAF(2),VFR(2),o[0],0,0,0), C1,0); \
    KRD(GL,3); GAPB(o[1]=__builtin_amdgcn_mfma_f32_32x32x16_bf16(PAF(2),VFR(6),o[1],0,0,0), C1,4); \
    GAPB(o[0]=__builtin_amdgcn_mfma_f32_32x32x16_bf16(PAF(3),VFR(3),o[0],0,0,0), C1,8); \
    GAPB(o[1]=__builtin_amdgcn_mfma_f32_32x32x16_bf16(PAF(3),VFR(7),o[1],0,0,0), C1,12); \
    }while(0)
  int t=1;
  #undef CMASK
  #define CMASK(P0,P1,t) do{}while(0)
  for(;t+7<NT;t+=2){
    STEP(pB0,pB1,pA0,pA1,t,true,true,true);     WAIT_BAR(2); RESC(); ROT();
    STEP(pA0,pA1,pB0,pB1,t+1,true,true,true);   WAIT_BAR(2); RESC(); ROT();
  }
  #undef CMASK
  #define CMASK(P0,P1,t) do{int jb_=(t)-(NT-4); if(jb_>=-2)biasadd(P0,P1,lutl-64*jb_); if(jb_>=0)cmask(P0,P1,jb_,qrel,hi);}while(0)
  #define ENDW(tt) do{ if((tt)+3<NT){WAIT_BAR(2);} else if((tt)+2<NT){WAIT_BAR(1);} else {WAIT_BAR(0);} }while(0)
  for(;t+1<NT;t+=2){
    STEP(pB0,pB1,pA0,pA1,t,(t+3<NT),(t+1<NT),(t+1<NT));       ENDW(t);   RESC(); ROT();
    STEP(pA0,pA1,pB0,pB1,t+1,(t+4<NT),(t+2<NT),(t+2<NT));     ENDW(t+1); RESC(); ROT();
  }
  STEP(pB0,pB1,pA0,pA1,NT-1,false,false,false); RESC();
  { float sacc=pB0[0]+pB0[1]; _Pragma("unroll") for(int r=2;r<16;++r)sacc+=pB0[r]; _Pragma("unroll") for(int r=0;r<16;++r)sacc+=pB1[r]; l_reg+=sacc;
    pw0=(u32x4){PKW(pB0,0),PKW(pB0,2),PKW(pB0,4),PKW(pB0,6)};pw1=(u32x4){PKW(pB0,8),PKW(pB0,10),PKW(pB0,12),PKW(pB0,14)};pw2=(u32x4){PKW(pB1,0),PKW(pB1,2),PKW(pB1,4),PKW(pB1,6)};pw3=(u32x4){PKW(pB1,8),PKW(pB1,10),PKW(pB1,12),PKW(pB1,14)};
    SBAR(); pv(o,vb0+sl_cur,PAF(0),PAF(1),PAF(2),PAF(3)); }
  #undef PKW
  #undef PAF
  #undef VFR
  #undef PIN
  #undef MX3
  #undef GAPA
  #undef GAPB
  #undef EX
  #undef VRD
  #undef KRD
  #undef STEP
  #undef ENDW
  {auto rr=__builtin_amdgcn_permlane32_swap(__float_as_uint(l_reg),__float_as_uint(l_reg),false,false);l_reg=__uint_as_float(rr[0])+__uint_as_float(rr[1]);}
  if(hi==0)wsf[32+r32]=l_reg;asm volatile("s_waitcnt lgkmcnt(0)":::"memory");
  float rli[16];
  #pragma unroll
  for(int r=0;r<16;++r)rli[r]=__builtin_amdgcn_rcpf(wsf[32+crow(r,hi)]);
  bf16*Ow=Oh+(long)(q0+wid*QBLK)*OPITCH;
  { bf16*stg=(bf16*)(shm+LDS_OST)+wid*2048;
    #pragma unroll
    for(int r=0;r<16;++r){const int orow=crow(r,hi);
      #pragma unroll
      for(int d0=0;d0<2;++d0)stg[orow*64+d0*32+r32]=__float2bfloat16(o[d0][r]*rli[r]);}
    asm volatile("s_waitcnt lgkmcnt(0)":::"memory");
    #pragma unroll
    for(int i=0;i<4;++i){const int row=i*8+(lane>>3),ch=lane&7; const u32x4 v=*(const u32x4*)(stg+row*64+ch*8); ATTN_STORE16(Ow+(long)row*OPITCH+ch*8,v);} }
  asm volatile("s_waitcnt lgkmcnt(0)\n\ts_barrier":::"memory");
  #undef DMA_K
  #undef DMA_V
  #undef CMASK
  #undef START
  #undef RESC
  #undef ROT
}
constexpr int ATTN_LDS_BYTES=LDS_BYTES;
#undef SBAR
#undef WAIT_BAR
}
#define XB_TMO      128
#define XB_XCNT(j)  (256  + 64 * (j))
#define XB_XSUB(j)  (1280 + 64 * (j))
#define XB_XGEN(j)  (2304 + 64 * (j))
#define XB_TOP      3328
#define XB_TOPGEN   3392
#define XCD_BAR_WORDS 3456
#define XB_SPIN_CAP (1u << 18)

__device__ __forceinline__ unsigned xb_ld(unsigned* p)              { return __hip_atomic_load(p, __ATOMIC_RELAXED, __HIP_MEMORY_SCOPE_AGENT); }
__device__ __forceinline__ unsigned xb_add(unsigned* p, unsigned v) { return __hip_atomic_fetch_add(p, v, __ATOMIC_RELAXED, __HIP_MEMORY_SCOPE_AGENT); }
__device__ __forceinline__ unsigned xb_xcc_id() { return (unsigned)__builtin_amdgcn_s_getreg((3 << 11) | 20) & 0xFu; }
#define XB_SPIN(cond, bar) do { unsigned _sp = 0; while (cond) { __builtin_amdgcn_s_sleep(1); \
    if ((++_sp & 255u) == 0u) { if (xb_ld(&(bar)[XB_TMO])) break; if (_sp > XB_SPIN_CAP) { atomicAdd(&(bar)[XB_TMO], 1u); break; } } } } while (0)

struct XcdBarrier {
    unsigned* bar; unsigned x;
    volatile LAS unsigned* st;
};

__device__ __forceinline__ XcdBarrier xcd_barrier_post(unsigned* bar, volatile LAS unsigned* st) {
    XcdBarrier b; b.bar = bar; b.x = xb_xcc_id(); b.st = st;
    if (threadIdx.x == 0) (void)xb_add(&bar[XB_XCNT(b.x)], 1u);
    return b;
}
__device__ __forceinline__ void xcd_barrier_complete(unsigned* bar, unsigned x, unsigned& nloc, unsigned& nx) {
    const unsigned G = gridDim.x * gridDim.y * gridDim.z;
    unsigned sum, cnt, mine, sp = 0u;
    for (;;) {
        sum = 0u; cnt = 0u; mine = 0u;
#pragma unroll
        for (unsigned j = 0; j < 16; ++j) { const unsigned c = xb_ld(&bar[XB_XCNT(j)]); sum += c; cnt += (c > 0u) ? 1u : 0u; mine = (j == x) ? c : mine; }
        if (sum == G) break;
        __builtin_amdgcn_s_sleep(1);
        if ((++sp & 255u) == 0u) { if (xb_ld(&bar[XB_TMO])) break; if (sp > XB_SPIN_CAP) { atomicAdd(&bar[XB_TMO], 1u); break; } }
    }
    nloc = mine > 0u ? mine : 1u; nx = cnt > 0u ? cnt : 1u;
}

__device__ __forceinline__ void xcd_barrier(const XcdBarrier& b) {
    asm volatile("s_waitcnt vmcnt(0)" ::: "memory");
    __syncthreads();
    if (threadIdx.x == 0) {
        unsigned* bar = b.bar;
        __builtin_amdgcn_s_waitcnt(0);
        unsigned nloc = b.st[0], nx = b.st[1];
        if (nloc == 0u) { xcd_barrier_complete(bar, b.x, nloc, nx); b.st[0] = nloc; b.st[1] = nx; }
        const unsigned old = xb_add(&bar[XB_XSUB(b.x)], 1u);
        const unsigned gen = old / nloc;
        if (old + 1u == (gen + 1u) * nloc) {
            __builtin_amdgcn_fence(__ATOMIC_RELEASE, "agent");
            asm volatile("s_waitcnt vmcnt(0)" ::: "memory");
            const unsigned og = xb_add(&bar[XB_TOP], 1u);
            const unsigned tg = og / nx;
            if (og + 1u == (tg + 1u) * nx) xb_add(&bar[XB_TOPGEN], 1u);
            else XB_SPIN(xb_ld(&bar[XB_TOPGEN]) == tg, bar);
            __builtin_amdgcn_fence(__ATOMIC_ACQUIRE, "agent");
            xb_add(&bar[XB_XGEN(b.x)], 1u);
            asm volatile("s_waitcnt vmcnt(0)" ::: "memory");
        } else {
            XB_SPIN(xb_ld(&bar[XB_XGEN(b.x)]) == gen, bar);
            __builtin_amdgcn_fence(__ATOMIC_ACQUIRE, "agent");
            asm volatile("s_waitcnt vmcnt(0)" ::: "memory");
        }
    }
    __syncthreads();
}
struct Args { const float* in[27]; float* out; unsigned char* ws; int ph_lo, ph_hi, li, pad; };
enum { I_X = 0, I_MEM, I_REL, I_ANORM, I_WIN, I_BGATE, I_CONV, I_ALOG, I_DTB, I_DNON, I_DAQN, I_DAKN, I_LAM, I_SUBLN, I_MEMNORM, I_WMKV, I_MXQN, I_MXKN, I_WBR, I_WOUT, I_FNORM,
       I_WR, I_BR, I_WGU, I_BGU, I_WD, I_BD };

DI void tr_item(const float* __restrict__ W, size_t ldw, int k0, int c0, bf16* WT, int K, size_t drow0, LAS float* scr, int lane) {
#pragma unroll 8
    for (int k = 0; k < 64; ++k) scr[k * 65 + lane] = W[(size_t)(k0 + k) * ldw + c0 + lane];
    LDS_WAIT();
    const int c = lane & 7;
#pragma unroll
    for (int j = 0; j < 8; ++j) { const int n = (lane >> 3) + 8 * j; const LAS float* s = scr + (8 * c) * 65 + n;
        v4u o; o.x = pk2(s[0 * 65], s[1 * 65]); o.y = pk2(s[2 * 65], s[3 * 65]); o.z = pk2(s[4 * 65], s[5 * 65]); o.w = pk2(s[6 * 65], s[7 * 65]);
        *(v4u*)(WT + (drow0 + n) * K + k0 + 8 * c) = o; }
    LDS_WAIT();
}

DI void p0_prologue(const Args& a, LAS unsigned char* lds, int vcu, int G, int wave, int lane) {
    unsigned char* ws = a.ws;
    LAS float* scr = (LAS float*)(lds + wave * 16640);
    const int gw = vcu * 8 + wave, NGW = G * 8;
    constexpr int I_IN = 16 * 112, I_GU = 16 * 32 * NEXP, I_DN = 16 * 16 * NEXP, I_BRI = 3 * 8 * 16, I_OUT = 16 * 16, I_MK = 16 * 16;
    constexpr int NITEMS = I_IN + I_GU + I_DN + I_BRI + I_OUT + I_MK;
    for (int it = gw; it < NITEMS; it += NGW) {
        int r = it;
        if (r < I_GU) { const int e = r / 512, q = r % 512, kb = q / 32, nb = q % 32; const int n0 = nb * 64, pn = n0 >> 8, bj = (n0 >> 7) & 1, i0 = n0 & 127;
            tr_item(a.in[I_WGU] + (size_t)e * 1024 * 2048, 2048, kb * 64, bj * 1024 + 128 * pn + i0, (bf16*)(ws + WS_WGU), 1024, (size_t)e * 2048 + n0, scr, lane); continue; } r -= I_GU;
        if (r < I_DN) { const int e = r / 256, q = r % 256, kb = q / 16, nb = q % 16;
            tr_item(a.in[I_WD] + (size_t)e * 1024 * 1024, 1024, kb * 64, nb * 64, (bf16*)(ws + WS_WD), 1024, (size_t)e * 1024 + nb * 64, scr, lane); continue; } r -= I_DN;
        if (r < I_IN) { const int kb = r / 112, nb = r % 112; const int n0 = nb * 64;
            tr_item(a.in[I_WIN], INW, kb * 64, n0 < 2048 ? n0 : n0 + 8, (bf16*)(ws + WS_WIN), 1024, (size_t)n0, scr, lane); continue; } r -= I_IN;
        if (r < I_BRI) { const int br = r / 128, q = r % 128, kb = q / 16, nb = q % 16;
            tr_item(a.in[I_WBR] + (size_t)br * 512 * 1024, 1024, kb * 64, nb * 64, (bf16*)(ws + WS_WB), 512, (size_t)br * 1024 + nb * 64, scr, lane); continue; } r -= I_BRI;
        if (r < I_OUT) { const int kb = r / 16, nb = r % 16;
            tr_item(a.in[I_WOUT], 1024, kb * 64, nb * 64, (bf16*)(ws + WS_WOUT), 1024, (size_t)nb * 64, scr, lane); continue; } r -= I_OUT;
        { const int kb = r / 16, nb = r % 16;
            tr_item(a.in[I_WMKV], 1024, kb * 64, nb * 64, (bf16*)(ws + WS_WMKV), 1024, (size_t)nb * 64, scr, lane); }
    }
    {
        const float* win = a.in[I_WIN];
        f32x4 gv[4];
#pragma unroll
        for (int j = 0; j < 4; ++j) gv[j] = ((const f32x4*)a.in[I_ANORM])[lane + 64 * j];
        f32x4 wa[4][4], wb[4][4];
#pragma unroll
        for (int j = 0; j < 4; ++j)
#pragma unroll
            for (int c = 0; c < 4; ++c) { const f32x4* p = (const f32x4*)(win + (size_t)(4 * lane + 256 * j + c) * INW + 2048); wa[j][c] = p[0]; wb[j][c] = p[1]; }
        const float alog = a.in[I_ALOG][lane & 3], dtb = a.in[I_DTB][lane & 3];
        float* G_ = (float*)(ws + WS_G); float* B_ = (float*)(ws + WS_BETA);
        bf16* H = (bf16*)(ws + WS_H);
        for (int m = gw; m < T; m += NGW) {
            const f32x4* xr = (const f32x4*)(a.in[I_X] + (size_t)m * D) + lane;
            f32x4 v[4]; float ss = 0.f;
#pragma unroll
            for (int j = 0; j < 4; ++j) { v[j] = xr[64 * j]; ss += (v[j].x * v[j].x + v[j].y * v[j].y) + (v[j].z * v[j].z + v[j].w * v[j].w); }
            const float rstd = rsqrtf(wave_sum(ss) * (1.f / D) + EPS);
            f32x4 pa = {0.f, 0.f, 0.f, 0.f}, pb = {0.f, 0.f, 0.f, 0.f};
            unsigned long long* o8 = (unsigned long long*)(H + (size_t)m * D) + lane;
#pragma unroll
            for (int j = 0; j < 4; ++j) { v[j] = v[j] * rstd * gv[j];
                o8[64 * j] = (unsigned long long)pk2(v[j].x, v[j].y) | ((unsigned long long)pk2(v[j].z, v[j].w) << 32);
                pa += wa[j][0] * v[j].x + wa[j][1] * v[j].y + wa[j][2] * v[j].z + wa[j][3] * v[j].w;
                pb += wb[j][0] * v[j].x + wb[j][1] * v[j].y + wb[j][2] * v[j].z + wb[j][3] * v[j].w; }
            pa.x = wave_sum(pa.x); pa.y = wave_sum(pa.y); pa.z = wave_sum(pa.z); pa.w = wave_sum(pa.w);
            pb.x = wave_sum(pb.x); pb.y = wave_sum(pb.y); pb.z = wave_sum(pb.z); pb.w = wave_sum(pb.w);
            if (lane < 4) {
                const float av = lane == 0 ? pa.x : lane == 1 ? pa.y : lane == 2 ? pa.z : pa.w;
                const float bv = lane == 0 ? pb.x : lane == 1 ? pb.y : lane == 2 ? pb.z : pb.w;
                const float z = av + dtb; const float sp = z > 20.f ? z : log1pf(expf(z));
                G_[(size_t)m * 4 + lane] = -expf(alog) * sp;
                B_[(size_t)m * 4 + lane] = 1.f / (1.f + expf(-bv));
            }
        }
    }
    {
        f32x4 gv[4];
#pragma unroll
        for (int j = 0; j < 4; ++j) gv[j] = ((const f32x4*)a.in[I_MEMNORM])[lane + 64 * j];
        bf16* MN = (bf16*)(ws + WS_MEMN);
        for (int m = gw; m < BATCH * NMEM; m += NGW) {
            const f32x4* xr = (const f32x4*)(a.in[I_MEM] + (size_t)m * D) + lane;
            f32x4 v[4]; float ss = 0.f;
#pragma unroll
            for (int j = 0; j < 4; ++j) { v[j] = xr[64 * j]; ss += (v[j].x * v[j].x + v[j].y * v[j].y) + (v[j].z * v[j].z + v[j].w * v[j].w); }
            const float rstd = rsqrtf(wave_sum(ss) * (1.f / D) + EPS);
            unsigned long long* o8 = (unsigned long long*)(MN + (size_t)m * D) + lane;
#pragma unroll
            for (int j = 0; j < 4; ++j) { v[j] = v[j] * rstd * gv[j]; o8[64 * j] = (unsigned long long)pk2(v[j].x, v[j].y) | ((unsigned long long)pk2(v[j].z, v[j].w) << 32); }
        }
    }
}

struct EpiP {
    static constexpr bool PERM = true;
    bf16* O; const float* b_gate;
    DI void operator()(const f32x4 (&acc)[2][2][4][2], const pg8::Unit& u, int wr, int wc, int fr, int fq) const {
        const int row0 = u.pm * 256 + wr * 64 + fr, col0 = u.pn * 256 + wc * 32 + 8 * fq;
        const bool isg = u.pn >= 16;
        f32x4 bv[2][2];
#pragma unroll
        for (int bj = 0; bj < 2; ++bj)
#pragma unroll
            for (int n = 0; n < 2; ++n) bv[bj][n] = isg ? *(const f32x4*)(b_gate + (col0 - P_GATE) + bj * 128 + 4 * n) : (f32x4){0.f, 0.f, 0.f, 0.f};
#pragma unroll
        for (int ai = 0; ai < 2; ++ai)
#pragma unroll
            for (int m = 0; m < 4; ++m) { bf16* rowp = O + (size_t)(row0 + ai * 128 + m * 16) * PW + col0;
#pragma unroll
                for (int bj = 0; bj < 2; ++bj) { f32x4 v0 = acc[ai][bj][m][0] + bv[bj][0], v1 = acc[ai][bj][m][1] + bv[bj][1];
                    if (isg) { v0.x = sigmoidf_(v0.x); v0.y = sigmoidf_(v0.y); v0.z = sigmoidf_(v0.z); v0.w = sigmoidf_(v0.w);
                               v1.x = sigmoidf_(v1.x); v1.y = sigmoidf_(v1.y); v1.z = sigmoidf_(v1.z); v1.w = sigmoidf_(v1.w); }
                    v4u w; w.x = pk2(v0.x, v0.y); w.y = pk2(v0.z, v0.w); w.z = pk2(v1.x, v1.y); w.w = pk2(v1.z, v1.w);
                    *(v4u*)(rowp + bj * 128) = w; } }
    }
};
struct EpiPlain {
    static constexpr bool PERM = true;
    bf16* O; int ldc;
    DI void operator()(const f32x4 (&acc)[2][2][4][2], const pg8::Unit& u, int wr, int wc, int fr, int fq) const {
        const int row0 = u.pm * 256 + wr * 64 + fr, col0 = u.pn * 256 + wc * 32 + 8 * fq;
#pragma unroll
        for (int ai = 0; ai < 2; ++ai)
#pragma unroll
            for (int m = 0; m < 4; ++m) { bf16* rowp = O + (size_t)(row0 + ai * 128 + m * 16) * ldc + col0;
#pragma unroll
                for (int bj = 0; bj < 2; ++bj) { const f32x4 v0 = acc[ai][bj][m][0], v1 = acc[ai][bj][m][1];
                    v4u w; w.x = pk2(v0.x, v0.y); w.y = pk2(v0.z, v0.w); w.z = pk2(v1.x, v1.y); w.w = pk2(v1.z, v1.w);
                    *(v4u*)(rowp + bj * 128) = w; } }
    }
};

DI void p2_norm_rows(const Args& a, int vcu, int G, int wave, int lane) {
    unsigned char* ws = a.ws; bf16* P = (bf16*)(ws + WS_P);
    const int gw = vcu * 8 + wave, NGW = G * 8;
    float gda[16], gmx[8], gmk[8];
    { const float* gsrc = (lane < 32 ? a.in[I_DAQN] : a.in[I_DAKN]) + 16 * (lane & 3);
#pragma unroll
      for (int i = 0; i < 16; ++i) gda[i] = gsrc[i];
#pragma unroll
      for (int i = 0; i < 8; ++i) { gmx[i] = a.in[I_MXQN][8 * (lane & 15) + i]; gmk[i] = a.in[I_MXKN][8 * (lane & 15) + i]; } }
    const float sc_da = lane < 32 ? 0.125f * LOG2E : 1.f;
    const float sc_mx = 0.08838834764831845f * LOG2E;
    for (int m = gw; m < T; m += NGW) {
        { v4u* p = (v4u*)(P + (size_t)m * PW + P_DAQ + 16 * lane); v4u w0 = p[0], w1 = p[1];
          float f[16]; f[0] = bflo(w0.x); f[1] = bfhi(w0.x); f[2] = bflo(w0.y); f[3] = bfhi(w0.y); f[4] = bflo(w0.z); f[5] = bfhi(w0.z); f[6] = bflo(w0.w); f[7] = bfhi(w0.w);
          f[8] = bflo(w1.x); f[9] = bfhi(w1.x); f[10] = bflo(w1.y); f[11] = bfhi(w1.y); f[12] = bflo(w1.z); f[13] = bfhi(w1.z); f[14] = bflo(w1.w); f[15] = bfhi(w1.w);
          float ss = 0.f;
#pragma unroll
          for (int i = 0; i < 16; ++i) ss += f[i] * f[i];
          ss += __shfl_xor(ss, 1); ss += __shfl_xor(ss, 2);
          const float r = rsqrtf(ss * (1.f / 64.f) + EPS) * sc_da;
#pragma unroll
          for (int i = 0; i < 16; ++i) f[i] = f[i] * r * gda[i];
          w0.x = pk2(f[0], f[1]); w0.y = pk2(f[2], f[3]); w0.z = pk2(f[4], f[5]); w0.w = pk2(f[6], f[7]);
          w1.x = pk2(f[8], f[9]); w1.y = pk2(f[10], f[11]); w1.z = pk2(f[12], f[13]); w1.w = pk2(f[14], f[15]);
          p[0] = w0; p[1] = w1; }
        { v4u* p = (v4u*)(P + (size_t)m * PW + P_MXQ + 8 * lane); v4u w0 = p[0];
          float f[8]; f[0] = bflo(w0.x); f[1] = bfhi(w0.x); f[2] = bflo(w0.y); f[3] = bfhi(w0.y); f[4] = bflo(w0.z); f[5] = bfhi(w0.z); f[6] = bflo(w0.w); f[7] = bfhi(w0.w);
          float ss = 0.f;
#pragma unroll
          for (int i = 0; i < 8; ++i) ss += f[i] * f[i];
          ss += __shfl_xor(ss, 1); ss += __shfl_xor(ss, 2); ss += __shfl_xor(ss, 4); ss += __shfl_xor(ss, 8);
          const float r = rsqrtf(ss * (1.f / 128.f) + EPS) * sc_mx;
#pragma unroll
          for (int i = 0; i < 8; ++i) f[i] = f[i] * r * gmx[i];
          w0.x = pk2(f[0], f[1]); w0.y = pk2(f[2], f[3]); w0.z = pk2(f[4], f[5]); w0.w = pk2(f[6], f[7]);
          p[0] = w0; }
    }
    bf16* MKV = (bf16*)(ws + WS_MKV);
    for (int m = gw; m < BATCH * NMEM; m += NGW) {
        v4u* p = (v4u*)(MKV + (size_t)m * 1024 + 8 * lane); v4u w0 = p[0];
        float f[8]; f[0] = bflo(w0.x); f[1] = bfhi(w0.x); f[2] = bflo(w0.y); f[3] = bfhi(w0.y); f[4] = bflo(w0.z); f[5] = bfhi(w0.z); f[6] = bflo(w0.w); f[7] = bfhi(w0.w);
        float ss = 0.f;
#pragma unroll
        for (int i = 0; i < 8; ++i) ss += f[i] * f[i];
        ss += __shfl_xor(ss, 1); ss += __shfl_xor(ss, 2); ss += __shfl_xor(ss, 4); ss += __shfl_xor(ss, 8);
        const float r = rsqrtf(ss * (1.f / 128.f) + EPS);
#pragma unroll
        for (int i = 0; i < 8; ++i) f[i] = f[i] * r * gmk[i];
        w0.x = pk2(f[0], f[1]); w0.y = pk2(f[2], f[3]); w0.z = pk2(f[4], f[5]); w0.w = pk2(f[6], f[7]);
        p[0] = w0;
    }
}

constexpr int PREP_GC = 0, PREP_BETA = 256, PREP_QS = 1024, PREP_KS = PREP_QS + 64 * 272, PREP_LM = PREP_KS + 64 * 272, PREP_RHS = PREP_LM + 64 * 64 * 4, PREP_END = PREP_RHS + 64 * 256 * 4;
static_assert(PREP_END <= RING_BYTES, "prep LDS");
DI void dn_prep_unit(const Args& a, LAS unsigned char* lds, int ck, int tid_in, int wave, int lane_in) {
    const int tid = fresh_tid(), lane = tid & 63; (void)tid_in; (void)lane_in;
    unsigned char* ws = a.ws; const bf16* P = (const bf16*)(ws + WS_P);
    const int n = ck & 127, h = (ck >> 7) & 3, b = ck >> 9;
    const size_t t0 = (size_t)b * SEQ + (size_t)n * 64;
    LAS float* gc = (LAS float*)(lds + PREP_GC); LAS float* bet = (LAS float*)(lds + PREP_BETA);
    LAS float* Lm = (LAS float*)(lds + PREP_LM); LAS float* RHS = (LAS float*)(lds + PREP_RHS);
    if (wave == 0) {
        float v = ((const float*)(ws + WS_G))[(t0 + lane) * 4 + h];
#pragma unroll
        for (int o = 1; o < 64; o <<= 1) { const float u = __shfl_up(v, o); if (lane >= o) v += u; }
        gc[lane] = v; bet[lane] = ((const float*)(ws + WS_BETA))[(t0 + lane) * 4 + h];
    }
    __syncthreads();
    if (wave < 6) {
        const int part = wave >> 1, rg = (tid >> 4) & 7, cg = tid & 15, i0 = rg * 8;
        const int ch0 = part * 512 + h * 128 + cg * 8;
        float w[4][8];
#pragma unroll
        for (int j = 0; j < 4; ++j) { const f32x4* p = (const f32x4*)(a.in[I_CONV] + j * 1536 + ch0); const f32x4 w0 = p[0], w1 = p[1];
            w[j][0] = w0.x; w[j][1] = w0.y; w[j][2] = w0.z; w[j][3] = w0.w; w[j][4] = w1.x; w[j][5] = w1.y; w[j][6] = w1.z; w[j][7] = w1.w; }
        v4u xin[11];
        const bf16* xp = P + ((long)b * SEQ + n * 64 + i0 - 3) * PW + ch0;
        asm volatile("" : "+v"(xp));
#pragma unroll
        for (int jj = 0; jj < 11; ++jj) { const int s = n * 64 + i0 - 3 + jj;
            xin[jj] = (s >= 0) ? *(const GAS v4u*)(xp + (long)jj * PW) : (v4u){0u, 0u, 0u, 0u}; }
        float o[8][8];
#pragma unroll
        for (int ri = 0; ri < 8; ++ri) {
            float acc[8];
#pragma unroll
            for (int c = 0; c < 8; ++c) acc[c] = 0.f;
#pragma unroll
            for (int j = 0; j < 4; ++j) { const v4u x = xin[ri + j];
                acc[0] += w[j][0] * bflo(x.x); acc[1] += w[j][1] * bfhi(x.x); acc[2] += w[j][2] * bflo(x.y); acc[3] += w[j][3] * bfhi(x.y);
                acc[4] += w[j][4] * bflo(x.z); acc[5] += w[j][5] * bfhi(x.z); acc[6] += w[j][6] * bflo(x.w); acc[7] += w[j][7] * bfhi(x.w); }
            float ss = 0.f;
#pragma unroll
            for (int c = 0; c < 8; ++c) { const float s_ = acc[c] * sigmoidf_(acc[c]); o[ri][c] = s_; ss += s_ * s_; }
            ss += __shfl_xor(ss, 1); ss += __shfl_xor(ss, 2); ss += __shfl_xor(ss, 4); ss += __shfl_xor(ss, 8);
            const float nrm = part == 0 ? rsqrtf(ss + EPS) * 0.08838834764831845f : part == 1 ? rsqrtf(ss + EPS) : 1.f;
#pragma unroll
            for (int c = 0; c < 8; ++c) o[ri][c] *= nrm;
        }
        bf16* qdp = (bf16*)(ws + WS_QD) + (t0 + i0) * 512 + h * 128 + cg * 8;
        asm volatile("" : "+v"(qdp));
#pragma unroll
        for (int ri = 0; ri < 8; ++ri) {
            const int row = i0 + ri; const float g_ = gc[row], be = bet[row];
            if (part == 0) {
                v4u wq; wq.x = pk2(o[ri][0], o[ri][1]); wq.y = pk2(o[ri][2], o[ri][3]); wq.z = pk2(o[ri][4], o[ri][5]); wq.w = pk2(o[ri][6], o[ri][7]);
                *(LAS v4u*)(lds + PREP_QS + row * 272 + cg * 16) = wq;
                const float eg = fast_exp(g_);
                v4u wd; wd.x = pk2(o[ri][0] * eg, o[ri][1] * eg); wd.y = pk2(o[ri][2] * eg, o[ri][3] * eg); wd.z = pk2(o[ri][4] * eg, o[ri][5] * eg); wd.w = pk2(o[ri][6] * eg, o[ri][7] * eg);
                *(GAS v4u*)(qdp + ri * 512) = wd;
            } else if (part == 1) {
                v4u wq; wq.x = pk2(o[ri][0], o[ri][1]); wq.y = pk2(o[ri][2], o[ri][3]); wq.z = pk2(o[ri][4], o[ri][5]); wq.w = pk2(o[ri][6], o[ri][7]);
                *(LAS v4u*)(lds + PREP_KS + row * 272 + cg * 16) = wq;
                const float f = be * fast_exp(g_);
                LAS f32x4* r4 = (LAS f32x4*)(RHS + row * 256 + 128 + cg * 8);
                r4[0] = (f32x4){o[ri][0] * f, o[ri][1] * f, o[ri][2] * f, o[ri][3] * f}; r4[1] = (f32x4){o[ri][4] * f, o[ri][5] * f, o[ri][6] * f, o[ri][7] * f};
            } else {
                LAS f32x4* r4 = (LAS f32x4*)(RHS + row * 256 + cg * 8);
                r4[0] = (f32x4){o[ri][0] * be, o[ri][1] * be, o[ri][2] * be, o[ri][3] * be}; r4[1] = (f32x4){o[ri][4] * be, o[ri][5] * be, o[ri][6] * be, o[ri][7] * be};
            }
        }
    }
    __syncthreads();
    {
        const int sel = wave >> 2, it = (wave >> 1) & 1, jt = wave & 1, r = lane & 31, hh = lane >> 5;
        const LAS unsigned char* Ab = lds + (sel ? PREP_QS : PREP_KS) + (32 * it + r) * 272 + hh * 16;
        const LAS unsigned char* Bb = lds + PREP_KS + (32 * jt + r) * 272 + hh * 16;
        f32x16 acc = {};
#pragma unroll
        for (int s = 0; s < 8; ++s) { const bf16x8 av = *(const LAS bf16x8*)(Ab + s * 32), bv = *(const LAS bf16x8*)(Bb + s * 32);
            acc = __builtin_amdgcn_mfma_f32_32x32x16_bf16(av, bv, acc, 0, 0, 0); }
        const int col = 32 * jt + r; const float gcol = gc[col];
        bf16* QKB = (bf16*)(ws + WS_QK) + (size_t)ck * 4096;
#pragma unroll
        for (int i = 0; i < 16; ++i) { const int row = 32 * it + crow(i, hh);
            const float dec = fast_exp(col <= row ? gc[row] - gcol : 0.f);
            if (sel == 0) Lm[row * 64 + col] = (col < row) ? acc[i] * dec * bet[row] : 0.f;
            else QKB[row * 64 + col] = (bf16)f2bf((col <= row) ? acc[i] * dec : 0.f); }
    }
    __syncthreads();
    if (wave < 4) {
        const int c = tid;
        float sv[64];
#pragma unroll
        for (int i = 0; i < 64; ++i) sv[i] = RHS[i * 256 + c];
#pragma unroll
        for (int i = 1; i < 64; ++i) {
            float acc = sv[i];
#pragma unroll
            for (int jq = 0; jq < (i + 3) / 4; ++jq) { const f32x4 l4 = *(const LAS f32x4*)(Lm + i * 64 + 4 * jq);
                if (4 * jq + 0 < i) acc -= l4.x * sv[4 * jq + 0];
                if (4 * jq + 1 < i) acc -= l4.y * sv[4 * jq + 1];
                if (4 * jq + 2 < i) acc -= l4.z * sv[4 * jq + 2];
                if (4 * jq + 3 < i) acc -= l4.w * sv[4 * jq + 3]; }
            sv[i] = acc;
        }
#pragma unroll
        for (int i = 1; i < 64; ++i) RHS[i * 256 + c] = sv[i];
    } else {
        const int q = tid - 256, kd = q & 127, half = q >> 7;
        const float gl = gc[63];
        bf16* KDT = (bf16*)(ws + WS_KDT) + (size_t)ck * 8192 + kd * 64 + half * 32;
#pragma unroll
        for (int c8 = 0; c8 < 4; ++c8) { float f[8];
#pragma unroll
            for (int j = 0; j < 8; ++j) { const int c = 32 * half + 8 * c8 + j; f[j] = bf2f(*(const LAS bf16*)(lds + PREP_KS + c * 272 + kd * 2)) * fast_exp(gl - gc[c]); }
            v4u w; w.x = pk2(f[0], f[1]); w.y = pk2(f[2], f[3]); w.z = pk2(f[4], f[5]); w.w = pk2(f[6], f[7]);
            *(v4u*)(KDT + 8 * c8) = w; }
        if (q == 0) ((float*)(ws + WS_EGL))[ck] = fast_exp(gl);
    }
    __syncthreads();
    {
        const int row = tid >> 3, seg = tid & 7;
        const LAS f32x4* s4 = (const LAS f32x4*)(RHS + row * 256 + seg * 32);
        const float sg = seg < 4 ? 1.f : -1.f;
        bf16* dst = (bf16*)(ws + (seg < 4 ? WS_U : WS_NW)) + (t0 + row) * 512 + h * 128 + (seg & 3) * 32;
#pragma unroll
        for (int q = 0; q < 4; ++q) { const f32x4 x0 = s4[2 * q] * sg, x1 = s4[2 * q + 1] * sg;
            v4u w; w.x = pk2(x0.x, x0.y); w.y = pk2(x0.z, x0.w); w.z = pk2(x1.x, x1.y); w.w = pk2(x1.z, x1.w);
            *(v4u*)(dst + 8 * q) = w; }
    }
    __syncthreads();
}

constexpr int SCAN_ST = 0, SCAN_VN = 2 * 32 * 272, SCAN_END = SCAN_VN + 2 * 32 * 144;
struct ScanFrag { bf16x8 a0[8]; bf16x8 a1[4]; bf16x8 a3[4]; float egl; };
DI void dn_scan(const Args& a, LAS unsigned char* lds, int j, int wave, int lane) {
    unsigned char* ws = a.ws;
    const int grp = wave >> 2, w4 = wave & 3, task = 2 * j + grp, bh = task >> 2, vs = task & 3, b = bh >> 2, h = bh & 3;
    const int r = lane & 31, hh = lane >> 5;
    LAS unsigned char* ST = lds + SCAN_ST + grp * (32 * 272); LAS unsigned char* VN = lds + SCAN_VN + grp * (32 * 144);
    const bf16* A0 = (const bf16*)(ws + (w4 < 2 ? WS_NW : WS_QD)); const bf16* U = (const bf16*)(ws + WS_U);
    const bf16* KDT = (const bf16*)(ws + WS_KDT); const bf16* QKB = (const bf16*)(ws + WS_QK); const float* EGL = (const float*)(ws + WS_EGL);
    bf16* ODN = (bf16*)(ws + WS_ODN);
    bf16x8 bI[2];
#pragma unroll
    for (int s = 0; s < 2; ++s)
#pragma unroll
        for (int jj = 0; jj < 8; ++jj) bI[s][jj] = (16 * s + 8 * hh + jj == r) ? (short)0x3F80 : (short)0;
    f32x16 sacc = {};
    const int ct = w4 & 1;
#define SCAN_LOAD(F, n_) do { const int n__ = (n_) < SEQ / 64 ? (n_) : SEQ / 64 - 1; const int ck_ = bh * 128 + n__; const size_t t0_ = (size_t)b * SEQ + (size_t)n__ * 64; \
        const size_t arow_ = (t0_ + 32 * ct + r) * 512 + h * 128 + 8 * hh; \
        _Pragma("unroll") for (int s = 0; s < 8; ++s) F.a0[s] = *(const bf16x8*)(A0 + arow_ + 16 * s); \
        if (w4 < 2) { _Pragma("unroll") for (int s = 0; s < 2; ++s) F.a1[s] = *(const bf16x8*)(U + arow_ + vs * 32 + 16 * s); } \
        else { _Pragma("unroll") for (int s = 0; s < 4; ++s) F.a1[s] = *(const bf16x8*)(QKB + ((size_t)ck_ * 64 + 32 * ct + r) * 64 + 8 * hh + 16 * s); } \
        _Pragma("unroll") for (int s = 0; s < 4; ++s) F.a3[s] = *(const bf16x8*)(KDT + ((size_t)ck_ * 128 + 32 * w4 + r) * 64 + 8 * hh + 16 * s); \
        F.egl = EGL[ck_]; } while (0)
#define SCAN_STEP(F, n_) do { const size_t t0_ = (size_t)b * SEQ + (size_t)(n_) * 64; \
        _Pragma("unroll") for (int g = 0; g < 4; ++g) { v2u w; w.x = pk2(sacc[4 * g], sacc[4 * g + 1]); w.y = pk2(sacc[4 * g + 2], sacc[4 * g + 3]); \
            *(LAS v2u*)(ST + r * 272 + (32 * w4 + 8 * g + 4 * hh) * 2) = w; } \
        LDS_WAIT(); __builtin_amdgcn_s_barrier(); \
        f32x16 acc = {}, acc2 = {}; \
        if (w4 < 2) { acc = __builtin_amdgcn_mfma_f32_32x32x16_bf16(F.a1[0], bI[0], acc, 0, 0, 0); acc2 = __builtin_amdgcn_mfma_f32_32x32x16_bf16(F.a1[1], bI[1], acc2, 0, 0, 0); } \
        _Pragma("unroll") for (int s = 0; s < 8; s += 2) { const bf16x8 b0 = *(const LAS bf16x8*)(ST + r * 272 + (16 * s + 8 * hh) * 2), b1 = *(const LAS bf16x8*)(ST + r * 272 + (16 * s + 16 + 8 * hh) * 2); \
            acc = __builtin_amdgcn_mfma_f32_32x32x16_bf16(F.a0[s], b0, acc, 0, 0, 0); acc2 = __builtin_amdgcn_mfma_f32_32x32x16_bf16(F.a0[s + 1], b1, acc2, 0, 0, 0); } \
        acc += acc2; \
        if (w4 < 2) { _Pragma("unroll") for (int g = 0; g < 4; ++g) { v2u w; w.x = pk2(acc[4 * g], acc[4 * g + 1]); w.y = pk2(acc[4 * g + 2], acc[4 * g + 3]); \
            *(LAS v2u*)(VN + r * 144 + (32 * ct + 8 * g + 4 * hh) * 2) = w; } } \
        LDS_WAIT(); __builtin_amdgcn_s_barrier(); \
        bf16x8 bv[4]; _Pragma("unroll") for (int s = 0; s < 4; ++s) bv[s] = *(const LAS bf16x8*)(VN + r * 144 + (16 * s + 8 * hh) * 2); \
        _Pragma("unroll") for (int i = 0; i < 16; ++i) sacc[i] *= F.egl; \
        _Pragma("unroll") for (int s = 0; s < 4; ++s) sacc = __builtin_amdgcn_mfma_f32_32x32x16_bf16(F.a3[s], bv[s], sacc, 0, 0, 0); \
        if (w4 >= 2) { _Pragma("unroll") for (int s = 0; s < 4; ++s) acc = __builtin_amdgcn_mfma_f32_32x32x16_bf16(F.a1[s], bv[s], acc, 0, 0, 0); \
            _Pragma("unroll") for (int i = 0; i < 16; ++i) ODN[(t0_ + 32 * ct + crow(i, hh)) * 512 + h * 128 + vs * 32 + r] = (bf16)f2bf(acc[i]); } \
    } while (0)
    ScanFrag FA, FB;
    SCAN_LOAD(FA, 0);
    for (int n = 0; n < SEQ / 64; n += 2) {
        SCAN_LOAD(FB, n + 1);
        SCAN_STEP(FA, n);
        SCAN_LOAD(FA, n + 2);
        SCAN_STEP(FB, n + 1);
    }
#undef SCAN_LOAD
#undef SCAN_STEP
    __syncthreads();
}
constexpr int MX_K = 0, MX_V = 65536;
DI void mx_unit(const Args& a, LAS unsigned char* lds, int bh, int qb, int tid, int wave, int lane) {
    unsigned char* ws = a.ws; const int b = bh >> 2, h = bh & 3;
    const bf16* MKV = (const bf16*)(ws + WS_MKV) + (size_t)b * NMEM * 1024 + h * 128;
#pragma unroll
    for (int i = 0; i < 8; ++i) { const int q = tid + 512 * i, row = q >> 4, ch = q & 15;
        const v4u kv = *(const v4u*)(MKV + (size_t)row * 1024 + ch * 8), vv = *(const v4u*)(MKV + (size_t)row * 1024 + 512 + ch * 8);
        *(LAS v4u*)(lds + MX_K + row * 256 + ((ch ^ (row & 7)) * 16)) = kv; *(LAS v4u*)(lds + MX_V + row * 256 + ch * 16) = vv; }
    const int r = lane & 31, hh = lane >> 5;
    const size_t qrow = (size_t)b * SEQ + (size_t)qb * 256 + wave * 32;
    const bf16* Q = (const bf16*)(ws + WS_P) + (qrow + r) * PW + P_MXQ + h * 128;
    bf16x8 qf[8];
#pragma unroll
    for (int s = 0; s < 8; ++s) qf[s] = *(const bf16x8*)(Q + 16 * s + 8 * hh);
    __syncthreads();
    float mx = -INFINITY;
#pragma unroll 1
    for (int kt = 0; kt < 8; ++kt) { f32x16 acc = {}; const int row = 32 * kt + r;
#pragma unroll
        for (int s = 0; s < 8; ++s) { const bf16x8 kf = *(const LAS bf16x8*)(lds + MX_K + row * 256 + (((2 * s + hh) ^ (row & 7)) * 16));
            acc = __builtin_amdgcn_mfma_f32_32x32x16_bf16(kf, qf[s], acc, 0, 0, 0); }
#pragma unroll
        for (int i = 0; i < 16; ++i) mx = fmaxf(mx, acc[i]); }
    mx = fmaxf(mx, __shfl_xor(mx, 32));
    float sum = 0.f;
    f32x16 o[4] = {};
    const int g16 = lane >> 4, i16 = lane & 15, qq = i16 >> 2, pp = i16 & 3;
    const LAS unsigned char* vb = lds + MX_V + (4 * hh + qq) * 256 + (16 * (g16 & 1) + 4 * pp) * 2;
#pragma unroll 1
    for (int kt = 0; kt < 8; ++kt) { f32x16 st = {}; const int row = 32 * kt + r;
#pragma unroll
        for (int s = 0; s < 8; ++s) { const bf16x8 kf = *(const LAS bf16x8*)(lds + MX_K + row * 256 + (((2 * s + hh) ^ (row & 7)) * 16));
            st = __builtin_amdgcn_mfma_f32_32x32x16_bf16(kf, qf[s], st, 0, 0, 0); }
#pragma unroll
        for (int i = 0; i < 16; ++i) { const float p = __builtin_amdgcn_exp2f(st[i] - mx); st[i] = p; sum += p; }
#pragma unroll
        for (int s2 = 0; s2 < 2; ++s2) {
            v4u pw; pw.x = pk2(st[8 * s2 + 0], st[8 * s2 + 1]); pw.y = pk2(st[8 * s2 + 2], st[8 * s2 + 3]); pw.z = pk2(st[8 * s2 + 4], st[8 * s2 + 5]); pw.w = pk2(st[8 * s2 + 6], st[8 * s2 + 7]);
            const bf16x8 pa = __builtin_bit_cast(bf16x8, pw);
#pragma unroll
            for (int dt = 0; dt < 4; ++dt) {
                const LAS unsigned char* vp = vb + (32 * kt + 16 * s2) * 256 + dt * 64;
                const s16x4 lo = __builtin_bit_cast(s16x4, __builtin_amdgcn_ds_read_tr16_b64_v4i16((LAS s16x4*)vp));
                const s16x4 hi = __builtin_bit_cast(s16x4, __builtin_amdgcn_ds_read_tr16_b64_v4i16((LAS s16x4*)(vp + 8 * 256)));
                const bf16x8 vf = {lo[0], lo[1], lo[2], lo[3], hi[0], hi[1], hi[2], hi[3]};
                o[dt] = __builtin_amdgcn_mfma_f32_32x32x16_bf16(pa, vf, o[dt], 0, 0, 0);
            }
        }
    }
    sum += __shfl_xor(sum, 32);
    LAS float* wsc = (LAS float*)(lds + LWSC_OFF + wave * 256);
    if (hh == 0) wsc[r] = __builtin_amdgcn_rcpf(sum);
    LDS_WAIT();
    bf16* O = (bf16*)(ws + WS_OMX) + qrow * 512 + h * 128;
#pragma unroll
    for (int i = 0; i < 16; ++i) { const int qr_ = crow(i, hh); const float rl = wsc[qr_];
#pragma unroll
        for (int dt = 0; dt < 4; ++dt) O[(size_t)qr_ * 512 + dt * 32 + r] = (bf16)f2bf(o[dt][i] * rl); }
    __syncthreads();
}

DI void p4_norm_rows(const Args& a, int vcu, int G, int wave, int lane) {
    unsigned char* ws = a.ws; const int gw = vcu * 8 + wave, NGW = G * 8;
    const float* lp = a.in[I_LAM];
    const float l1 = wave_sum(lp[lane] * lp[64 + lane]), l2 = wave_sum(lp[128 + lane] * lp[192 + lane]);
    const float lam_init = 0.2f, lam = expf(l1) - expf(l2) + lam_init;
    float gdn[8], gda[8];
#pragma unroll
    for (int i = 0; i < 8; ++i) { gdn[i] = a.in[I_DNON][8 * (lane & 15) + i]; gda[i] = a.in[I_SUBLN][8 * (lane & 15) + i] * (1.f - lam_init); }
    const bf16* P = (const bf16*)(ws + WS_P);
    for (int m = gw; m < T; m += NGW) {
        { const v4u w0 = *(const v4u*)((const bf16*)(ws + WS_ODN) + (size_t)m * 512 + 8 * lane), z0 = *(const v4u*)(P + (size_t)m * PW + P_DNZ + 8 * lane);
          float f[8], z[8]; f[0] = bflo(w0.x); f[1] = bfhi(w0.x); f[2] = bflo(w0.y); f[3] = bfhi(w0.y); f[4] = bflo(w0.z); f[5] = bfhi(w0.z); f[6] = bflo(w0.w); f[7] = bfhi(w0.w);
          z[0] = bflo(z0.x); z[1] = bfhi(z0.x); z[2] = bflo(z0.y); z[3] = bfhi(z0.y); z[4] = bflo(z0.z); z[5] = bfhi(z0.z); z[6] = bflo(z0.w); z[7] = bfhi(z0.w);
          float ss = 0.f;
#pragma unroll
          for (int i = 0; i < 8; ++i) ss += f[i] * f[i];
          ss += __shfl_xor(ss, 1); ss += __shfl_xor(ss, 2); ss += __shfl_xor(ss, 4); ss += __shfl_xor(ss, 8);
          const float r = rsqrtf(ss * (1.f / 128.f) + EPS);
#pragma unroll
          for (int i = 0; i < 8; ++i) f[i] = f[i] * r * gdn[i] * (z[i] * sigmoidf_(z[i]));
          v4u o; o.x = pk2(f[0], f[1]); o.y = pk2(f[2], f[3]); o.z = pk2(f[4], f[5]); o.w = pk2(f[6], f[7]);
          *(v4u*)((bf16*)(ws + WS_ODNF) + (size_t)m * 512 + 8 * lane) = o; }
        { const v4u w1 = *(const v4u*)((const bf16*)(ws + WS_O1) + (size_t)m * 512 + 8 * lane), w2 = *(const v4u*)((const bf16*)(ws + WS_O2) + (size_t)m * 512 + 8 * lane);
          float f[8]; f[0] = bflo(w1.x) - lam * bflo(w2.x); f[1] = bfhi(w1.x) - lam * bfhi(w2.x); f[2] = bflo(w1.y) - lam * bflo(w2.y); f[3] = bfhi(w1.y) - lam * bfhi(w2.y);
          f[4] = bflo(w1.z) - lam * bflo(w2.z); f[5] = bfhi(w1.z) - lam * bfhi(w2.z); f[6] = bflo(w1.w) - lam * bflo(w2.w); f[7] = bfhi(w1.w) - lam * bfhi(w2.w);
          float ss = 0.f;
#pragma unroll
          for (int i = 0; i < 8; ++i) ss += f[i] * f[i];
          ss += __shfl_xor(ss, 1); ss += __shfl_xor(ss, 2); ss += __shfl_xor(ss, 4); ss += __shfl_xor(ss, 8);
          const float r = rsqrtf(ss * (1.f / 128.f) + EPS);
#pragma unroll
          for (int i = 0; i < 8; ++i) f[i] = f[i] * r * gda[i];
          v4u o; o.x = pk2(f[0], f[1]); o.y = pk2(f[2], f[3]); o.z = pk2(f[4], f[5]); o.w = pk2(f[6], f[7]);
          *(v4u*)((bf16*)(ws + WS_ODAF) + (size_t)m * 512 + 8 * lane) = o; }
    }
}

struct BranchOrder {
    pg8::StaticOrder so; long a1, a2;
    DI bool next(int i, pg8::Unit& u) const {
        const int tl = i / 3, r = i - 3 * tl;
        if (!so.tile((long)tl * so.G + so.c, u.pm, u.pn)) return false;
        u.aoff = r == 0 ? 0 : (r == 1 ? a1 : a2); u.boff = (long)r * 1024 * 512 * 2; u.tag = r; return true;
    }
};
struct EpiMerge {
    static constexpr bool PERM = true;
    bf16* MRG; const bf16* P;
    DI void operator()(const f32x4 (&acc)[2][2][4][2], const pg8::Unit& u, int wr, int wc, int fr, int fq) const {
        const int row0 = u.pm * 256 + wr * 64 + fr, col0 = u.pn * 256 + wc * 32 + 8 * fq; const int r = u.tag;
#pragma unroll
        for (int ai = 0; ai < 2; ++ai)
#pragma unroll
            for (int m = 0; m < 4; ++m) { const size_t row = (size_t)(row0 + ai * 128 + m * 16);
#pragma unroll
                for (int bj = 0; bj < 2; ++bj) { const int col = col0 + bj * 128;
                    const v4u gw = *(const v4u*)(P + row * PW + P_GATE + r * 1024 + col);
                    f32x4 v0 = acc[ai][bj][m][0], v1 = acc[ai][bj][m][1];
                    v0.x *= bflo(gw.x); v0.y *= bfhi(gw.x); v0.z *= bflo(gw.y); v0.w *= bfhi(gw.y); v1.x *= bflo(gw.z); v1.y *= bfhi(gw.z); v1.z *= bflo(gw.w); v1.w *= bfhi(gw.w);
                    v4u* dst = (v4u*)(MRG + row * 1024 + col);
                    if (r > 0) { const v4u ow = *dst; v0.x += bflo(ow.x); v0.y += bfhi(ow.x); v0.z += bflo(ow.y); v0.w += bfhi(ow.y); v1.x += bflo(ow.z); v1.y += bfhi(ow.z); v1.z += bflo(ow.w); v1.w += bfhi(ow.w); }
                    v4u w; w.x = pk2(v0.x, v0.y); w.y = pk2(v0.z, v0.w); w.z = pk2(v1.x, v1.y); w.w = pk2(v1.z, v1.w);
                    *dst = w; } }
    }
};
struct EpiResF32 {
    static constexpr bool PERM = false;
    float* C; const float* X;
    DI void operator()(const f32x4 (&acc)[2][2][4][2], const pg8::Unit& u, int wr, int wc, int fr, int fq) const {
        const int row0 = u.pm * 256 + wr * 64 + fr, col0 = u.pn * 256 + wc * 32 + 4 * fq;
#pragma unroll
        for (int ai = 0; ai < 2; ++ai)
#pragma unroll
            for (int m = 0; m < 4; ++m) { const size_t ro = (size_t)(row0 + ai * 128 + m * 16) * 1024 + col0;
#pragma unroll
                for (int bj = 0; bj < 2; ++bj)
#pragma unroll
                    for (int n = 0; n < 2; ++n) *(f32x4*)(C + ro + bj * 128 + n * 16) = acc[ai][bj][m][n] + *(const f32x4*)(X + ro + bj * 128 + n * 16); }
    }
};

constexpr int RT_W = 0, RT_LG = 65536;
DI void p5_router(const Args& a, LAS unsigned char* lds, int vcu, int G, int tid, int wave, int lane) {
    unsigned char* ws = a.ws; const int gw = vcu * 8 + wave, NGW = G * 8;
    const float* X1 = a.out;
    {
        f32x4 gv[4];
#pragma unroll
        for (int j = 0; j < 4; ++j) gv[j] = ((const f32x4*)a.in[I_FNORM])[lane + 64 * j];
        bf16* H2 = (bf16*)(ws + WS_H);
        for (int m = gw; m < T; m += NGW) {
            const f32x4* xr = (const f32x4*)(X1 + (size_t)m * D) + lane;
            f32x4 v[4]; float ss = 0.f;
#pragma unroll
            for (int j = 0; j < 4; ++j) { v[j] = xr[64 * j]; ss += (v[j].x * v[j].x + v[j].y * v[j].y) + (v[j].z * v[j].z + v[j].w * v[j].w); }
            const float rstd = rsqrtf(wave_sum(ss) * (1.f / D) + EPS);
            unsigned long long* o8 = (unsigned long long*)(H2 + (size_t)m * D) + lane;
#pragma unroll
            for (int j = 0; j < 4; ++j) { v[j] = v[j] * rstd * gv[j]; o8[64 * j] = (unsigned long long)pk2(v[j].x, v[j].y) | ((unsigned long long)pk2(v[j].z, v[j].w) << 32); }
        }
    }
    LAS int* hist = (LAS int*)(lds + LCNT_OFF);
    if (tid < 32) hist[tid] = 0;
    const int r = lane & 31, hh = lane >> 5;
    for (int tb = vcu; tb < T / 128; tb += G) {
        const int tok0 = tb * 128 + wave * 32;
        f32x16 acc = {}; float ssq = 0.f;
        for (int kh = 0; kh < 2; ++kh) {
            __syncthreads();
#pragma unroll
            for (int i = 0; i < 8; ++i) { const int q = tid + 512 * i, k = q >> 3, e4 = (q & 7) * 4;
                const float gk = a.in[I_FNORM][kh * 512 + k]; f32x4 w = *(const f32x4*)(a.in[I_WR] + (size_t)(kh * 512 + k) * 32 + e4);
                *(LAS f32x4*)(lds + RT_W + (k * 32 + e4) * 4) = w * gk; }
            __syncthreads();
            if (wave < 4) {
                const float* xp = X1 + (size_t)(tok0 + r) * D + kh * 512 + 4 * hh;
                for (int i = 0; i < 64; ++i) { const f32x4 xv = *(const f32x4*)(xp + 8 * i);
                    ssq += (xv.x * xv.x + xv.y * xv.y) + (xv.z * xv.z + xv.w * xv.w);
                    const LAS float* wp = (const LAS float*)(lds + RT_W) + (8 * i + 4 * hh) * 32 + r;
                    acc = __builtin_amdgcn_mfma_f32_32x32x2f32(xv.x, wp[0], acc, 0, 0, 0);
                    acc = __builtin_amdgcn_mfma_f32_32x32x2f32(xv.y, wp[32], acc, 0, 0, 0);
                    acc = __builtin_amdgcn_mfma_f32_32x32x2f32(xv.z, wp[64], acc, 0, 0, 0);
                    acc = __builtin_amdgcn_mfma_f32_32x32x2f32(xv.w, wp[96], acc, 0, 0, 0); }
            }
        }
        if (wave < 4) {
            ssq += __shfl_xor(ssq, 32);
            LAS float* wsc = (LAS float*)(lds + LWSC_OFF + wave * 256);
            if (hh == 0) wsc[r] = rsqrtf(ssq * (1.f / D) + EPS);
            LDS_WAIT();
            LAS float* LG = (LAS float*)(lds + RT_LG + wave * (32 * 33 * 4));
            const float br = a.in[I_BR][r];
#pragma unroll
            for (int i = 0; i < 16; ++i) { const int tk = crow(i, hh); LG[tk * 33 + r] = acc[i] * wsc[tk] + br; }
            LDS_WAIT();
            if (lane < 32) {
                const LAS float* row = LG + lane * 33;
                float best[4]; int bi[4];
                unsigned taken = 0u;
#pragma unroll
                for (int k = 0; k < 4; ++k) { float bv = -INFINITY; int be = 0;
                    for (int e = 0; e < 32; ++e) { const float v = row[e]; const bool ok = !((taken >> e) & 1u) && v > bv; bv = ok ? v : bv; be = ok ? e : be; }
                    best[k] = bv; bi[k] = be; taken |= 1u << be; }
                const float e0 = 1.f, e1 = expf(best[1] - best[0]), e2 = expf(best[2] - best[0]), e3 = expf(best[3] - best[0]);
                const float inv = 1.f / (e0 + e1 + e2 + e3);
                int* TE = (int*)(ws + WS_TOKE) + (size_t)(tok0 + lane) * 4; float* TW = (float*)(ws + WS_TOKW) + (size_t)(tok0 + lane) * 4;
                TE[0] = bi[0]; TE[1] = bi[1]; TE[2] = bi[2]; TE[3] = bi[3];
                TW[0] = e0 * inv; TW[1] = e1 * inv; TW[2] = e2 * inv; TW[3] = e3 * inv;
                lds_add(&hist[bi[0]], 1); lds_add(&hist[bi[1]], 1); lds_add(&hist[bi[2]], 1); lds_add(&hist[bi[3]], 1);
            }
        }
    }
    __syncthreads();
    if (tid < 32) atomicAdd((unsigned*)(ws + WS_CTL) + CW_CNT + tid, (unsigned)hist[tid]);
}

DI void moe_table(const Args& a, LAS unsigned char* lds, int tid) {
    LAS int* cnt = (LAS int*)(lds + LCNT_OFF); LAS int* base = cnt + 32; LAS int* misc = cnt + 64; LAS int* tab = (LAS int*)(lds + LTAB_OFF);
    __syncthreads();
    if (tid < 32) cnt[tid] = (int)__hip_atomic_load((unsigned*)(a.ws + WS_CTL) + CW_CNT + tid, RLX_AGENT);
    __syncthreads();
    if (tid == 0) { int ti = 0; for (int e = 0; e < 32; ++e) { base[e] = ti * 256; const int nt = (cnt[e] + 255) >> 8; for (int q = 0; q < nt; ++q) tab[ti + q] = e; ti += nt; } misc[0] = ti; }
    __syncthreads();
}
DI void p6_slots(const Args& a, LAS unsigned char* lds, int vcu, int G, int tid, int wave, int lane) {
    unsigned char* ws = a.ws;
    LAS int* cnt = (LAS int*)(lds + LCNT_OFF); LAS int* base = cnt + 32;
    LAS int* lh = (LAS int*)(lds + 0); LAS int* wb = lh + 32; LAS int* pslot = lh + 64;
    moe_table(a, lds, tid);
    int* SD = (int*)(ws + WS_SDST); float* SW = (float*)(ws + WS_SW);
    for (int e = vcu; e < 32; e += G) { const int lo = base[e] + cnt[e], hi = base[e] + (((cnt[e] + 255) >> 8) << 8); for (int s = lo + tid; s < hi; s += 512) SD[s] = -1; }
    const int* TE = (const int*)(ws + WS_TOKE); const float* TW = (const float*)(ws + WS_TOKW);
    const bf16* H2 = (const bf16*)(ws + WS_H); bf16* XS = (bf16*)(ws + WS_XS);
    for (int tb = vcu; tb < T / 128; tb += G) {
        __syncthreads();
        if (tid < 32) lh[tid] = 0;
        __syncthreads();
        const int pair = tb * 512 + tid; const int e = TE[pair];
        const int rank = lds_add(&lh[e], 1);
        __syncthreads();
        if (tid < 32) wb[tid] = (int)atomicAdd((unsigned*)(ws + WS_CTL) + CW_CUR + tid, (unsigned)lh[tid]);
        __syncthreads();
        const int slot = base[e] + wb[e] + rank;
        SD[slot] = pair; SW[slot] = TW[pair]; pslot[tid] = slot;
        __syncthreads();
        for (int q = 0; q < 16; ++q) { const int tl = wave * 16 + q; const size_t tok = (size_t)tb * 128 + tl;
            const v4u* src = (const v4u*)(H2 + tok * 1024 + 16 * lane); const v4u w0 = src[0], w1 = src[1];
#pragma unroll
            for (int k = 0; k < 4; ++k) { v4u* dst = (v4u*)(XS + (size_t)pslot[tl * 4 + k] * 1024 + 16 * lane); dst[0] = w0; dst[1] = w1; } }
    }
    __syncthreads();
}

struct MoeOrder {
    const LAS int* tab; int ntiles, npn, G, c; long bstride;
    DI bool next(int i, pg8::Unit& u) const {
        const long L = (long)i * G + c; const int rt = (int)(L / npn);
        if (rt >= ntiles) return false;
        const int e = __builtin_amdgcn_readfirstlane(tab[rt]);
        u.pm = rt; u.pn = (int)(L % npn); u.aoff = 0; u.boff = (long)e * bstride; u.tag = e; return true;
    }
};
struct EpiSwiGLU {
    static constexpr bool PERM = true;
    bf16* ACT; const float* bgu;
    DI void operator()(const f32x4 (&acc)[2][2][4][2], const pg8::Unit& u, int wr, int wc, int fr, int fq) const {
        const int row0 = u.pm * 256 + wr * 64 + fr, j0 = u.pn * 128 + wc * 32 + 8 * fq;
        const float* bp = bgu + (size_t)u.tag * 2048 + j0;
        const f32x4 bg0 = *(const f32x4*)(bp), bg1 = *(const f32x4*)(bp + 4), bu0 = *(const f32x4*)(bp + 1024), bu1 = *(const f32x4*)(bp + 1028);
#pragma unroll
        for (int ai = 0; ai < 2; ++ai)
#pragma unroll
            for (int m = 0; m < 4; ++m) {
                f32x4 g0 = acc[ai][0][m][0] + bg0, g1 = acc[ai][0][m][1] + bg1, u0 = acc[ai][1][m][0] + bu0, u1 = acc[ai][1][m][1] + bu1;
                float o[8];
#pragma unroll
                for (int q = 0; q < 4; ++q) { float g = fminf(g0[q], 7.f), up = fminf(fmaxf(u0[q], -7.f), 7.f); o[q] = (up + 1.f) * g * sigmoidf_(1.702f * g);
                    g = fminf(g1[q], 7.f); up = fminf(fmaxf(u1[q], -7.f), 7.f); o[4 + q] = (up + 1.f) * g * sigmoidf_(1.702f * g); }
                v4u w; w.x = pk2(o[0], o[1]); w.y = pk2(o[2], o[3]); w.z = pk2(o[4], o[5]); w.w = pk2(o[6], o[7]);
                *(v4u*)(ACT + (size_t)(row0 + ai * 128 + m * 16) * 1024 + j0) = w; }
    }
};
struct EpiDown {
    static constexpr bool PERM = true;
    bf16* Y2; const float* bd; const int* SD; const float* SW;
    DI void operator()(const f32x4 (&acc)[2][2][4][2], const pg8::Unit& u, int wr, int wc, int fr, int fq) const {
        const int row0 = u.pm * 256 + wr * 64 + fr, col0 = u.pn * 256 + wc * 32 + 8 * fq;
        const float* bp = bd + (size_t)u.tag * 1024 + col0;
        f32x4 bv[2][2];
#pragma unroll
        for (int bj = 0; bj < 2; ++bj)
#pragma unroll
            for (int n = 0; n < 2; ++n) bv[bj][n] = *(const f32x4*)(bp + bj * 128 + 4 * n);
#pragma unroll
        for (int ai = 0; ai < 2; ++ai)
#pragma unroll
            for (int m = 0; m < 4; ++m) { const int slot = row0 + ai * 128 + m * 16; const int dst = SD[slot];
                if (dst >= 0) { const float sw = SW[slot]; bf16* rowp = Y2 + (size_t)dst * 1024 + col0;
#pragma unroll
                    for (int bj = 0; bj < 2; ++bj) { const f32x4 v0 = (acc[ai][bj][m][0] + bv[bj][0]) * sw, v1 = (acc[ai][bj][m][1] + bv[bj][1]) * sw;
                        v4u w; w.x = pk2(v0.x, v0.y); w.y = pk2(v0.z, v0.w); w.z = pk2(v1.x, v1.y); w.w = pk2(v1.z, v1.w);
                        *(v4u*)(rowp + bj * 128) = w; } } }
    }
};

DI void p9_combine(const Args& a, int vcu, int G, int wave, int lane) {
    unsigned char* ws = a.ws; const int gw = vcu * 8 + wave, NGW = G * 8;
    const bf16* Y2 = (const bf16*)(ws + WS_XS);
    for (int m = gw; m < T; m += NGW) {
        f32x4* op = (f32x4*)(a.out + (size_t)m * D + 16 * lane);
        f32x4 o0 = op[0], o1 = op[1], o2 = op[2], o3 = op[3];
#pragma unroll
        for (int k = 0; k < 4; ++k) { const v4u* yp = (const v4u*)(Y2 + ((size_t)m * 4 + k) * 1024 + 16 * lane); const v4u w0 = yp[0], w1 = yp[1];
            o0.x += bflo(w0.x); o0.y += bfhi(w0.x); o0.z += bflo(w0.y); o0.w += bfhi(w0.y); o1.x += bflo(w0.z); o1.y += bfhi(w0.z); o1.z += bflo(w0.w); o1.w += bfhi(w0.w);
            o2.x += bflo(w1.x); o2.y += bfhi(w1.x); o2.z += bflo(w1.y); o2.w += bfhi(w1.y); o3.x += bflo(w1.z); o3.y += bfhi(w1.z); o3.z += bflo(w1.w); o3.w += bfhi(w1.w); }
        op[0] = o0; op[1] = o1; op[2] = o2; op[3] = o3;
    }
}
constexpr int NPHASE = 12;
constexpr int N_ATT_ITEMS = 2048, N_MX_ITEMS = 512, N_SCAN_WG = 32;
typedef const Args __attribute__((address_space(4))) CArgs;
#if defined(__HIP_DEVICE_COMPILE__)
DI CArgs* fresh_args() { unsigned long long v = (unsigned long long)__builtin_amdgcn_kernarg_segment_ptr(); asm volatile("" : "+s"(v)); return (CArgs*)v; }
#else
__device__ CArgs* fresh_args();
#endif
DI Args load_args() { CArgs* p = fresh_args(); Args a;
#pragma unroll
    for (int i = 0; i < 27; ++i) a.in[i] = p->in[i];
    a.out = p->out; a.ws = p->ws; a.ph_lo = p->ph_lo; a.ph_hi = p->ph_hi; a.li = p->li; a.pad = 0; return a; }
#ifndef MK_N_LAUNCHES
#define MK_N_LAUNCHES 1
#endif
__global__ void __launch_bounds__(512, 2) mk_fwd(Args args_unused) {
    extern __shared__ __attribute__((aligned(16))) unsigned char lds_raw[];
    LAS unsigned char* lds = (LAS unsigned char*)lds_raw;
    volatile LAS unsigned* MISC = (volatile LAS unsigned*)(lds + MISC_OFF);
    for (int u = threadIdx.x; u < (LDS_BYTES - LDSCTL_OFF) / 4; u += 512) ((LAS unsigned*)(lds + LDSCTL_OFF))[u] = 0u;
    __syncthreads();
    { const Args A0 = load_args(); (void)xcd_barrier_post((unsigned*)(A0.ws + WS_CTL) + CW_BAR, MISC + 8); }
#ifdef ONLY_PHASE
#define IN(k) ((k) == ONLY_PHASE)
#elif MK_N_LAUNCHES == 1
#define IN(k) true
#else
#define IN(k) (fresh_args()->ph_lo <= (k) && (k) < fresh_args()->ph_hi)
#endif
#define FRESH() const Args A_ = load_args(); unsigned char* const ws = A_.ws; (void)ws; const int tid_ = fresh_tid(), lane_ = tid_ & 63, wave_ = __builtin_amdgcn_readfirstlane(tid_ >> 6); (void)lane_; (void)wave_; \
    const int G = gridDim.x, bx = blockIdx.x, vcu = (G % 8 == 0) ? (bx % 8) * (G / 8) + bx / 8 : bx; (void)vcu
#ifndef REPEAT_PHASE
#define REPEAT_PHASE -1
#endif
#define NREP(k) ((k) == REPEAT_PHASE ? 2 : 1)
#define GBAR() do { XcdBarrier b_; b_.bar = (unsigned*)(fresh_args()->ws + WS_CTL) + CW_BAR; b_.x = xb_xcc_id(); b_.st = MISC + 8; xcd_barrier(b_); } while (0)
#define SEAM(k) do { if (IN(k) && IN((k) + 1)) { XcdBarrier b_; b_.bar = (unsigned*)(fresh_args()->ws + WS_CTL) + CW_BAR; b_.x = xb_xcc_id(); b_.st = MISC + 8; xcd_barrier(b_); } } while (0)

    if (IN(0)) _Pragma("unroll") for (int rep_ = 0; rep_ < NREP(0); ++rep_) { if (rep_) GBAR(); FRESH(); p0_prologue(A_, lds, vcu, G, wave_, lane_); }
    SEAM(0);
    if (IN(1)) _Pragma("unroll") for (int rep_ = 0; rep_ < NREP(1); ++rep_) { if (rep_) GBAR();
        FRESH();
        { pg8::Gemm g{(const bf16*)(ws + WS_H), (const bf16*)(ws + WS_WIN), 1024, 1024, 1024}; pg8::StaticOrder S; S.init(T, PW, G, bx);
          EpiP E{(bf16*)(ws + WS_P), A_.in[I_BGATE]};
          pg8::gemm_phase<EpiP, pg8::StaticOrder>(lds, g, S, E, tid_); }
        { pg8::Gemm g{(const bf16*)(ws + WS_MEMN), (const bf16*)(ws + WS_WMKV), 1024, 1024, 1024}; pg8::StaticOrder S; S.init(BATCH * NMEM, 1024, G, bx);
          EpiPlain E{(bf16*)(ws + WS_MKV), 1024};
          pg8::gemm_phase<EpiPlain, pg8::StaticOrder>(lds, g, S, E, tid_); }
    }
    SEAM(1);
    if (IN(2)) _Pragma("unroll") for (int rep_ = 0; rep_ < NREP(2); ++rep_) { if (rep_) GBAR();
        FRESH();
#ifndef NO_PREP
        for (int ck = vcu; ck < NCHUNK; ck += G) dn_prep_unit(A_, lds, ck, tid_, wave_, lane_);
#endif
#ifndef NO_NORM
        if (rep_ == 0) p2_norm_rows(A_, vcu, G, wave_, lane_);
#endif
    }
    SEAM(2);
    if (IN(3)) _Pragma("unroll") for (int rep_ = 0; rep_ < NREP(3); ++rep_) { if (rep_) GBAR();
#ifndef NO_SCAN
        if (blockIdx.x < N_SCAN_WG) { FRESH(); dn_scan(A_, lds, bx, wave_, lane_); }
#endif
#ifndef NO_ATT
        for (;;) {
            CArgs* ap = fresh_args(); unsigned char* ws = ap->ws; const int tid_ = fresh_tid();
            if (tid_ == 0) MISC[16] = __hip_atomic_fetch_add((unsigned*)(ws + WS_CTL) + CW_QHEAD + 32 * rep_, 1u, RLX_AGENT);
            __syncthreads();
            const int item = (int)MISC[16];
            __syncthreads();
            if (item >= N_ATT_ITEMS) break;
            const int qb = 31 - (item >> 6), rest = item & 63, b = rest >> 4, h = (rest >> 2) & 3, map = (rest >> 1) & 1, half = rest & 1;
            const attn_body::bf16* Pb = (const attn_body::bf16*)(ws + WS_P) + (size_t)b * SEQ * PW;
            attn_body::bf16* Ob = (attn_body::bf16*)(ws + (map ? WS_O2 : WS_O1)) + (size_t)b * SEQ * 512 + h * 128 + half * 64;
            attn_body::attn_unit<8>(qb, Pb + P_DAQ + h * 128 + map * 64, Pb + P_DAK + h * 128 + map * 64, Pb + P_DAV + h * 128 + half * 64, Ob, ap->in[I_REL], h, (char*)lds_raw, tid_);
        }
#endif
#ifndef NO_MX
        for (;;) {
            FRESH();
            if (tid_ == 0) MISC[16] = __hip_atomic_fetch_add((unsigned*)(ws + WS_CTL) + CW_QHEAD + 16 + 32 * rep_, 1u, RLX_AGENT);
            __syncthreads();
            const int idx = (int)MISC[16];
            __syncthreads();
            if (idx >= N_MX_ITEMS) break;
            mx_unit(A_, lds, idx >> 5, idx & 31, tid_, wave_, lane_);
        }
#endif
    }
    SEAM(3);
    if (IN(4)) _Pragma("unroll") for (int rep_ = 0; rep_ < NREP(4); ++rep_) { if (rep_) GBAR(); FRESH(); p4_norm_rows(A_, vcu, G, wave_, lane_); }
    SEAM(4);
    if (IN(5)) _Pragma("unroll") for (int rep_ = 0; rep_ < NREP(5); ++rep_) { if (rep_) GBAR();
        FRESH();
        pg8::Gemm g{(const bf16*)(ws + WS_ODNF), (const bf16*)(ws + WS_WB), 512, 512, 512};
        BranchOrder S; S.so.init(T, 1024, G, bx); S.a1 = (long)(WS_ODAF - WS_ODNF); S.a2 = (long)(WS_OMX - WS_ODNF);
        EpiMerge E{(bf16*)(ws + WS_MRG), (const bf16*)(ws + WS_P)};
        pg8::gemm_phase<EpiMerge, BranchOrder>(lds, g, S, E, tid_);
    }
    SEAM(5);
    if (IN(6)) _Pragma("unroll") for (int rep_ = 0; rep_ < NREP(6); ++rep_) { if (rep_) GBAR();
        FRESH();
        pg8::Gemm g{(const bf16*)(ws + WS_MRG), (const bf16*)(ws + WS_WOUT), 1024, 1024, 1024}; pg8::StaticOrder S; S.init(T, 1024, G, bx);
        EpiResF32 E{A_.out, A_.in[I_X]};
        pg8::gemm_phase<EpiResF32, pg8::StaticOrder>(lds, g, S, E, tid_);
    }
    SEAM(6);
    if (IN(7)) { FRESH(); p5_router(A_, lds, vcu, G, tid_, wave_, lane_); }
    SEAM(7);
    if (IN(8)) { FRESH(); p6_slots(A_, lds, vcu, G, tid_, wave_, lane_); }
    SEAM(8);
    if (IN(9)) _Pragma("unroll") for (int rep_ = 0; rep_ < NREP(9); ++rep_) { if (rep_) GBAR();
        FRESH();
        moe_table(A_, lds, tid_);
        pg8::Gemm g{(const bf16*)(ws + WS_XS), (const bf16*)(ws + WS_WGU), 1024, 1024, 1024};
        MoeOrder S{(const LAS int*)(lds + LTAB_OFF), ((const LAS int*)(lds + LCNT_OFF))[64], 8, G, bx, (long)2048 * 1024 * 2};
        EpiSwiGLU E{(bf16*)(ws + WS_ACT), A_.in[I_BGU]};
        pg8::gemm_phase<EpiSwiGLU, MoeOrder>(lds, g, S, E, tid_);
    }
    SEAM(9);
    if (IN(10)) _Pragma("unroll") for (int rep_ = 0; rep_ < NREP(10); ++rep_) { if (rep_) GBAR();
        FRESH();
        moe_table(A_, lds, tid_);
        pg8::Gemm g{(const bf16*)(ws + WS_ACT), (const bf16*)(ws + WS_WD), 1024, 1024, 1024};
        MoeOrder S{(const LAS int*)(lds + LTAB_OFF), ((const LAS int*)(lds + LCNT_OFF))[64], 4, G, bx, (long)1024 * 1024 * 2};
        EpiDown E{(bf16*)(ws + WS_XS), A_.in[I_BD], (const int*)(ws + WS_SDST), (const float*)(ws + WS_SW)};
        pg8::gemm_phase<EpiDown, MoeOrder>(lds, g, S, E, tid_);
    }
    SEAM(10);
    if (IN(11)) {
        FRESH();
        p9_combine(A_, vcu, G, wave_, lane_);
        if (bx == 0 && tid_ == 0) { if (__hip_atomic_load((unsigned*)(ws + WS_CTL) + CW_BAR + XB_TMO, RLX_AGENT) != 0u) A_.out[0] = __builtin_nanf(""); }
    }
#undef IN
#undef SEAM
#undef FRESH
}

extern "C" void kernel_launch(void* const* d_in, const int* in_sizes, int n_in, void* d_out, int out_size, void* d_ws, size_t ws_size, hipStream_t stream) {
    static int grid = 0;
    if (grid == 0) {
        if (n_in != 27 || in_sizes[0] != T * D || out_size != T * D || ws_size < WS_END) {
            fprintf(stderr, "kernel_launch: unexpected shapes (n_in %d, in0 %d, out %d, ws %zu < %zu); nothing launched\n", n_in, n_in > 0 ? in_sizes[0] : -1, out_size, ws_size, (size_t)WS_END); grid = -1; return; }
        int dev = 0, cus = 0, per_cu = 0;
        if (hipGetDevice(&dev) != hipSuccess || hipDeviceGetAttribute(&cus, hipDeviceAttributeMultiprocessorCount, dev) != hipSuccess) { grid = -1; return; }
        if (hipFuncSetAttribute((const void*)mk_fwd, hipFuncAttributeMaxDynamicSharedMemorySize, LDS_BYTES) != hipSuccess) { fprintf(stderr, "kernel_launch: hipFuncSetAttribute failed\n"); grid = -1; return; }
        if (hipOccupancyMaxActiveBlocksPerMultiprocessor(&per_cu, (const void*)mk_fwd, 512, LDS_BYTES) != hipSuccess || per_cu < 1)
            fprintf(stderr, "kernel_launch: note: occupancy query reports %d workgroups per CU\n", per_cu);
        (void)hipGetLastError();
        grid = cus;
        if (grid > 256) grid = 256;
    }
    if (grid < 0) return;
    if (hipMemsetAsync((char*)d_ws + WS_CTL, 0, CTL_ZERO_BYTES, stream) != hipSuccess) return;
    Args a{};
    for (int i = 0; i < 27; ++i) a.in[i] = (const float*)d_in[i];
    a.out = (float*)d_out; a.ws = (unsigned char*)d_ws;
#if MK_N_LAUNCHES == 1
    a.ph_lo = 0; a.ph_hi = NPHASE; a.li = 0; a.pad = 0;
    hipLaunchKernelGGL(mk_fwd, dim3(grid), dim3(512), LDS_BYTES, stream, a);
#else
    for (int p = 0; p < NPHASE; ++p) { a.ph_lo = p; a.ph_hi = p + 1; a.li = 0; a.pad = 0; hipLaunchKernelGGL(mk_fwd, dim3(grid), dim3(512), LDS_BYTES, stream, a); }
#endif
}
```

```cpp
#include <hip/hip_runtime.h>
#include <hip/hip_bf16.h>
#include <cstdio>
#include <cstdint>
#include <cmath>

#define GAS __attribute__((address_space(1)))
#define LAS __attribute__((address_space(3)))
typedef unsigned short bf16;
typedef unsigned v4u __attribute__((ext_vector_type(4)));
typedef unsigned v2u __attribute__((ext_vector_type(2)));
typedef float f32x4 __attribute__((ext_vector_type(4)));
typedef float f32x16 __attribute__((ext_vector_type(16)));
typedef short bf16x8 __attribute__((ext_vector_type(8)));
typedef short s16x4 __attribute__((ext_vector_type(4)));
typedef GAS unsigned gu32;
#define RLX_AGENT __ATOMIC_RELAXED, __HIP_MEMORY_SCOPE_AGENT
#define LDS_WAIT() asm volatile("s_waitcnt lgkmcnt(0)" ::: "memory")
#define VM_WAIT() asm volatile("s_waitcnt vmcnt(0)" ::: "memory")
#define DI __device__ __forceinline__

DI unsigned f2bf(float f) { unsigned u = __builtin_bit_cast(unsigned, f); return (u + 0x7fffu + ((u >> 16) & 1u)) >> 16; }
DI unsigned pk2(float lo, float hi) { return f2bf(lo) | (f2bf(hi) << 16); }
DI float bflo(unsigned w) { return __builtin_bit_cast(float, w << 16); }
DI float bfhi(unsigned w) { return __builtin_bit_cast(float, w & 0xffff0000u); }
DI float bf2f(bf16 b) { return __builtin_bit_cast(float, (unsigned)b << 16); }
DI float wave_sum(float v) {
#pragma unroll
    for (int o = 1; o < 64; o <<= 1) v += __shfl_xor(v, o);
    return v;
}
DI float fast_exp(float x) { return __builtin_amdgcn_exp2f(x * 1.4426950408889634f); }
DI float sigmoidf_(float x) { return __builtin_amdgcn_rcpf(1.f + fast_exp(-x)); }
DI int lds_add(LAS int* p, int v) { return __hip_atomic_fetch_add(p, v, __ATOMIC_RELAXED, __HIP_MEMORY_SCOPE_WORKGROUP); }
DI int fresh_tid() { int t; asm volatile("v_mov_b32 %0, %1" : "=v"(t) : "v"((int)threadIdx.x)); return t; }
DI int crow(int r, int hi) { return (r & 3) + 8 * (r >> 2) + 4 * hi; }

constexpr int BATCH = 4, SEQ = 8192, T = BATCH * SEQ, D = 1024, INW = 7176, PW = 7168, NMEM = 256;
constexpr float EPS = 1e-6f;
constexpr int P_DNQ = 0, P_DNK = 512, P_DNV = 1024, P_DNZ = 1536, P_DAQ = 2048, P_DAK = 2560, P_DAV = 3072, P_MXQ = 3584, P_GATE = 4096;
constexpr int NEXP = 32, DFF = 1024, NSLOT_MAX = T * 4 + NEXP * 256, NTILE_MAX = NSLOT_MAX / 256;
constexpr int NCHUNK = BATCH * 4 * (SEQ / 64);
constexpr float LOG2E = 1.4426950408889634f;

constexpr size_t MiB = 1u << 20;
constexpr size_t WS_CTL = 0, CTL_ZERO_BYTES = 1 * MiB;
constexpr size_t WS_G = 1 * MiB;
constexpr size_t WS_BETA = WS_G + 512 * 1024;
constexpr size_t WS_TOKE = 2 * MiB;
constexpr size_t WS_TOKW = WS_TOKE + 512 * 1024;
constexpr size_t WS_SDST = 3 * MiB;
constexpr size_t WS_SW = 4 * MiB;
constexpr size_t WS_EGL = 5 * MiB;
constexpr size_t WS_WB = 6 * MiB;
constexpr size_t WS_WOUT = 9 * MiB;
constexpr size_t WS_WMKV = 11 * MiB;
constexpr size_t WS_MEMN = 13 * MiB;
constexpr size_t WS_MKV = 15 * MiB;
constexpr size_t WS_WIN = 17 * MiB;
constexpr size_t WS_WGU = 32 * MiB;
constexpr size_t WS_WD = 160 * MiB;
constexpr size_t WS_H = 224 * MiB;
constexpr size_t WS_P = 288 * MiB;
constexpr size_t WS_NW = 736 * MiB;
constexpr size_t WS_QD = 768 * MiB;
constexpr size_t WS_KDT = 800 * MiB;
constexpr size_t WS_U = 832 * MiB;
constexpr size_t WS_QK = 864 * MiB;
constexpr size_t WS_ODN = 880 * MiB;
constexpr size_t WS_O1 = 912 * MiB;
constexpr size_t WS_O2 = 944 * MiB;
constexpr size_t WS_OMX = 976 * MiB;
constexpr size_t WS_ODNF = 736 * MiB;
constexpr size_t WS_ODAF = 768 * MiB;
constexpr size_t WS_MRG = 800 * MiB;
constexpr size_t WS_XS = 288 * MiB;
constexpr size_t WS_ACT = 560 * MiB;
constexpr size_t WS_END = 1024 * MiB;
static_assert(WS_OMX + (size_t)T * 512 * 2 <= WS_END && WS_ACT + (size_t)NSLOT_MAX * 1024 * 2 <= WS_END && WS_XS + (size_t)NSLOT_MAX * 1024 * 2 <= WS_ACT, "ws map");

constexpr int CW_QHEAD = 64;
constexpr int CW_CNT = 128;
constexpr int CW_CUR = 192;
constexpr int CW_BAR = 4096;

constexpr int RING_BYTES = 136 * 1024;
constexpr int LDSCTL_OFF = RING_BYTES;
constexpr int MISC_OFF = LDSCTL_OFF;
constexpr int LTAB_OFF = LDSCTL_OFF + 128;
constexpr int LCNT_OFF = LTAB_OFF + NTILE_MAX * 4;
constexpr int LWSC_OFF = LCNT_OFF + 512;
constexpr int LDS_BYTES = 144 * 1024;
static_assert(LWSC_OFF + 8 * 256 <= LDS_BYTES, "LDS map");

namespace pg8 {
constexpr int BM = 256, BK = 64, HALF = 128, HTB = HALF * BK * 2, STAGE_BYTES = 8 * HTB, NXCD = 8, WGM = 8;
DI int lds_byte(int r, int c) { const int st = (r >> 4) * 2 + (c >> 5), rr = r & 15, cc = c & 31, ob = rr * 64 + cc * 2; return st * 1024 + (ob ^ (((ob >> 9) & 1) << 5)); }
DI void stage_rc(int b, int& R, int& C) { const int st = b / 1024, sb = b % 1024, swz = sb ^ (((sb >> 9) & 1) << 5); R = (st >> 1) * 16 + swz / 64; C = (st & 1) * 32 + (swz % 64) / 2; }
DI int perm32(int rho) { const int n = rho >> 4, i = rho & 15; return 8 * (i >> 2) + 4 * n + (i & 3); }

struct Unit { int pm, pn; long aoff, boff; int tag; };
struct Gemm { const bf16* A; const bf16* Bt; int lda, ldb, K; };

struct StaticOrder {
    int nM, nN, nwg, G, c;
    DI void init(int M, int N, int G_, int c_) { nM = M / BM; nN = N / BM; nwg = nM * nN; G = G_; c = c_; }
    DI bool tile(long L, int& pm, int& pn) const {
        if (L >= nwg) return false;
        int wgid = (int)L; { const int q = nwg / NXCD, r = nwg % NXCD, xcd = wgid % NXCD, off = wgid / NXCD; wgid = (xcd < r ? xcd * (q + 1) : r * (q + 1) + (xcd - r) * q) + off; }
        const int nig = WGM * nN, gid = wgid / nig, fm = gid * WGM, gsz = (nM - fm) < WGM ? (nM - fm) : WGM;
        pm = fm + ((wgid % nig) % gsz); pn = (wgid % nig) / gsz; return true;
    }
    DI bool next(int i, Unit& u) const { u.aoff = 0; u.boff = 0; u.tag = 0; return tile((long)i * G + c, u.pm, u.pn); }
};

template <class Epi, class Sched>
DI void gemm_phase(LAS unsigned char* lds, const Gemm g, const Sched& S, const Epi& E, const int tid) {
    const int wid = __builtin_amdgcn_readfirstlane(tid >> 6), lane = tid & 63, wr = wid >> 2, wc = wid & 3, fr = lane & 15, fq = lane >> 4;
    const int K = g.K, nt = K / BK;
    unsigned voffA[2], voffB[2];
#pragma unroll
    for (int i = 0; i < 2; ++i) { int R, C; stage_rc(tid * 16 + i * 8192, R, C); const int Rb = Epi::PERM ? ((R & ~31) + perm32(R & 31)) : R;
        voffA[i] = (unsigned)(R * g.lda + C) * 2u; voffB[i] = (unsigned)(Rb * g.ldb + C) * 2u; }
    const size_t kstep = (size_t)(BK * 2);
    const size_t hstepA = (size_t)HALF * g.lda * 2, hstepB = (size_t)HALF * g.ldb * 2;
    const size_t tstepA = 2 * hstepA, tstepB = 2 * hstepB;
    const unsigned ldsw = (unsigned)wid * 1024u;
    const int aoff = lds_byte(wr * 64 + fr, fq * 8), boff = lds_byte(wc * 32 + fr, fq * 8);
#define PG8_SA(b, h) (((b) * 2 + (h)) * HTB)
#define PG8_SB(b, h) ((4 + (b) * 2 + (h)) * HTB)
#define PG8_STAGE(bufoff, gbase, voff) do { _Pragma("unroll") for (int _i = 0; _i < 2; ++_i) \
        __builtin_amdgcn_global_load_lds((const unsigned*)((const char*)(gbase) + (voff)[_i]), (LAS unsigned*)(lds + (bufoff) + ldsw + _i * 8192), 16, 0, 0); } while (0)
#define PG8_LDA(dst, b, h) do { _Pragma("unroll") for (int m = 0; m < 4; ++m) _Pragma("unroll") for (int k = 0; k < 2; ++k) dst[m][k] = *(const LAS bf16x8*)(lds + PG8_SA(b, h) + aoff + m * 2048 + k * 1024); } while (0)
#define PG8_LDB(dst, b, h) do { _Pragma("unroll") for (int n = 0; n < 2; ++n) _Pragma("unroll") for (int k = 0; k < 2; ++k) dst[n][k] = *(const LAS bf16x8*)(lds + PG8_SB(b, h) + boff + n * 2048 + k * 1024); } while (0)
#define PG8_MMA(ai, bj, At, Bt) do { __builtin_amdgcn_s_setprio(1); _Pragma("unroll") for (int m = 0; m < 4; ++m) _Pragma("unroll") for (int n = 0; n < 2; ++n) _Pragma("unroll") for (int k = 0; k < 2; ++k) \
        acc[ai][bj][m][n] = __builtin_amdgcn_mfma_f32_16x16x32_bf16(Bt[n][k], At[m][k], acc[ai][bj][m][n], 0, 0, 0); __builtin_amdgcn_s_setprio(0); } while (0)
#define PG8_WAIT_V(n) asm volatile("s_waitcnt vmcnt(" #n ")" ::: "memory")
#define PG8_WAIT_L(n) asm volatile("s_waitcnt lgkmcnt(" #n ")" ::: "memory")
#define PG8_BAR __builtin_amdgcn_s_barrier()
#define PG8_SCHED __builtin_amdgcn_sched_barrier(0)
    Unit cur, nxt; int ui = 0;
    if (!S.next(0, cur)) return;
    f32x4 acc[2][2][4][2];
#pragma unroll
    for (int a = 0; a < 2; ++a)
#pragma unroll
        for (int b = 0; b < 2; ++b)
#pragma unroll
            for (int m = 0; m < 4; ++m)
#pragma unroll
                for (int n = 0; n < 2; ++n) acc[a][b][m][n] = (f32x4){0.f, 0.f, 0.f, 0.f};
    bf16x8 At[4][2], B0[2][2], B1[2][2];
    const char* cA = (const char*)g.A + (size_t)cur.pm * tstepA + cur.aoff; const char* cB = (const char*)g.Bt + (size_t)cur.pn * tstepB + cur.boff;
    PG8_STAGE(PG8_SB(0, 0), cB, voffB); PG8_STAGE(PG8_SB(0, 1), cB + hstepB, voffB); PG8_STAGE(PG8_SA(0, 0), cA, voffA); PG8_STAGE(PG8_SA(0, 1), cA + hstepA, voffA);
    if (wr == 1) PG8_BAR;
    PG8_WAIT_V(2); PG8_BAR;
    PG8_STAGE(PG8_SB(1, 0), cB + kstep, voffB); PG8_STAGE(PG8_SA(1, 0), cA + kstep, voffA); PG8_STAGE(PG8_SB(1, 1), cB + hstepB + kstep, voffB);
    PG8_WAIT_V(6); PG8_BAR;
    for (;;) {
        const bool has_next = S.next(ui + 1, nxt);
        const char* nA = has_next ? (const char*)g.A + (size_t)nxt.pm * tstepA + nxt.aoff : cA; const char* nB = has_next ? (const char*)g.Bt + (size_t)nxt.pn * tstepB + nxt.boff : cB;
        for (int t = 0; t < nt; t += 2) {
            const bool last = (t == nt - 2);
            const char* a1 = cA + (size_t)(t + 1) * kstep;
            const char* a2 = last ? nA : cA + (size_t)(t + 2) * kstep; const char* b2 = last ? nB : cB + (size_t)(t + 2) * kstep;
            const char* a3 = a2 + kstep; const char* b3 = b2 + kstep;
            PG8_LDB(B0, 0, 0); PG8_LDB(B1, 0, 1); PG8_SCHED; PG8_LDA(At, 0, 0); PG8_STAGE(PG8_SA(1, 1), a1 + hstepA, voffA);
            PG8_WAIT_V(8); PG8_WAIT_L(0); PG8_BAR; PG8_MMA(0, 0, At, B0); PG8_MMA(0, 1, At, B1); PG8_BAR; PG8_SCHED;
            PG8_LDA(At, 0, 1); PG8_STAGE(PG8_SB(0, 0), b2, voffB); PG8_STAGE(PG8_SB(0, 1), b2 + hstepB, voffB); PG8_STAGE(PG8_SA(0, 0), a2, voffA);
            PG8_WAIT_V(8); PG8_WAIT_L(0); PG8_BAR; PG8_MMA(1, 0, At, B0); PG8_MMA(1, 1, At, B1); PG8_BAR; PG8_SCHED;
            PG8_LDB(B0, 1, 0); PG8_LDB(B1, 1, 1); PG8_SCHED; PG8_LDA(At, 1, 0); PG8_STAGE(PG8_SA(0, 1), a2 + hstepA, voffA);
            PG8_WAIT_V(8); PG8_WAIT_L(0); PG8_BAR; PG8_MMA(0, 0, At, B0); PG8_MMA(0, 1, At, B1); PG8_BAR; PG8_SCHED;
            PG8_LDA(At, 1, 1); PG8_STAGE(PG8_SB(1, 0), b3, voffB); PG8_STAGE(PG8_SB(1, 1), b3 + hstepB, voffB); PG8_STAGE(PG8_SA(1, 0), a3, voffA);
            PG8_WAIT_V(8); PG8_WAIT_L(0); PG8_BAR; PG8_MMA(1, 0, At, B0); PG8_MMA(1, 1, At, B1); PG8_BAR; PG8_SCHED;
        }
        if (wr == 0) PG8_BAR;
        E(acc, cur, wr, wc, fr, fq);
        if (!has_next) break;
#pragma unroll
        for (int a = 0; a < 2; ++a)
#pragma unroll
            for (int b = 0; b < 2; ++b)
#pragma unroll
                for (int m = 0; m < 4; ++m)
#pragma unroll
                    for (int n = 0; n < 2; ++n) acc[a][b][m][n] = (f32x4){0.f, 0.f, 0.f, 0.f};
        cur = nxt; cA = nA; cB = nB; ++ui;
        if (wr == 1) PG8_BAR;
    }
    PG8_WAIT_V(0);
    PG8_BAR;
#undef PG8_SA
#undef PG8_SB
#undef PG8_STAGE
#undef PG8_LDA
#undef PG8_LDB
#undef PG8_MMA
#undef PG8_WAIT_V
#undef PG8_WAIT_L
#undef PG8_BAR
#undef PG8_SCHED
}
}
namespace attn_body {
using bf16=__hip_bfloat16;
using bf16x8=__attribute__((ext_vector_type(8)))short;
using s16x4=__attribute__((ext_vector_type(4)))short;
using f32x16=__attribute__((ext_vector_type(16)))float;
using u32x4=__attribute__((ext_vector_type(4)))unsigned;
constexpr int SEQ=8192,D=64,DM=7168,OPITCH=512;
constexpr int NW=8,QBLK=32,QB=QBLK*NW,KVBLK=64,NQB=SEQ/QB;
constexpr int ATTN_UNIT_ROWS=QB;
__device__ __forceinline__ int crow(int r,int hi){return (r&3)+8*(r>>2)+4*hi;}
#define SBAR() __builtin_amdgcn_sched_barrier(0)
__device__ __forceinline__ void cmask(f32x16&p0,f32x16&p1,int jb,int qrel,int hi){
  const float NEG=-INFINITY; int kb=64*jb+4*hi;
  #pragma unroll
  for(int r=0;r<16;++r){int kv=kb+(r&3)+8*(r>>2); if(kv>qrel)p0[r]=NEG; if(kv+32>qrel)p1[r]=NEG;}
}

__device__ __forceinline__ void biasadd(f32x16&p0,f32x16&p1,const float*lp){
  #pragma unroll
  for(int r=0;r<16;r+=2){ const float a0=lp[59-((r&3)+8*(r>>2))],a1=lp[59-(((r+1)&3)+8*((r+1)>>2))],b0=lp[59-32-((r&3)+8*(r>>2))],b1=lp[59-32-(((r+1)&3)+8*((r+1)>>2))];
    p0[r]+=a0; p0[r+1]+=a1; p1[r]+=b0; p1[r+1]+=b1; __builtin_amdgcn_sched_barrier(0); }
}
constexpr int NSLOT=3, SLOTB=8192;
constexpr int LDS_K=0, LDS_V=NSLOT*SLOTB, LDS_WS=2*NSLOT*SLOTB, LDS_OST=LDS_WS+NW*64*4, LDS_LUT=LDS_OST+NW*4096, LDS_BYTES=LDS_LUT+640*4;
constexpr float C2=0.125f*1.4426950408889634f;
__device__ __forceinline__ void glds16(const void*gsrc,unsigned lds_dst){unsigned keep;
  asm volatile("s_mov_b32 %0, m0\n\ts_mov_b32 m0, %2\n\ts_nop 0\n\tglobal_load_lds_dwordx4 %1, off\n\ts_mov_b32 m0, %0":"=&s"(keep):"v"(gsrc),"s"(lds_dst):"memory");}
__device__ __forceinline__ float max3f(float a,float b,float c){float r;asm("v_max3_f32 %0, %1, %2, %3":"=v"(r):"v"(a),"v"(b),"v"(c));return r;}
__device__ __forceinline__ float max2f(float a,float b){float r;asm("v_max_f32_e32 %0, %1, %2":"=v"(r):"v"(a),"v"(b));return r;}
__device__ __forceinline__ float fadd_s(float a,float b){float r;asm("v_add_f32_e32 %0, %1, %2":"=v"(r):"v"(a),"v"(b));return r;}
__device__ __forceinline__ float fsub_s(float a,float b){float r;asm("v_sub_f32_e32 %0, %1, %2":"=v"(r):"v"(a),"v"(b));return r;}
typedef float f32x2_t __attribute__((ext_vector_type(2))); typedef __bf16 bf16x2_t __attribute__((ext_vector_type(2)));
__device__ __forceinline__ unsigned cvtpk_s(float lo,float hi){f32x2_t v={lo,hi};bf16x2_t b=__builtin_convertvector(v,bf16x2_t);return __builtin_bit_cast(unsigned,b);}
#define WAIT_BAR(N) asm volatile("s_waitcnt vmcnt(" #N ") lgkmcnt(0)\n\ts_barrier":::"memory")

__device__ __forceinline__ void qkt(f32x16&p0,f32x16&p1,const char*Kslot,const bf16x8*qr,const f32x16&negm,int r32,int hi){
  const char*kb=Kslot+hi*1024+r32*16;
  #pragma unroll
  for(int d0=0;d0<4;++d0){
    const bf16x8 b0=*reinterpret_cast<const bf16x8*>(kb+d0*2048);
    const bf16x8 b1=*reinterpret_cast<const bf16x8*>(kb+d0*2048+512);
    if(d0==0){p0=__builtin_amdgcn_mfma_f32_32x32x16_bf16(b0,qr[0],negm,0,0,0);p1=__builtin_amdgcn_mfma_f32_32x32x16_bf16(b1,qr[0],negm,0,0,0);}
    else{p0=__builtin_amdgcn_mfma_f32_32x32x16_bf16(b0,qr[d0],p0,0,0,0);p1=__builtin_amdgcn_mfma_f32_32x32x16_bf16(b1,qr[d0],p1,0,0,0);}}
}
typedef __attribute__((address_space(3))) const char* lds_cptr;
typedef short v4i16_t __attribute__((ext_vector_type(4)));
__device__ __forceinline__ void kload8(bf16x8*kf,lds_cptr kp){
  kf[0]=*(const __attribute__((address_space(3))) bf16x8*)(kp);      kf[1]=*(const __attribute__((address_space(3))) bf16x8*)(kp+512);
  kf[2]=*(const __attribute__((address_space(3))) bf16x8*)(kp+2048); kf[3]=*(const __attribute__((address_space(3))) bf16x8*)(kp+2560);
  kf[4]=*(const __attribute__((address_space(3))) bf16x8*)(kp+4096); kf[5]=*(const __attribute__((address_space(3))) bf16x8*)(kp+4608);
  kf[6]=*(const __attribute__((address_space(3))) bf16x8*)(kp+6144); kf[7]=*(const __attribute__((address_space(3))) bf16x8*)(kp+6656);
}
__device__ __forceinline__ void kload2(bf16x8*kf,lds_cptr kp,int j){ kf[2*j]=*(const __attribute__((address_space(3))) bf16x8*)(kp+j*2048); kf[2*j+1]=*(const __attribute__((address_space(3))) bf16x8*)(kp+j*2048+512); }
__device__ __forceinline__ s16x4 vtr(lds_cptr p){ return __builtin_bit_cast(s16x4,__builtin_amdgcn_ds_read_tr16_b64_v4i16((__attribute__((address_space(3))) v4i16_t*)p)); }
__device__ __forceinline__ float rowmax(const f32x16&p0,const f32x16&p1){
  float a=max3f(p0[0],p0[1],p1[0]),b=max3f(p0[2],p0[3],p1[1]);a=max3f(a,p1[2],p1[3]);
  #pragma unroll
  for(int r=4;r<16;r+=4){a=max3f(a,p0[r],p0[r+1]);b=max3f(b,p0[r+2],p0[r+3]);a=max3f(a,p1[r],p1[r+1]);b=max3f(b,p1[r+2],p1[r+3]);}
  const float m=max2f(a,b);
  auto rr=__builtin_amdgcn_permlane32_swap(__float_as_uint(m),__float_as_uint(m),false,false);
  return max2f(__uint_as_float(rr[0]),__uint_as_float(rr[1]));
}
__device__ __forceinline__ void pv(f32x16*o,int vb,bf16x8 pa0,bf16x8 pa1,bf16x8 pa2,bf16x8 pa3){
  #pragma unroll
  for(int d0=0;d0<2;++d0){s16x4 lo[4],hi[4];
    #pragma unroll
    for(int ks=0;ks<4;++ks){
      asm volatile("ds_read_b64_tr_b16 %0,%1 offset:%c2":"=&v"(lo[ks]):"v"(vb),"i"(d0*4096+ks*1024):"memory");
      asm volatile("ds_read_b64_tr_b16 %0,%1 offset:%c2":"=&v"(hi[ks]):"v"(vb),"i"(d0*4096+ks*1024+512):"memory");}
    asm volatile("s_waitcnt lgkmcnt(0)":::"memory");SBAR();
    #define PK(k) (bf16x8){lo[k][0],lo[k][1],lo[k][2],lo[k][3],hi[k][0],hi[k][1],hi[k][2],hi[k][3]}
    o[d0]=__builtin_amdgcn_mfma_f32_32x32x16_bf16(pa0,PK(0),o[d0],0,0,0);
    o[d0]=__builtin_amdgcn_mfma_f32_32x32x16_bf16(pa1,PK(1),o[d0],0,0,0);
    o[d0]=__builtin_amdgcn_mfma_f32_32x32x16_bf16(pa2,PK(2),o[d0],0,0,0);
    o[d0]=__builtin_amdgcn_mfma_f32_32x32x16_bf16(pa3,PK(3),o[d0],0,0,0);
    #undef PK
  }
}

#ifndef ATTN_STORE16
#define ATTN_STORE16(p,v) (*(u32x4*)(p)=(v))
#endif
template<int THRL> __device__ __forceinline__ void attn_unit(int qb,const bf16*Qh,const bf16*__restrict__ Kh,const bf16*__restrict__ Vh,bf16*Oh,const float* __restrict__ rel_table,int head,char*shm,const int tid){
  const int lane=tid&63,r32=lane&31,hi=lane>>5; const int wid=__builtin_amdgcn_readfirstlane(tid>>6);
  const int q0=qb*QB;
  const bf16*Qw=Qh+(long)(q0+wid*QBLK)*DM;
  const unsigned lds0=(unsigned)(uintptr_t)shm;
  float*wsf=(float*)(shm+LDS_WS)+wid*64;
  const bf16*ksrc=Kh+(long)lane*DM+wid*8;
  const bf16*vsrc=Vh+(long)(16*(wid&3)+(lane>>2))*DM+(wid>>2)*32+(lane&3)*8;
  const unsigned kdst=lds0+LDS_K+wid*1024, vdst=lds0+LDS_V+wid*1024;
  #define DMA_K(t,slot) glds16(ksrc+(long)(t)*KVBLK*DM,(unsigned)__builtin_amdgcn_readfirstlane(kdst+(slot)))
  #define DMA_V(t,slot) glds16(vsrc+(long)(t)*KVBLK*DM,(unsigned)__builtin_amdgcn_readfirstlane(vdst+(slot)))
  const int vb0=(int)(lds0+LDS_V)+((lane>>4)&1)*32+(lane&3)*8+(4*hi+((lane&15)>>2))*64;
  const char*Kbase=shm+LDS_K; bf16x8 kf[8];
  const lds_cptr shm3=(lds_cptr)shm; const lds_cptr kp0=shm3+LDS_K+hi*1024+r32*16; const lds_cptr vp0=shm3+LDS_V+((lane>>4)&1)*32+(lane&3)*8+(4*hi+((lane&15)>>2))*64;
  const int NT=(q0+QB)/KVBLK;
  { float*lut=(float*)(shm+LDS_LUT); const float t31=rel_table[31*4+head];
    for(int i=tid;i<640;i+=512){ const int d=i-256; float v=0.f;
      if(d>=0&&d<128){ int bk; if(d<16)bk=d; else { bk=16+(int)(logf((float)d*(1.f/16.f))/logf(8.f)*16.f); bk=bk<31?bk:31; } v=(rel_table[bk*4+head]-t31)*1.4426950408889634f; }
      lut[i]=v; } }
  const float*lutl=(const float*)(shm+LDS_LUT)+(wid*QBLK+r32-4*hi+256-59);
  DMA_K(0,0);DMA_V(0,0);DMA_K(1,SLOTB);
  bf16x8 qr[4];
  #pragma unroll
  for(int d0=0;d0<4;++d0)qr[d0]=*reinterpret_cast<const bf16x8*>(&Qw[(long)r32*DM+d0*16+hi*8]);
  float mhat=0.f,l_reg=0.f;f32x16 o[2];o[0]=f32x16{};o[1]=f32x16{};f32x16 negm=f32x16{};asm volatile("":"+v"(negm));
  const int qrel=wid*QBLK+r32;
  #define CMASK(P0,P1,t) do{int jb_=(t)-(NT-4); if(jb_>=-2)biasadd(P0,P1,lutl-64*jb_); if(jb_>=0)cmask(P0,P1,jb_,qrel,hi);}while(0)
  bool resc=false;
  #define START(P0,P1) do{ const float rm=rowmax(P0,P1); resc=false; \
    { const float dl=rm; mhat=fadd_s(mhat,dl); \
      _Pragma("unroll") for(int r=0;r<16;++r){P0[r]=fsub_s(P0[r],dl);P1[r]=fsub_s(P1[r],dl);} \
      _Pragma("unroll") for(int r=0;r<16;++r)negm[r]=-mhat; asm volatile("":"+v"(negm)); } \
    _Pragma("unroll") for(int r=0;r<16;++r)P0[r]=__builtin_amdgcn_exp2f(P0[r]); }while(0)
  #define RESC() do{ if(resc){ asm volatile("s_waitcnt lgkmcnt(0)":::"memory"); \
      _Pragma("unroll") for(int d_=0;d_<2;++d_) _Pragma("unroll") for(int r=0;r<16;++r)o[d_][r]*=wsf[crow(r,hi)]; } }while(0)
  f32x16 pA0,pA1,pB0,pB1;
  int sl_prev=0,sl_cur=0,sl_next=SLOTB;
  #define ROT() do{sl_prev=sl_cur;sl_cur=sl_next;sl_next=(sl_next==(NSLOT-1)*SLOTB)?0:sl_next+SLOTB;}while(0)
  DMA_K(2,2*SLOTB);
  WAIT_BAR(3);
  qkt(pA0,pA1,Kbase,qr,negm,r32,hi);asm volatile("s_nop 15\n\ts_nop 7":"+v"(pA0),"+v"(pA1));CMASK(pA0,pA1,0);
  START(pA0,pA1);
  _Pragma("unroll") for(int r=0;r<16;++r)pA1[r]=__builtin_amdgcn_exp2f(pA1[r]);
  WAIT_BAR(0);
  DMA_K(3,0);DMA_V(1,SLOTB);
  ROT();
  kload8(kf,kp0+sl_cur);
  WAIT_BAR(2);
  s16x4 vlo[8],vhi[8]; u32x4 pw0,pw1,pw2,pw3;
  #define PKW(P,B) cvtpk_s(P[B],P[B+1])
  #define PAF(k) __builtin_bit_cast(bf16x8,pw##k)
  #define VFR(i) (bf16x8){vlo[i][0],vlo[i][1],vlo[i][2],vlo[i][3],vhi[i][0],vhi[i][1],vhi[i][2],vhi[i][3]}
  #define PIN(x) asm volatile("":"+v"(x))
  #define MX3(a,b,c) __builtin_fmaxf(__builtin_fmaxf((a),(b)),(c))
  #define GAPA(MF,A0,A1,A2,A3,W0,W1,PW) do{ MF; sacc+=A0; sacc+=A1; sacc+=A2; sacc+=A3; PIN(sacc); W0; W1; PIN(PW); SBAR(); }while(0)
  #define EX(v) __builtin_amdgcn_exp2f(v)
  #define GAPB(MF,X,B) do{ MF; X[B]=EX(X[B]); X[B+1]=EX(X[B+1]); X[B+2]=EX(X[B+2]); X[B+3]=EX(X[B+3]); PIN(X); SBAR(); }while(0)
  #define VRD(i) do{ vlo[i]=vtr(vp_+(((i)>>2)*4096+((i)&3)*1024)); vhi[i]=vtr(vp_+(((i)>>2)*4096+((i)&3)*1024+512)); }while(0)
  #define KRD(G,j) do{ if(G){ kload2(kf,kp0+sl_next,j); SBAR(); } }while(0)
  #define STEP(C0,C1,P0,P1,t,GK,GV,GL) do{ SBAR(); \
    const lds_cptr vp_=vp0+sl_prev; \
    VRD(0); SBAR(); float sacc=(P0[0]+P0[1]); \
    GAPA(C0=__builtin_amdgcn_mfma_f32_32x32x16_bf16(kf[0],qr[0],negm,0,0,0), P0[2],P0[3],P0[4],P0[5],     pw0[0]=PKW(P0,0), pw0[1]=PKW(P0,2), pw0); \
    VRD(4); SBAR(); GAPA(C1=__builtin_amdgcn_mfma_f32_32x32x16_bf16(kf[1],qr[0],negm,0,0,0), P0[6],P0[7],P0[8],P0[9],     pw0[2]=PKW(P0,4), pw0[3]=PKW(P0,6), pw0); \
    VRD(1); SBAR(); GAPA(C0=__builtin_amdgcn_mfma_f32_32x32x16_bf16(kf[2],qr[1],C0,0,0,0),   P0[10],P0[11],P0[12],P0[13], pw1[0]=PKW(P0,8), pw1[1]=PKW(P0,10), pw1); \
    VRD(5); SBAR(); GAPA(C1=__builtin_amdgcn_mfma_f32_32x32x16_bf16(kf[3],qr[1],C1,0,0,0),   P0[14],P0[15],P1[0],P1[1],   pw1[2]=PKW(P0,12),pw1[3]=PKW(P0,14), pw1); \
    VRD(2); SBAR(); GAPA(C0=__builtin_amdgcn_mfma_f32_32x32x16_bf16(kf[4],qr[2],C0,0,0,0),   P1[2],P1[3],P1[4],P1[5],     pw2[0]=PKW(P1,0), pw2[1]=PKW(P1,2), pw2); \
    VRD(6); SBAR(); GAPA(C1=__builtin_amdgcn_mfma_f32_32x32x16_bf16(kf[5],qr[2],C1,0,0,0),   P1[6],P1[7],P1[8],P1[9],     pw2[2]=PKW(P1,4), pw2[3]=PKW(P1,6), pw2); \
    VRD(3); SBAR(); GAPA(C0=__builtin_amdgcn_mfma_f32_32x32x16_bf16(kf[6],qr[3],C0,0,0,0),   P1[10],P1[11],P1[12],P1[13], pw3[0]=PKW(P1,8), pw3[1]=PKW(P1,10), pw3); \
    VRD(7); SBAR(); GAPA(C1=__builtin_amdgcn_mfma_f32_32x32x16_bf16(kf[7],qr[3],C1,0,0,0),   P1[14],P1[15],0.f,0.f,       pw3[2]=PKW(P1,12),pw3[3]=PKW(P1,14), pw3); \
    l_reg+=sacc; \
    if(GK){DMA_K((t)+3,sl_cur);} if(GV){DMA_V((t)+1,sl_next);} \
    CMASK(C0,C1,t); \
    { float a=MX3(C0[0],C0[1],C1[0]),b=MX3(C0[2],C0[3],C1[1]); a=MX3(a,C1[2],C1[3]); \
      _Pragma("unroll") for(int r=4;r<16;r+=4){a=MX3(a,C0[r],C0[r+1]);b=MX3(b,C0[r+2],C0[r+3]);a=MX3(a,C1[r],C1[r+1]);b=MX3(b,C1[r+2],C1[r+3]);} \
      float rm=__builtin_fmaxf(a,b); { auto rr=__builtin_amdgcn_permlane32_swap(__float_as_uint(rm),__float_as_uint(rm),false,false); rm=__builtin_fmaxf(__uint_as_float(rr[0]),__uint_as_float(rr[1])); } \
      resc=false; \
      if(__builtin_expect(__any(rm>(float)THRL),0)){ const float dl=__builtin_fmaxf(rm,0.f); mhat+=dl; \
        _Pragma("unroll") for(int r=0;r<16;++r){C0[r]-=dl;C1[r]-=dl;} \
        _Pragma("unroll") for(int r=0;r<16;++r)negm[r]=-mhat; asm volatile("":"+v"(negm)); \
        const float f=__builtin_amdgcn_exp2f(-dl); l_reg*=f; if(hi==0)wsf[r32]=f; resc=true; } } \
    SBAR(); \
    GAPB(o[0]=__builtin_amdgcn_mfma_f32_32x32x16_bf16(PAF(0),VFR(0),o[0],0,0,0), C0,0); \
    GAPB(o[1]=__builtin_amdgcn_mfma_f32_32x32x16_bf16(PAF(0),VFR(4),o[1],0,0,0), C0,4); \
    KRD(GL,0); GAPB(o[0]=__builtin_amdgcn_mfma_f32_32x32x16_bf16(PAF(1),VFR(1),o[0],0,0,0), C0,8); \
    KRD(GL,1); GAPB(o[1]=__builtin_amdgcn_mfma_f32_32x32x16_bf16(PAF(1),VFR(5),o[1],0,0,0), C0,12); \
    KRD(GL,2); GAPB(o[0]=__builtin_amdgcn_mfma_f32_32x32x16_bf16(PAF(2),VFR(2),o[0],0,0,0), C1,0); \
    KRD(GL,3); GAPB(o[1]=__builtin_amdgcn_mfma_f32_32x32x16_bf16(PAF(2),VFR(6),o[1],0,0,0), C1,4); \
    GAPB(o[0]=__builtin_amdgcn_mfma_f32_32x32x16_bf16(PAF(3),VFR(3),o[0],0,0,0), C1,8); \
    GAPB(o[1]=__builtin_amdgcn_mfma_f32_32x32x16_bf16(PAF(3),VFR(7),o[1],0,0,0), C1,12); \
    }while(0)
  int t=1;
  #undef CMASK
  #define CMASK(P0,P1,t) do{}while(0)
  for(;t+7<NT;t+=2){
    STEP(pB0,pB1,pA0,pA1,t,true,true,true);     WAIT_BAR(2); RESC(); ROT();
    STEP(pA0,pA1,pB0,pB1,t+1,true,true,true);   WAIT_BAR(2); RESC(); ROT();
  }
  #undef CMASK
  #define CMASK(P0,P1,t) do{int jb_=(t)-(NT-4); if(jb_>=-2)biasadd(P0,P1,lutl-64*jb_); if(jb_>=0)cmask(P0,P1,jb_,qrel,hi);}while(0)
  #define ENDW(tt) do{ if((tt)+3<NT){WAIT_BAR(2);} else if((tt)+2<NT){WAIT_BAR(1);} else {WAIT_BAR(0);} }while(0)
  for(;t+1<NT;t+=2){
    STEP(pB0,pB1,pA0,pA1,t,(t+3<NT),(t+1<NT),(t+1<NT));       ENDW(t);   RESC(); ROT();
    STEP(pA0,pA1,pB0,pB1,t+1,(t+4<NT),(t+2<NT),(t+2<NT));     ENDW(t+1); RESC(); ROT();
  }
  STEP(pB0,pB1,pA0,pA1,NT-1,false,false,false); RESC();
  { float sacc=pB0[0]+pB0[1]; _Pragma("unroll") for(int r=2;r<16;++r)sacc+=pB0[r]; _Pragma("unroll") for(int r=0;r<16;++r)sacc+=pB1[r]; l_reg+=sacc;
    pw0=(u32x4){PKW(pB0,0),PKW(pB0,2),PKW(pB0,4),PKW(pB0,6)};pw1=(u32x4){PKW(pB0,8),PKW(pB0,10),PKW(pB0,12),PKW(pB0,14)};pw2=(u32x4){PKW(pB1,0),PKW(pB1,2),PKW(pB1,4),PKW(pB1,6)};pw3=(u32x4){PKW(pB1,8),PKW(pB1,10),PKW(pB1,12),PKW(pB1,14)};
    SBAR(); pv(o,vb0+sl_cur,PAF(0),PAF(1),PAF(2),PAF(3)); }
  #undef PKW
  #undef PAF
  #undef VFR
  #undef PIN
  #undef MX3
  #undef GAPA
  #undef GAPB
  #undef EX
  #undef VRD
  #undef KRD
  #undef STEP
  #undef ENDW
  {auto rr=__builtin_amdgcn_permlane32_swap(__float_as_uint(l_reg),__float_as_uint(l_reg),false,false);l_reg=__uint_as_float(rr[0])+__uint_as_float(rr[1]);}
  if(hi==0)wsf[32+r32]=l_reg;asm volatile("s_waitcnt lgkmcnt(0)":::"memory");
  float rli[16];
  #pragma unroll
  for(int r=0;r<16;++r)rli[r]=__builtin_amdgcn_rcpf(wsf[32+crow(r,hi)]);
  bf16*Ow=Oh+(long)(q0+wid*QBLK)*OPITCH;
  { bf16*stg=(bf16*)(shm+LDS_OST)+wid*2048;
    #pragma unroll
    for(int r=0;r<16;++r){const int orow=crow(r,hi);
      #pragma unroll
      for(int d0=0;d0<2;++d0)stg[orow*64+d0*32+r32]=__float2bfloat16(o[d0][r]*rli[r]);}
    asm volatile("s_waitcnt lgkmcnt(0)":::"memory");
    #pragma unroll
    for(int i=0;i<4;++i){const int row=i*8+(lane>>3),ch=lane&7; const u32x4 v=*(const u32x4*)(stg+row*64+ch*8); ATTN_STORE16(Ow+(long)row*OPITCH+ch*8,v);} }
  asm volatile("s_waitcnt lgkmcnt(0)\n\ts_barrier":::"memory");
  #undef DMA_K
  #undef DMA_V
  #undef CMASK
  #undef START
  #undef RESC
  #undef ROT
}
constexpr int ATTN_LDS_BYTES=LDS_BYTES;
#undef SBAR
#undef WAIT_BAR
}
#define XB_TMO      128
#define XB_XCNT(j)  (256  + 64 * (j))
#define XB_XSUB(j)  (1280 + 64 * (j))
#define XB_XGEN(j)  (2304 + 64 * (j))
#define XB_TOP      3328
#define XB_TOPGEN   3392
#define XCD_BAR_WORDS 3456
#define XB_SPIN_CAP (1u << 18)

__device__ __forceinline__ unsigned xb_ld(unsigned* p)              { return __hip_atomic_load(p, __ATOMIC_RELAXED, __HIP_MEMORY_SCOPE_AGENT); }
__device__ __forceinline__ unsigned xb_add(unsigned* p, unsigned v) { return __hip_atomic_fetch_add(p, v, __ATOMIC_RELAXED, __HIP_MEMORY_SCOPE_AGENT); }
__device__ __forceinline__ unsigned xb_xcc_id() { return (unsigned)__builtin_amdgcn_s_getreg((3 << 11) | 20) & 0xFu; }
#define XB_SPIN(cond, bar) do { unsigned _sp = 0; while (cond) { __builtin_amdgcn_s_sleep(1); \
    if ((++_sp & 255u) == 0u) { if (xb_ld(&(bar)[XB_TMO])) break; if (_sp > XB_SPIN_CAP) { atomicAdd(&(bar)[XB_TMO], 1u); break; } } } } while (0)

struct XcdBarrier {
    unsigned* bar; unsigned x;
    volatile LAS unsigned* st;
};

__device__ __forceinline__ XcdBarrier xcd_barrier_post(unsigned* bar, volatile LAS unsigned* st) {
    XcdBarrier b; b.bar = bar; b.x = xb_xcc_id(); b.st = st;
    if (threadIdx.x == 0) (void)xb_add(&bar[XB_XCNT(b.x)], 1u);
    return b;
}
__device__ __forceinline__ void xcd_barrier_complete(unsigned* bar, unsigned x, unsigned& nloc, unsigned& nx) {
    const unsigned G = gridDim.x * gridDim.y * gridDim.z;
    unsigned sum, cnt, mine, sp = 0u;
    for (;;) {
        sum = 0u; cnt = 0u; mine = 0u;
#pragma unroll
        for (unsigned j = 0; j < 16; ++j) { const unsigned c = xb_ld(&bar[XB_XCNT(j)]); sum += c; cnt += (c > 0u) ? 1u : 0u; mine = (j == x) ? c : mine; }
        if (sum == G) break;
        __builtin_amdgcn_s_sleep(1);
        if ((++sp & 255u) == 0u) { if (xb_ld(&bar[XB_TMO])) break; if (sp > XB_SPIN_CAP) { atomicAdd(&bar[XB_TMO], 1u); break; } }
    }
    nloc = mine > 0u ? mine : 1u; nx = cnt > 0u ? cnt : 1u;
}

__device__ __forceinline__ void xcd_barrier(const XcdBarrier& b) {
    asm volatile("s_waitcnt vmcnt(0)" ::: "memory");
    __syncthreads();
    if (threadIdx.x == 0) {
        unsigned* bar = b.bar;
        __builtin_amdgcn_s_waitcnt(0);
        unsigned nloc = b.st[0], nx = b.st[1];
        if (nloc == 0u) { xcd_barrier_complete(bar, b.x, nloc, nx); b.st[0] = nloc; b.st[1] = nx; }
        const unsigned old = xb_add(&bar[XB_XSUB(b.x)], 1u);
        const unsigned gen = old / nloc;
        if (old + 1u == (gen + 1u) * nloc) {
            __builtin_amdgcn_fence(__ATOMIC_RELEASE, "agent");
            asm volatile("s_waitcnt vmcnt(0)" ::: "memory");
            const unsigned og = xb_add(&bar[XB_TOP], 1u);
            const unsigned tg = og / nx;
            if (og + 1u == (tg + 1u) * nx) xb_add(&bar[XB_TOPGEN], 1u);
            else XB_SPIN(xb_ld(&bar[XB_TOPGEN]) == tg, bar);
            __builtin_amdgcn_fence(__ATOMIC_ACQUIRE, "agent");
            xb_add(&bar[XB_XGEN(b.x)], 1u);
            asm volatile("s_waitcnt vmcnt(0)" ::: "memory");
        } else {
            XB_SPIN(xb_ld(&bar[XB_XGEN(b.x)]) == gen, bar);
            __builtin_amdgcn_fence(__ATOMIC_ACQUIRE, "agent");
            asm volatile("s_waitcnt vmcnt(0)" ::: "memory");
        }
    }
    __syncthreads();
}
struct Args { const float* in[27]; float* out; unsigned char* ws; int ph_lo, ph_hi, li, pad; };
enum { I_X = 0, I_MEM, I_REL, I_ANORM, I_WIN, I_BGATE, I_CONV, I_ALOG, I_DTB, I_DNON, I_DAQN, I_DAKN, I_LAM, I_SUBLN, I_MEMNORM, I_WMKV, I_MXQN, I_MXKN, I_WBR, I_WOUT, I_FNORM,
       I_WR, I_BR, I_WGU, I_BGU, I_WD, I_BD };

DI void tr_item(const float* __restrict__ W, size_t ldw, int k0, int c0, bf16* WT, int K, size_t drow0, LAS float* scr, int lane) {
#pragma unroll 8
    for (int k = 0; k < 64; ++k) scr[k * 65 + lane] = W[(size_t)(k0 + k) * ldw + c0 + lane];
    LDS_WAIT();
    const int c = lane & 7;
#pragma unroll
    for (int j = 0; j < 8; ++j) { const int n = (lane >> 3) + 8 * j; const LAS float* s = scr + (8 * c) * 65 + n;
        v4u o; o.x = pk2(s[0 * 65], s[1 * 65]); o.y = pk2(s[2 * 65], s[3 * 65]); o.z = pk2(s[4 * 65], s[5 * 65]); o.w = pk2(s[6 * 65], s[7 * 65]);
        *(v4u*)(WT + (drow0 + n) * K + k0 + 8 * c) = o; }
    LDS_WAIT();
}

DI void p0_prologue(const Args& a, LAS unsigned char* lds, int vcu, int G, int wave, int lane) {
    unsigned char* ws = a.ws;
    LAS float* scr = (LAS float*)(lds + wave * 16640);
    const int gw = vcu * 8 + wave, NGW = G * 8;
    constexpr int I_IN = 16 * 112, I_GU = 16 * 32 * NEXP, I_DN = 16 * 16 * NEXP, I_BRI = 3 * 8 * 16, I_OUT = 16 * 16, I_MK = 16 * 16;
    constexpr int NITEMS = I_IN + I_GU + I_DN + I_BRI + I_OUT + I_MK;
    for (int it = gw; it < NITEMS; it += NGW) {
        int r = it;
        if (r < I_GU) { const int e = r / 512, q = r % 512, kb = q / 32, nb = q % 32; const int n0 = nb * 64, pn = n0 >> 8, bj = (n0 >> 7) & 1, i0 = n0 & 127;
            tr_item(a.in[I_WGU] + (size_t)e * 1024 * 2048, 2048, kb * 64, bj * 1024 + 128 * pn + i0, (bf16*)(ws + WS_WGU), 1024, (size_t)e * 2048 + n0, scr, lane); continue; } r -= I_GU;
        if (r < I_DN) { const int e = r / 256, q = r % 256, kb = q / 16, nb = q % 16;
            tr_item(a.in[I_WD] + (size_t)e * 1024 * 1024, 1024, kb * 64, nb * 64, (bf16*)(ws + WS_WD), 1024, (size_t)e * 1024 + nb * 64, scr, lane); continue; } r -= I_DN;
        if (r < I_IN) { const int kb = r / 112, nb = r % 112; const int n0 = nb * 64;
            tr_item(a.in[I_WIN], INW, kb * 64, n0 < 2048 ? n0 : n0 + 8, (bf16*)(ws + WS_WIN), 1024, (size_t)n0, scr, lane); continue; } r -= I_IN;
        if (r < I_BRI) { const int br = r / 128, q = r % 128, kb = q / 16, nb = q % 16;
            tr_item(a.in[I_WBR] + (size_t)br * 512 * 1024, 1024, kb * 64, nb * 64, (bf16*)(ws + WS_WB), 512, (size_t)br * 1024 + nb * 64, scr, lane); continue; } r -= I_BRI;
        if (r < I_OUT) { const int kb = r / 16, nb = r % 16;
            tr_item(a.in[I_WOUT], 1024, kb * 64, nb * 64, (bf16*)(ws + WS_WOUT), 1024, (size_t)nb * 64, scr, lane); continue; } r -= I_OUT;
        { const int kb = r / 16, nb = r % 16;
            tr_item(a.in[I_WMKV], 1024, kb * 64, nb * 64, (bf16*)(ws + WS_WMKV), 1024, (size_t)nb * 64, scr, lane); }
    }
    {
        const float* win = a.in[I_WIN];
        f32x4 gv[4];
#pragma unroll
        for (int j = 0; j < 4; ++j) gv[j] = ((const f32x4*)a.in[I_ANORM])[lane + 64 * j];
        f32x4 wa[4][4], wb[4][4];
#pragma unroll
        for (int j = 0; j < 4; ++j)
#pragma unroll
            for (int c = 0; c < 4; ++c) { const f32x4* p = (const f32x4*)(win + (size_t)(4 * lane + 256 * j + c) * INW + 2048); wa[j][c] = p[0]; wb[j][c] = p[1]; }
        const float alog = a.in[I_ALOG][lane & 3], dtb = a.in[I_DTB][lane & 3];
        float* G_ = (float*)(ws + WS_G); float* B_ = (float*)(ws + WS_BETA);
        bf16* H = (bf16*)(ws + WS_H);
        for (int m = gw; m < T; m += NGW) {
            const f32x4* xr = (const f32x4*)(a.in[I_X] + (size_t)m * D) + lane;
            f32x4 v[4]; float ss = 0.f;
#pragma unroll
            for (int j = 0; j < 4; ++j) { v[j] = xr[64 * j]; ss += (v[j].x * v[j].x + v[j].y * v[j].y) + (v[j].z * v[j].z + v[j].w * v[j].w); }
            const float rstd = rsqrtf(wave_sum(ss) * (1.f / D) + EPS);
            f32x4 pa = {0.f, 0.f, 0.f, 0.f}, pb = {0.f, 0.f, 0.f, 0.f};
            unsigned long long* o8 = (unsigned long long*)(H + (size_t)m * D) + lane;
#pragma unroll
            for (int j = 0; j < 4; ++j) { v[j] = v[j] * rstd * gv[j];
                o8[64 * j] = (unsigned long long)pk2(v[j].x, v[j].y) | ((unsigned long long)pk2(v[j].z, v[j].w) << 32);
                pa += wa[j][0] * v[j].x + wa[j][1] * v[j].y + wa[j][2] * v[j].z + wa[j][3] * v[j].w;
                pb += wb[j][0] * v[j].x + wb[j][1] * v[j].y + wb[j][2] * v[j].z + wb[j][3] * v[j].w; }
            pa.x = wave_sum(pa.x); pa.y = wave_sum(pa.y); pa.z = wave_sum(pa.z); pa.w = wave_sum(pa.w);
            pb.x = wave_sum(pb.x); pb.y = wave_sum(pb.y); pb.z = wave_sum(pb.z); pb.w = wave_sum(pb.w);
            if (lane < 4) {
                const float av = lane == 0 ? pa.x : lane == 1 ? pa.y : lane == 2 ? pa.z : pa.w;
                const float bv = lane == 0 ? pb.x : lane == 1 ? pb.y : lane == 2 ? pb.z : pb.w;
                const float z = av + dtb; const float sp = z > 20.f ? z : log1pf(expf(z));
                G_[(size_t)m * 4 + lane] = -expf(alog) * sp;
                B_[(size_t)m * 4 + lane] = 1.f / (1.f + expf(-bv));
            }
        }
    }
    {
        f32x4 gv[4];
#pragma unroll
        for (int j = 0; j < 4; ++j) gv[j] = ((const f32x4*)a.in[I_MEMNORM])[lane + 64 * j];
        bf16* MN = (bf16*)(ws + WS_MEMN);
        for (int m = gw; m < BATCH * NMEM; m += NGW) {
            const f32x4* xr = (const f32x4*)(a.in[I_MEM] + (size_t)m * D) + lane;
            f32x4 v[4]; float ss = 0.f;
#pragma unroll
            for (int j = 0; j < 4; ++j) { v[j] = xr[64 * j]; ss += (v[j].x * v[j].x + v[j].y * v[j].y) + (v[j].z * v[j].z + v[j].w * v[j].w); }
            const float rstd = rsqrtf(wave_sum(ss) * (1.f / D) + EPS);
            unsigned long long* o8 = (unsigned long long*)(MN + (size_t)m * D) + lane;
#pragma unroll
            for (int j = 0; j < 4; ++j) { v[j] = v[j] * rstd * gv[j]; o8[64 * j] = (unsigned long long)pk2(v[j].x, v[j].y) | ((unsigned long long)pk2(v[j].z, v[j].w) << 32); }
        }
    }
}

struct EpiP {
    static constexpr bool PERM = true;
    bf16* O; const float* b_gate;
    DI void operator()(const f32x4 (&acc)[2][2][4][2], const pg8::Unit& u, int wr, int wc, int fr, int fq) const {
        const int row0 = u.pm * 256 + wr * 64 + fr, col0 = u.pn * 256 + wc * 32 + 8 * fq;
        const bool isg = u.pn >= 16;
        f32x4 bv[2][2];
#pragma unroll
        for (int bj = 0; bj < 2; ++bj)
#pragma unroll
            for (int n = 0; n < 2; ++n) bv[bj][n] = isg ? *(const f32x4*)(b_gate + (col0 - P_GATE) + bj * 128 + 4 * n) : (f32x4){0.f, 0.f, 0.f, 0.f};
#pragma unroll
        for (int ai = 0; ai < 2; ++ai)
#pragma unroll
            for (int m = 0; m < 4; ++m) { bf16* rowp = O + (size_t)(row0 + ai * 128 + m * 16) * PW + col0;
#pragma unroll
                for (int bj = 0; bj < 2; ++bj) { f32x4 v0 = acc[ai][bj][m][0] + bv[bj][0], v1 = acc[ai][bj][m][1] + bv[bj][1];
                    if (isg) { v0.x = sigmoidf_(v0.x); v0.y = sigmoidf_(v0.y); v0.z = sigmoidf_(v0.z); v0.w = sigmoidf_(v0.w);
                               v1.x = sigmoidf_(v1.x); v1.y = sigmoidf_(v1.y); v1.z = sigmoidf_(v1.z); v1.w = sigmoidf_(v1.w); }
                    v4u w; w.x = pk2(v0.x, v0.y); w.y = pk2(v0.z, v0.w); w.z = pk2(v1.x, v1.y); w.w = pk2(v1.z, v1.w);
                    *(v4u*)(rowp + bj * 128) = w; } }
    }
};
struct EpiPlain {
    static constexpr bool PERM = true;
    bf16* O; int ldc;
    DI void operator()(const f32x4 (&acc)[2][2][4][2], const pg8::Unit& u, int wr, int wc, int fr, int fq) const {
        const int row0 = u.pm * 256 + wr * 64 + fr, col0 = u.pn * 256 + wc * 32 + 8 * fq;
#pragma unroll
        for (int ai = 0; ai < 2; ++ai)
#pragma unroll
            for (int m = 0; m < 4; ++m) { bf16* rowp = O + (size_t)(row0 + ai * 128 + m * 16) * ldc + col0;
#pragma unroll
                for (int bj = 0; bj < 2; ++bj) { const f32x4 v0 = acc[ai][bj][m][0], v1 = acc[ai][bj][m][1];
                    v4u w; w.x = pk2(v0.x, v0.y); w.y = pk2(v0.z, v0.w); w.z = pk2(v1.x, v1.y); w.w = pk2(v1.z, v1.w);
                    *(v4u*)(rowp + bj * 128) = w; } }
    }
};

DI void p2_norm_rows(const Args& a, int vcu, int G, int wave, int lane) {
    unsigned char* ws = a.ws; bf16* P = (bf16*)(ws + WS_P);
    const int gw = vcu * 8 + wave, NGW = G * 8;
    float gda[16], gmx[8], gmk[8];
    { const float* gsrc = (lane < 32 ? a.in[I_DAQN] : a.in[I_DAKN]) + 16 * (lane & 3);
#pragma unroll
      for (int i = 0; i < 16; ++i) gda[i] = gsrc[i];
#pragma unroll
      for (int i = 0; i < 8; ++i) { gmx[i] = a.in[I_MXQN][8 * (lane & 15) + i]; gmk[i] = a.in[I_MXKN][8 * (lane & 15) + i]; } }
    const float sc_da = lane < 32 ? 0.125f * LOG2E : 1.f;
    const float sc_mx = 0.08838834764831845f * LOG2E;
    for (int m = gw; m < T; m += NGW) {
        { v4u* p = (v4u*)(P + (size_t)m * PW + P_DAQ + 16 * lane); v4u w0 = p[0], w1 = p[1];
          float f[16]; f[0] = bflo(w0.x); f[1] = bfhi(w0.x); f[2] = bflo(w0.y); f[3] = bfhi(w0.y); f[4] = bflo(w0.z); f[5] = bfhi(w0.z); f[6] = bflo(w0.w); f[7] = bfhi(w0.w);
          f[8] = bflo(w1.x); f[9] = bfhi(w1.x); f[10] = bflo(w1.y); f[11] = bfhi(w1.y); f[12] = bflo(w1.z); f[13] = bfhi(w1.z); f[14] = bflo(w1.w); f[15] = bfhi(w1.w);
          float ss = 0.f;
#pragma unroll
          for (int i = 0; i < 16; ++i) ss += f[i] * f[i];
          ss += __shfl_xor(ss, 1); ss += __shfl_xor(ss, 2);
          const float r = rsqrtf(ss * (1.f / 64.f) + EPS) * sc_da;
#pragma unroll
          for (int i = 0; i < 16; ++i) f[i] = f[i] * r * gda[i];
          w0.x = pk2(f[0], f[1]); w0.y = pk2(f[2], f[3]); w0.z = pk2(f[4], f[5]); w0.w = pk2(f[6], f[7]);
          w1.x = pk2(f[8], f[9]); w1.y = pk2(f[10], f[11]); w1.z = pk2(f[12], f[13]); w1.w = pk2(f[14], f[15]);
          p[0] = w0; p[1] = w1; }
        { v4u* p = (v4u*)(P + (size_t)m * PW + P_MXQ + 8 * lane); v4u w0 = p[0];
          float f[8]; f[0] = bflo(w0.x); f[1] = bfhi(w0.x); f[2] = bflo(w0.y); f[3] = bfhi(w0.y); f[4] = bflo(w0.z); f[5] = bfhi(w0.z); f[6] = bflo(w0.w); f[7] = bfhi(w0.w);
          float ss = 0.f;
#pragma unroll
          for (int i = 0; i < 8; ++i) ss += f[i] * f[i];
          ss += __shfl_xor(ss, 1); ss += __shfl_xor(ss, 2); ss += __shfl_xor(ss, 4); ss += __shfl_xor(ss, 8);
          const float r = rsqrtf(ss * (1.f / 128.f) + EPS) * sc_mx;
#pragma unroll
          for (int i = 0; i < 8; ++i) f[i] = f[i] * r * gmx[i];
          w0.x = pk2(f[0], f[1]); w0.y = pk2(f[2], f[3]); w0.z = pk2(f[4], f[5]); w0.w = pk2(f[6], f[7]);
          p[0] = w0; }
    }
    bf16* MKV = (bf16*)(ws + WS_MKV);
    for (int m = gw; m < BATCH * NMEM; m += NGW) {
        v4u* p = (v4u*)(MKV + (size_t)m * 1024 + 8 * lane); v4u w0 = p[0];
        float f[8]; f[0] = bflo(w0.x); f[1] = bfhi(w0.x); f[2] = bflo(w0.y); f[3] = bfhi(w0.y); f[4] = bflo(w0.z); f[5] = bfhi(w0.z); f[6] = bflo(w0.w); f[7] = bfhi(w0.w);
        float ss = 0.f;
#pragma unroll
        for (int i = 0; i < 8; ++i) ss += f[i] * f[i];
        ss += __shfl_xor(ss, 1); ss += __shfl_xor(ss, 2); ss += __shfl_xor(ss, 4); ss += __shfl_xor(ss, 8);
        const float r = rsqrtf(ss * (1.f / 128.f) + EPS);
#pragma unroll
        for (int i = 0; i < 8; ++i) f[i] = f[i] * r * gmk[i];
        w0.x = pk2(f[0], f[1]); w0.y = pk2(f[2], f[3]); w0.z = pk2(f[4], f[5]); w0.w = pk2(f[6], f[7]);
        p[0] = w0;
    }
}

constexpr int PREP_GC = 0, PREP_BETA = 256, PREP_QS = 1024, PREP_KS = PREP_QS + 64 * 272, PREP_LM = PREP_KS + 64 * 272, PREP_RHS = PREP_LM + 64 * 64 * 4, PREP_END = PREP_RHS + 64 * 256 * 4;
static_assert(PREP_END <= RING_BYTES, "prep LDS");
DI void dn_prep_unit(const Args& a, LAS unsigned char* lds, int ck, int tid_in, int wave, int lane_in) {
    const int tid = fresh_tid(), lane = tid & 63; (void)tid_in; (void)lane_in;
    unsigned char* ws = a.ws; const bf16* P = (const bf16*)(ws + WS_P);
    const int n = ck & 127, h = (ck >> 7) & 3, b = ck >> 9;
    const size_t t0 = (size_t)b * SEQ + (size_t)n * 64;
    LAS float* gc = (LAS float*)(lds + PREP_GC); LAS float* bet = (LAS float*)(lds + PREP_BETA);
    LAS float* Lm = (LAS float*)(lds + PREP_LM); LAS float* RHS = (LAS float*)(lds + PREP_RHS);
    if (wave == 0) {
        float v = ((const float*)(ws + WS_G))[(t0 + lane) * 4 + h];
#pragma unroll
        for (int o = 1; o < 64; o <<= 1) { const float u = __shfl_up(v, o); if (lane >= o) v += u; }
        gc[lane] = v; bet[lane] = ((const float*)(ws + WS_BETA))[(t0 + lane) * 4 + h];
    }
    __syncthreads();
    if (wave < 6) {
        const int part = wave >> 1, rg = (tid >> 4) & 7, cg = tid & 15, i0 = rg * 8;
        const int ch0 = part * 512 + h * 128 + cg * 8;
        float w[4][8];
#pragma unroll
        for (int j = 0; j < 4; ++j) { const f32x4* p = (const f32x4*)(a.in[I_CONV] + j * 1536 + ch0); const f32x4 w0 = p[0], w1 = p[1];
            w[j][0] = w0.x; w[j][1] = w0.y; w[j][2] = w0.z; w[j][3] = w0.w; w[j][4] = w1.x; w[j][5] = w1.y; w[j][6] = w1.z; w[j][7] = w1.w; }
        v4u xin[11];
        const bf16* xp = P + ((long)b * SEQ + n * 64 + i0 - 3) * PW + ch0;
        asm volatile("" : "+v"(xp));
#pragma unroll
        for (int jj = 0; jj < 11; ++jj) { const int s = n * 64 + i0 - 3 + jj;
            xin[jj] = (s >= 0) ? *(const GAS v4u*)(xp + (long)jj * PW) : (v4u){0u, 0u, 0u, 0u}; }
        float o[8][8];
#pragma unroll
        for (int ri = 0; ri < 8; ++ri) {
            float acc[8];
#pragma unroll
            for (int c = 0; c < 8; ++c) acc[c] = 0.f;
#pragma unroll
            for (int j = 0; j < 4; ++j) { const v4u x = xin[ri + j];
                acc[0] += w[j][0] * bflo(x.x); acc[1] += w[j][1] * bfhi(x.x); acc[2] += w[j][2] * bflo(x.y); acc[3] += w[j][3] * bfhi(x.y);
                acc[4] += w[j][4] * bflo(x.z); acc[5] += w[j][5] * bfhi(x.z); acc[6] += w[j][6] * bflo(x.w); acc[7] += w[j][7] * bfhi(x.w); }
            float ss = 0.f;
#pragma unroll
            for (int c = 0; c < 8; ++c) { const float s_ = acc[c] * sigmoidf_(acc[c]); o[ri][c] = s_; ss += s_ * s_; }
            ss += __shfl_xor(ss, 1); ss += __shfl_xor(ss, 2); ss += __shfl_xor(ss, 4); ss += __shfl_xor(ss, 8);
            const float nrm = part == 0 ? rsqrtf(ss + EPS) * 0.08838834764831845f : part == 1 ? rsqrtf(ss + EPS) : 1.f;
#pragma unroll
            for (int c = 0; c < 8; ++c) o[ri][c] *= nrm;
        }
        bf16* qdp = (bf16*)(ws + WS_QD) + (size_t)ck * 8192 + (size_t)(((i0 >> 5) * 8 + (cg >> 1)) * 64 + (i0 & 31) + 32 * (cg & 1)) * 8;
        asm volatile("" : "+v"(qdp));
#pragma unroll
        for (int ri = 0; ri < 8; ++ri) {
            const int row = i0 + ri; const float g_ = gc[row], be = bet[row];
            if (part == 0) {
                v4u wq; wq.x = pk2(o[ri][0], o[ri][1]); wq.y = pk2(o[ri][2], o[ri][3]); wq.z = pk2(o[ri][4], o[ri][5]); wq.w = pk2(o[ri][6], o[ri][7]);
                *(LAS v4u*)(lds + PREP_QS + row * 272 + cg * 16) = wq;
                const float eg = fast_exp(g_);
                v4u wd; wd.x = pk2(o[ri][0] * eg, o[ri][1] * eg); wd.y = pk2(o[ri][2] * eg, o[ri][3] * eg); wd.z = pk2(o[ri][4] * eg, o[ri][5] * eg); wd.w = pk2(o[ri][6] * eg, o[ri][7] * eg);
                *(GAS v4u*)(qdp + ri * 8) = wd;
            } else if (part == 1) {
                v4u wq; wq.x = pk2(o[ri][0], o[ri][1]); wq.y = pk2(o[ri][2], o[ri][3]); wq.z = pk2(o[ri][4], o[ri][5]); wq.w = pk2(o[ri][6], o[ri][7]);
                *(LAS v4u*)(lds + PREP_KS + row * 272 + cg * 16) = wq;
                const float f = be * fast_exp(g_);
                LAS f32x4* r4 = (LAS f32x4*)(RHS + row * 256 + 128 + cg * 8);
                r4[0] = (f32x4){o[ri][0] * f, o[ri][1] * f, o[ri][2] * f, o[ri][3] * f}; r4[1] = (f32x4){o[ri][4] * f, o[ri][5] * f, o[ri][6] * f, o[ri][7] * f};
            } else {
                LAS f32x4* r4 = (LAS f32x4*)(RHS + row * 256 + cg * 8);
                r4[0] = (f32x4){o[ri][0] * be, o[ri][1] * be, o[ri][2] * be, o[ri][3] * be}; r4[1] = (f32x4){o[ri][4] * be, o[ri][5] * be, o[ri][6] * be, o[ri][7] * be};
            }
        }
    }
    __syncthreads();
    {
        const int sel = wave >> 2, it = (wave >> 1) & 1, jt = wave & 1, r = lane & 31, hh = lane >> 5;
        const LAS unsigned char* Ab = lds + (sel ? PREP_QS : PREP_KS) + (32 * it + r) * 272 + hh * 16;
        const LAS unsigned char* Bb = lds + PREP_KS + (32 * jt + r) * 272 + hh * 16;
        f32x16 acc = {};
#pragma unroll
        for (int s = 0; s < 8; ++s) { const bf16x8 av = *(const LAS bf16x8*)(Ab + s * 32), bv = *(const LAS bf16x8*)(Bb + s * 32);
            acc = __builtin_amdgcn_mfma_f32_32x32x16_bf16(av, bv, acc, 0, 0, 0); }
        const int col = 32 * jt + r; const float gcol = gc[col];
        bf16* QKB = (bf16*)(ws + WS_QK) + (size_t)ck * 4096;
#pragma unroll
        for (int i = 0; i < 16; ++i) { const int row = 32 * it + crow(i, hh);
            const float dec = fast_exp(col <= row ? gc[row] - gcol : 0.f);
            if (sel == 0) Lm[row * 64 + col] = (col < row) ? acc[i] * dec * bet[row] : 0.f;
            else QKB[(((row >> 5) * 4 + (col >> 4)) * 64 + (row & 31) + 32 * ((col >> 3) & 1)) * 8 + (col & 7)] = (bf16)f2bf((col <= row) ? acc[i] * dec : 0.f); }
    }
    __syncthreads();
    if (wave < 4) {
        const int c = tid;
        float sv[64];
#pragma unroll
        for (int i = 0; i < 64; ++i) sv[i] = RHS[i * 256 + c];
#pragma unroll
        for (int i = 1; i < 64; ++i) {
            float acc = sv[i];
#pragma unroll
            for (int jq = 0; jq < (i + 3) / 4; ++jq) { const f32x4 l4 = *(const LAS f32x4*)(Lm + i * 64 + 4 * jq);
                if (4 * jq + 0 < i) acc -= l4.x * sv[4 * jq + 0];
                if (4 * jq + 1 < i) acc -= l4.y * sv[4 * jq + 1];
                if (4 * jq + 2 < i) acc -= l4.z * sv[4 * jq + 2];
                if (4 * jq + 3 < i) acc -= l4.w * sv[4 * jq + 3]; }
            sv[i] = acc;
        }
#pragma unroll
        for (int i = 1; i < 64; ++i) RHS[i * 256 + c] = sv[i];
    } else {
        const int q = tid - 256, kd = q & 127, half = q >> 7;
        const float gl = gc[63];
        bf16* KDT = (bf16*)(ws + WS_KDT) + (size_t)ck * 8192;
#pragma unroll
        for (int c8 = 0; c8 < 4; ++c8) { float f[8];
#pragma unroll
            for (int j = 0; j < 8; ++j) { const int c = 32 * half + 8 * c8 + j; f[j] = bf2f(*(const LAS bf16*)(lds + PREP_KS + c * 272 + kd * 2)) * fast_exp(gl - gc[c]); }
            v4u w; w.x = pk2(f[0], f[1]); w.y = pk2(f[2], f[3]); w.z = pk2(f[4], f[5]); w.w = pk2(f[6], f[7]);
            *(v4u*)(KDT + (size_t)((((kd >> 5) * 4 + 2 * half + (c8 >> 1)) * 64) + (kd & 31) + 32 * (c8 & 1)) * 8) = w; }
        if (q == 0) ((float*)(ws + WS_EGL))[ck] = fast_exp(gl);
    }
    __syncthreads();
    {
        const int row = tid >> 3, seg = tid & 7;
        const LAS f32x4* s4 = (const LAS f32x4*)(RHS + row * 256 + seg * 32);
        const float sg = seg < 4 ? 1.f : -1.f;
        bf16* dst = (bf16*)(ws + (seg < 4 ? WS_U : WS_NW)) + (size_t)ck * 8192;
        const int ctr = row >> 5, rr = row & 31;
#pragma unroll
        for (int q = 0; q < 4; ++q) { const f32x4 x0 = s4[2 * q] * sg, x1 = s4[2 * q + 1] * sg;
            v4u w; w.x = pk2(x0.x, x0.y); w.y = pk2(x0.z, x0.w); w.z = pk2(x1.x, x1.y); w.w = pk2(x1.z, x1.w);
            const int fi = seg < 4 ? ((ctr * 4 + seg) * 2 + (q >> 1)) : (ctr * 8 + (seg - 4) * 2 + (q >> 1));
            *(v4u*)(dst + (size_t)(fi * 64 + rr + 32 * (q & 1)) * 8) = w; }
    }
    __syncthreads();
}

constexpr int SCAN_ST = 0, SCAN_VN = 2 * 32 * 272, SCAN_END = SCAN_VN + 2 * 32 * 144;
struct ScanFrag { bf16x8 a0[8]; bf16x8 a1[4]; bf16x8 a3[4]; float egl; };
DI void dn_scan(const Args& a, LAS unsigned char* lds, int j, int wave, int lane) {
    unsigned char* ws = a.ws;
    const int grp = wave >> 2, w4 = wave & 3, task = 2 * j + grp, bh = task >> 2, vs = task & 3, b = bh >> 2, h = bh & 3;
    const int r = lane & 31, hh = lane >> 5;
    LAS unsigned char* ST = lds + SCAN_ST + grp * (32 * 272); LAS unsigned char* VN = lds + SCAN_VN + grp * (32 * 144);
    const bf16* A0 = (const bf16*)(ws + (w4 < 2 ? WS_NW : WS_QD)); const bf16* U = (const bf16*)(ws + WS_U);
    const bf16* KDT = (const bf16*)(ws + WS_KDT); const bf16* QKB = (const bf16*)(ws + WS_QK); const float* EGL = (const float*)(ws + WS_EGL);
    bf16* ODN = (bf16*)(ws + WS_ODN);
    bf16x8 bI[2];
#pragma unroll
    for (int s = 0; s < 2; ++s)
#pragma unroll
        for (int jj = 0; jj < 8; ++jj) bI[s][jj] = (16 * s + 8 * hh + jj == r) ? (short)0x3F80 : (short)0;
    f32x16 sacc = {};
    const int ct = w4 & 1;
#define SCAN_LOAD(F, n_) do { const int n__ = (n_) < SEQ / 64 ? (n_) : SEQ / 64 - 1; const size_t ck_ = (size_t)(bh * 128 + n__); \
        _Pragma("unroll") for (int s = 0; s < 8; ++s) F.a0[s] = *(const bf16x8*)(A0 + ck_ * 8192 + (size_t)((ct * 8 + s) * 64 + lane) * 8); \
        if (w4 < 2) { _Pragma("unroll") for (int s = 0; s < 2; ++s) F.a1[s] = *(const bf16x8*)(U + ck_ * 8192 + (size_t)(((ct * 4 + vs) * 2 + s) * 64 + lane) * 8); } \
        else { _Pragma("unroll") for (int s = 0; s < 4; ++s) F.a1[s] = *(const bf16x8*)(QKB + ck_ * 4096 + (size_t)((ct * 4 + s) * 64 + lane) * 8); } \
        _Pragma("unroll") for (int s = 0; s < 4; ++s) F.a3[s] = *(const bf16x8*)(KDT + ck_ * 8192 + (size_t)((w4 * 4 + s) * 64 + lane) * 8); \
        F.egl = EGL[ck_]; } while (0)
#define SCAN_STEP(F, n_) do { const size_t t0_ = (size_t)b * SEQ + (size_t)(n_) * 64; \
        _Pragma("unroll") for (int g = 0; g < 4; ++g) { v2u w; w.x = pk2(sacc[4 * g], sacc[4 * g + 1]); w.y = pk2(sacc[4 * g + 2], sacc[4 * g + 3]); \
            *(LAS v2u*)(ST + r * 272 + (32 * w4 + 8 * g + 4 * hh) * 2) = w; } \
        LDS_WAIT(); __builtin_amdgcn_s_barrier(); \
        f32x16 acc = {}, acc2 = {}; \
        if (w4 < 2) { acc = __builtin_amdgcn_mfma_f32_32x32x16_bf16(F.a1[0], bI[0], acc, 0, 0, 0); acc2 = __builtin_amdgcn_mfma_f32_32x32x16_bf16(F.a1[1], bI[1], acc2, 0, 0, 0); } \
        _Pragma("unroll") for (int s = 0; s < 8; s += 2) { const bf16x8 b0 = *(const LAS bf16x8*)(ST + r * 272 + (16 * s + 8 * hh) * 2), b1 = *(const LAS bf16x8*)(ST + r * 272 + (16 * s + 16 + 8 * hh) * 2); \
            acc = __builtin_amdgcn_mfma_f32_32x32x16_bf16(F.a0[s], b0, acc, 0, 0, 0); acc2 = __builtin_amdgcn_mfma_f32_32x32x16_bf16(F.a0[s + 1], b1, acc2, 0, 0, 0); } \
        acc += acc2; \
        if (w4 < 2) { _Pragma("unroll") for (int g = 0; g < 4; ++g) { v2u w; w.x = pk2(acc[4 * g], acc[4 * g + 1]); w.y = pk2(acc[4 * g + 2], acc[4 * g + 3]); \
            *(LAS v2u*)(VN + r * 144 + (32 * ct + 8 * g + 4 * hh) * 2) = w; } } \
        LDS_WAIT(); __builtin_amdgcn_s_barrier(); \
        bf16x8 bv[4]; _Pragma("unroll") for (int s = 0; s < 4; ++s) bv[s] = *(const LAS bf16x8*)(VN + r * 144 + (16 * s + 8 * hh) * 2); \
        _Pragma("unroll") for (int i = 0; i < 16; ++i) sacc[i] *= F.egl; \
        _Pragma("unroll") for (int s = 0; s < 4; ++s) sacc = __builtin_amdgcn_mfma_f32_32x32x16_bf16(F.a3[s], bv[s], sacc, 0, 0, 0); \
        if (w4 >= 2) { _Pragma("unroll") for (int s = 0; s < 4; ++s) acc = __builtin_amdgcn_mfma_f32_32x32x16_bf16(F.a1[s], bv[s], acc, 0, 0, 0); \
            _Pragma("unroll") for (int i = 0; i < 16; ++i) ODN[(t0_ + 32 * ct + crow(i, hh)) * 512 + h * 128 + vs * 32 + r] = (bf16)f2bf(acc[i]); } \
    } while (0)
    ScanFrag FA, FB;
    SCAN_LOAD(FA, 0);
    for (int n = 0; n < SEQ / 64; n += 2) {
        SCAN_LOAD(FB, n + 1);
        SCAN_STEP(FA, n);
        SCAN_LOAD(FA, n + 2);
        SCAN_STEP(FB, n + 1);
    }
#undef SCAN_LOAD
#undef SCAN_STEP
    __syncthreads();
}
constexpr int MX_K = 0, MX_V = 65536;
DI void mx_unit(const Args& a, LAS unsigned char* lds, int bh, int qb, int tid, int wave, int lane) {
    unsigned char* ws = a.ws; const int b = bh >> 2, h = bh & 3;
    const bf16* MKV = (const bf16*)(ws + WS_MKV) + (size_t)b * NMEM * 1024 + h * 128;
#pragma unroll
    for (int i = 0; i < 8; ++i) { const int q = tid + 512 * i, row = q >> 4, ch = q & 15;
        const v4u kv = *(const v4u*)(MKV + (size_t)row * 1024 + ch * 8), vv = *(const v4u*)(MKV + (size_t)row * 1024 + 512 + ch * 8);
        *(LAS v4u*)(lds + MX_K + row * 256 + ((ch ^ (row & 7)) * 16)) = kv; *(LAS v4u*)(lds + MX_V + row * 256 + ch * 16) = vv; }
    const int r = lane & 31, hh = lane >> 5;
    const size_t qrow = (size_t)b * SEQ + (size_t)qb * 256 + wave * 32;
    const bf16* Q = (const bf16*)(ws + WS_P) + (qrow + r) * PW + P_MXQ + h * 128;
    bf16x8 qf[8];
#pragma unroll
    for (int s = 0; s < 8; ++s) qf[s] = *(const bf16x8*)(Q + 16 * s + 8 * hh);
    __syncthreads();
    float mx = -INFINITY;
#pragma unroll 1
    for (int kt = 0; kt < 8; ++kt) { f32x16 acc = {}; const int row = 32 * kt + r;
#pragma unroll
        for (int s = 0; s < 8; ++s) { const bf16x8 kf = *(const LAS bf16x8*)(lds + MX_K + row * 256 + (((2 * s + hh) ^ (row & 7)) * 16));
            acc = __builtin_amdgcn_mfma_f32_32x32x16_bf16(kf, qf[s], acc, 0, 0, 0); }
#pragma unroll
        for (int i = 0; i < 16; ++i) mx = fmaxf(mx, acc[i]); }
    mx = fmaxf(mx, __shfl_xor(mx, 32));
    float sum = 0.f;
    f32x16 o[4] = {};
    const int g16 = lane >> 4, i16 = lane & 15, qq = i16 >> 2, pp = i16 & 3;
    const LAS unsigned char* vb = lds + MX_V + (4 * hh + qq) * 256 + (16 * (g16 & 1) + 4 * pp) * 2;
#pragma unroll 1
    for (int kt = 0; kt < 8; ++kt) { f32x16 st = {}; const int row = 32 * kt + r;
#pragma unroll
        for (int s = 0; s < 8; ++s) { const bf16x8 kf = *(const LAS bf16x8*)(lds + MX_K + row * 256 + (((2 * s + hh) ^ (row & 7)) * 16));
            st = __builtin_amdgcn_mfma_f32_32x32x16_bf16(kf, qf[s], st, 0, 0, 0); }
#pragma unroll
        for (int i = 0; i < 16; ++i) { const float p = __builtin_amdgcn_exp2f(st[i] - mx); st[i] = p; sum += p; }
#pragma unroll
        for (int s2 = 0; s2 < 2; ++s2) {
            v4u pw; pw.x = pk2(st[8 * s2 + 0], st[8 * s2 + 1]); pw.y = pk2(st[8 * s2 + 2], st[8 * s2 + 3]); pw.z = pk2(st[8 * s2 + 4], st[8 * s2 + 5]); pw.w = pk2(st[8 * s2 + 6], st[8 * s2 + 7]);
            const bf16x8 pa = __builtin_bit_cast(bf16x8, pw);
#pragma unroll
            for (int dt = 0; dt < 4; ++dt) {
                const LAS unsigned char* vp = vb + (32 * kt + 16 * s2) * 256 + dt * 64;
                const s16x4 lo = __builtin_bit_cast(s16x4, __builtin_amdgcn_ds_read_tr16_b64_v4i16((LAS s16x4*)vp));
                const s16x4 hi = __builtin_bit_cast(s16x4, __builtin_amdgcn_ds_read_tr16_b64_v4i16((LAS s16x4*)(vp + 8 * 256)));
                const bf16x8 vf = {lo[0], lo[1], lo[2], lo[3], hi[0], hi[1], hi[2], hi[3]};
                o[dt] = __builtin_amdgcn_mfma_f32_32x32x16_bf16(pa, vf, o[dt], 0, 0, 0);
            }
        }
    }
    sum += __shfl_xor(sum, 32);
    LAS float* wsc = (LAS float*)(lds + LWSC_OFF + wave * 256);
    if (hh == 0) wsc[r] = __builtin_amdgcn_rcpf(sum);
    LDS_WAIT();
    bf16* O = (bf16*)(ws + WS_OMX) + qrow * 512 + h * 128;
#pragma unroll
    for (int i = 0; i < 16; ++i) { const int qr_ = crow(i, hh); const float rl = wsc[qr_];
#pragma unroll
        for (int dt = 0; dt < 4; ++dt) O[(size_t)qr_ * 512 + dt * 32 + r] = (bf16)f2bf(o[dt][i] * rl); }
    __syncthreads();
}

DI void p4_norm_rows(const Args& a, int vcu, int G, int wave, int lane) {
    unsigned char* ws = a.ws; const int gw = vcu * 8 + wave, NGW = G * 8;
    const float* lp = a.in[I_LAM];
    const float l1 = wave_sum(lp[lane] * lp[64 + lane]), l2 = wave_sum(lp[128 + lane] * lp[192 + lane]);
    const float lam_init = 0.2f, lam = expf(l1) - expf(l2) + lam_init;
    float gdn[8], gda[8];
#pragma unroll
    for (int i = 0; i < 8; ++i) { gdn[i] = a.in[I_DNON][8 * (lane & 15) + i]; gda[i] = a.in[I_SUBLN][8 * (lane & 15) + i] * (1.f - lam_init); }
    const bf16* P = (const bf16*)(ws + WS_P);
    for (int m = gw; m < T; m += NGW) {
        { const v4u w0 = *(const v4u*)((const bf16*)(ws + WS_ODN) + (size_t)m * 512 + 8 * lane), z0 = *(const v4u*)(P + (size_t)m * PW + P_DNZ + 8 * lane);
          float f[8], z[8]; f[0] = bflo(w0.x); f[1] = bfhi(w0.x); f[2] = bflo(w0.y); f[3] = bfhi(w0.y); f[4] = bflo(w0.z); f[5] = bfhi(w0.z); f[6] = bflo(w0.w); f[7] = bfhi(w0.w);
          z[0] = bflo(z0.x); z[1] = bfhi(z0.x); z[2] = bflo(z0.y); z[3] = bfhi(z0.y); z[4] = bflo(z0.z); z[5] = bfhi(z0.z); z[6] = bflo(z0.w); z[7] = bfhi(z0.w);
          float ss = 0.f;
#pragma unroll
          for (int i = 0; i < 8; ++i) ss += f[i] * f[i];
          ss += __shfl_xor(ss, 1); ss += __shfl_xor(ss, 2); ss += __shfl_xor(ss, 4); ss += __shfl_xor(ss, 8);
          const float r = rsqrtf(ss * (1.f / 128.f) + EPS);
#pragma unroll
          for (int i = 0; i < 8; ++i) f[i] = f[i] * r * gdn[i] * (z[i] * sigmoidf_(z[i]));
          v4u o; o.x = pk2(f[0], f[1]); o.y = pk2(f[2], f[3]); o.z = pk2(f[4], f[5]); o.w = pk2(f[6], f[7]);
          *(v4u*)((bf16*)(ws + WS_ODNF) + (size_t)m * 512 + 8 * lane) = o; }
        { const v4u w1 = *(const v4u*)((const bf16*)(ws + WS_O1) + (size_t)m * 512 + 8 * lane), w2 = *(const v4u*)((const bf16*)(ws + WS_O2) + (size_t)m * 512 + 8 * lane);
          float f[8]; f[0] = bflo(w1.x) - lam * bflo(w2.x); f[1] = bfhi(w1.x) - lam * bfhi(w2.x); f[2] = bflo(w1.y) - lam * bflo(w2.y); f[3] = bfhi(w1.y) - lam * bfhi(w2.y);
          f[4] = bflo(w1.z) - lam * bflo(w2.z); f[5] = bfhi(w1.z) - lam * bfhi(w2.z); f[6] = bflo(w1.w) - lam * bflo(w2.w); f[7] = bfhi(w1.w) - lam * bfhi(w2.w);
          float ss = 0.f;
#pragma unroll
          for (int i = 0; i < 8; ++i) ss += f[i] * f[i];
          ss += __shfl_xor(ss, 1); ss += __shfl_xor(ss, 2); ss += __shfl_xor(ss, 4); ss += __shfl_xor(ss, 8);
          const float r = rsqrtf(ss * (1.f / 128.f) + EPS);
#pragma unroll
          for (int i = 0; i < 8; ++i) f[i] = f[i] * r * gda[i];
          v4u o; o.x = pk2(f[0], f[1]); o.y = pk2(f[2], f[3]); o.z = pk2(f[4], f[5]); o.w = pk2(f[6], f[7]);
          *(v4u*)((bf16*)(ws + WS_ODAF) + (size_t)m * 512 + 8 * lane) = o; }
    }
}

struct BranchOrder {
    pg8::StaticOrder so; long a1, a2;
    DI bool next(int i, pg8::Unit& u) const {
        const int tl = i / 3, r = i - 3 * tl;
        if (!so.tile((long)tl * so.G + so.c, u.pm, u.pn)) return false;
        u.aoff = r == 0 ? 0 : (r == 1 ? a1 : a2); u.boff = (long)r * 1024 * 512 * 2; u.tag = r; return true;
    }
};
struct EpiMerge {
    static constexpr bool PERM = true;
    bf16* MRG; const bf16* P;
    DI void operator()(const f32x4 (&acc)[2][2][4][2], const pg8::Unit& u, int wr, int wc, int fr, int fq) const {
        const int row0 = u.pm * 256 + wr * 64 + fr, col0 = u.pn * 256 + wc * 32 + 8 * fq; const int r = u.tag;
#pragma unroll
        for (int ai = 0; ai < 2; ++ai) {
            v4u gw[4][2], ow[4][2];
#pragma unroll
            for (int m = 0; m < 4; ++m)
#pragma unroll
                for (int bj = 0; bj < 2; ++bj) { const size_t row = (size_t)(row0 + ai * 128 + m * 16); const int col = col0 + bj * 128;
                    gw[m][bj] = *(const v4u*)(P + row * PW + P_GATE + r * 1024 + col);
                    ow[m][bj] = (r > 0) ? *(const v4u*)(MRG + row * 1024 + col) : (v4u){0u, 0u, 0u, 0u}; }
#pragma unroll
            for (int m = 0; m < 4; ++m)
#pragma unroll
                for (int bj = 0; bj < 2; ++bj) { const size_t row = (size_t)(row0 + ai * 128 + m * 16); const int col = col0 + bj * 128;
                    const v4u g = gw[m][bj], o = ow[m][bj];
                    f32x4 v0 = acc[ai][bj][m][0], v1 = acc[ai][bj][m][1];
                    v0.x = v0.x * bflo(g.x) + bflo(o.x); v0.y = v0.y * bfhi(g.x) + bfhi(o.x); v0.z = v0.z * bflo(g.y) + bflo(o.y); v0.w = v0.w * bfhi(g.y) + bfhi(o.y);
                    v1.x = v1.x * bflo(g.z) + bflo(o.z); v1.y = v1.y * bfhi(g.z) + bfhi(o.z); v1.z = v1.z * bflo(g.w) + bflo(o.w); v1.w = v1.w * bfhi(g.w) + bfhi(o.w);
                    v4u w; w.x = pk2(v0.x, v0.y); w.y = pk2(v0.z, v0.w); w.z = pk2(v1.x, v1.y); w.w = pk2(v1.z, v1.w);
                    *(v4u*)(MRG + row * 1024 + col) = w; }
        }
    }
};
struct EpiResF32 {
    static constexpr bool PERM = false;
    float* C; const float* X;
    DI void operator()(const f32x4 (&acc)[2][2][4][2], const pg8::Unit& u, int wr, int wc, int fr, int fq) const {
        const int row0 = u.pm * 256 + wr * 64 + fr, col0 = u.pn * 256 + wc * 32 + 4 * fq;
#pragma unroll
        for (int ai = 0; ai < 2; ++ai) {
            f32x4 xv[4][2][2];
#pragma unroll
            for (int m = 0; m < 4; ++m) { const size_t ro = (size_t)(row0 + ai * 128 + m * 16) * 1024 + col0;
#pragma unroll
                for (int bj = 0; bj < 2; ++bj)
#pragma unroll
                    for (int n = 0; n < 2; ++n) xv[m][bj][n] = *(const f32x4*)(X + ro + bj * 128 + n * 16); }
#pragma unroll
            for (int m = 0; m < 4; ++m) { const size_t ro = (size_t)(row0 + ai * 128 + m * 16) * 1024 + col0;
#pragma unroll
                for (int bj = 0; bj < 2; ++bj)
#pragma unroll
                    for (int n = 0; n < 2; ++n) *(f32x4*)(C + ro + bj * 128 + n * 16) = acc[ai][bj][m][n] + xv[m][bj][n]; }
        }
    }
};

constexpr int RT_W = 0, RT_LG = 65536;
DI void p5_router(const Args& a, LAS unsigned char* lds, int vcu, int G, int tid, int wave, int lane, int cw_cnt) {
    unsigned char* ws = a.ws; const int gw = vcu * 8 + wave, NGW = G * 8;
    const float* X1 = a.out;
    {
        f32x4 gv[4];
#pragma unroll
        for (int j = 0; j < 4; ++j) gv[j] = ((const f32x4*)a.in[I_FNORM])[lane + 64 * j];
        bf16* H2 = (bf16*)(ws + WS_H);
        for (int m = gw; m < T; m += NGW) {
            const f32x4* xr = (const f32x4*)(X1 + (size_t)m * D) + lane;
            f32x4 v[4]; float ss = 0.f;
#pragma unroll
            for (int j = 0; j < 4; ++j) { v[j] = xr[64 * j]; ss += (v[j].x * v[j].x + v[j].y * v[j].y) + (v[j].z * v[j].z + v[j].w * v[j].w); }
            const float rstd = rsqrtf(wave_sum(ss) * (1.f / D) + EPS);
            unsigned long long* o8 = (unsigned long long*)(H2 + (size_t)m * D) + lane;
#pragma unroll
            for (int j = 0; j < 4; ++j) { v[j] = v[j] * rstd * gv[j]; o8[64 * j] = (unsigned long long)pk2(v[j].x, v[j].y) | ((unsigned long long)pk2(v[j].z, v[j].w) << 32); }
        }
    }
    LAS int* hist = (LAS int*)(lds + LCNT_OFF);
    if (tid < 32) hist[tid] = 0;
    const int r = lane & 31, hh = lane >> 5;
    for (int tb = vcu; tb < T / 128; tb += G) {
        const int tok0 = tb * 128 + wave * 32;
        f32x16 acc = {}; float ssq = 0.f;
        for (int kh = 0; kh < 2; ++kh) {
            __syncthreads();
#pragma unroll
            for (int i = 0; i < 8; ++i) { const int q = tid + 512 * i, k = q >> 3, e4 = (q & 7) * 4;
                const float gk = a.in[I_FNORM][kh * 512 + k]; f32x4 w = *(const f32x4*)(a.in[I_WR] + (size_t)(kh * 512 + k) * 32 + e4);
                *(LAS f32x4*)(lds + RT_W + (k * 32 + e4) * 4) = w * gk; }
            __syncthreads();
            if (wave < 4) {
                const float* xp = X1 + (size_t)(tok0 + r) * D + kh * 512 + 4 * hh;
                for (int i = 0; i < 64; ++i) { const f32x4 xv = *(const f32x4*)(xp + 8 * i);
                    ssq += (xv.x * xv.x + xv.y * xv.y) + (xv.z * xv.z + xv.w * xv.w);
                    const LAS float* wp = (const LAS float*)(lds + RT_W) + (8 * i + 4 * hh) * 32 + r;
                    acc = __builtin_amdgcn_mfma_f32_32x32x2f32(xv.x, wp[0], acc, 0, 0, 0);
                    acc = __builtin_amdgcn_mfma_f32_32x32x2f32(xv.y, wp[32], acc, 0, 0, 0);
                    acc = __builtin_amdgcn_mfma_f32_32x32x2f32(xv.z, wp[64], acc, 0, 0, 0);
                    acc = __builtin_amdgcn_mfma_f32_32x32x2f32(xv.w, wp[96], acc, 0, 0, 0); }
            }
        }
        if (wave < 4) {
            ssq += __shfl_xor(ssq, 32);
            LAS float* wsc = (LAS float*)(lds + LWSC_OFF + wave * 256);
            if (hh == 0) wsc[r] = rsqrtf(ssq * (1.f / D) + EPS);
            LDS_WAIT();
            LAS float* LG = (LAS float*)(lds + RT_LG + wave * (32 * 33 * 4));
            const float br = a.in[I_BR][r];
#pragma unroll
            for (int i = 0; i < 16; ++i) { const int tk = crow(i, hh); LG[tk * 33 + r] = acc[i] * wsc[tk] + br; }
            LDS_WAIT();
            if (lane < 32) {
                const LAS float* row = LG + lane * 33;
                float best[4]; int bi[4];
                unsigned taken = 0u;
#pragma unroll
                for (int k = 0; k < 4; ++k) { float bv = -INFINITY; int be = 0;
                    for (int e = 0; e < 32; ++e) { const float v = row[e]; const bool ok = !((taken >> e) & 1u) && v > bv; bv = ok ? v : bv; be = ok ? e : be; }
                    best[k] = bv; bi[k] = be; taken |= 1u << be; }
                const float e0 = 1.f, e1 = expf(best[1] - best[0]), e2 = expf(best[2] - best[0]), e3 = expf(best[3] - best[0]);
                const float inv = 1.f / (e0 + e1 + e2 + e3);
                int* TE = (int*)(ws + WS_TOKE) + (size_t)(tok0 + lane) * 4; float* TW = (float*)(ws + WS_TOKW) + (size_t)(tok0 + lane) * 4;
                TE[0] = bi[0]; TE[1] = bi[1]; TE[2] = bi[2]; TE[3] = bi[3];
                TW[0] = e0 * inv; TW[1] = e1 * inv; TW[2] = e2 * inv; TW[3] = e3 * inv;
                lds_add(&hist[bi[0]], 1); lds_add(&hist[bi[1]], 1); lds_add(&hist[bi[2]], 1); lds_add(&hist[bi[3]], 1);
            }
        }
    }
    __syncthreads();
    if (tid < 32) atomicAdd((unsigned*)(ws + WS_CTL) + cw_cnt + tid, (unsigned)hist[tid]);
}

DI void moe_table(const Args& a, LAS unsigned char* lds, int tid) {
    LAS int* cnt = (LAS int*)(lds + LCNT_OFF); LAS int* base = cnt + 32; LAS int* misc = cnt + 64; LAS int* tab = (LAS int*)(lds + LTAB_OFF);
    __syncthreads();
    if (tid < 32) cnt[tid] = (int)__hip_atomic_load((unsigned*)(a.ws + WS_CTL) + CW_CNT + tid, RLX_AGENT);
    __syncthreads();
    if (tid == 0) { int ti = 0; for (int e = 0; e < 32; ++e) { base[e] = ti * 256; const int nt = (cnt[e] + 255) >> 8; for (int q = 0; q < nt; ++q) tab[ti + q] = e; ti += nt; } misc[0] = ti; }
    __syncthreads();
}
DI void p6_slots(const Args& a, LAS unsigned char* lds, int vcu, int G, int tid, int wave, int lane, int cw_cur) {
    unsigned char* ws = a.ws;
    LAS int* cnt = (LAS int*)(lds + LCNT_OFF); LAS int* base = cnt + 32;
    LAS int* lh = (LAS int*)(lds + 0); LAS int* wb = lh + 32; LAS int* pslot = lh + 64;
    moe_table(a, lds, tid);
    int* SD = (int*)(ws + WS_SDST); float* SW = (float*)(ws + WS_SW);
    for (int e = vcu; e < 32; e += G) { const int lo = base[e] + cnt[e], hi = base[e] + (((cnt[e] + 255) >> 8) << 8); for (int s = lo + tid; s < hi; s += 512) SD[s] = -1; }
    const int* TE = (const int*)(ws + WS_TOKE); const float* TW = (const float*)(ws + WS_TOKW);
    const bf16* H2 = (const bf16*)(ws + WS_H); bf16* XS = (bf16*)(ws + WS_XS);
    for (int tb = vcu; tb < T / 128; tb += G) {
        __syncthreads();
        if (tid < 32) lh[tid] = 0;
        __syncthreads();
        const int pair = tb * 512 + tid; const int e = TE[pair];
        const int rank = lds_add(&lh[e], 1);
        __syncthreads();
        if (tid < 32) wb[tid] = (int)atomicAdd((unsigned*)(ws + WS_CTL) + cw_cur + tid, (unsigned)lh[tid]);
        __syncthreads();
        const int slot = base[e] + wb[e] + rank;
        SD[slot] = pair; SW[slot] = TW[pair]; pslot[tid] = slot;
        __syncthreads();
        for (int q = 0; q < 16; ++q) { const int tl = wave * 16 + q; const size_t tok = (size_t)tb * 128 + tl;
            const v4u* src = (const v4u*)(H2 + tok * 1024 + 16 * lane); const v4u w0 = src[0], w1 = src[1];
#pragma unroll
            for (int k = 0; k < 4; ++k) { v4u* dst = (v4u*)(XS + (size_t)pslot[tl * 4 + k] * 1024 + 16 * lane); dst[0] = w0; dst[1] = w1; } }
    }
    __syncthreads();
}

struct MoeOrder {
    const LAS int* tab; int ntiles, npn, G, c; long bstride;
    DI bool next(int i, pg8::Unit& u) const {
        const long L = (long)i * G + c; const int rt = (int)(L / npn);
        if (rt >= ntiles) return false;
        const int e = __builtin_amdgcn_readfirstlane(tab[rt]);
        u.pm = rt; u.pn = (int)(L % npn); u.aoff = 0; u.boff = (long)e * bstride; u.tag = e; return true;
    }
};
struct EpiSwiGLU {
    static constexpr bool PERM = true;
    bf16* ACT; const float* bgu;
    DI void operator()(const f32x4 (&acc)[2][2][4][2], const pg8::Unit& u, int wr, int wc, int fr, int fq) const {
        const int row0 = u.pm * 256 + wr * 64 + fr, j0 = u.pn * 128 + wc * 32 + 8 * fq;
        const float* bp = bgu + (size_t)u.tag * 2048 + j0;
        const f32x4 bg0 = *(const f32x4*)(bp), bg1 = *(const f32x4*)(bp + 4), bu0 = *(const f32x4*)(bp + 1024), bu1 = *(const f32x4*)(bp + 1028);
#pragma unroll
        for (int ai = 0; ai < 2; ++ai)
#pragma unroll
            for (int m = 0; m < 4; ++m) {
                f32x4 g0 = acc[ai][0][m][0] + bg0, g1 = acc[ai][0][m][1] + bg1, u0 = acc[ai][1][m][0] + bu0, u1 = acc[ai][1][m][1] + bu1;
                float o[8];
#pragma unroll
                for (int q = 0; q < 4; ++q) { float g = fminf(g0[q], 7.f), up = fminf(fmaxf(u0[q], -7.f), 7.f); o[q] = (up + 1.f) * g * sigmoidf_(1.702f * g);
                    g = fminf(g1[q], 7.f); up = fminf(fmaxf(u1[q], -7.f), 7.f); o[4 + q] = (up + 1.f) * g * sigmoidf_(1.702f * g); }
                v4u w; w.x = pk2(o[0], o[1]); w.y = pk2(o[2], o[3]); w.z = pk2(o[4], o[5]); w.w = pk2(o[6], o[7]);
                *(v4u*)(ACT + (size_t)(row0 + ai * 128 + m * 16) * 1024 + j0) = w; }
    }
};
struct EpiDown {
    static constexpr bool PERM = true;
    bf16* Y2; const float* bd; const int* SD; const float* SW;
    DI void operator()(const f32x4 (&acc)[2][2][4][2], const pg8::Unit& u, int wr, int wc, int fr, int fq) const {
        const int row0 = u.pm * 256 + wr * 64 + fr, col0 = u.pn * 256 + wc * 32 + 8 * fq;
        const float* bp = bd + (size_t)u.tag * 1024 + col0;
        f32x4 bv[2][2];
#pragma unroll
        for (int bj = 0; bj < 2; ++bj)
#pragma unroll
            for (int n = 0; n < 2; ++n) bv[bj][n] = *(const f32x4*)(bp + bj * 128 + 4 * n);
        int dsts[2][4]; float sws[2][4];
#pragma unroll
        for (int ai = 0; ai < 2; ++ai)
#pragma unroll
            for (int m = 0; m < 4; ++m) { const int slot = row0 + ai * 128 + m * 16; dsts[ai][m] = SD[slot]; sws[ai][m] = SW[slot]; }
#pragma unroll
        for (int ai = 0; ai < 2; ++ai)
#pragma unroll
            for (int m = 0; m < 4; ++m) { const int dst = dsts[ai][m];
                if (dst >= 0) { const float sw = sws[ai][m]; bf16* rowp = Y2 + (size_t)dst * 1024 + col0;
#pragma unroll
                    for (int bj = 0; bj < 2; ++bj) { const f32x4 v0 = (acc[ai][bj][m][0] + bv[bj][0]) * sw, v1 = (acc[ai][bj][m][1] + bv[bj][1]) * sw;
                        v4u w; w.x = pk2(v0.x, v0.y); w.y = pk2(v0.z, v0.w); w.z = pk2(v1.x, v1.y); w.w = pk2(v1.z, v1.w);
                        *(v4u*)(rowp + bj * 128) = w; } } }
    }
};

DI void p9_combine(const Args& a, int vcu, int G, int wave, int lane) {
    unsigned char* ws = a.ws; const int gw = vcu * 8 + wave, NGW = G * 8;
    const bf16* Y2 = (const bf16*)(ws + WS_XS);
    for (int m = gw; m < T; m += NGW) {
        f32x4* op = (f32x4*)(a.out + (size_t)m * D + 16 * lane);
        f32x4 o0 = op[0], o1 = op[1], o2 = op[2], o3 = op[3];
#pragma unroll
        for (int k = 0; k < 4; ++k) { const v4u* yp = (const v4u*)(Y2 + ((size_t)m * 4 + k) * 1024 + 16 * lane); const v4u w0 = yp[0], w1 = yp[1];
            o0.x += bflo(w0.x); o0.y += bfhi(w0.x); o0.z += bflo(w0.y); o0.w += bfhi(w0.y); o1.x += bflo(w0.z); o1.y += bfhi(w0.z); o1.z += bflo(w0.w); o1.w += bfhi(w0.w);
            o2.x += bflo(w1.x); o2.y += bfhi(w1.x); o2.z += bflo(w1.y); o2.w += bfhi(w1.y); o3.x += bflo(w1.z); o3.y += bfhi(w1.z); o3.z += bflo(w1.w); o3.w += bfhi(w1.w); }
        op[0] = o0; op[1] = o1; op[2] = o2; op[3] = o3;
    }
}
constexpr int NPHASE = 12;
constexpr int N_ATT_ITEMS = 2048, N_MX_ITEMS = 512, N_SCAN_WG = 32;
typedef const Args __attribute__((address_space(4))) CArgs;
#if defined(__HIP_DEVICE_COMPILE__)
DI CArgs* fresh_args() { unsigned long long v = (unsigned long long)__builtin_amdgcn_kernarg_segment_ptr(); asm volatile("" : "+s"(v)); return (CArgs*)v; }
#else
__device__ CArgs* fresh_args();
#endif
DI Args load_args() { CArgs* p = fresh_args(); Args a;
#pragma unroll
    for (int i = 0; i < 27; ++i) a.in[i] = p->in[i];
    a.out = p->out; a.ws = p->ws; a.ph_lo = p->ph_lo; a.ph_hi = p->ph_hi; a.li = p->li; a.pad = 0; return a; }
#ifndef MK_N_LAUNCHES
#define MK_N_LAUNCHES 1
#endif
__global__ void __launch_bounds__(512, 2) mk_fwd(Args args_unused) {
    extern __shared__ __attribute__((aligned(16))) unsigned char lds_raw[];
    LAS unsigned char* lds = (LAS unsigned char*)lds_raw;
    volatile LAS unsigned* MISC = (volatile LAS unsigned*)(lds + MISC_OFF);
    for (int u = threadIdx.x; u < (LDS_BYTES - LDSCTL_OFF) / 4; u += 512) ((LAS unsigned*)(lds + LDSCTL_OFF))[u] = 0u;
    __syncthreads();
    { const Args A0 = load_args(); (void)xcd_barrier_post((unsigned*)(A0.ws + WS_CTL) + CW_BAR, MISC + 8); }
#ifdef ONLY_PHASE
#define IN(k) ((k) == ONLY_PHASE)
#elif MK_N_LAUNCHES == 1
#define IN(k) true
#else
#define IN(k) (fresh_args()->ph_lo <= (k) && (k) < fresh_args()->ph_hi)
#endif
#define FRESH() const Args A_ = load_args(); unsigned char* const ws = A_.ws; (void)ws; const int tid_ = fresh_tid(), lane_ = tid_ & 63, wave_ = __builtin_amdgcn_readfirstlane(tid_ >> 6); (void)lane_; (void)wave_; \
    const int G = gridDim.x, bx = blockIdx.x, vcu = (G % 8 == 0) ? (bx % 8) * (G / 8) + bx / 8 : bx; (void)vcu
#ifndef REPEAT_PHASE
#define REPEAT_PHASE -1
#endif
#define NREP(k) ((k) == REPEAT_PHASE ? 2 : 1)
#define GBAR() do { XcdBarrier b_; b_.bar = (unsigned*)(fresh_args()->ws + WS_CTL) + CW_BAR; b_.x = xb_xcc_id(); b_.st = MISC + 8; xcd_barrier(b_); } while (0)
#define SEAM(k) do { if (IN(k) && IN((k) + 1)) { XcdBarrier b_; b_.bar = (unsigned*)(fresh_args()->ws + WS_CTL) + CW_BAR; b_.x = xb_xcc_id(); b_.st = MISC + 8; xcd_barrier(b_); } } while (0)

    if (IN(0)) _Pragma("unroll") for (int rep_ = 0; rep_ < NREP(0); ++rep_) { if (rep_) GBAR(); FRESH(); p0_prologue(A_, lds, vcu, G, wave_, lane_); }
    SEAM(0);
    if (IN(1)) _Pragma("unroll") for (int rep_ = 0; rep_ < NREP(1); ++rep_) { if (rep_) GBAR();
        FRESH();
        { pg8::Gemm g{(const bf16*)(ws + WS_H), (const bf16*)(ws + WS_WIN), 1024, 1024, 1024}; pg8::StaticOrder S; S.init(T, PW, G, bx);
          EpiP E{(bf16*)(ws + WS_P), A_.in[I_BGATE]};
          pg8::gemm_phase<EpiP, pg8::StaticOrder>(lds, g, S, E, tid_); }
        { pg8::Gemm g{(const bf16*)(ws + WS_MEMN), (const bf16*)(ws + WS_WMKV), 1024, 1024, 1024}; pg8::StaticOrder S; S.init(BATCH * NMEM, 1024, G, bx);
          EpiPlain E{(bf16*)(ws + WS_MKV), 1024};
          pg8::gemm_phase<EpiPlain, pg8::StaticOrder>(lds, g, S, E, tid_); }
    }
    SEAM(1);
    if (IN(2)) _Pragma("unroll") for (int rep_ = 0; rep_ < NREP(2); ++rep_) { if (rep_) GBAR();
        FRESH();
#ifndef NO_PREP
        for (int ck = vcu; ck < NCHUNK; ck += G) dn_prep_unit(A_, lds, ck, tid_, wave_, lane_);
#endif
#ifndef NO_NORM
        if (rep_ == 0) p2_norm_rows(A_, vcu, G, wave_, lane_);
#endif
    }
    SEAM(2);
    if (IN(3)) _Pragma("unroll") for (int rep_ = 0; rep_ < NREP(3); ++rep_) { if (rep_) GBAR();
#ifndef NO_SCAN
        if (blockIdx.x < N_SCAN_WG) { FRESH(); dn_scan(A_, lds, bx, wave_, lane_); }
#ifdef PROBE_SCAN_ALONE
        GBAR();
#endif
#ifdef PROBE_SCAN_TWICE
        if (blockIdx.x < N_SCAN_WG) { FRESH(); dn_scan(A_, lds, bx, wave_, lane_); }
#endif
#endif
#ifndef NO_ATT
        for (;;) {
            CArgs* ap = fresh_args(); unsigned char* ws = ap->ws; const int tid_ = fresh_tid();
            if (tid_ == 0) MISC[16] = __hip_atomic_fetch_add((unsigned*)(ws + WS_CTL) + CW_QHEAD + 32 * rep_, 1u, RLX_AGENT);
            __syncthreads();
            const int item = (int)MISC[16];
            __syncthreads();
            if (item >= N_ATT_ITEMS) break;
            const int qb = 31 - (item >> 6), rest = item & 63, b = rest >> 4, h = (rest >> 2) & 3, map = (rest >> 1) & 1, half = rest & 1;
            const attn_body::bf16* Pb = (const attn_body::bf16*)(ws + WS_P) + (size_t)b * SEQ * PW;
            attn_body::bf16* Ob = (attn_body::bf16*)(ws + (map ? WS_O2 : WS_O1)) + (size_t)b * SEQ * 512 + h * 128 + half * 64;
            attn_body::attn_unit<8>(qb, Pb + P_DAQ + h * 128 + map * 64, Pb + P_DAK + h * 128 + map * 64, Pb + P_DAV + h * 128 + half * 64, Ob, ap->in[I_REL], h, (char*)lds_raw, tid_);
        }
#endif
#ifndef NO_MX
        for (;;) {
            FRESH();
            if (tid_ == 0) MISC[16] = __hip_atomic_fetch_add((unsigned*)(ws + WS_CTL) + CW_QHEAD + 16 + 32 * rep_, 1u, RLX_AGENT);
            __syncthreads();
            const int idx = (int)MISC[16];
            __syncthreads();
            if (idx >= N_MX_ITEMS) break;
            mx_unit(A_, lds, idx >> 5, idx & 31, tid_, wave_, lane_);
        }
#endif
    }
    SEAM(3);
    if (IN(4)) _Pragma("unroll") for (int rep_ = 0; rep_ < NREP(4); ++rep_) { if (rep_) GBAR(); FRESH(); p4_norm_rows(A_, vcu, G, wave_, lane_); }
    SEAM(4);
    if (IN(5)) _Pragma("unroll") for (int rep_ = 0; rep_ < NREP(5); ++rep_) { if (rep_) GBAR();
        FRESH();
        pg8::Gemm g{(const bf16*)(ws + WS_ODNF), (const bf16*)(ws + WS_WB), 512, 512, 512};
        BranchOrder S; S.so.init(T, 1024, G, bx); S.a1 = (long)(WS_ODAF - WS_ODNF); S.a2 = (long)(WS_OMX - WS_ODNF);
        EpiMerge E{(bf16*)(ws + WS_MRG), (const bf16*)(ws + WS_P)};
        pg8::gemm_phase<EpiMerge, BranchOrder>(lds, g, S, E, tid_);
    }
    SEAM(5);
    if (IN(6)) _Pragma("unroll") for (int rep_ = 0; rep_ < NREP(6); ++rep_) { if (rep_) GBAR();
        FRESH();
        pg8::Gemm g{(const bf16*)(ws + WS_MRG), (const bf16*)(ws + WS_WOUT), 1024, 1024, 1024}; pg8::StaticOrder S; S.init(T, 1024, G, bx);
        EpiResF32 E{A_.out, A_.in[I_X]};
        pg8::gemm_phase<EpiResF32, pg8::StaticOrder>(lds, g, S, E, tid_);
    }
    SEAM(6);
    if (IN(7)) _Pragma("unroll") for (int rep_ = 0; rep_ < NREP(7); ++rep_) { if (rep_) GBAR(); FRESH(); p5_router(A_, lds, vcu, G, tid_, wave_, lane_, CW_CNT + 256 * rep_); }
    SEAM(7);
    if (IN(8)) _Pragma("unroll") for (int rep_ = 0; rep_ < NREP(8); ++rep_) { if (rep_) GBAR(); FRESH(); p6_slots(A_, lds, vcu, G, tid_, wave_, lane_, CW_CUR + 256 * rep_); }
    SEAM(8);
    if (IN(9)) _Pragma("unroll") for (int rep_ = 0; rep_ < NREP(9); ++rep_) { if (rep_) GBAR();
        FRESH();
        moe_table(A_, lds, tid_);
        pg8::Gemm g{(const bf16*)(ws + WS_XS), (const bf16*)(ws + WS_WGU), 1024, 1024, 1024};
        MoeOrder S{(const LAS int*)(lds + LTAB_OFF), ((const LAS int*)(lds + LCNT_OFF))[64], 8, G, bx, (long)2048 * 1024 * 2};
        EpiSwiGLU E{(bf16*)(ws + WS_ACT), A_.in[I_BGU]};
        pg8::gemm_phase<EpiSwiGLU, MoeOrder>(lds, g, S, E, tid_);
    }
    SEAM(9);
    if (IN(10)) _Pragma("unroll") for (int rep_ = 0; rep_ < NREP(10); ++rep_) { if (rep_) GBAR();
        FRESH();
        moe_table(A_, lds, tid_);
        pg8::Gemm g{(const bf16*)(ws + WS_ACT), (const bf16*)(ws + WS_WD), 1024, 1024, 1024};
        MoeOrder S{(const LAS int*)(lds + LTAB_OFF), ((const LAS int*)(lds + LCNT_OFF))[64], 4, G, bx, (long)1024 * 1024 * 2};
        EpiDown E{(bf16*)(ws + WS_XS), A_.in[I_BD], (const int*)(ws + WS_SDST), (const float*)(ws + WS_SW)};
        pg8::gemm_phase<EpiDown, MoeOrder>(lds, g, S, E, tid_);
    }
    SEAM(10);
    if (IN(11)) {
        FRESH();
#ifdef PROBE_P11
        p9_combine_probe(A_, vcu, G, wave_, lane_); GBAR();
#endif
        p9_combine(A_, vcu, G, wave_, lane_);
        if (bx == 0 && tid_ == 0) { if (__hip_atomic_load((unsigned*)(ws + WS_CTL) + CW_BAR + XB_TMO, RLX_AGENT) != 0u) A_.out[0] = __builtin_nanf(""); }
    }
#undef IN
#undef SEAM
#undef FRESH
}

extern "C" void kernel_launch(void* const* d_in, const int* in_sizes, int n_in, void* d_out, int out_size, void* d_ws, size_t ws_size, hipStream_t stream) {
    static int grid = 0;
    if (grid == 0) {
        if (n_in != 27 || in_sizes[0] != T * D || out_size != T * D || ws_size < WS_END) {
            fprintf(stderr, "kernel_launch: unexpected shapes (n_in %d, in0 %d, out %d, ws %zu < %zu); nothing launched\n", n_in, n_in > 0 ? in_sizes[0] : -1, out_size, ws_size, (size_t)WS_END); grid = -1; return; }
        int dev = 0, cus = 0, per_cu = 0;
        if (hipGetDevice(&dev) != hipSuccess || hipDeviceGetAttribute(&cus, hipDeviceAttributeMultiprocessorCount, dev) != hipSuccess) { grid = -1; return; }
        if (hipFuncSetAttribute((const void*)mk_fwd, hipFuncAttributeMaxDynamicSharedMemorySize, LDS_BYTES) != hipSuccess) { fprintf(stderr, "kernel_launch: hipFuncSetAttribute failed\n"); grid = -1; return; }
        if (hipOccupancyMaxActiveBlocksPerMultiprocessor(&per_cu, (const void*)mk_fwd, 512, LDS_BYTES) != hipSuccess || per_cu < 1)
            fprintf(stderr, "kernel_launch: note: occupancy query reports %d workgroups per CU\n", per_cu);
        (void)hipGetLastError();
        grid = cus;
        if (grid > 256) grid = 256;
    }
    if (grid < 0) return;
    if (hipMemsetAsync((char*)d_ws + WS_CTL, 0, CTL_ZERO_BYTES, stream) != hipSuccess) return;
    Args a{};
    for (int i = 0; i < 27; ++i) a.in[i] = (const float*)d_in[i];
    a.out = (float*)d_out; a.ws = (unsigned char*)d_ws;
#if MK_N_LAUNCHES == 1
    a.ph_lo = 0; a.ph_hi = NPHASE; a.li = 0; a.pad = 0;
    hipLaunchKernelGGL(mk_fwd, dim3(grid), dim3(512), LDS_BYTES, stream, a);
#else
    for (int p = 0; p < NPHASE; ++p) { a.ph_lo = p; a.ph_hi = p + 1; a.li = 0; a.pad = 0; hipLaunchKernelGGL(mk_fwd, dim3(grid), dim3(512), LDS_BYTES, stream, a); }
#endif
}
```

```cpp
#include <hip/hip_runtime.h>
#include <hip/hip_bf16.h>
#include <cstdio>
#include <cstdint>
#include <cmath>

#define GAS __attribute__((address_space(1)))
#define LAS __attribute__((address_space(3)))
typedef unsigned short bf16;
typedef unsigned v4u __attribute__((ext_vector_type(4)));
typedef unsigned v2u __attribute__((ext_vector_type(2)));
typedef float f32x4 __attribute__((ext_vector_type(4)));
typedef float f32x16 __attribute__((ext_vector_type(16)));
typedef short bf16x8 __attribute__((ext_vector_type(8)));
typedef short s16x4 __attribute__((ext_vector_type(4)));
typedef GAS unsigned gu32;
#define RLX_AGENT __ATOMIC_RELAXED, __HIP_MEMORY_SCOPE_AGENT
#define LDS_WAIT() asm volatile("s_waitcnt lgkmcnt(0)" ::: "memory")
#define VM_WAIT() asm volatile("s_waitcnt vmcnt(0)" ::: "memory")
#define DI __device__ __forceinline__

DI unsigned f2bf(float f) { unsigned u = __builtin_bit_cast(unsigned, f); return (u + 0x7fffu + ((u >> 16) & 1u)) >> 16; }
typedef float f32x2_t_ __attribute__((ext_vector_type(2))); typedef __bf16 bf16x2_t_ __attribute__((ext_vector_type(2)));
DI unsigned pk2(float lo, float hi) { f32x2_t_ v = {lo, hi}; bf16x2_t_ b = __builtin_convertvector(v, bf16x2_t_); return __builtin_bit_cast(unsigned, b); }
typedef int v8i_ __attribute__((ext_vector_type(8))); typedef int v4i_ __attribute__((ext_vector_type(4)));
DI unsigned pk4f8(float a, float b, float c, float d) { int w = __builtin_amdgcn_cvt_pk_fp8_f32(a, b, 0, false); w = __builtin_amdgcn_cvt_pk_fp8_f32(c, d, w, true); return (unsigned)w; }
DI v8i_ cat8(bf16x8 lo, bf16x8 hi) { return __builtin_shufflevector(__builtin_bit_cast(v4i_, lo), __builtin_bit_cast(v4i_, hi), 0, 1, 2, 3, 4, 5, 6, 7); }
DI void mfma_f8(f32x4& c, v8i_ a, v8i_ b) { asm volatile("v_mfma_f32_16x16x128_f8f6f4 %0, %1, %2, %0" : "+v"(c) : "v"(a), "v"(b)); }
DI float bflo(unsigned w) { return __builtin_bit_cast(float, w << 16); }
DI float bfhi(unsigned w) { return __builtin_bit_cast(float, w & 0xffff0000u); }
DI float bf2f(bf16 b) { return __builtin_bit_cast(float, (unsigned)b << 16); }
DI float wave_sum(float v) {
#pragma unroll
    for (int o = 1; o < 64; o <<= 1) v += __shfl_xor(v, o);
    return v;
}
DI float fast_exp(float x) { return __builtin_amdgcn_exp2f(x * 1.4426950408889634f); }
DI float sigmoidf_(float x) { return __builtin_amdgcn_rcpf(1.f + fast_exp(-x)); }
DI int lds_add(LAS int* p, int v) { return __hip_atomic_fetch_add(p, v, __ATOMIC_RELAXED, __HIP_MEMORY_SCOPE_WORKGROUP); }
DI int fresh_tid() { int t; asm volatile("v_mov_b32 %0, %1" : "=v"(t) : "v"((int)threadIdx.x)); return t; }
DI int crow(int r, int hi) { return (r & 3) + 8 * (r >> 2) + 4 * hi; }

constexpr int BATCH = 4, SEQ = 8192, T = BATCH * SEQ, D = 1024, INW = 7176, NPROJ = 7168, PW = 4096, NMEM = 256;
constexpr float EPS = 1e-6f;
constexpr int P_DNQ = 0, P_DNK = 512, P_DNV = 1024, P_DNZ = 1536, P_DAQ = 2048, P_DAK = 2560, P_DAV = 3072, P_MXQ = 3584, P_GATE = 4096;
constexpr int NEXP = 32, DFF = 1024, NSLOT_MAX = T * 4 + NEXP * 256, NTILE_MAX = NSLOT_MAX / 256;
constexpr int NCHUNK = BATCH * 4 * (SEQ / 64);
constexpr float LOG2E = 1.4426950408889634f;

constexpr size_t MiB = 1u << 20;
constexpr size_t WS_CTL = 0, CTL_ZERO_BYTES = 1 * MiB;
constexpr size_t WS_G = 1 * MiB;
constexpr size_t WS_BETA = WS_G + 512 * 1024;
constexpr size_t WS_TOKE = 2 * MiB;
constexpr size_t WS_TOKW = WS_TOKE + 512 * 1024;
constexpr size_t WS_SDST = 3 * MiB;
constexpr size_t WS_SW = 4 * MiB;
constexpr size_t WS_EGL = 5 * MiB;
constexpr size_t WS_RSTD = 5 * MiB + 64 * 1024;
constexpr size_t WS_SR = 31 * MiB;
constexpr size_t WS_TSLOT = 5 * MiB + 512 * 1024;
constexpr size_t WS_WB = 6 * MiB;
constexpr size_t WS_WOUT = 9 * MiB;
constexpr size_t WS_WMKV = 11 * MiB;
constexpr size_t WS_MEMN = 13 * MiB;
constexpr size_t WS_MKV = 15 * MiB;
constexpr size_t WS_WIN = 17 * MiB;
constexpr size_t WS_WGU = 32 * MiB;
constexpr size_t WS_WD = 160 * MiB;
constexpr size_t WS_H8 = 96 * MiB;
constexpr size_t WS_WIN8 = 128 * MiB;
constexpr size_t WS_H = 224 * MiB;
constexpr size_t WS_P = 288 * MiB;
constexpr size_t WS_GF = 544 * MiB;
constexpr size_t WS_MF = 864 * MiB;
constexpr size_t WS_NW = 736 * MiB;
constexpr size_t WS_QD = 768 * MiB;
constexpr size_t WS_KDT = 800 * MiB;
constexpr size_t WS_U = 832 * MiB;
constexpr size_t WS_QK = 864 * MiB;
constexpr size_t WS_ODN = 880 * MiB;
constexpr size_t WS_O1 = 912 * MiB;
constexpr size_t WS_O2 = 944 * MiB;
constexpr size_t WS_OMX = 976 * MiB;
constexpr size_t WS_ODNF = 736 * MiB;
constexpr size_t WS_ODAF = 768 * MiB;
constexpr size_t WS_X1B = 736 * MiB;
constexpr size_t WS_MRG = 800 * MiB;
constexpr size_t WS_XS = 288 * MiB;
constexpr size_t WS_ACT = 560 * MiB;
constexpr size_t WS_END = 1024 * MiB;
static_assert(WS_OMX + (size_t)T * 512 * 2 <= WS_END && WS_ACT + (size_t)NSLOT_MAX * 1024 * 2 <= WS_END && WS_XS + (size_t)NSLOT_MAX * 1024 * 2 <= WS_ACT, "ws map");

constexpr int CW_QHEAD = 1024;
constexpr int CW_CNT = 128;
constexpr int CW_CUR = 192;
constexpr int CW_MKV = 2560;
constexpr int CW_BAR = 4096;

constexpr int RING_BYTES = 136 * 1024;
constexpr int LDSCTL_OFF = RING_BYTES;
constexpr int MISC_OFF = LDSCTL_OFF;
constexpr int LTAB_OFF = LDSCTL_OFF + 128;
constexpr int LCNT_OFF = LTAB_OFF + NTILE_MAX * 4;
constexpr int LWSC_OFF = LCNT_OFF + 512;
constexpr int LDS_BYTES = 144 * 1024;
static_assert(LWSC_OFF + 8 * 256 <= LDS_BYTES, "LDS map");

namespace pg8 {
constexpr int BM = 256, BK = 64, HALF = 128, HTB = HALF * BK * 2, STAGE_BYTES = 8 * HTB, NXCD = 8, WGM = 8;
DI int lds_byte(int r, int c) { const int st = (r >> 4) * 2 + (c >> 5), rr = r & 15, cc = c & 31, ob = rr * 64 + cc * 2; return st * 1024 + (ob ^ (((ob >> 9) & 1) << 5)); }
DI void stage_rc(int b, int& R, int& C) { const int st = b / 1024, sb = b % 1024, swz = sb ^ (((sb >> 9) & 1) << 5); R = (st >> 1) * 16 + swz / 64; C = (st & 1) * 32 + (swz % 64) / 2; }
DI int perm32(int rho) { const int n = rho >> 4, i = rho & 15; return 8 * (i >> 2) + 4 * n + (i & 3); }

struct Unit { int pm, pn; long aoff, boff; int tag; };
struct Gemm { const bf16* A; const bf16* Bt; int lda, ldb, K; const int* rowmap; int probe; };

struct StaticOrder {
    int nM, nN, nwg, G, c;
    DI void init(int M, int N, int G_, int c_) { nM = M / BM; nN = N / BM; nwg = nM * nN; G = G_; c = c_; }
    DI bool tile(long L, int& pm, int& pn) const {
        if (L >= nwg) return false;
        int wgid = (int)L; { const int q = nwg / NXCD, r = nwg % NXCD, xcd = wgid % NXCD, off = wgid / NXCD; wgid = (xcd < r ? xcd * (q + 1) : r * (q + 1) + (xcd - r) * q) + off; }
        const int nig = WGM * nN, gid = wgid / nig, fm = gid * WGM, gsz = (nM - fm) < WGM ? (nM - fm) : WGM;
        pm = fm + ((wgid % nig) % gsz); pn = (wgid % nig) / gsz; return true;
    }
    DI bool next(int i, Unit& u) const { u.aoff = 0; u.boff = 0; u.tag = 0; return tile((long)i * G + c, u.pm, u.pn); }
};

template <class Epi, class Sched, bool GATHER = false, bool FP8 = false>
DI void gemm_phase(LAS unsigned char* lds, const Gemm g, const Sched& S, const Epi& E, const int tid) {
    const int wid = __builtin_amdgcn_readfirstlane(tid >> 6), lane = tid & 63, wr = wid >> 2, wc = wid & 3, fr = lane & 15, fq = lane >> 4;
    int nt = g.K / BK; asm volatile("" : "+s"(nt));
    unsigned voffA[2], voffB[2];
#pragma unroll
    for (int i = 0; i < 2; ++i) { int R, C; stage_rc(tid * 16 + i * 8192, R, C); const int Rb = Epi::PERM ? ((R & ~31) + perm32(R & 31)) : R;
        voffA[i] = (unsigned)(R * g.lda + C) * 2u; voffB[i] = (unsigned)(Rb * g.ldb + C) * 2u; }
    const size_t kstep = (size_t)(BK * 2);
    const size_t hstepA = (size_t)HALF * g.lda * 2, hstepB = (size_t)HALF * g.ldb * 2;
    const size_t tstepA = (GATHER || (g.probe & 1)) ? 0 : 2 * hstepA, tstepB = (g.probe & 2) ? 0 : 2 * hstepB;
    unsigned cA0[2], cA1[2], nA0[2], nA1[2];
#define PG8_AOFFS(dst0, dst1, unit) do { if constexpr (GATHER) { _Pragma("unroll") for (int _i = 0; _i < 2; ++_i) { int R_, C_; stage_rc(tid * 16 + _i * 8192, R_, C_); \
            const int s0_ = g.rowmap[(unit).pm * BM + R_], s1_ = g.rowmap[(unit).pm * BM + HALF + R_]; \
            const unsigned c2_ = (unsigned)C_ * 2u; \
            dst0[_i] = (unsigned)((s0_ < 0 ? 0 : s0_ >> 2) * g.lda) * 2u + c2_; dst1[_i] = (unsigned)((s1_ < 0 ? 0 : s1_ >> 2) * g.lda) * 2u + c2_; } } \
        else { _Pragma("unroll") for (int _i = 0; _i < 2; ++_i) { dst0[_i] = voffA[_i]; dst1[_i] = voffA[_i] + (unsigned)hstepA; } } } while (0)
    const unsigned ldsw = (unsigned)wid * 1024u;
    const int aoff = lds_byte(wr * 64 + fr, fq * 8), boff = lds_byte(wc * 32 + fr, fq * 8);
#define PG8_SA(b, h) (((b) * 2 + (h)) * HTB)
#define PG8_SB(b, h) ((4 + (b) * 2 + (h)) * HTB)
#define PG8_STAGE(bufoff, gbase, voff) do { _Pragma("unroll") for (int _i = 0; _i < 2; ++_i) \
        __builtin_amdgcn_global_load_lds((const unsigned*)((const char*)(gbase) + (voff)[_i]), (LAS unsigned*)(lds + (bufoff) + ldsw + _i * 8192), 16, 0, 0); } while (0)
#define PG8_LDA(dst, b, h) do { _Pragma("unroll") for (int m = 0; m < 4; ++m) _Pragma("unroll") for (int k = 0; k < 2; ++k) dst[m][k] = *(const LAS bf16x8*)(lds + PG8_SA(b, h) + aoff + m * 2048 + k * 1024); } while (0)
#define PG8_LDB(dst, b, h) do { _Pragma("unroll") for (int n = 0; n < 2; ++n) _Pragma("unroll") for (int k = 0; k < 2; ++k) dst[n][k] = *(const LAS bf16x8*)(lds + PG8_SB(b, h) + boff + n * 2048 + k * 1024); } while (0)
#define PG8_MMA(ai, bj, At, Bt) do { __builtin_amdgcn_s_setprio(1); _Pragma("unroll") for (int m = 0; m < 4; ++m) _Pragma("unroll") for (int n = 0; n < 2; ++n) { \
        if constexpr (FP8) mfma_f8(acc[ai][bj][m][n], cat8(Bt[n][0], Bt[n][1]), cat8(At[m][0], At[m][1])); \
        else { _Pragma("unroll") for (int k = 0; k < 2; ++k) acc[ai][bj][m][n] = __builtin_amdgcn_mfma_f32_16x16x32_bf16(Bt[n][k], At[m][k], acc[ai][bj][m][n], 0, 0, 0); } } __builtin_amdgcn_s_setprio(0); } while (0)
#define PG8_WAIT_V(n) asm volatile("s_waitcnt vmcnt(" #n ")" ::: "memory")
#define PG8_WAIT_L(n) asm volatile("s_waitcnt lgkmcnt(" #n ")" ::: "memory")
#define PG8_BAR __builtin_amdgcn_s_barrier()
#define PG8_SCHED __builtin_amdgcn_sched_barrier(0)
    Unit cur, nxt; int ui = 0;
    if (!S.next(0, cur)) return;
    f32x4 acc[2][2][4][2];
#pragma unroll
    for (int a = 0; a < 2; ++a)
#pragma unroll
        for (int b = 0; b < 2; ++b)
#pragma unroll
            for (int m = 0; m < 4; ++m)
#pragma unroll
                for (int n = 0; n < 2; ++n) acc[a][b][m][n] = (f32x4){0.f, 0.f, 0.f, 0.f};
    bf16x8 At[4][2], B0[2][2], B1[2][2];
    const char* cA = (const char*)g.A + (size_t)cur.pm * tstepA + cur.aoff; const char* cB = (const char*)g.Bt + (size_t)cur.pn * tstepB + cur.boff;
    PG8_AOFFS(cA0, cA1, cur);
    PG8_STAGE(PG8_SB(0, 0), cB, voffB); PG8_STAGE(PG8_SB(0, 1), cB + hstepB, voffB); PG8_STAGE(PG8_SA(0, 0), cA, cA0); PG8_STAGE(PG8_SA(0, 1), cA, cA1);
    if (wr == 1) PG8_BAR;
    PG8_WAIT_V(2); PG8_BAR;
    PG8_STAGE(PG8_SB(1, 0), cB + kstep, voffB); PG8_STAGE(PG8_SA(1, 0), cA + kstep, cA0); PG8_STAGE(PG8_SB(1, 1), cB + hstepB + kstep, voffB);
    PG8_WAIT_V(6); PG8_BAR;
    for (;;) {
        const bool has_next = S.next(ui + 1, nxt);
        const char* nA = has_next ? (const char*)g.A + (size_t)nxt.pm * tstepA + nxt.aoff : cA; const char* nB = has_next ? (const char*)g.Bt + (size_t)nxt.pn * tstepB + nxt.boff : cB;
        if (has_next) PG8_AOFFS(nA0, nA1, nxt); else { _Pragma("unroll") for (int _i = 0; _i < 2; ++_i) { nA0[_i] = cA0[_i]; nA1[_i] = cA1[_i]; } }
        unsigned pf0_ = 0u, pf1_ = 0u, pf2_ = 0u, pf3_ = 0u;
#pragma nounroll
        for (int t = 0; t < nt; t += 2) {
            const bool last = (t == nt - 2);
            if constexpr (Epi::PREFETCH) { if (t == nt - 4) E.prefetch(cur, wr, wc, fr, fq, pf0_, pf1_, pf2_, pf3_); }
            const char* a1 = cA + (size_t)(t + 1) * kstep;
            const char* a2 = last ? nA : cA + (size_t)(t + 2) * kstep; const char* b2 = last ? nB : cB + (size_t)(t + 2) * kstep;
            const char* a3 = a2 + kstep; const char* b3 = b2 + kstep;
            unsigned sA0[2], sA1[2];
#pragma unroll
            for (int _i = 0; _i < 2; ++_i) { sA0[_i] = last ? nA0[_i] : cA0[_i]; sA1[_i] = last ? nA1[_i] : cA1[_i]; }
            PG8_LDB(B0, 0, 0); PG8_LDB(B1, 0, 1); PG8_SCHED; PG8_LDA(At, 0, 0); PG8_STAGE(PG8_SA(1, 1), a1, cA1);
            PG8_WAIT_V(8); PG8_WAIT_L(0); PG8_BAR; PG8_MMA(0, 0, At, B0); PG8_MMA(0, 1, At, B1); PG8_BAR; PG8_SCHED;
            PG8_LDA(At, 0, 1); PG8_STAGE(PG8_SB(0, 0), b2, voffB); PG8_STAGE(PG8_SB(0, 1), b2 + hstepB, voffB); PG8_STAGE(PG8_SA(0, 0), a2, sA0);
            PG8_WAIT_V(8); PG8_WAIT_L(0); PG8_BAR; PG8_MMA(1, 0, At, B0); PG8_MMA(1, 1, At, B1); PG8_BAR; PG8_SCHED;
            PG8_LDB(B0, 1, 0); PG8_LDB(B1, 1, 1); PG8_SCHED; PG8_LDA(At, 1, 0); PG8_STAGE(PG8_SA(0, 1), a2, sA1);
            PG8_WAIT_V(8); PG8_WAIT_L(0); PG8_BAR; PG8_MMA(0, 0, At, B0); PG8_MMA(0, 1, At, B1); PG8_BAR; PG8_SCHED;
            PG8_LDA(At, 1, 1); PG8_STAGE(PG8_SB(1, 0), b3, voffB); PG8_STAGE(PG8_SB(1, 1), b3 + hstepB, voffB); PG8_STAGE(PG8_SA(1, 0), a3, sA0);
            PG8_WAIT_V(8); PG8_WAIT_L(0); PG8_BAR; PG8_MMA(1, 0, At, B0); PG8_MMA(1, 1, At, B1); PG8_BAR; PG8_SCHED;
        }
        if constexpr (Epi::PREFETCH) asm volatile("" :: "v"(pf0_), "v"(pf1_), "v"(pf2_), "v"(pf3_));
        if constexpr (FP8) asm volatile("s_nop 15" ::: "memory");
        if (wr == 0) PG8_BAR;
        bool keep = false;
        if constexpr (Epi::CHAIN) keep = E.chain(acc, cur, wr, wc, fr, fq); else E(acc, cur, wr, wc, fr, fq);
        if (!has_next) break;
        if (!keep) {
#pragma unroll
        for (int a = 0; a < 2; ++a)
#pragma unroll
            for (int b = 0; b < 2; ++b)
#pragma unroll
                for (int m = 0; m < 4; ++m)
#pragma unroll
                    for (int n = 0; n < 2; ++n) acc[a][b][m][n] = (f32x4){0.f, 0.f, 0.f, 0.f};
        }
        cur = nxt; cA = nA; cB = nB; ++ui;
#pragma unroll
        for (int _i = 0; _i < 2; ++_i) { cA0[_i] = nA0[_i]; cA1[_i] = nA1[_i]; }
        if (wr == 1) PG8_BAR;
    }
    PG8_WAIT_V(0);
    PG8_BAR;
#undef PG8_AOFFS
#undef PG8_SA
#undef PG8_SB
#undef PG8_STAGE
#undef PG8_LDA
#undef PG8_LDB
#undef PG8_MMA
#undef PG8_WAIT_V
#undef PG8_WAIT_L
#undef PG8_BAR
#undef PG8_SCHED
}
}
namespace attn_body {
using bf16=__hip_bfloat16;
using bf16x8=__attribute__((ext_vector_type(8)))short;
using s16x4=__attribute__((ext_vector_type(4)))short;
using f32x16=__attribute__((ext_vector_type(16)))float;
using u32x4=__attribute__((ext_vector_type(4)))unsigned;
constexpr int SEQ=8192,D=64,DM=4096,OPITCH=512;
constexpr int NW=8,QBLK=32,QB=QBLK*NW,KVBLK=64,NQB=SEQ/QB;
constexpr int ATTN_UNIT_ROWS=QB;
__device__ __forceinline__ int crow(int r,int hi){return (r&3)+8*(r>>2)+4*hi;}
#define SBAR() __builtin_amdgcn_sched_barrier(0)
__device__ __forceinline__ void cmask(f32x16&p0,f32x16&p1,int jb,int qrel,int hi){
  const float NEG=-INFINITY; int kb=64*jb+4*hi;
  #pragma unroll
  for(int r=0;r<16;++r){int kv=kb+(r&3)+8*(r>>2); if(kv>qrel)p0[r]=NEG; if(kv+32>qrel)p1[r]=NEG;}
}

__device__ __forceinline__ void biasadd(f32x16&p0,f32x16&p1,const float*lp){
  #pragma unroll
  for(int r=0;r<16;r+=2){ const float a0=lp[59-((r&3)+8*(r>>2))],a1=lp[59-(((r+1)&3)+8*((r+1)>>2))],b0=lp[59-32-((r&3)+8*(r>>2))],b1=lp[59-32-(((r+1)&3)+8*((r+1)>>2))];
    p0[r]+=a0; p0[r+1]+=a1; p1[r]+=b0; p1[r+1]+=b1; __builtin_amdgcn_sched_barrier(0); }
}
constexpr int NSLOT=3, SLOTB=8192;
constexpr int LDS_K=0, LDS_V=NSLOT*SLOTB, LDS_WS=3*NSLOT*SLOTB, LDS_OST=LDS_WS+NW*64*4, LDS_LUT=LDS_OST+NW*4096, LDS_BYTES=LDS_LUT+640*4;
constexpr float C2=0.125f*1.4426950408889634f;
__device__ __forceinline__ void glds16(const void*gsrc,unsigned lds_dst){unsigned keep;
  asm volatile("s_mov_b32 %0, m0\n\ts_mov_b32 m0, %2\n\ts_nop 0\n\tglobal_load_lds_dwordx4 %1, off\n\ts_mov_b32 m0, %0":"=&s"(keep):"v"(gsrc),"s"(lds_dst):"memory");}
__device__ __forceinline__ void glds16s(const void*sbase,unsigned voff,unsigned lds_dst){unsigned keep;
  asm volatile("s_mov_b32 %0, m0\n\ts_mov_b32 m0, %3\n\ts_nop 0\n\tglobal_load_lds_dwordx4 %1, %2\n\ts_mov_b32 m0, %0":"=&s"(keep):"v"(voff),"s"(sbase),"s"(lds_dst):"memory");}
__device__ __forceinline__ float max3f(float a,float b,float c){float r;asm("v_max3_f32 %0, %1, %2, %3":"=v"(r):"v"(a),"v"(b),"v"(c));return r;}
__device__ __forceinline__ float max2f(float a,float b){float r;asm("v_max_f32_e32 %0, %1, %2":"=v"(r):"v"(a),"v"(b));return r;}
__device__ __forceinline__ float fadd_s(float a,float b){float r;asm("v_add_f32_e32 %0, %1, %2":"=v"(r):"v"(a),"v"(b));return r;}
__device__ __forceinline__ float fsub_s(float a,float b){float r;asm("v_sub_f32_e32 %0, %1, %2":"=v"(r):"v"(a),"v"(b));return r;}
typedef float f32x2_t __attribute__((ext_vector_type(2))); typedef __bf16 bf16x2_t __attribute__((ext_vector_type(2)));
__device__ __forceinline__ unsigned cvtpk_s(float lo,float hi){f32x2_t v={lo,hi};bf16x2_t b=__builtin_convertvector(v,bf16x2_t);return __builtin_bit_cast(unsigned,b);}
#define WAIT_BAR(N) asm volatile("s_waitcnt vmcnt(" #N ") lgkmcnt(0)\n\ts_barrier":::"memory")

__device__ __forceinline__ void qkt(f32x16&p0,f32x16&p1,const char*Kslot,const bf16x8*qr,const f32x16&negm,int r32,int hi){
  const char*kb=Kslot+hi*1024+r32*16;
  #pragma unroll
  for(int d0=0;d0<4;++d0){
    const bf16x8 b0=*reinterpret_cast<const bf16x8*>(kb+d0*2048);
    const bf16x8 b1=*reinterpret_cast<const bf16x8*>(kb+d0*2048+512);
    if(d0==0){p0=__builtin_amdgcn_mfma_f32_32x32x16_bf16(b0,qr[0],negm,0,0,0);p1=__builtin_amdgcn_mfma_f32_32x32x16_bf16(b1,qr[0],negm,0,0,0);}
    else{p0=__builtin_amdgcn_mfma_f32_32x32x16_bf16(b0,qr[d0],p0,0,0,0);p1=__builtin_amdgcn_mfma_f32_32x32x16_bf16(b1,qr[d0],p1,0,0,0);}}
}
typedef __attribute__((address_space(3))) const char* lds_cptr;
typedef short v4i16_t __attribute__((ext_vector_type(4)));
__device__ __forceinline__ void kload8(bf16x8*kf,lds_cptr kp){
  kf[0]=*(const __attribute__((address_space(3))) bf16x8*)(kp);      kf[1]=*(const __attribute__((address_space(3))) bf16x8*)(kp+512);
  kf[2]=*(const __attribute__((address_space(3))) bf16x8*)(kp+2048); kf[3]=*(const __attribute__((address_space(3))) bf16x8*)(kp+2560);
  kf[4]=*(const __attribute__((address_space(3))) bf16x8*)(kp+4096); kf[5]=*(const __attribute__((address_space(3))) bf16x8*)(kp+4608);
  kf[6]=*(const __attribute__((address_space(3))) bf16x8*)(kp+6144); kf[7]=*(const __attribute__((address_space(3))) bf16x8*)(kp+6656);
}
__device__ __forceinline__ void kload2(bf16x8*kf,lds_cptr kp,int j){ kf[2*j]=*(const __attribute__((address_space(3))) bf16x8*)(kp+j*2048); kf[2*j+1]=*(const __attribute__((address_space(3))) bf16x8*)(kp+j*2048+512); }
__device__ __forceinline__ s16x4 vtr(lds_cptr p){ return __builtin_bit_cast(s16x4,__builtin_amdgcn_ds_read_tr16_b64_v4i16((__attribute__((address_space(3))) v4i16_t*)p)); }
__device__ __forceinline__ float rowmax(const f32x16&p0,const f32x16&p1){
  float a=max3f(p0[0],p0[1],p1[0]),b=max3f(p0[2],p0[3],p1[1]);a=max3f(a,p1[2],p1[3]);
  #pragma unroll
  for(int r=4;r<16;r+=4){a=max3f(a,p0[r],p0[r+1]);b=max3f(b,p0[r+2],p0[r+3]);a=max3f(a,p1[r],p1[r+1]);b=max3f(b,p1[r+2],p1[r+3]);}
  const float m=max2f(a,b);
  auto rr=__builtin_amdgcn_permlane32_swap(__float_as_uint(m),__float_as_uint(m),false,false);
  return max2f(__uint_as_float(rr[0]),__uint_as_float(rr[1]));
}
__device__ __forceinline__ void pv(f32x16*o,int vb,bf16x8 pa0,bf16x8 pa1,bf16x8 pa2,bf16x8 pa3){
  #pragma unroll
  for(int d0=0;d0<4;++d0){s16x4 lo[4],hi[4];
    #pragma unroll
    for(int ks=0;ks<4;++ks){
      asm volatile("ds_read_b64_tr_b16 %0,%1 offset:%c2":"=&v"(lo[ks]):"v"(vb),"i"(d0*4096+ks*1024):"memory");
      asm volatile("ds_read_b64_tr_b16 %0,%1 offset:%c2":"=&v"(hi[ks]):"v"(vb),"i"(d0*4096+ks*1024+512):"memory");}
    asm volatile("s_waitcnt lgkmcnt(0)":::"memory");SBAR();
    #define PK(k) (bf16x8){lo[k][0],lo[k][1],lo[k][2],lo[k][3],hi[k][0],hi[k][1],hi[k][2],hi[k][3]}
    o[d0]=__builtin_amdgcn_mfma_f32_32x32x16_bf16(pa0,PK(0),o[d0],0,0,0);
    o[d0]=__builtin_amdgcn_mfma_f32_32x32x16_bf16(pa1,PK(1),o[d0],0,0,0);
    o[d0]=__builtin_amdgcn_mfma_f32_32x32x16_bf16(pa2,PK(2),o[d0],0,0,0);
    o[d0]=__builtin_amdgcn_mfma_f32_32x32x16_bf16(pa3,PK(3),o[d0],0,0,0);
    #undef PK
  }
}

#ifndef ATTN_STORE16
#define ATTN_STORE16(p,v) (*(u32x4*)(p)=(v))
#endif
template<int THRL,bool NOBIAS=false> __device__ __forceinline__ void attn_unit(int qb,const bf16*Qh,const bf16*__restrict__ Kh,const bf16*__restrict__ Vh,bf16*Oh,const float* __restrict__ rel_table,int head,char*shm,const int tid){
  const int lane=tid&63,r32=lane&31,hi=lane>>5; const int wid=__builtin_amdgcn_readfirstlane(tid>>6);
  const int q0=qb*QB;
  const bf16*Qw=Qh+(long)(q0+wid*QBLK)*DM;
  const unsigned lds0=(unsigned)(uintptr_t)shm;
  float*wsf=(float*)(shm+LDS_WS)+wid*64;
  const unsigned koff=(unsigned)(lane*DM+wid*8)*2u;
  const unsigned voff=(unsigned)((16*(wid&3)+(lane>>2))*DM+(wid>>2)*32+(lane&3)*8)*2u;
  const unsigned kdst=lds0+LDS_K+wid*1024, vdst=lds0+LDS_V+wid*1024;
  #define DMA_K(t,slot) glds16s(Kh+(long)(t)*KVBLK*DM,koff,(unsigned)__builtin_amdgcn_readfirstlane(kdst+(slot)))
  #define DMA_V(t,slot) do{ glds16s(Vh+(long)(t)*KVBLK*DM,voff,(unsigned)__builtin_amdgcn_readfirstlane(vdst+2*(slot))); glds16s(Vh+64+(long)(t)*KVBLK*DM,voff,(unsigned)__builtin_amdgcn_readfirstlane(vdst+2*(slot)+8192)); }while(0)
  const int vb0=(int)(lds0+LDS_V)+((lane>>4)&1)*32+(lane&3)*8+(4*hi+((lane&15)>>2))*64;
  const char*Kbase=shm+LDS_K; bf16x8 kf[8];
  const lds_cptr shm3=(lds_cptr)shm; const lds_cptr kp0=shm3+LDS_K+hi*1024+r32*16; const lds_cptr vp0=shm3+LDS_V+((lane>>4)&1)*32+(lane&3)*8+(4*hi+((lane&15)>>2))*64;
  const int NT=(q0+QB)/KVBLK;
  { float*lut=(float*)(shm+LDS_LUT); const float t31=rel_table[31*4+head];
    for(int i=tid;i<640;i+=512){ const int d=i-256; float v=0.f;
      if(d>=0&&d<128){ int bk; if(d<16)bk=d; else { bk=16+(int)(logf((float)d*(1.f/16.f))/logf(8.f)*16.f); bk=bk<31?bk:31; } v=(rel_table[bk*4+head]-t31)*1.4426950408889634f; }
      lut[i]=v; } }
  DMA_K(0,0);DMA_V(0,0);DMA_K(1,SLOTB);
  bf16x8 qr[4];
  #pragma unroll
  for(int d0=0;d0<4;++d0)qr[d0]=*reinterpret_cast<const bf16x8*>(&Qw[(long)r32*DM+d0*16+hi*8]);
  float mhat=0.f,l_reg=0.f;f32x16 o[4];o[0]=f32x16{};o[1]=f32x16{};o[2]=f32x16{};o[3]=f32x16{};f32x16 negm=f32x16{};asm volatile("":"+v"(negm));
  const int qrel=wid*QBLK+r32;
  #define CMASK(P0,P1,t) do{int jb_=(t)-(NT-4); if(!NOBIAS&&jb_>=-2)biasadd(P0,P1,(const float*)(shm+LDS_LUT)+(wid*QBLK+r32-4*hi+256-59)-64*jb_); if(jb_>=0)cmask(P0,P1,jb_,qrel,hi);}while(0)
  bool resc=false;
  #define START(P0,P1) do{ const float rm=rowmax(P0,P1); resc=false; \
    { const float dl=rm; mhat=fadd_s(mhat,dl); \
      _Pragma("unroll") for(int r=0;r<16;++r){P0[r]=fsub_s(P0[r],dl);P1[r]=fsub_s(P1[r],dl);} \
      _Pragma("unroll") for(int r=0;r<16;++r)negm[r]=-mhat; asm volatile("":"+v"(negm)); } \
    _Pragma("unroll") for(int r=0;r<16;++r)P0[r]=__builtin_amdgcn_exp2f(P0[r]); }while(0)
  #define RESC() do{ if(resc){ asm volatile("s_waitcnt lgkmcnt(0)":::"memory"); \
      _Pragma("unroll") for(int d_=0;d_<4;++d_) _Pragma("unroll") for(int r=0;r<16;++r)o[d_][r]*=wsf[crow(r,hi)]; } }while(0)
  f32x16 pA0,pA1,pB0,pB1;
  int sl_prev=0,sl_cur=0,sl_next=SLOTB;
  #define ROT() do{sl_prev=sl_cur;sl_cur=sl_next;sl_next=(sl_next==(NSLOT-1)*SLOTB)?0:sl_next+SLOTB;}while(0)
  DMA_K(2,2*SLOTB);
  WAIT_BAR(3);
  qkt(pA0,pA1,Kbase,qr,negm,r32,hi);asm volatile("s_nop 15\n\ts_nop 7":"+v"(pA0),"+v"(pA1));CMASK(pA0,pA1,0);
  START(pA0,pA1);
  _Pragma("unroll") for(int r=0;r<16;++r)pA1[r]=__builtin_amdgcn_exp2f(pA1[r]);
  WAIT_BAR(0);
  DMA_K(3,0);DMA_V(1,SLOTB);
  ROT();
  kload8(kf,kp0+sl_cur);
  WAIT_BAR(3);
  s16x4 vlo[4],vhi[4]; u32x4 pw0,pw1,pw2,pw3;
  #define PKW(P,B) cvtpk_s(P[B],P[B+1])
  #define PAF(k) __builtin_bit_cast(bf16x8,pw##k)
  #define VFR(i) (bf16x8){vlo[i][0],vlo[i][1],vlo[i][2],vlo[i][3],vhi[i][0],vhi[i][1],vhi[i][2],vhi[i][3]}
  #define PIN(x) asm volatile("":"+v"(x))
  #define MX3(a,b,c) __builtin_fmaxf(__builtin_fmaxf((a),(b)),(c))
  #define GAPA(MF,A0,A1,A2,A3,W0,W1,PW) do{ MF; sacc+=A0; sacc+=A1; sacc+=A2; sacc+=A3; PIN(sacc); W0; W1; PIN(PW); SBAR(); }while(0)
  #define EX(v) __builtin_amdgcn_exp2f(v)
  #define GAPB(MF,X,B) do{ MF; X[B]=EX(X[B]); X[B+1]=EX(X[B+1]); X[B+2]=EX(X[B+2]); X[B+3]=EX(X[B+3]); PIN(X); SBAR(); }while(0)
  #define GAPB2(MF,X,B) do{ MF; X[B]=EX(X[B]); X[B+1]=EX(X[B+1]); PIN(X); SBAR(); }while(0)
  #define VRDS(i,f) do{ vlo[i]=vtr(vp_+(((f)>>2)*4096+((f)&3)*1024)); vhi[i]=vtr(vp_+(((f)>>2)*4096+((f)&3)*1024+512)); SBAR(); }while(0)
  #define VRD(i) do{ vlo[i]=vtr(vp_+(((i)>>2)*4096+((i)&3)*1024)); vhi[i]=vtr(vp_+(((i)>>2)*4096+((i)&3)*1024+512)); }while(0)
  #define KRD(G,j) do{ if(G){ kload2(kf,kp0+sl_next,j); SBAR(); } }while(0)
  #define STEP(C0,C1,P0,P1,t,GK,GV,GL) do{ SBAR(); \
    const lds_cptr vp_=vp0+2*sl_prev; \
    VRDS(0,0);  float sacc=(P0[0]+P0[1]); \
    GAPA(C0=__builtin_amdgcn_mfma_f32_32x32x16_bf16(kf[0],qr[0],negm,0,0,0), P0[2],P0[3],P0[4],P0[5],     pw0[0]=PKW(P0,0), pw0[1]=PKW(P0,2), pw0); \
    VRDS(1,4);  GAPA(C1=__builtin_amdgcn_mfma_f32_32x32x16_bf16(kf[1],qr[0],negm,0,0,0), P0[6],P0[7],P0[8],P0[9],     pw0[2]=PKW(P0,4), pw0[3]=PKW(P0,6), pw0); \
    VRDS(2,1);  GAPA(C0=__builtin_amdgcn_mfma_f32_32x32x16_bf16(kf[2],qr[1],C0,0,0,0),   P0[10],P0[11],P0[12],P0[13], pw1[0]=PKW(P0,8), pw1[1]=PKW(P0,10), pw1); \
    VRDS(3,5);  GAPA(C1=__builtin_amdgcn_mfma_f32_32x32x16_bf16(kf[3],qr[1],C1,0,0,0),   P0[14],P0[15],P1[0],P1[1],   pw1[2]=PKW(P0,12),pw1[3]=PKW(P0,14), pw1); \
     GAPA(C0=__builtin_amdgcn_mfma_f32_32x32x16_bf16(kf[4],qr[2],C0,0,0,0),   P1[2],P1[3],P1[4],P1[5],     pw2[0]=PKW(P1,0), pw2[1]=PKW(P1,2), pw2); \
     GAPA(C1=__builtin_amdgcn_mfma_f32_32x32x16_bf16(kf[5],qr[2],C1,0,0,0),   P1[6],P1[7],P1[8],P1[9],     pw2[2]=PKW(P1,4), pw2[3]=PKW(P1,6), pw2); \
     GAPA(C0=__builtin_amdgcn_mfma_f32_32x32x16_bf16(kf[6],qr[3],C0,0,0,0),   P1[10],P1[11],P1[12],P1[13], pw3[0]=PKW(P1,8), pw3[1]=PKW(P1,10), pw3); \
     GAPA(C1=__builtin_amdgcn_mfma_f32_32x32x16_bf16(kf[7],qr[3],C1,0,0,0),   P1[14],P1[15],0.f,0.f,       pw3[2]=PKW(P1,12),pw3[3]=PKW(P1,14), pw3); \
    l_reg+=sacc; \
    if(GK){DMA_K((t)+3,sl_cur);} if(GV){DMA_V((t)+1,sl_next);} \
    CMASK(C0,C1,t); \
    { float a=MX3(C0[0],C0[1],C1[0]),b=MX3(C0[2],C0[3],C1[1]); a=MX3(a,C1[2],C1[3]); \
      _Pragma("unroll") for(int r=4;r<16;r+=4){a=MX3(a,C0[r],C0[r+1]);b=MX3(b,C0[r+2],C0[r+3]);a=MX3(a,C1[r],C1[r+1]);b=MX3(b,C1[r+2],C1[r+3]);} \
      float rm=__builtin_fmaxf(a,b); { auto rr=__builtin_amdgcn_permlane32_swap(__float_as_uint(rm),__float_as_uint(rm),false,false); rm=__builtin_fmaxf(__uint_as_float(rr[0]),__uint_as_float(rr[1])); } \
      resc=false; \
      if(__builtin_expect(__any(rm>(float)THRL),0)){ const float dl=__builtin_fmaxf(rm,0.f); mhat+=dl; \
        _Pragma("unroll") for(int r=0;r<16;++r){C0[r]-=dl;C1[r]-=dl;} \
        _Pragma("unroll") for(int r=0;r<16;++r)negm[r]=-mhat; asm volatile("":"+v"(negm)); \
        const float f=__builtin_amdgcn_exp2f(-dl); l_reg*=f; if(hi==0)wsf[r32]=f; resc=true; } } \
    SBAR(); \
    GAPB2(o[0]=__builtin_amdgcn_mfma_f32_32x32x16_bf16(PAF(0),VFR(0),o[0],0,0,0), C0,0); VRDS(0,2); \
    GAPB2(o[1]=__builtin_amdgcn_mfma_f32_32x32x16_bf16(PAF(0),VFR(1),o[1],0,0,0), C0,2); VRDS(1,6); \
    KRD(GL,0); GAPB2(o[0]=__builtin_amdgcn_mfma_f32_32x32x16_bf16(PAF(1),VFR(2),o[0],0,0,0), C0,4); VRDS(2,3); \
    KRD(GL,1); GAPB2(o[1]=__builtin_amdgcn_mfma_f32_32x32x16_bf16(PAF(1),VFR(3),o[1],0,0,0), C0,6); VRDS(3,7); \
    KRD(GL,2); GAPB2(o[0]=__builtin_amdgcn_mfma_f32_32x32x16_bf16(PAF(2),VFR(0),o[0],0,0,0), C0,8); VRDS(0,8); \
    KRD(GL,3); GAPB2(o[1]=__builtin_amdgcn_mfma_f32_32x32x16_bf16(PAF(2),VFR(1),o[1],0,0,0), C0,10); VRDS(1,12); \
    GAPB2(o[0]=__builtin_amdgcn_mfma_f32_32x32x16_bf16(PAF(3),VFR(2),o[0],0,0,0), C0,12); VRDS(2,9); \
    GAPB2(o[1]=__builtin_amdgcn_mfma_f32_32x32x16_bf16(PAF(3),VFR(3),o[1],0,0,0), C0,14); VRDS(3,13); \
    GAPB2(o[2]=__builtin_amdgcn_mfma_f32_32x32x16_bf16(PAF(0),VFR(0),o[2],0,0,0), C1,0); VRDS(0,10); \
    GAPB2(o[3]=__builtin_amdgcn_mfma_f32_32x32x16_bf16(PAF(0),VFR(1),o[3],0,0,0), C1,2); VRDS(1,14); \
    GAPB2(o[2]=__builtin_amdgcn_mfma_f32_32x32x16_bf16(PAF(1),VFR(2),o[2],0,0,0), C1,4); VRDS(2,11); \
    GAPB2(o[3]=__builtin_amdgcn_mfma_f32_32x32x16_bf16(PAF(1),VFR(3),o[3],0,0,0), C1,6); VRDS(3,15); \
    GAPB2(o[2]=__builtin_amdgcn_mfma_f32_32x32x16_bf16(PAF(2),VFR(0),o[2],0,0,0), C1,8); \
    GAPB2(o[3]=__builtin_amdgcn_mfma_f32_32x32x16_bf16(PAF(2),VFR(1),o[3],0,0,0), C1,10); \
    GAPB2(o[2]=__builtin_amdgcn_mfma_f32_32x32x16_bf16(PAF(3),VFR(2),o[2],0,0,0), C1,12); \
    GAPB2(o[3]=__builtin_amdgcn_mfma_f32_32x32x16_bf16(PAF(3),VFR(3),o[3],0,0,0), C1,14); \
    }while(0)
  int t=1;
  #undef CMASK
  #define CMASK(P0,P1,t) do{}while(0)
  for(;t+(NOBIAS?5:7)<NT;t+=2){
    STEP(pB0,pB1,pA0,pA1,t,true,true,true);     WAIT_BAR(3); RESC(); ROT();
    STEP(pA0,pA1,pB0,pB1,t+1,true,true,true);   WAIT_BAR(3); RESC(); ROT();
  }
  #undef CMASK
  #define CMASK(P0,P1,t) do{int jb_=(t)-(NT-4); if(!NOBIAS&&jb_>=-2)biasadd(P0,P1,(const float*)(shm+LDS_LUT)+(wid*QBLK+r32-4*hi+256-59)-64*jb_); if(jb_>=0)cmask(P0,P1,jb_,qrel,hi);}while(0)
  #define ENDW(tt) do{ if((tt)+3<NT){WAIT_BAR(3);} else if((tt)+2<NT){WAIT_BAR(2);} else {WAIT_BAR(0);} }while(0)
  for(;t+1<NT;t+=2){
    STEP(pB0,pB1,pA0,pA1,t,(t+3<NT),(t+1<NT),(t+1<NT));       ENDW(t);   RESC(); ROT();
    STEP(pA0,pA1,pB0,pB1,t+1,(t+4<NT),(t+2<NT),(t+2<NT));     ENDW(t+1); RESC(); ROT();
  }
  STEP(pB0,pB1,pA0,pA1,NT-1,false,false,false); RESC();
  { float sacc=pB0[0]+pB0[1]; _Pragma("unroll") for(int r=2;r<16;++r)sacc+=pB0[r]; _Pragma("unroll") for(int r=0;r<16;++r)sacc+=pB1[r]; l_reg+=sacc;
    pw0=(u32x4){PKW(pB0,0),PKW(pB0,2),PKW(pB0,4),PKW(pB0,6)};pw1=(u32x4){PKW(pB0,8),PKW(pB0,10),PKW(pB0,12),PKW(pB0,14)};pw2=(u32x4){PKW(pB1,0),PKW(pB1,2),PKW(pB1,4),PKW(pB1,6)};pw3=(u32x4){PKW(pB1,8),PKW(pB1,10),PKW(pB1,12),PKW(pB1,14)};
    SBAR(); pv(o,vb0+2*sl_cur,PAF(0),PAF(1),PAF(2),PAF(3)); }
  #undef PKW
  #undef PAF
  #undef VFR
  #undef PIN
  #undef MX3
  #undef GAPA
  #undef GAPB
  #undef GAPB2
  #undef VRDS
  #undef EX
  #undef VRD
  #undef KRD
  #undef STEP
  #undef ENDW
  {auto rr=__builtin_amdgcn_permlane32_swap(__float_as_uint(l_reg),__float_as_uint(l_reg),false,false);l_reg=__uint_as_float(rr[0])+__uint_as_float(rr[1]);}
  if(hi==0)wsf[32+r32]=l_reg;asm volatile("s_waitcnt lgkmcnt(0)":::"memory");
  float rli[16];
  #pragma unroll
  for(int r=0;r<16;++r)rli[r]=__builtin_amdgcn_rcpf(wsf[32+crow(r,hi)]);
  bf16*Ow=Oh+(long)(q0+wid*QBLK)*OPITCH;
  { bf16*stg=(bf16*)(shm+LDS_OST)+wid*2048;
    #pragma unroll
    for(int p=0;p<2;++p){
      #pragma unroll
      for(int r=0;r<16;++r){const int orow=crow(r,hi);
        #pragma unroll
        for(int d0=0;d0<2;++d0)stg[orow*64+d0*32+r32]=__float2bfloat16(o[2*p+d0][r]*rli[r]);}
      asm volatile("s_waitcnt lgkmcnt(0)":::"memory");
      #pragma unroll
      for(int i=0;i<4;++i){const int row=i*8+(lane>>3),ch=lane&7; const u32x4 v=*(const u32x4*)(stg+row*64+ch*8); ATTN_STORE16(Ow+(long)row*OPITCH+p*64+ch*8,v);}
      asm volatile("s_waitcnt lgkmcnt(0)":::"memory"); } }
  asm volatile("s_waitcnt lgkmcnt(0)\n\ts_barrier":::"memory");
  #undef DMA_K
  #undef DMA_V
  #undef CMASK
  #undef START
  #undef RESC
  #undef ROT
}
constexpr int ATTN_LDS_BYTES=LDS_BYTES;
#undef SBAR
#undef WAIT_BAR
}
#define XB_TMO      128
#define XB_XCNT(j)  (256  + 64 * (j))
#define XB_XSUB(j)  (1280 + 64 * (j))
#define XB_XGEN(j)  (2304 + 64 * (j))
#define XB_TOP      3328
#define XB_TOPGEN   3392
#define XCD_BAR_WORDS 3456
#define XB_SPIN_CAP (1u << 18)

__device__ __forceinline__ unsigned xb_ld(unsigned* p)              { return __hip_atomic_load(p, __ATOMIC_RELAXED, __HIP_MEMORY_SCOPE_AGENT); }
__device__ __forceinline__ unsigned xb_add(unsigned* p, unsigned v) { return __hip_atomic_fetch_add(p, v, __ATOMIC_RELAXED, __HIP_MEMORY_SCOPE_AGENT); }
__device__ __forceinline__ unsigned xb_xcc_id() { return (unsigned)__builtin_amdgcn_s_getreg((3 << 11) | 20) & 0xFu; }
#define XB_SPIN(cond, bar) do { unsigned _sp = 0; while (cond) { __builtin_amdgcn_s_sleep(1); \
    if ((++_sp & 255u) == 0u) { if (xb_ld(&(bar)[XB_TMO])) break; if (_sp > XB_SPIN_CAP) { atomicAdd(&(bar)[XB_TMO], 1u); break; } } } } while (0)

struct XcdBarrier {
    unsigned* bar; unsigned x;
    volatile LAS unsigned* st;
};

__device__ __forceinline__ XcdBarrier xcd_barrier_post(unsigned* bar, volatile LAS unsigned* st) {
    XcdBarrier b; b.bar = bar; b.x = xb_xcc_id(); b.st = st;
    if (threadIdx.x == 0) (void)xb_add(&bar[XB_XCNT(b.x)], 1u);
    return b;
}
__device__ __forceinline__ void xcd_barrier_complete(unsigned* bar, unsigned x, unsigned& nloc, unsigned& nx) {
    const unsigned G = gridDim.x * gridDim.y * gridDim.z;
    unsigned sum, cnt, mine, sp = 0u;
    for (;;) {
        sum = 0u; cnt = 0u; mine = 0u;
#pragma unroll
        for (unsigned j = 0; j < 16; ++j) { const unsigned c = xb_ld(&bar[XB_XCNT(j)]); sum += c; cnt += (c > 0u) ? 1u : 0u; mine = (j == x) ? c : mine; }
        if (sum == G) break;
        __builtin_amdgcn_s_sleep(1);
        if ((++sp & 255u) == 0u) { if (xb_ld(&bar[XB_TMO])) break; if (sp > XB_SPIN_CAP) { atomicAdd(&bar[XB_TMO], 1u); break; } }
    }
    nloc = mine > 0u ? mine : 1u; nx = cnt > 0u ? cnt : 1u;
}

__device__ __forceinline__ void xcd_barrier(const XcdBarrier& b) {
    asm volatile("s_waitcnt vmcnt(0)" ::: "memory");
    __syncthreads();
    if (threadIdx.x == 0) {
        unsigned* bar = b.bar;
        __builtin_amdgcn_s_waitcnt(0);
        unsigned nloc = b.st[0], nx = b.st[1];
        if (nloc == 0u) { xcd_barrier_complete(bar, b.x, nloc, nx); b.st[0] = nloc; b.st[1] = nx; }
        const unsigned old = xb_add(&bar[XB_XSUB(b.x)], 1u);
        const unsigned gen = old / nloc;
        if (old + 1u == (gen + 1u) * nloc) {
            __builtin_amdgcn_fence(__ATOMIC_RELEASE, "agent");
            asm volatile("s_waitcnt vmcnt(0)" ::: "memory");
            const unsigned og = xb_add(&bar[XB_TOP], 1u);
            const unsigned tg = og / nx;
            if (og + 1u == (tg + 1u) * nx) xb_add(&bar[XB_TOPGEN], 1u);
            else XB_SPIN(xb_ld(&bar[XB_TOPGEN]) == tg, bar);
            __builtin_amdgcn_fence(__ATOMIC_ACQUIRE, "agent");
            xb_add(&bar[XB_XGEN(b.x)], 1u);
            asm volatile("s_waitcnt vmcnt(0)" ::: "memory");
        } else {
            XB_SPIN(xb_ld(&bar[XB_XGEN(b.x)]) == gen, bar);
            __builtin_amdgcn_fence(__ATOMIC_ACQUIRE, "agent");
            asm volatile("s_waitcnt vmcnt(0)" ::: "memory");
        }
    }
    __syncthreads();
}
struct Args { const float* in[27]; float* out; unsigned char* ws; int ph_lo, ph_hi, li, pad; };
enum { I_X = 0, I_MEM, I_REL, I_ANORM, I_WIN, I_BGATE, I_CONV, I_ALOG, I_DTB, I_DNON, I_DAQN, I_DAKN, I_LAM, I_SUBLN, I_MEMNORM, I_WMKV, I_MXQN, I_MXKN, I_WBR, I_WOUT, I_FNORM,
       I_WR, I_BR, I_WGU, I_BGU, I_WD, I_BD };

#ifndef MOE_FP8
#define MOE_FP8 1
#endif
constexpr float W8_SCALE = 64.f, A8_SCALE = 4.f, ACC8_SCALE = 1.f / (W8_SCALE * A8_SCALE);
#ifndef TR_DEPTH3
#define TR_DEPTH3 0
#endif
#ifndef NORM_IN_EPI
#define NORM_IN_EPI 1
#endif
#ifndef GATE_U8
#define GATE_U8 1
#endif
DI unsigned pk4u8(float a, float b, float c, float d) {
    const unsigned fa = __builtin_bit_cast(unsigned, __builtin_fmaf(a, 255.f, 8388608.f)), fb = __builtin_bit_cast(unsigned, __builtin_fmaf(b, 255.f, 8388608.f));
    const unsigned fc = __builtin_bit_cast(unsigned, __builtin_fmaf(c, 255.f, 8388608.f)), fd = __builtin_bit_cast(unsigned, __builtin_fmaf(d, 255.f, 8388608.f));
    return __builtin_amdgcn_perm(fb, fa, 0x0c0c0400u) | __builtin_amdgcn_perm(fd, fc, 0x04000c0cu);
}
#ifndef P1_FA0
#define P1_FA0 0
#define P1_FA1 0
#endif
DI constexpr bool p1_isf8(int pn) { return pn >= 16 || (pn >= P1_FA0 && pn < P1_FA1); }
DI void tr_item(const float* __restrict__ W, size_t ldw, int k0, int c0, bf16* WT, int K, size_t drow0, LAS float* scr, int lane, float sc = 1.f) {
    float v[64];
    const float* wp = W + (size_t)k0 * ldw + c0 + lane;
#pragma unroll
    for (int k = 0; k < 64; ++k) v[k] = wp[(size_t)k * ldw];
#pragma unroll
    for (int k = 0; k < 64; ++k) scr[k * 65 + lane] = v[k] * sc;
    LDS_WAIT();
    const int c = lane & 7;
#pragma unroll
    for (int j = 0; j < 8; ++j) { const int n = (lane >> 3) + 8 * j; const LAS float* s = scr + (8 * c) * 65 + n;
        v4u o; o.x = pk2(s[0 * 65], s[1 * 65]); o.y = pk2(s[2 * 65], s[3 * 65]); o.z = pk2(s[4 * 65], s[5 * 65]); o.w = pk2(s[6 * 65], s[7 * 65]);
        *(v4u*)(WT + (drow0 + n) * K + k0 + 8 * c) = o; }
    LDS_WAIT();
}

DI void tr_item8(const float* __restrict__ W, size_t ldw, int k0, int c0, unsigned char* WT, int K, size_t drow0, LAS float* scr, int lane) {
    float v[64];
    const float* wp = W + (size_t)k0 * ldw + c0 + lane;
#pragma unroll
    for (int k = 0; k < 64; ++k) v[k] = wp[(size_t)k * ldw];
#pragma unroll
    for (int k = 0; k < 64; ++k) scr[k * 65 + lane] = v[k] * W8_SCALE;
    LDS_WAIT();
    const int c = lane & 7;
#pragma unroll
    for (int j = 0; j < 8; ++j) { const int n = (lane >> 3) + 8 * j; const LAS float* s = scr + (8 * c) * 65 + n;
        v2u o; o.x = pk4f8(s[0 * 65], s[1 * 65], s[2 * 65], s[3 * 65]); o.y = pk4f8(s[4 * 65], s[5 * 65], s[6 * 65], s[7 * 65]);
        *(v2u*)(WT + (drow0 + n) * K + k0 + 8 * c) = o; }
    LDS_WAIT();
}
#if MOE_FP8
struct TrDesc { const float* wp; size_t ldw; unsigned char* dst; int K; };
DI TrDesc moe_tr_desc(const Args& a, int it, int lane) {
    constexpr int I_GU = 16 * 32 * NEXP;
    unsigned char* ws = a.ws; TrDesc d;
    if (it < I_GU) { const int e = it / 512, q = it % 512, kb = q / 32, nb = q % 32; const int n0 = nb * 64, pn = n0 >> 8, bj = (n0 >> 7) & 1, i0 = n0 & 127;
        d.wp = a.in[I_WGU] + (size_t)e * 1024 * 2048 + (size_t)(kb * 64) * 2048 + (bj * 1024 + 128 * pn + i0) + lane; d.ldw = 2048;
        d.dst = (ws + WS_WGU) + ((size_t)e * 2048 + n0) * 1024 + kb * 64; d.K = 1024; }
    else { const int r = it - I_GU; const int e = r / 256, q = r % 256, kb = q / 16, nb = q % 16;
        d.wp = a.in[I_WD] + (size_t)e * 1024 * 1024 + (size_t)(kb * 64) * 1024 + nb * 64 + lane; d.ldw = 1024;
        d.dst = (ws + WS_WD) + ((size_t)e * 1024 + nb * 64) * 1024 + kb * 64; d.K = 1024; }
    return d;
}
#define TR_LOAD(v, d) do { _Pragma("unroll") for (int k_ = 0; k_ < 64; ++k_) v[k_] = __builtin_nontemporal_load((d).wp + (size_t)k_ * (d).ldw); } while (0)
#define TR_STORE(v, d) do { _Pragma("unroll") for (int k_ = 0; k_ < 64; ++k_) scr[k_ * 65 + lane] = v[k_] * W8_SCALE; \
        LDS_WAIT(); const int c_ = lane & 7; \
        _Pragma("unroll") for (int j_ = 0; j_ < 8; ++j_) { const int n_ = (lane >> 3) + 8 * j_; const LAS float* s_ = scr + (8 * c_) * 65 + n_; \
            v2u o_; o_.x = pk4f8(s_[0 * 65], s_[1 * 65], s_[2 * 65], s_[3 * 65]); o_.y = pk4f8(s_[4 * 65], s_[5 * 65], s_[6 * 65], s_[7 * 65]); \
            __builtin_nontemporal_store(o_, (v2u*)((d).dst + (size_t)n_ * (d).K + 8 * c_)); } \
        LDS_WAIT(); } while (0)
#else
struct TrDesc { const float* wp; size_t ldw; bf16* dst; int K; };
DI TrDesc moe_tr_desc(const Args& a, int it, int lane) {
    constexpr int I_GU = 16 * 32 * NEXP;
    unsigned char* ws = a.ws; TrDesc d;
    if (it < I_GU) { const int e = it / 512, q = it % 512, kb = q / 32, nb = q % 32; const int n0 = nb * 64, pn = n0 >> 8, bj = (n0 >> 7) & 1, i0 = n0 & 127;
        d.wp = a.in[I_WGU] + (size_t)e * 1024 * 2048 + (size_t)(kb * 64) * 2048 + (bj * 1024 + 128 * pn + i0) + lane; d.ldw = 2048;
        d.dst = (bf16*)(ws + WS_WGU) + ((size_t)e * 2048 + n0) * 1024 + kb * 64; d.K = 1024; }
    else { const int r = it - I_GU; const int e = r / 256, q = r % 256, kb = q / 16, nb = q % 16;
        d.wp = a.in[I_WD] + (size_t)e * 1024 * 1024 + (size_t)(kb * 64) * 1024 + nb * 64 + lane; d.ldw = 1024;
        d.dst = (bf16*)(ws + WS_WD) + ((size_t)e * 1024 + nb * 64) * 1024 + kb * 64; d.K = 1024; }
    return d;
}
#define TR_LOAD(v, d) do { _Pragma("unroll") for (int k_ = 0; k_ < 64; ++k_) v[k_] = (d).wp[(size_t)k_ * (d).ldw]; } while (0)
#define TR_STORE(v, d) do { _Pragma("unroll") for (int k_ = 0; k_ < 64; ++k_) scr[k_ * 65 + lane] = v[k_]; \
        LDS_WAIT(); const int c_ = lane & 7; \
        _Pragma("unroll") for (int j_ = 0; j_ < 8; ++j_) { const int n_ = (lane >> 3) + 8 * j_; const LAS float* s_ = scr + (8 * c_) * 65 + n_; \
            v4u o_; o_.x = pk2(s_[0 * 65], s_[1 * 65]); o_.y = pk2(s_[2 * 65], s_[3 * 65]); o_.z = pk2(s_[4 * 65], s_[5 * 65]); o_.w = pk2(s_[6 * 65], s_[7 * 65]); \
            *(v4u*)((d).dst + (size_t)n_ * (d).K + 8 * c_) = o_; } \
        LDS_WAIT(); } while (0)
#endif
DI void moe_transposes(const Args& a, LAS unsigned char* lds, int part, int nparts, int wave, int lane) {
    LAS float* scr = (LAS float*)(lds + wave * 16640);
    constexpr int NIT = 16 * 32 * NEXP + 16 * 16 * NEXP;
    const int per = (NIT + nparts * 8 - 1) / (nparts * 8), stride = 1;
    int it = (part * 8 + wave) * per; const int it_end = (it + per < NIT) ? it + per : NIT;
    if (it >= it_end) return;
#if TR_DEPTH3
    float vA[64], vB[64], vC[64];
    TrDesc dA = moe_tr_desc(a, it, lane), dB = dA, dC = dA;
    TR_LOAD(vA, dA);
    if (it + 1 < it_end) { dB = moe_tr_desc(a, it + 1, lane); TR_LOAD(vB, dB); }
    for (;;) {
        if (it + 2 < it_end) { dC = moe_tr_desc(a, it + 2, lane); TR_LOAD(vC, dC); }
        TR_STORE(vA, dA);
        if (it + 1 >= it_end) break;
        if (it + 3 < it_end) { dA = moe_tr_desc(a, it + 3, lane); TR_LOAD(vA, dA); }
        TR_STORE(vB, dB);
        if (it + 2 >= it_end) break;
        if (it + 4 < it_end) { dB = moe_tr_desc(a, it + 4, lane); TR_LOAD(vB, dB); }
        TR_STORE(vC, dC);
        if (it + 3 >= it_end) break;
        it += 3;
    }
#else
    float vA[64], vB[64];
    TrDesc dA = moe_tr_desc(a, it, lane), dB = dA;
    TR_LOAD(vA, dA);
    for (;;) {
        const bool hb = it + stride < it_end;
        if (hb) { dB = moe_tr_desc(a, it + stride, lane); TR_LOAD(vB, dB); }
        TR_STORE(vA, dA);
        if (!hb) break;
        it += stride;
        const bool ha = it + stride < it_end;
        if (ha) { dA = moe_tr_desc(a, it + stride, lane); TR_LOAD(vA, dA); }
        TR_STORE(vB, dB);
        if (!ha) break;
        it += stride;
    }
#endif
}
DI void p3_small_copies(const Args& a, LAS unsigned char* lds, int part, int nparts, int wave, int lane) {
    unsigned char* ws = a.ws; LAS float* scr = (LAS float*)(lds + wave * 16640);
    constexpr int I_BRI = 3 * 8 * 16, I_OUT = 16 * 16;
    for (int it = part * 8 + wave; it < I_BRI + I_OUT; it += nparts * 8) {
        int r = it;
        if (r < I_BRI) { const int br = r / 128, q = r % 128, kb = q / 16, nb = q % 16;
            tr_item(a.in[I_WBR] + (size_t)br * 512 * 1024, 1024, kb * 64, nb * 64, (bf16*)(ws + WS_WB), 512, (size_t)br * 1024 + nb * 64, scr, lane, GATE_U8 ? (1.f / 255.f) : 1.f); continue; } r -= I_BRI;
        { const int kb = r / 16, nb = r % 16;
            tr_item(a.in[I_WOUT], 1024, kb * 64, nb * 64, (bf16*)(ws + WS_WOUT), 1024, (size_t)nb * 64, scr, lane); }
    }
}
DI void p0_prologue(const Args& a, LAS unsigned char* lds, int vcu, int G, int wave, int lane, int pmode = 0) {
    unsigned char* ws = a.ws;
    LAS float* scr = (LAS float*)(lds + wave * 16640);
    const int gw = vcu * 8 + wave, NGW = G * 8;
    constexpr int I_IN = 16 * 112, I_GU = 16 * 32 * NEXP, I_DN = 16 * 16 * NEXP, I_BRI = 3 * 8 * 16, I_OUT = 16 * 16, I_MK = 16 * 16;
    constexpr int NITEMS = I_IN + I_MK; (void)I_GU; (void)I_DN; (void)I_BRI; (void)I_OUT;
#define P0_ITEMS() do {     for (int it = gw; it < ((pmode & 1) ? 0 : NITEMS); it += NGW) { \
        int r = it; \
        if (r < I_IN) { const int kb = r / 112, nb = r % 112; const int n0 = nb * 64; \
            if (p1_isf8(n0 >> 8)) tr_item8(a.in[I_WIN], INW, kb * 64, n0 < 2048 ? n0 : n0 + 8, ws + WS_WIN8, 1024, (size_t)n0, scr, lane); \
            else tr_item(a.in[I_WIN], INW, kb * 64, n0 < 2048 ? n0 : n0 + 8, (bf16*)(ws + WS_WIN), 1024, (size_t)n0, scr, lane); \
            continue; } r -= I_IN; \
        { const int kb = r / 16, nb = r % 16; \
            tr_item(a.in[I_WMKV], 1024, kb * 64, nb * 64, (bf16*)(ws + WS_WMKV), 1024, (size_t)nb * 64, scr, lane); } \
    } } while (0)
    const bool items_first = (__builtin_amdgcn_readfirstlane((int)blockIdx.x) & 1) == 0;
    if (items_first) P0_ITEMS();
    if (!(pmode & 2)) {
        const float* win = a.in[I_WIN];
        f32x4 gv[4];
#pragma unroll
        for (int j = 0; j < 4; ++j) gv[j] = ((const f32x4*)a.in[I_ANORM])[lane + 64 * j];
        f32x4 wa[4][4], wb[4][4];
#pragma unroll
        for (int j = 0; j < 4; ++j)
#pragma unroll
            for (int c = 0; c < 4; ++c) { const f32x4* p = (const f32x4*)(win + (size_t)(4 * lane + 256 * j + c) * INW + 2048); wa[j][c] = p[0]; wb[j][c] = p[1]; }
        const float alog = a.in[I_ALOG][lane & 3], dtb = a.in[I_DTB][lane & 3];
        float* G_ = (float*)(ws + WS_G); float* B_ = (float*)(ws + WS_BETA);
        bf16* H = (bf16*)(ws + WS_H);
        f32x4 nv[4];
        { const f32x4* xr = (const f32x4*)(a.in[I_X] + (size_t)gw * D) + lane;
#pragma unroll
          for (int j = 0; j < 4; ++j) nv[j] = __builtin_nontemporal_load(xr + 64 * j); }
        for (int m = gw; m < T; m += NGW) {
            f32x4 v[4]; float ss = 0.f;
#pragma unroll
            for (int j = 0; j < 4; ++j) { v[j] = nv[j]; ss += (v[j].x * v[j].x + v[j].y * v[j].y) + (v[j].z * v[j].z + v[j].w * v[j].w); }
            { const int mn = (m + NGW < T) ? m + NGW : m; const f32x4* xr = (const f32x4*)(a.in[I_X] + (size_t)mn * D) + lane;
#pragma unroll
              for (int j = 0; j < 4; ++j) nv[j] = __builtin_nontemporal_load(xr + 64 * j); }
            const float rstd = rsqrtf(wave_sum(ss) * (1.f / D) + EPS);
            f32x4 pa = {0.f, 0.f, 0.f, 0.f}, pb = {0.f, 0.f, 0.f, 0.f};
            unsigned* o4 = (unsigned*)(ws + WS_H8 + (size_t)m * D) + lane;
            unsigned long long* o8 = (unsigned long long*)(H + (size_t)m * D) + lane;
#pragma unroll
            for (int j = 0; j < 4; ++j) { v[j] = v[j] * rstd * gv[j];
                o4[64 * j] = pk4f8(v[j].x * A8_SCALE, v[j].y * A8_SCALE, v[j].z * A8_SCALE, v[j].w * A8_SCALE);
                o8[64 * j] = (unsigned long long)pk2(v[j].x, v[j].y) | ((unsigned long long)pk2(v[j].z, v[j].w) << 32);
                pa += wa[j][0] * v[j].x + wa[j][1] * v[j].y + wa[j][2] * v[j].z + wa[j][3] * v[j].w;
                pb += wb[j][0] * v[j].x + wb[j][1] * v[j].y + wb[j][2] * v[j].z + wb[j][3] * v[j].w; }
            pa.x = wave_sum(pa.x); pa.y = wave_sum(pa.y); pa.z = wave_sum(pa.z); pa.w = wave_sum(pa.w);
            pb.x = wave_sum(pb.x); pb.y = wave_sum(pb.y); pb.z = wave_sum(pb.z); pb.w = wave_sum(pb.w);
            if (lane < 4) {
                const float av = lane == 0 ? pa.x : lane == 1 ? pa.y : lane == 2 ? pa.z : pa.w;
                const float bv = lane == 0 ? pb.x : lane == 1 ? pb.y : lane == 2 ? pb.z : pb.w;
                const float z = av + dtb; const float sp = z > 20.f ? z : log1pf(expf(z));
                G_[(size_t)m * 4 + lane] = -expf(alog) * sp;
                B_[(size_t)m * 4 + lane] = 1.f / (1.f + expf(-bv));
            }
        }
    }
    {
        f32x4 gv[4];
#pragma unroll
        for (int j = 0; j < 4; ++j) gv[j] = ((const f32x4*)a.in[I_MEMNORM])[lane + 64 * j];
        bf16* MN = (bf16*)(ws + WS_MEMN);
        for (int m = gw; m < BATCH * NMEM; m += NGW) {
            const f32x4* xr = (const f32x4*)(a.in[I_MEM] + (size_t)m * D) + lane;
            f32x4 v[4]; float ss = 0.f;
#pragma unroll
            for (int j = 0; j < 4; ++j) { v[j] = xr[64 * j]; ss += (v[j].x * v[j].x + v[j].y * v[j].y) + (v[j].z * v[j].z + v[j].w * v[j].w); }
            const float rstd = rsqrtf(wave_sum(ss) * (1.f / D) + EPS);
            unsigned long long* o8 = (unsigned long long*)(MN + (size_t)m * D) + lane;
#pragma unroll
            for (int j = 0; j < 4; ++j) { v[j] = v[j] * rstd * gv[j]; o8[64 * j] = (unsigned long long)pk2(v[j].x, v[j].y) | ((unsigned long long)pk2(v[j].z, v[j].w) << 32); }
        }
    }
    if (!items_first) P0_ITEMS();
#undef P0_ITEMS
}

template <bool F8>
struct EpiPT {
    static constexpr bool PERM = true; static constexpr bool CHAIN = false; static constexpr bool PREFETCH = false;
    bf16* O; const float* b_gate; int skip; bf16* GF;
    LAS float* EX; const float* daqn; const float* dakn; const float* mxqn;
    DI void operator()(const f32x4 (&acc)[2][2][4][2], const pg8::Unit& u, int wr, int wc, int fr, int fq) const {
        if (skip == 1) { f32x4 s_ = {0.f, 0.f, 0.f, 0.f}; _Pragma("unroll") for (int a_ = 0; a_ < 2; ++a_) _Pragma("unroll") for (int b_ = 0; b_ < 2; ++b_) _Pragma("unroll") for (int m_ = 0; m_ < 4; ++m_) _Pragma("unroll") for (int n_ = 0; n_ < 2; ++n_) s_ += acc[a_][b_][m_][n_]; if (s_.x + s_.y + s_.z + s_.w == 123.456f) O[0] = 0; return; }
        const int row0 = u.pm * 256 + wr * 64 + fr, col0 = u.pn * 256 + wc * 32 + 8 * fq;
        const bool isg = u.pn >= 16;
        f32x4 bv[2][2];
#pragma unroll
        for (int bj = 0; bj < 2; ++bj)
#pragma unroll
            for (int n = 0; n < 2; ++n) bv[bj][n] = isg ? *(const f32x4*)(b_gate + (col0 - 4096) + bj * 128 + 4 * n) : (f32x4){0.f, 0.f, 0.f, 0.f};
        const size_t gtile = isg ? ((size_t)(((u.pn - 16) >> 2) * 128 + u.pm) * 4 + ((u.pn - 16) & 3)) : 0;
        const int wl = (wr * 4 + wc) * 64 + fq * 16 + fr;
#if NORM_IN_EPI
        if (!F8 && ((u.pn >= 8 && u.pn < 12) || (u.pn >= 14 && u.pn < 16))) {
            const bool mx = u.pn >= 14;
            int fr_ = fr, fq_ = fq; asm volatile("" : "+v"(fr_), "+v"(fq_));
            LAS float* e0 = EX + (wr * 4 + wc) * 256 + fr_; const LAS float* e1 = EX + (wr * 4 + (wc ^ 1)) * 256 + fr_;
            const LAS float* e2 = EX + (wr * 4 + (wc ^ 2)) * 256 + fr_; const LAS float* e3 = EX + (wr * 4 + (wc ^ 3)) * 256 + fr_;
#pragma unroll
            for (int ai = 0; ai < 2; ++ai)
#pragma unroll
                for (int m = 0; m < 4; ++m)
#pragma unroll
                    for (int bj = 0; bj < 2; ++bj) { const f32x4 v0 = acc[ai][bj][m][0], v1 = acc[ai][bj][m][1];
                        float ss = (v0.x * v0.x + v0.y * v0.y) + (v0.z * v0.z + v0.w * v0.w) + (v1.x * v1.x + v1.y * v1.y) + (v1.z * v1.z + v1.w * v1.w);
                        ss += __shfl_xor(ss, 16); ss += __shfl_xor(ss, 32);
                        if (fq_ == 0) e0[((ai * 4 + m) * 2 + bj) * 16] = ss; }
            LDS_WAIT(); __builtin_amdgcn_s_barrier();
            const float* pq_ = daqn; const float* pk_ = dakn; const float* px_ = mxqn; asm volatile("" : "+s"(pq_), "+s"(pk_), "+s"(px_));
            const float* gp = (u.pn < 10 ? pq_ : u.pn < 12 ? pk_ : px_) + (mx ? wc * 32 : (wc & 1) * 32) + 8 * fq_;
            const f32x4 g0 = *(const f32x4*)gp, g1 = *(const f32x4*)(gp + 4);
            const float sc = u.pn < 10 ? 0.125f * LOG2E : u.pn < 12 ? 1.f : 0.08838834764831845f * LOG2E, idim = mx ? (1.f / 128.f) : (1.f / 64.f);
#pragma unroll
            for (int ai = 0; ai < 2; ++ai)
#pragma unroll
                for (int m = 0; m < 4; ++m) { bf16* rowp = O + (size_t)(u.pm * 256 + wr * 64 + fr_ + ai * 128 + m * 16) * PW + (u.pn * 256 + wc * 32 + 8 * fq_);
#pragma unroll
                    for (int bj = 0; bj < 2; ++bj) { const int f = (ai * 4 + m) * 2 + bj;
                        float t = e0[f * 16] + e1[f * 16];
                        if (mx) t += e2[f * 16] + e3[f * 16];
                        const float r = rsqrtf(t * idim + EPS) * sc;
                        const f32x4 v0 = acc[ai][bj][m][0] * r * g0, v1 = acc[ai][bj][m][1] * r * g1;
                        v4u w; w.x = pk2(v0.x, v0.y); w.y = pk2(v0.z, v0.w); w.z = pk2(v1.x, v1.y); w.w = pk2(v1.z, v1.w);
                        *(v4u*)(rowp + bj * 128) = w; } }
            return;
        }
#endif
#pragma unroll
        for (int ai = 0; ai < 2; ++ai)
#pragma unroll
            for (int m = 0; m < 4; ++m) { bf16* rowp = O + (size_t)(row0 + ai * 128 + m * 16) * PW + col0;
                v4u g8;
#pragma unroll
                for (int bj = 0; bj < 2; ++bj) {
                    f32x4 v0, v1;
                    if constexpr (F8) { v0 = acc[ai][bj][m][0] * ACC8_SCALE + bv[bj][0]; v1 = acc[ai][bj][m][1] * ACC8_SCALE + bv[bj][1]; }
                    else { v0 = acc[ai][bj][m][0] + bv[bj][0]; v1 = acc[ai][bj][m][1] + bv[bj][1]; }
                    if (isg) { v0.x = sigmoidf_(v0.x); v0.y = sigmoidf_(v0.y); v0.z = sigmoidf_(v0.z); v0.w = sigmoidf_(v0.w);
                               v1.x = sigmoidf_(v1.x); v1.y = sigmoidf_(v1.y); v1.z = sigmoidf_(v1.z); v1.w = sigmoidf_(v1.w); }
#if GATE_U8
                    if (isg) { const unsigned lo = pk4u8(v0.x, v0.y, v0.z, v0.w), hi = pk4u8(v1.x, v1.y, v1.z, v1.w); if (bj == 0) { g8.x = lo; g8.y = hi; } else { g8.z = lo; g8.w = hi; } }
                    else { v4u w; w.x = pk2(v0.x, v0.y); w.y = pk2(v0.z, v0.w); w.z = pk2(v1.x, v1.y); w.w = pk2(v1.z, v1.w); *(v4u*)(rowp + bj * 128) = w; }
#else
                    v4u w; w.x = pk2(v0.x, v0.y); w.y = pk2(v0.z, v0.w); w.z = pk2(v1.x, v1.y); w.w = pk2(v1.z, v1.w);
                    if (isg) *(v4u*)(GF + (((gtile * 16 + (ai * 4 + m) * 2 + bj) * 512) + wl) * 8) = w;
                    else *(v4u*)(rowp + bj * 128) = w;
#endif
                }
#if GATE_U8
                if (isg) __builtin_nontemporal_store(g8, (v4u*)((unsigned char*)GF + ((gtile * 8 + (ai * 4 + m)) * 512 + wl) * 16));
#endif
            }
    }
};
typedef EpiPT<false> EpiP;
struct OffOrder { pg8::StaticOrder S; int n0, a0, a1; int i0 = 0, ni = 1 << 30;
    DI bool next(int i, pg8::Unit& u) const { if (i >= ni) return false; const bool ok = S.next(i + i0, u); u.pn = u.pn < n0 ? a0 + u.pn : a1 + (u.pn - n0); return ok; } };
struct EpiPlain {
    static constexpr bool PERM = true; static constexpr bool CHAIN = false; static constexpr bool PREFETCH = false;
    bf16* O; int ldc;
    DI void operator()(const f32x4 (&acc)[2][2][4][2], const pg8::Unit& u, int wr, int wc, int fr, int fq) const {
        const int row0 = u.pm * 256 + wr * 64 + fr, col0 = u.pn * 256 + wc * 32 + 8 * fq;
#pragma unroll
        for (int ai = 0; ai < 2; ++ai)
#pragma unroll
            for (int m = 0; m < 4; ++m) { bf16* rowp = O + (size_t)(row0 + ai * 128 + m * 16) * ldc + col0;
#pragma unroll
                for (int bj = 0; bj < 2; ++bj) { const f32x4 v0 = acc[ai][bj][m][0], v1 = acc[ai][bj][m][1];
                    v4u w; w.x = pk2(v0.x, v0.y); w.y = pk2(v0.z, v0.w); w.z = pk2(v1.x, v1.y); w.w = pk2(v1.z, v1.w);
                    *(v4u*)(rowp + bj * 128) = w; } }
    }
};

DI void p2_norm_rows(const Args& a, int vcu, int G, int wave, int lane) {
    unsigned char* ws = a.ws; bf16* P = (bf16*)(ws + WS_P);
    const int gw = vcu * 8 + wave, NGW = G * 8;
    float gda[16], gmx[8], gmk[8];
    { const float* gsrc = (lane < 32 ? a.in[I_DAQN] : a.in[I_DAKN]) + 16 * (lane & 3);
#pragma unroll
      for (int i = 0; i < 16; ++i) gda[i] = gsrc[i];
#pragma unroll
      for (int i = 0; i < 8; ++i) { gmx[i] = a.in[I_MXQN][8 * (lane & 15) + i]; gmk[i] = a.in[I_MXKN][8 * (lane & 15) + i]; } }
    const float sc_da = lane < 32 ? 0.125f * LOG2E : 1.f;
    const float sc_mx = 0.08838834764831845f * LOG2E;
    for (int m = gw; m < T; m += NGW) {
        { v4u* p = (v4u*)(P + (size_t)m * PW + P_DAQ + 16 * lane); v4u w0 = p[0], w1 = p[1];
          float f[16]; f[0] = bflo(w0.x); f[1] = bfhi(w0.x); f[2] = bflo(w0.y); f[3] = bfhi(w0.y); f[4] = bflo(w0.z); f[5] = bfhi(w0.z); f[6] = bflo(w0.w); f[7] = bfhi(w0.w);
          f[8] = bflo(w1.x); f[9] = bfhi(w1.x); f[10] = bflo(w1.y); f[11] = bfhi(w1.y); f[12] = bflo(w1.z); f[13] = bfhi(w1.z); f[14] = bflo(w1.w); f[15] = bfhi(w1.w);
          float ss = 0.f;
#pragma unroll
          for (int i = 0; i < 16; ++i) ss += f[i] * f[i];
          ss += __shfl_xor(ss, 1); ss += __shfl_xor(ss, 2);
          const float r = rsqrtf(ss * (1.f / 64.f) + EPS) * sc_da;
#pragma unroll
          for (int i = 0; i < 16; ++i) f[i] = f[i] * r * gda[i];
          w0.x = pk2(f[0], f[1]); w0.y = pk2(f[2], f[3]); w0.z = pk2(f[4], f[5]); w0.w = pk2(f[6], f[7]);
          w1.x = pk2(f[8], f[9]); w1.y = pk2(f[10], f[11]); w1.z = pk2(f[12], f[13]); w1.w = pk2(f[14], f[15]);
          p[0] = w0; p[1] = w1; }
        { v4u* p = (v4u*)(P + (size_t)m * PW + P_MXQ + 8 * lane); v4u w0 = p[0];
          float f[8]; f[0] = bflo(w0.x); f[1] = bfhi(w0.x); f[2] = bflo(w0.y); f[3] = bfhi(w0.y); f[4] = bflo(w0.z); f[5] = bfhi(w0.z); f[6] = bflo(w0.w); f[7] = bfhi(w0.w);
          float ss = 0.f;
#pragma unroll
          for (int i = 0; i < 8; ++i) ss += f[i] * f[i];
          ss += __shfl_xor(ss, 1); ss += __shfl_xor(ss, 2); ss += __shfl_xor(ss, 4); ss += __shfl_xor(ss, 8);
          const float r = rsqrtf(ss * (1.f / 128.f) + EPS) * sc_mx;
#pragma unroll
          for (int i = 0; i < 8; ++i) f[i] = f[i] * r * gmx[i];
          w0.x = pk2(f[0], f[1]); w0.y = pk2(f[2], f[3]); w0.z = pk2(f[4], f[5]); w0.w = pk2(f[6], f[7]);
          p[0] = w0; }
    }
}

constexpr int LMS = 65;
constexpr int PREP_GC = 0, PREP_BETA = 256, PREP_QS = 1024, PREP_KS = PREP_QS + 64 * 272, PREP_LM = PREP_KS + 64 * 272, PREP_TM = PREP_LM + 64 * LMS * 4, PREP_RHS = PREP_TM + 4 * 16 * 17 * 4 + 64, PREP_END = PREP_RHS + 64 * 256 * 4;
static_assert(PREP_RHS % 16 == 0, "prep LDS alignment");
static_assert(PREP_END <= RING_BYTES, "prep LDS");
struct PrepPre { float g, be; v4u xin[11]; };
DI void prep_prefetch(const Args& a, int ck, int tid, int wave, PrepPre& pp) {
    unsigned char* ws = a.ws; const bf16* P = (const bf16*)(ws + WS_P);
    const int lane = tid & 63, n = ck & 127, h = (ck >> 7) & 3, b = ck >> 9;
    const size_t t0 = (size_t)b * SEQ + (size_t)n * 64;
    if (wave == 0) { pp.g = ((const float*)(ws + WS_G))[(t0 + lane) * 4 + h]; pp.be = ((const float*)(ws + WS_BETA))[(t0 + lane) * 4 + h]; }
    if (wave < 6) {
        const int part = wave >> 1, rg = (tid >> 4) & 7, cg = tid & 15, i0 = rg * 8;
        const int ch0 = part * 512 + h * 128 + cg * 8;
        const bf16* xp = P + ((long)b * SEQ + n * 64 + i0 - 3) * PW + ch0;
        asm volatile("" : "+v"(xp));
#pragma unroll
        for (int jj = 0; jj < 11; ++jj) { const int s = n * 64 + i0 - 3 + jj;
            pp.xin[jj] = (s >= 0) ? *(const GAS v4u*)(xp + (long)jj * PW) : (v4u){0u, 0u, 0u, 0u}; }
    }
}
template <int PROBE_SKIP = 0>
DI void dn_prep_unit(const Args& a, LAS unsigned char* lds, int ck, int ck_next, PrepPre& pp, int wave) {
    const int tid = fresh_tid(), lane = tid & 63;
    unsigned char* ws = a.ws; const bf16* P = (const bf16*)(ws + WS_P);
    const int n = ck & 127, h = (ck >> 7) & 3, b = ck >> 9;
    const size_t t0 = (size_t)b * SEQ + (size_t)n * 64;
    LAS float* gc = (LAS float*)(lds + PREP_GC); LAS float* bet = (LAS float*)(lds + PREP_BETA);
    LAS float* Lm = (LAS float*)(lds + PREP_LM); LAS float* RHS = (LAS float*)(lds + PREP_RHS);
    if (wave == 0) {
        float v = pp.g;
#pragma unroll
        for (int o = 1; o < 64; o <<= 1) { const float u = __shfl_up(v, o); if (lane >= o) v += u; }
        gc[lane] = v; bet[lane] = pp.be;
    }
    __syncthreads();
    if (wave < 6) {
        const int part = wave >> 1, rg = (tid >> 4) & 7, cg = tid & 15, i0 = rg * 8;
        const int ch0 = part * 512 + h * 128 + cg * 8;
        float w[4][8];
#pragma unroll
        for (int j = 0; j < 4; ++j) { const f32x4* p = (const f32x4*)(a.in[I_CONV] + j * 1536 + ch0); const f32x4 w0 = p[0], w1 = p[1];
            w[j][0] = w0.x; w[j][1] = w0.y; w[j][2] = w0.z; w[j][3] = w0.w; w[j][4] = w1.x; w[j][5] = w1.y; w[j][6] = w1.z; w[j][7] = w1.w; }
        v4u xin[11];
#pragma unroll
        for (int jj = 0; jj < 11; ++jj) xin[jj] = pp.xin[jj];
        float o[8][8];
#pragma unroll
        for (int ri = 0; ri < 8; ++ri) {
            float acc[8];
#pragma unroll
            for (int c = 0; c < 8; ++c) acc[c] = 0.f;
#pragma unroll
            for (int j = 0; j < 4; ++j) { const v4u x = xin[ri + j];
                acc[0] += w[j][0] * bflo(x.x); acc[1] += w[j][1] * bfhi(x.x); acc[2] += w[j][2] * bflo(x.y); acc[3] += w[j][3] * bfhi(x.y);
                acc[4] += w[j][4] * bflo(x.z); acc[5] += w[j][5] * bfhi(x.z); acc[6] += w[j][6] * bflo(x.w); acc[7] += w[j][7] * bfhi(x.w); }
            float ss = 0.f;
#pragma unroll
            for (int c = 0; c < 8; ++c) { const float s_ = acc[c] * sigmoidf_(acc[c]); o[ri][c] = s_; ss += s_ * s_; }
            ss += __shfl_xor(ss, 1); ss += __shfl_xor(ss, 2); ss += __shfl_xor(ss, 4); ss += __shfl_xor(ss, 8);
            const float nrm = part == 0 ? rsqrtf(ss + EPS) * 0.08838834764831845f : part == 1 ? rsqrtf(ss + EPS) : 1.f;
#pragma unroll
            for (int c = 0; c < 8; ++c) o[ri][c] *= nrm;
        }
        bf16* qdp = (bf16*)(ws + WS_QD) + (size_t)ck * 8192 + (size_t)(((i0 >> 5) * 8 + (cg >> 1)) * 64 + (i0 & 31) + 32 * (cg & 1)) * 8;
        asm volatile("" : "+v"(qdp));
#pragma unroll
        for (int ri = 0; ri < 8; ++ri) {
            const int row = i0 + ri; const float g_ = gc[row], be = bet[row];
            if (part == 0) {
                v4u wq; wq.x = pk2(o[ri][0], o[ri][1]); wq.y = pk2(o[ri][2], o[ri][3]); wq.z = pk2(o[ri][4], o[ri][5]); wq.w = pk2(o[ri][6], o[ri][7]);
                *(LAS v4u*)(lds + PREP_QS + row * 272 + cg * 16) = wq;
                const float eg = fast_exp(g_);
                v4u wd; wd.x = pk2(o[ri][0] * eg, o[ri][1] * eg); wd.y = pk2(o[ri][2] * eg, o[ri][3] * eg); wd.z = pk2(o[ri][4] * eg, o[ri][5] * eg); wd.w = pk2(o[ri][6] * eg, o[ri][7] * eg);
                *(GAS v4u*)(qdp + ri * 8) = wd;
            } else if (part == 1) {
                v4u wq; wq.x = pk2(o[ri][0], o[ri][1]); wq.y = pk2(o[ri][2], o[ri][3]); wq.z = pk2(o[ri][4], o[ri][5]); wq.w = pk2(o[ri][6], o[ri][7]);
                *(LAS v4u*)(lds + PREP_KS + row * 272 + cg * 16) = wq;
                const float f = be * fast_exp(g_);
                LAS f32x4* r4 = (LAS f32x4*)(RHS + row * 256 + 128 + cg * 8);
                r4[0] = (f32x4){o[ri][0] * f, o[ri][1] * f, o[ri][2] * f, o[ri][3] * f}; r4[1] = (f32x4){o[ri][4] * f, o[ri][5] * f, o[ri][6] * f, o[ri][7] * f};
            } else {
                LAS f32x4* r4 = (LAS f32x4*)(RHS + row * 256 + cg * 8);
                r4[0] = (f32x4){o[ri][0] * be, o[ri][1] * be, o[ri][2] * be, o[ri][3] * be}; r4[1] = (f32x4){o[ri][4] * be, o[ri][5] * be, o[ri][6] * be, o[ri][7] * be};
            }
        }
    }
    __syncthreads();
    if (ck_next < NCHUNK) prep_prefetch(a, ck_next, tid, wave, pp);
    {
        const int sel = wave >> 2, it = (wave >> 1) & 1, jt = wave & 1, r = lane & 31, hh = lane >> 5;
        const LAS unsigned char* Ab = lds + (sel ? PREP_QS : PREP_KS) + (32 * it + r) * 272 + hh * 16;
        const LAS unsigned char* Bb = lds + PREP_KS + (32 * jt + r) * 272 + hh * 16;
        f32x16 acc = {};
#pragma unroll
        for (int s = 0; s < 8; ++s) { const bf16x8 av = *(const LAS bf16x8*)(Ab + s * 32), bv = *(const LAS bf16x8*)(Bb + s * 32);
            acc = __builtin_amdgcn_mfma_f32_32x32x16_bf16(av, bv, acc, 0, 0, 0); }
        const int col = 32 * jt + r; const float gcol = gc[col];
        bf16* QKB = (bf16*)(ws + WS_QK) + (size_t)ck * 4096;
#pragma unroll
        for (int i = 0; i < 16; ++i) { const int row = 32 * it + crow(i, hh);
            const float dec = fast_exp(col <= row ? gc[row] - gcol : 0.f);
            if (sel == 0) Lm[row * LMS + col] = (col < row) ? acc[i] * dec * bet[row] : 0.f;
            else QKB[(((row >> 5) * 4 + (col >> 4)) * 64 + (row & 31) + 32 * ((col >> 3) & 1)) * 8 + (col & 7)] = (bf16)f2bf((col <= row) ? acc[i] * dec : 0.f); }
    }
    __syncthreads();
    LAS float* Tm = (LAS float*)(lds + PREP_TM);
    if (wave == 0) {
        const int blk = lane >> 4, c = lane & 15;
        const LAS float* Db = Lm + (16 * blk) * LMS + 16 * blk;
        float t[16];
#pragma unroll
        for (int r = 0; r < 16; ++r) { float acc = (r == c) ? 1.f : 0.f;
#pragma unroll
            for (int jj = 0; jj < r; ++jj) acc -= Db[r * LMS + jj] * t[jj];
            t[r] = acc; }
#pragma unroll
        for (int r = 0; r < 16; ++r) Tm[(blk * 16 + r) * 17 + c] = t[r];
    } else if (wave >= 4) {
        const int q = tid - 256, kd = q & 127, half = q >> 7;
        const float gl = gc[63];
        bf16* KDT = (bf16*)(ws + WS_KDT) + (size_t)ck * 8192;
#pragma unroll
        for (int c8 = 0; c8 < 4; ++c8) { float f[8];
#pragma unroll
            for (int jj = 0; jj < 8; ++jj) { const int c = 32 * half + 8 * c8 + jj; f[jj] = bf2f(*(const LAS bf16*)(lds + PREP_KS + c * 272 + kd * 2)) * fast_exp(gl - gc[c]); }
            v4u w; w.x = pk2(f[0], f[1]); w.y = pk2(f[2], f[3]); w.z = pk2(f[4], f[5]); w.w = pk2(f[6], f[7]);
            *(v4u*)(KDT + (size_t)((((kd >> 5) * 4 + 2 * half + (c8 >> 1)) * 64) + (kd & 31) + 32 * (c8 & 1)) * 8) = w; }
        if (q == 0) ((float*)(ws + WS_EGL))[ck] = fast_exp(gl);
    }
    __syncthreads();
    if (PROBE_SKIP != 1) {
        const int lr = lane & 15, lq = lane >> 4;
#pragma unroll
        for (int tt = 0; tt < 2; ++tt) {
            const int ct = wave * 2 + tt;
            f32x4 X[4];
#pragma unroll
            for (int b = 0; b < 4; ++b) {
                f32x4 acc;
#pragma unroll
                for (int rg = 0; rg < 4; ++rg) acc[rg] = RHS[(16 * b + 4 * lq + rg) * 256 + ct * 16 + lr];
#pragma unroll
                for (int jb = 0; jb < b; ++jb)
#pragma unroll
                    for (int rg = 0; rg < 4; ++rg) acc = __builtin_amdgcn_mfma_f32_16x16x4f32(-Lm[(16 * b + lr) * LMS + 16 * jb + 4 * lq + rg], X[jb][rg], acc, 0, 0, 0);
                f32x4 xb = {0.f, 0.f, 0.f, 0.f};
#pragma unroll
                for (int rg = 0; rg < 4; ++rg) xb = __builtin_amdgcn_mfma_f32_16x16x4f32(Tm[(b * 16 + lr) * 17 + 4 * lq + rg], acc[rg], xb, 0, 0, 0);
                X[b] = xb;
            }
#pragma unroll
            for (int b = 0; b < 4; ++b)
#pragma unroll
                for (int rg = 0; rg < 4; ++rg) RHS[(16 * b + 4 * lq + rg) * 256 + ct * 16 + lr] = X[b][rg];
        }
    }
    __syncthreads();
    {
        const int row = tid >> 3, seg = tid & 7;
        const LAS f32x4* s4 = (const LAS f32x4*)(RHS + row * 256 + seg * 32);
        const float sg = seg < 4 ? 1.f : -1.f;
        bf16* dst = (bf16*)(ws + (seg < 4 ? WS_U : WS_NW)) + (size_t)ck * 8192;
        const int ctr = row >> 5, rr = row & 31;
#pragma unroll
        for (int q = 0; q < 4; ++q) { const f32x4 x0 = s4[2 * q] * sg, x1 = s4[2 * q + 1] * sg;
            v4u w; w.x = pk2(x0.x, x0.y); w.y = pk2(x0.z, x0.w); w.z = pk2(x1.x, x1.y); w.w = pk2(x1.z, x1.w);
            const int fi = seg < 4 ? ((ctr * 4 + seg) * 2 + (q >> 1)) : (ctr * 8 + (seg - 4) * 2 + (q >> 1));
            *(v4u*)(dst + (size_t)(fi * 64 + rr + 32 * (q & 1)) * 8) = w; }
    }
    __syncthreads();
}

constexpr int SCAN_ST = 0, SCAN_VN = 2 * 32 * 272, SCAN_END = SCAN_VN + 2 * 32 * 144;
struct ScanFrag { bf16x8 a0[8]; bf16x8 a1[4]; bf16x8 a3[4]; float egl; };
DI void dn_scan(const Args& a, LAS unsigned char* lds, int j, int wave, int lane) {
    unsigned char* ws = a.ws;
    const int grp = wave >> 2, w4 = wave & 3, task = 2 * j + grp, bh = task >> 2, vs = task & 3, b = bh >> 2, h = bh & 3;
    const int r = lane & 31, hh = lane >> 5;
    LAS unsigned char* ST = lds + SCAN_ST + grp * (32 * 272); LAS unsigned char* VN = lds + SCAN_VN + grp * (32 * 144);
    const bf16* A0 = (const bf16*)(ws + (w4 < 2 ? WS_NW : WS_QD)); const bf16* U = (const bf16*)(ws + WS_U);
    const bf16* KDT = (const bf16*)(ws + WS_KDT); const bf16* QKB = (const bf16*)(ws + WS_QK); const float* EGL = (const float*)(ws + WS_EGL);
    bf16* ODN = (bf16*)(ws + WS_ODN);
    bf16x8 bI[2];
#pragma unroll
    for (int s = 0; s < 2; ++s)
#pragma unroll
        for (int jj = 0; jj < 8; ++jj) bI[s][jj] = (16 * s + 8 * hh + jj == r) ? (short)0x3F80 : (short)0;
    f32x16 sacc = {};
    const int ct = w4 & 1;
#define SCAN_LOAD(F, n_) do { const int n__ = (n_) < SEQ / 64 ? (n_) : SEQ / 64 - 1; const size_t ck_ = (size_t)(bh * 128 + n__); \
        _Pragma("unroll") for (int s = 0; s < 8; ++s) F.a0[s] = *(const bf16x8*)(A0 + ck_ * 8192 + (size_t)((ct * 8 + s) * 64 + lane) * 8); \
        if (w4 < 2) { _Pragma("unroll") for (int s = 0; s < 2; ++s) F.a1[s] = *(const bf16x8*)(U + ck_ * 8192 + (size_t)(((ct * 4 + vs) * 2 + s) * 64 + lane) * 8); } \
        else { _Pragma("unroll") for (int s = 0; s < 4; ++s) F.a1[s] = *(const bf16x8*)(QKB + ck_ * 4096 + (size_t)((ct * 4 + s) * 64 + lane) * 8); } \
        _Pragma("unroll") for (int s = 0; s < 4; ++s) F.a3[s] = *(const bf16x8*)(KDT + ck_ * 8192 + (size_t)((w4 * 4 + s) * 64 + lane) * 8); \
        F.egl = EGL[ck_]; } while (0)
#define SCAN_STEP(F, n_) do { const size_t t0_ = (size_t)b * SEQ + (size_t)(n_) * 64; \
        _Pragma("unroll") for (int g = 0; g < 4; ++g) { v2u w; w.x = pk2(sacc[4 * g], sacc[4 * g + 1]); w.y = pk2(sacc[4 * g + 2], sacc[4 * g + 3]); \
            *(LAS v2u*)(ST + r * 272 + (32 * w4 + 8 * g + 4 * hh) * 2) = w; } \
        LDS_WAIT(); __builtin_amdgcn_s_barrier(); \
        f32x16 acc = {}, acc2 = {}; \
        if (w4 < 2) { acc = __builtin_amdgcn_mfma_f32_32x32x16_bf16(F.a1[0], bI[0], acc, 0, 0, 0); acc2 = __builtin_amdgcn_mfma_f32_32x32x16_bf16(F.a1[1], bI[1], acc2, 0, 0, 0); } \
        _Pragma("unroll") for (int s = 0; s < 8; s += 2) { const bf16x8 b0 = *(const LAS bf16x8*)(ST + r * 272 + (16 * s + 8 * hh) * 2), b1 = *(const LAS bf16x8*)(ST + r * 272 + (16 * s + 16 + 8 * hh) * 2); \
            acc = __builtin_amdgcn_mfma_f32_32x32x16_bf16(F.a0[s], b0, acc, 0, 0, 0); acc2 = __builtin_amdgcn_mfma_f32_32x32x16_bf16(F.a0[s + 1], b1, acc2, 0, 0, 0); } \
        acc += acc2; \
        if (w4 < 2) { _Pragma("unroll") for (int g = 0; g < 4; ++g) { v2u w; w.x = pk2(acc[4 * g], acc[4 * g + 1]); w.y = pk2(acc[4 * g + 2], acc[4 * g + 3]); \
            *(LAS v2u*)(VN + r * 144 + (32 * ct + 8 * g + 4 * hh) * 2) = w; } } \
        LDS_WAIT(); __builtin_amdgcn_s_barrier(); \
        bf16x8 bv[4]; _Pragma("unroll") for (int s = 0; s < 4; ++s) bv[s] = *(const LAS bf16x8*)(VN + r * 144 + (16 * s + 8 * hh) * 2); \
        _Pragma("unroll") for (int i = 0; i < 16; ++i) sacc[i] *= F.egl; \
        _Pragma("unroll") for (int s = 0; s < 4; ++s) sacc = __builtin_amdgcn_mfma_f32_32x32x16_bf16(F.a3[s], bv[s], sacc, 0, 0, 0); \
        if (w4 >= 2) { _Pragma("unroll") for (int s = 0; s < 4; ++s) acc = __builtin_amdgcn_mfma_f32_32x32x16_bf16(F.a1[s], bv[s], acc, 0, 0, 0); \
            _Pragma("unroll") for (int i = 0; i < 16; ++i) ODN[(t0_ + 32 * ct + crow(i, hh)) * 512 + h * 128 + vs * 32 + r] = (bf16)f2bf(acc[i]); } \
    } while (0)
    ScanFrag FA, FB;
    SCAN_LOAD(FA, 0);
    for (int n = 0; n < SEQ / 64; n += 2) {
        SCAN_LOAD(FB, n + 1);
        SCAN_STEP(FA, n);
        SCAN_LOAD(FA, n + 2);
        SCAN_STEP(FB, n + 1);
    }
#undef SCAN_LOAD
#undef SCAN_STEP
    __syncthreads();
}
constexpr int MX_K = 0, MX_V = 65536;
DI void mx_unit(const Args& a, LAS unsigned char* lds, int bh, int qb, int tid, int wave, int lane) {
    unsigned char* ws = a.ws; const int b = bh >> 2, h = bh & 3;
    const bf16* MKV = (const bf16*)(ws + WS_MKV) + (size_t)b * NMEM * 1024 + h * 128;
    float gk[8];
#pragma unroll
    for (int i = 0; i < 8; ++i) gk[i] = a.in[I_MXKN][8 * (tid & 15) + i];
#pragma unroll
    for (int i = 0; i < 8; ++i) { const int q = tid + 512 * i, row = q >> 4, ch = q & 15;
        v4u kv = *(const v4u*)(MKV + (size_t)row * 1024 + ch * 8); const v4u vv = *(const v4u*)(MKV + (size_t)row * 1024 + 512 + ch * 8);
        float f[8]; f[0] = bflo(kv.x); f[1] = bfhi(kv.x); f[2] = bflo(kv.y); f[3] = bfhi(kv.y); f[4] = bflo(kv.z); f[5] = bfhi(kv.z); f[6] = bflo(kv.w); f[7] = bfhi(kv.w);
        float ss = 0.f;
#pragma unroll
        for (int jx = 0; jx < 8; ++jx) ss += f[jx] * f[jx];
        ss += __shfl_xor(ss, 1); ss += __shfl_xor(ss, 2); ss += __shfl_xor(ss, 4); ss += __shfl_xor(ss, 8);
        const float rn = rsqrtf(ss * (1.f / 128.f) + EPS);
        kv.x = pk2(f[0] * rn * gk[0], f[1] * rn * gk[1]); kv.y = pk2(f[2] * rn * gk[2], f[3] * rn * gk[3]); kv.z = pk2(f[4] * rn * gk[4], f[5] * rn * gk[5]); kv.w = pk2(f[6] * rn * gk[6], f[7] * rn * gk[7]);
        *(LAS v4u*)(lds + MX_K + row * 256 + ((ch ^ (row & 7)) * 16)) = kv; *(LAS v4u*)(lds + MX_V + row * 256 + ch * 16) = vv; }
    const int r = lane & 31, hh = lane >> 5;
    const size_t qrow = (size_t)b * SEQ + (size_t)qb * 256 + wave * 32;
    const bf16* Q = (const bf16*)(ws + WS_P) + (qrow + r) * PW + P_MXQ + h * 128;
    bf16x8 qf[8];
#pragma unroll
    for (int s = 0; s < 8; ++s) qf[s] = *(const bf16x8*)(Q + 16 * s + 8 * hh);
    __syncthreads();
    float mx = -INFINITY;
#pragma unroll 1
    for (int kt = 0; kt < 8; ++kt) { f32x16 acc = {}; const int row = 32 * kt + r;
#pragma unroll
        for (int s = 0; s < 8; ++s) { const bf16x8 kf = *(const LAS bf16x8*)(lds + MX_K + row * 256 + (((2 * s + hh) ^ (row & 7)) * 16));
            acc = __builtin_amdgcn_mfma_f32_32x32x16_bf16(kf, qf[s], acc, 0, 0, 0); }
#pragma unroll
        for (int i = 0; i < 16; ++i) mx = fmaxf(mx, acc[i]); }
    mx = fmaxf(mx, __shfl_xor(mx, 32));
    float sum = 0.f;
    f32x16 o[4] = {};
    const int g16 = lane >> 4, i16 = lane & 15, qq = i16 >> 2, pp = i16 & 3;
    const LAS unsigned char* vb = lds + MX_V + (4 * hh + qq) * 256 + (16 * (g16 & 1) + 4 * pp) * 2;
#pragma unroll 1
    for (int kt = 0; kt < 8; ++kt) { f32x16 st = {}; const int row = 32 * kt + r;
#pragma unroll
        for (int s = 0; s < 8; ++s) { const bf16x8 kf = *(const LAS bf16x8*)(lds + MX_K + row * 256 + (((2 * s + hh) ^ (row & 7)) * 16));
            st = __builtin_amdgcn_mfma_f32_32x32x16_bf16(kf, qf[s], st, 0, 0, 0); }
#pragma unroll
        for (int i = 0; i < 16; ++i) { const float p = __builtin_amdgcn_exp2f(st[i] - mx); st[i] = p; sum += p; }
#pragma unroll
        for (int s2 = 0; s2 < 2; ++s2) {
            v4u pw; pw.x = pk2(st[8 * s2 + 0], st[8 * s2 + 1]); pw.y = pk2(st[8 * s2 + 2], st[8 * s2 + 3]); pw.z = pk2(st[8 * s2 + 4], st[8 * s2 + 5]); pw.w = pk2(st[8 * s2 + 6], st[8 * s2 + 7]);
            const bf16x8 pa = __builtin_bit_cast(bf16x8, pw);
#pragma unroll
            for (int dt = 0; dt < 4; ++dt) {
                const LAS unsigned char* vp = vb + (32 * kt + 16 * s2) * 256 + dt * 64;
                const s16x4 lo = __builtin_bit_cast(s16x4, __builtin_amdgcn_ds_read_tr16_b64_v4i16((LAS s16x4*)vp));
                const s16x4 hi = __builtin_bit_cast(s16x4, __builtin_amdgcn_ds_read_tr16_b64_v4i16((LAS s16x4*)(vp + 8 * 256)));
                const bf16x8 vf = {lo[0], lo[1], lo[2], lo[3], hi[0], hi[1], hi[2], hi[3]};
                o[dt] = __builtin_amdgcn_mfma_f32_32x32x16_bf16(pa, vf, o[dt], 0, 0, 0);
            }
        }
    }
    sum += __shfl_xor(sum, 32);
    LAS float* wsc = (LAS float*)(lds + LWSC_OFF + wave * 256);
    if (hh == 0) wsc[r] = __builtin_amdgcn_rcpf(sum);
    LDS_WAIT();
    bf16* O = (bf16*)(ws + WS_OMX) + qrow * 512 + h * 128;
#pragma unroll
    for (int i = 0; i < 16; ++i) { const int qr_ = crow(i, hh); const float rl = wsc[qr_];
#pragma unroll
        for (int dt = 0; dt < 4; ++dt) O[(size_t)qr_ * 512 + dt * 32 + r] = (bf16)f2bf(o[dt][i] * rl); }
    __syncthreads();
}

DI void p4_norm_rows(const Args& a, int vcu, int G, int wave, int lane) {
    unsigned char* ws = a.ws; const int gw = vcu * 8 + wave, NGW = G * 8;
    const float* lp = a.in[I_LAM];
    const float l1 = wave_sum(lp[lane] * lp[64 + lane]), l2 = wave_sum(lp[128 + lane] * lp[192 + lane]);
    const float lam_init = 0.2f, lam = expf(l1) - expf(l2) + lam_init;
    float gdn[8], gda[8];
#pragma unroll
    for (int i = 0; i < 8; ++i) { gdn[i] = a.in[I_DNON][8 * (lane & 15) + i]; gda[i] = a.in[I_SUBLN][8 * (lane & 15) + i] * (1.f - lam_init); }
    const bf16* P = (const bf16*)(ws + WS_P);
    for (int m0 = gw; m0 < T; m0 += 4 * NGW) {
        v4u lw0[4], lz0[4], lw1[4], lw2[4];
#pragma unroll
        for (int q = 0; q < 4; ++q) { const size_t m = (size_t)(m0 + q * NGW);
            lw0[q] = *(const v4u*)((const bf16*)(ws + WS_ODN) + m * 512 + 8 * lane); lz0[q] = *(const v4u*)(P + m * PW + P_DNZ + 8 * lane);
            lw1[q] = *(const v4u*)((const bf16*)(ws + WS_O1) + m * 512 + 8 * lane); lw2[q] = *(const v4u*)((const bf16*)(ws + WS_O2) + m * 512 + 8 * lane); }
#pragma unroll
        for (int q = 0; q < 4; ++q) { const size_t m = (size_t)(m0 + q * NGW);
        { const v4u w0 = lw0[q], z0 = lz0[q];
          float f[8], z[8]; f[0] = bflo(w0.x); f[1] = bfhi(w0.x); f[2] = bflo(w0.y); f[3] = bfhi(w0.y); f[4] = bflo(w0.z); f[5] = bfhi(w0.z); f[6] = bflo(w0.w); f[7] = bfhi(w0.w);
          z[0] = bflo(z0.x); z[1] = bfhi(z0.x); z[2] = bflo(z0.y); z[3] = bfhi(z0.y); z[4] = bflo(z0.z); z[5] = bfhi(z0.z); z[6] = bflo(z0.w); z[7] = bfhi(z0.w);
          float ss = 0.f;
#pragma unroll
          for (int i = 0; i < 8; ++i) ss += f[i] * f[i];
          ss += __shfl_xor(ss, 1); ss += __shfl_xor(ss, 2); ss += __shfl_xor(ss, 4); ss += __shfl_xor(ss, 8);
          const float r = rsqrtf(ss * (1.f / 128.f) + EPS);
#pragma unroll
          for (int i = 0; i < 8; ++i) f[i] = f[i] * r * gdn[i] * (z[i] * sigmoidf_(z[i]));
          v4u o; o.x = pk2(f[0], f[1]); o.y = pk2(f[2], f[3]); o.z = pk2(f[4], f[5]); o.w = pk2(f[6], f[7]);
          *(v4u*)((bf16*)(ws + WS_ODNF) + m * 512 + 8 * lane) = o; }
        { const v4u w1 = lw1[q], w2 = lw2[q];
          float f[8]; f[0] = bflo(w1.x) - lam * bflo(w2.x); f[1] = bfhi(w1.x) - lam * bfhi(w2.x); f[2] = bflo(w1.y) - lam * bflo(w2.y); f[3] = bfhi(w1.y) - lam * bfhi(w2.y);
          f[4] = bflo(w1.z) - lam * bflo(w2.z); f[5] = bfhi(w1.z) - lam * bfhi(w2.z); f[6] = bflo(w1.w) - lam * bflo(w2.w); f[7] = bfhi(w1.w) - lam * bfhi(w2.w);
          float ss = 0.f;
#pragma unroll
          for (int i = 0; i < 8; ++i) ss += f[i] * f[i];
          ss += __shfl_xor(ss, 1); ss += __shfl_xor(ss, 2); ss += __shfl_xor(ss, 4); ss += __shfl_xor(ss, 8);
          const float r = rsqrtf(ss * (1.f / 128.f) + EPS);
#pragma unroll
          for (int i = 0; i < 8; ++i) f[i] = f[i] * r * gda[i];
          v4u o; o.x = pk2(f[0], f[1]); o.y = pk2(f[2], f[3]); o.z = pk2(f[4], f[5]); o.w = pk2(f[6], f[7]);
          *(v4u*)((bf16*)(ws + WS_ODAF) + m * 512 + 8 * lane) = o; }
        }
    }
}

struct BranchOrder {
    pg8::StaticOrder so; long a1, a2;
    DI bool next(int i, pg8::Unit& u) const {
        const int tl = i / 3, r = i - 3 * tl;
        if (!so.tile((long)tl * so.G + so.c, u.pm, u.pn)) return false;
        u.aoff = r == 0 ? 0 : (r == 1 ? a1 : a2); u.boff = (long)r * 1024 * 512 * 2; u.tag = r; return true;
    }
};
#ifndef MERGE_CHAIN
#define MERGE_CHAIN 1
#endif
#if MERGE_CHAIN && GATE_U8
struct EpiMerge {
    static constexpr bool PERM = true; static constexpr bool CHAIN = true; static constexpr bool PREFETCH = false;
    bf16* MRG; const bf16* GF; bf16* MF;
    DI static float gc(unsigned w, int b) { return fmaxf((float)((w >> (8 * b)) & 0xffu), 0.5f); }
    DI bool chain(f32x4 (&acc)[2][2][4][2], const pg8::Unit& u, int wr, int wc, int fr, int fq) const {
        int fr_ = fr, fq_ = fq; asm volatile("" : "+v"(fr_), "+v"(fq_));
        const int r = u.tag;
        const int wl = (wr * 4 + wc) * 64 + fq_ * 16 + fr_;
        const unsigned char* gfp = (const unsigned char*)GF + (((size_t)(r * 128 + u.pm) * 4 + u.pn) * 8 * 512 + wl) * 16;
        if (r < 2) {
#pragma unroll
            for (int ai = 0; ai < 2; ++ai) {
                v4u qa[4], qb[4];
#pragma unroll
                for (int m = 0; m < 4; ++m) { qa[m] = __builtin_nontemporal_load((const v4u*)(gfp + (size_t)(ai * 4 + m) * 8192)); qb[m] = __builtin_nontemporal_load((const v4u*)(gfp + (size_t)(ai * 4 + m) * 8192 + (size_t)128 * 4 * 65536)); }
#pragma unroll
                for (int m = 0; m < 4; ++m)
#pragma unroll
                    for (int bj = 0; bj < 2; ++bj) { const unsigned a0 = bj == 0 ? qa[m].x : qa[m].z, a1 = bj == 0 ? qa[m].y : qa[m].w, b0 = bj == 0 ? qb[m].x : qb[m].z, b1 = bj == 0 ? qb[m].y : qb[m].w;
                        f32x4 s0, s1;
                        s0.x = gc(a0, 0) * __builtin_amdgcn_rcpf(gc(b0, 0)); s0.y = gc(a0, 1) * __builtin_amdgcn_rcpf(gc(b0, 1)); s0.z = gc(a0, 2) * __builtin_amdgcn_rcpf(gc(b0, 2)); s0.w = gc(a0, 3) * __builtin_amdgcn_rcpf(gc(b0, 3));
                        s1.x = gc(a1, 0) * __builtin_amdgcn_rcpf(gc(b1, 0)); s1.y = gc(a1, 1) * __builtin_amdgcn_rcpf(gc(b1, 1)); s1.z = gc(a1, 2) * __builtin_amdgcn_rcpf(gc(b1, 2)); s1.w = gc(a1, 3) * __builtin_amdgcn_rcpf(gc(b1, 3));
                        acc[ai][bj][m][0] *= s0; acc[ai][bj][m][1] *= s1; }
            }
            return true;
        }
        const int row0 = u.pm * 256 + wr * 64 + fr_, col0 = u.pn * 256 + wc * 32 + 8 * fq_;
#pragma unroll
        for (int ai = 0; ai < 2; ++ai) {
            v4u qa[4];
#pragma unroll
            for (int m = 0; m < 4; ++m) qa[m] = __builtin_nontemporal_load((const v4u*)(gfp + (size_t)(ai * 4 + m) * 8192));
#pragma unroll
            for (int m = 0; m < 4; ++m)
#pragma unroll
                for (int bj = 0; bj < 2; ++bj) { const unsigned a0 = bj == 0 ? qa[m].x : qa[m].z, a1 = bj == 0 ? qa[m].y : qa[m].w;
                    const f32x4 v0 = acc[ai][bj][m][0], v1 = acc[ai][bj][m][1];
                    v4u w; w.x = pk2(v0.x * gc(a0, 0), v0.y * gc(a0, 1)); w.y = pk2(v0.z * gc(a0, 2), v0.w * gc(a0, 3)); w.z = pk2(v1.x * gc(a1, 0), v1.y * gc(a1, 1)); w.w = pk2(v1.z * gc(a1, 2), v1.w * gc(a1, 3));
                    *(v4u*)(MRG + (size_t)(row0 + ai * 128 + m * 16) * 1024 + col0 + bj * 128) = w; }
        }
        return false;
    }
};
#else
struct EpiMerge {
    static constexpr bool PERM = true; static constexpr bool CHAIN = false; static constexpr bool PREFETCH = false;
    bf16* MRG; const bf16* GF; bf16* MF;
    DI void operator()(const f32x4 (&acc)[2][2][4][2], const pg8::Unit& u, int wr, int wc, int fr, int fq) const {
        const int row0 = u.pm * 256 + wr * 64 + fr, col0 = u.pn * 256 + wc * 32 + 8 * fq; const int r = u.tag;
        const int wl = (wr * 4 + wc) * 64 + fq * 16 + fr;
#if GATE_U8
        const unsigned char* gfp = (const unsigned char*)GF + (((size_t)(r * 128 + u.pm) * 4 + u.pn) * 8 * 512 + wl) * 16;
#else
        const bf16* gfp = GF + (((size_t)(r * 128 + u.pm) * 4 + u.pn) * 16 * 512 + wl) * 8;
#endif
        bf16* mfp = MF + (((size_t)u.pm * 4 + u.pn) * 16 * 512 + wl) * 8;
#pragma unroll
        for (int ai = 0; ai < 2; ++ai) {
#if GATE_U8
            v4u gq[4], ow[4][2];
#pragma unroll
            for (int m = 0; m < 4; ++m) { gq[m] = *(const v4u*)(gfp + (size_t)(ai * 4 + m) * 8192);
#pragma unroll
                for (int bj = 0; bj < 2; ++bj) { const int f = (ai * 4 + m) * 2 + bj; ow[m][bj] = (r > 0) ? *(const v4u*)(mfp + (size_t)f * 4096) : (v4u){0u, 0u, 0u, 0u}; } }
#else
            v4u gw[4][2], ow[4][2];
#pragma unroll
            for (int m = 0; m < 4; ++m)
#pragma unroll
                for (int bj = 0; bj < 2; ++bj) { const int f = (ai * 4 + m) * 2 + bj;
                    gw[m][bj] = *(const v4u*)(gfp + (size_t)f * 4096);
                    ow[m][bj] = (r > 0) ? *(const v4u*)(mfp + (size_t)f * 4096) : (v4u){0u, 0u, 0u, 0u}; }
#endif
#pragma unroll
            for (int m = 0; m < 4; ++m)
#pragma unroll
                for (int bj = 0; bj < 2; ++bj) { const size_t row = (size_t)(row0 + ai * 128 + m * 16); const int col = col0 + bj * 128; const int f = (ai * 4 + m) * 2 + bj;
                    const v4u o = ow[m][bj];
                    f32x4 v0 = acc[ai][bj][m][0], v1 = acc[ai][bj][m][1];
#if GATE_U8
                    const unsigned ga = bj == 0 ? gq[m].x : gq[m].z, gb = bj == 0 ? gq[m].y : gq[m].w;
                    v0.x = v0.x * (float)(ga & 0xffu) + bflo(o.x); v0.y = v0.y * (float)((ga >> 8) & 0xffu) + bfhi(o.x); v0.z = v0.z * (float)((ga >> 16) & 0xffu) + bflo(o.y); v0.w = v0.w * (float)(ga >> 24) + bfhi(o.y);
                    v1.x = v1.x * (float)(gb & 0xffu) + bflo(o.z); v1.y = v1.y * (float)((gb >> 8) & 0xffu) + bfhi(o.z); v1.z = v1.z * (float)((gb >> 16) & 0xffu) + bflo(o.w); v1.w = v1.w * (float)(gb >> 24) + bfhi(o.w);
#else
                    const v4u g = gw[m][bj];
                    v0.x = v0.x * bflo(g.x) + bflo(o.x); v0.y = v0.y * bfhi(g.x) + bfhi(o.x); v0.z = v0.z * bflo(g.y) + bflo(o.y); v0.w = v0.w * bfhi(g.y) + bfhi(o.y);
                    v1.x = v1.x * bflo(g.z) + bflo(o.z); v1.y = v1.y * bfhi(g.z) + bfhi(o.z); v1.z = v1.z * bflo(g.w) + bflo(o.w); v1.w = v1.w * bfhi(g.w) + bfhi(o.w);
#endif
                    v4u w; w.x = pk2(v0.x, v0.y); w.y = pk2(v0.z, v0.w); w.z = pk2(v1.x, v1.y); w.w = pk2(v1.z, v1.w);
                    if (r < 2) *(v4u*)(mfp + (size_t)f * 4096) = w;
                    else *(v4u*)(MRG + row * 1024 + col) = w; }
        }
    }
};
#endif
#ifndef ROUTER_FUSED
#define ROUTER_FUSED 0
#endif
struct EpiResF32 {
    static constexpr bool PERM = false; static constexpr bool CHAIN = false; static constexpr bool PREFETCH = false;
    float* C; const float* X; unsigned char* H2; const float* fn;
    DI void operator()(const f32x4 (&acc)[2][2][4][2], const pg8::Unit& u, int wr, int wc, int fr, int fq) const {
        const int row0 = u.pm * 256 + wr * 64 + fr, col0 = u.pn * 256 + wc * 32 + 4 * fq;
#pragma unroll
        for (int ai = 0; ai < 2; ++ai) {
            f32x4 xv[4][2][2];
#pragma unroll
            for (int m = 0; m < 4; ++m) { const size_t ro = (size_t)(row0 + ai * 128 + m * 16) * 1024 + col0;
#pragma unroll
                for (int bj = 0; bj < 2; ++bj)
#pragma unroll
                    for (int n = 0; n < 2; ++n) xv[m][bj][n] = *(const f32x4*)(X + ro + bj * 128 + n * 16); }
#pragma unroll
            for (int m = 0; m < 4; ++m) { const size_t ro = (size_t)(row0 + ai * 128 + m * 16) * 1024 + col0;
#pragma unroll
                for (int bj = 0; bj < 2; ++bj)
#pragma unroll
                    for (int n = 0; n < 2; ++n) { const f32x4 v = acc[ai][bj][m][n] + xv[m][bj][n]; *(f32x4*)(C + ro + bj * 128 + n * 16) = v;
#if ROUTER_FUSED
                        const f32x4 g = *(const f32x4*)(fn + col0 + bj * 128 + n * 16) * A8_SCALE;
                        *(unsigned*)(H2 + ro + bj * 128 + n * 16) = pk4f8(v.x * g.x, v.y * g.y, v.z * g.z, v.w * g.w);
#endif
                    } }
        }
    }
};

#ifndef X1_BF16
#define X1_BF16 1
#endif
struct EpiResB {
    static constexpr bool PERM = true; static constexpr bool CHAIN = false; static constexpr bool PREFETCH = false;
    bf16* C; const float* X;
    DI void prefetch(const pg8::Unit& u, int wr, int wc, int fr, int fq, unsigned& d0, unsigned& d1, unsigned& d2, unsigned& d3) const {
        const float* p = X + (size_t)(u.pm * 256 + wr * 64 + fr + fq * 16) * 1024 + u.pn * 256 + wc * 32;
        asm volatile("global_load_dword %0, %1, off" : "=v"(d0) : "v"(p) : "memory");
        asm volatile("global_load_dword %0, %1, off" : "=v"(d1) : "v"(p + 128) : "memory");
        asm volatile("global_load_dword %0, %1, off" : "=v"(d2) : "v"(p + 128 * 1024) : "memory");
        asm volatile("global_load_dword %0, %1, off" : "=v"(d3) : "v"(p + 128 * 1024 + 128) : "memory");
    }
    DI void operator()(const f32x4 (&acc)[2][2][4][2], const pg8::Unit& u, int wr, int wc, int fr, int fq) const {
        int fr_ = fr, fq_ = fq; asm volatile("" : "+v"(fr_), "+v"(fq_));
        const int row0 = u.pm * 256 + wr * 64 + fr_, col0 = u.pn * 256 + wc * 32 + 8 * fq_;
#pragma unroll
        for (int ai = 0; ai < 2; ++ai) {
            f32x4 xv[4][2][2];
#pragma unroll
            for (int m = 0; m < 4; ++m) { const float* xp = X + (size_t)(row0 + ai * 128 + m * 16) * 1024 + col0;
#pragma unroll
                for (int bj = 0; bj < 2; ++bj) { xv[m][bj][0] = __builtin_nontemporal_load((const f32x4*)(xp + bj * 128)); xv[m][bj][1] = __builtin_nontemporal_load((const f32x4*)(xp + bj * 128 + 4)); } }
#pragma unroll
            for (int m = 0; m < 4; ++m) { bf16* cp = C + (size_t)(row0 + ai * 128 + m * 16) * 1024 + col0;
#pragma unroll
                for (int bj = 0; bj < 2; ++bj) { const f32x4 v0 = acc[ai][bj][m][0] + xv[m][bj][0], v1 = acc[ai][bj][m][1] + xv[m][bj][1];
                    v4u w; w.x = pk2(v0.x, v0.y); w.y = pk2(v0.z, v0.w); w.z = pk2(v1.x, v1.y); w.w = pk2(v1.z, v1.w);
                    *(v4u*)(cp + bj * 128) = w; } }
        }
    }
};
DI void bf8_to_f(const v4u w, float (&f)[8]) { f[0] = bflo(w.x); f[1] = bfhi(w.x); f[2] = bflo(w.y); f[3] = bfhi(w.y); f[4] = bflo(w.z); f[5] = bfhi(w.z); f[6] = bflo(w.w); f[7] = bfhi(w.w); }

constexpr int RT_W = 0, RT_LG = 65536;
#if X1_BF16
DI void p5_rows(const Args& a, int vcu, int G, int wave, int lane) {
    unsigned char* ws = a.ws; const int gw = vcu * 8 + wave, NGW = G * 8;
    const bf16* X1B = (const bf16*)(ws + WS_X1B);
    {
        float gv[16];
#pragma unroll
        for (int j = 0; j < 4; ++j) { const f32x4 g = ((const f32x4*)(a.in[I_FNORM] + 16 * lane))[j]; gv[4 * j] = g.x; gv[4 * j + 1] = g.y; gv[4 * j + 2] = g.z; gv[4 * j + 3] = g.w; }
        unsigned char* H2 = ws + WS_H;
        for (int m0 = gw; m0 < T; m0 += 4 * NGW) {
            v4u xw[4][2];
#pragma unroll
            for (int q = 0; q < 4; ++q) { const v4u* xr = (const v4u*)(X1B + (size_t)(m0 + q * NGW) * D + 16 * lane); xw[q][0] = xr[0]; xw[q][1] = xr[1]; }
#pragma unroll
            for (int q = 0; q < 4; ++q) {
                float f[16]; { float t[8]; bf8_to_f(xw[q][0], t); _Pragma("unroll") for (int i = 0; i < 8; ++i) f[i] = t[i]; bf8_to_f(xw[q][1], t); _Pragma("unroll") for (int i = 0; i < 8; ++i) f[8 + i] = t[i]; }
                float ss = 0.f;
#pragma unroll
                for (int i = 0; i < 16; ++i) ss += f[i] * f[i];
                const float rstd = rsqrtf(wave_sum(ss) * (1.f / D) + EPS) * A8_SCALE;
#pragma unroll
                for (int i = 0; i < 16; ++i) f[i] = f[i] * rstd * gv[i];
                v4u o; o.x = pk4f8(f[0], f[1], f[2], f[3]); o.y = pk4f8(f[4], f[5], f[6], f[7]); o.z = pk4f8(f[8], f[9], f[10], f[11]); o.w = pk4f8(f[12], f[13], f[14], f[15]);
                *(v4u*)(H2 + (size_t)(m0 + q * NGW) * D + 16 * lane) = o; }
        }
    }
}
#endif
DI void p5_router(const Args& a, LAS unsigned char* lds, int vcu, int G, int tid, int wave, int lane, int cw_cnt) {
    unsigned char* ws = a.ws; const int gw = vcu * 8 + wave, NGW = G * 8;
    const float* X1 = a.out;
#if X1_BF16
    const bf16* X1B = (const bf16*)(ws + WS_X1B);
    const bool rows_first = (__builtin_amdgcn_readfirstlane((int)blockIdx.x) & 1) == 0;
    if (rows_first) p5_rows(a, vcu, G, wave, lane);
#elif !ROUTER_FUSED
    {
        f32x4 gv[4];
#pragma unroll
        for (int j = 0; j < 4; ++j) gv[j] = ((const f32x4*)a.in[I_FNORM])[lane + 64 * j];
#if MOE_FP8
        unsigned char* H2 = ws + WS_H;
        for (int m = gw; m < T; m += NGW) {
            const f32x4* xr = (const f32x4*)(X1 + (size_t)m * D) + lane;
            f32x4 v[4]; float ss = 0.f;
#pragma unroll
            for (int j = 0; j < 4; ++j) { v[j] = xr[64 * j]; ss += (v[j].x * v[j].x + v[j].y * v[j].y) + (v[j].z * v[j].z + v[j].w * v[j].w); }
            const float rstd = rsqrtf(wave_sum(ss) * (1.f / D) + EPS) * A8_SCALE;
            unsigned* o4 = (unsigned*)(H2 + (size_t)m * D) + lane;
#pragma unroll
            for (int j = 0; j < 4; ++j) { v[j] = v[j] * rstd * gv[j]; o4[64 * j] = pk4f8(v[j].x, v[j].y, v[j].z, v[j].w); }
        }
#else
        bf16* H2 = (bf16*)(ws + WS_H);
        for (int m = gw; m < T; m += NGW) {
            const f32x4* xr = (const f32x4*)(X1 + (size_t)m * D) + lane;
            f32x4 v[4]; float ss = 0.f;
#pragma unroll
            for (int j = 0; j < 4; ++j) { v[j] = xr[64 * j]; ss += (v[j].x * v[j].x + v[j].y * v[j].y) + (v[j].z * v[j].z + v[j].w * v[j].w); }
            const float rstd = rsqrtf(wave_sum(ss) * (1.f / D) + EPS);
            unsigned long long* o8 = (unsigned long long*)(H2 + (size_t)m * D) + lane;
#pragma unroll
            for (int j = 0; j < 4; ++j) { v[j] = v[j] * rstd * gv[j]; o8[64 * j] = (unsigned long long)pk2(v[j].x, v[j].y) | ((unsigned long long)pk2(v[j].z, v[j].w) << 32); }
        }
#endif
    }
#endif
    LAS int* hist = (LAS int*)(lds + LCNT_OFF);
    if (tid < 32) hist[tid] = 0;
    const int r = lane & 31, hh = lane >> 5;
    for (int tb = vcu; tb < T / 128; tb += G) {
        const int tok0 = tb * 128 + wave * 32;
        f32x16 acc = {}; float ssq = 0.f;
        for (int kh = 0; kh < 2; ++kh) {
            __syncthreads();
#pragma unroll
            for (int i = 0; i < 8; ++i) { const int q = tid + 512 * i, k = q >> 3, e4 = (q & 7) * 4;
                const float gk = a.in[I_FNORM][kh * 512 + k]; f32x4 w = *(const f32x4*)(a.in[I_WR] + (size_t)(kh * 512 + k) * 32 + e4);
                *(LAS f32x4*)(lds + RT_W + (k * 32 + e4) * 4) = w * gk; }
            __syncthreads();
            if (wave < 4) {
#if X1_BF16
                const bf16* xp = X1B + (size_t)(tok0 + r) * D + kh * 512 + 4 * hh;
                for (int i = 0; i < 64; ++i) { const v2u xw = *(const v2u*)(xp + 8 * i); f32x4 xv; xv.x = bflo(xw.x); xv.y = bfhi(xw.x); xv.z = bflo(xw.y); xv.w = bfhi(xw.y);
#else
                const float* xp = X1 + (size_t)(tok0 + r) * D + kh * 512 + 4 * hh;
                for (int i = 0; i < 64; ++i) { const f32x4 xv = *(const f32x4*)(xp + 8 * i);
#endif
                    ssq += (xv.x * xv.x + xv.y * xv.y) + (xv.z * xv.z + xv.w * xv.w);
                    const LAS float* wp = (const LAS float*)(lds + RT_W) + (8 * i + 4 * hh) * 32 + r;
                    acc = __builtin_amdgcn_mfma_f32_32x32x2f32(xv.x, wp[0], acc, 0, 0, 0);
                    acc = __builtin_amdgcn_mfma_f32_32x32x2f32(xv.y, wp[32], acc, 0, 0, 0);
                    acc = __builtin_amdgcn_mfma_f32_32x32x2f32(xv.z, wp[64], acc, 0, 0, 0);
                    acc = __builtin_amdgcn_mfma_f32_32x32x2f32(xv.w, wp[96], acc, 0, 0, 0); }
            }
        }
        if (wave < 4) {
            ssq += __shfl_xor(ssq, 32);
            LAS float* wsc = (LAS float*)(lds + LWSC_OFF + wave * 256);
            if (hh == 0) { const float rs_ = rsqrtf(ssq * (1.f / D) + EPS); wsc[r] = rs_;
#if ROUTER_FUSED
                ((float*)(ws + WS_RSTD))[tok0 + r] = rs_;
#endif
            }
            LDS_WAIT();
            LAS float* LG = (LAS float*)(lds + RT_LG + wave * (32 * 33 * 4));
            const float br = a.in[I_BR][r];
#pragma unroll
            for (int i = 0; i < 16; ++i) { const int tk = crow(i, hh); LG[tk * 33 + r] = acc[i] * wsc[tk] + br; }
            LDS_WAIT();
            if (lane < 32) {
                const LAS float* row = LG + lane * 33;
                float best[4]; int bi[4];
                unsigned taken = 0u;
#pragma unroll
                for (int k = 0; k < 4; ++k) { float bv = -INFINITY; int be = 0;
                    for (int e = 0; e < 32; ++e) { const float v = row[e]; const bool ok = !((taken >> e) & 1u) && v > bv; bv = ok ? v : bv; be = ok ? e : be; }
                    best[k] = bv; bi[k] = be; taken |= 1u << be; }
                const float e0 = 1.f, e1 = expf(best[1] - best[0]), e2 = expf(best[2] - best[0]), e3 = expf(best[3] - best[0]);
                const float inv = 1.f / (e0 + e1 + e2 + e3);
                int* TE = (int*)(ws + WS_TOKE) + (size_t)(tok0 + lane) * 4; float* TW = (float*)(ws + WS_TOKW) + (size_t)(tok0 + lane) * 4;
                TE[0] = bi[0]; TE[1] = bi[1]; TE[2] = bi[2]; TE[3] = bi[3];
                TW[0] = e0 * inv; TW[1] = e1 * inv; TW[2] = e2 * inv; TW[3] = e3 * inv;
                lds_add(&hist[bi[0]], 1); lds_add(&hist[bi[1]], 1); lds_add(&hist[bi[2]], 1); lds_add(&hist[bi[3]], 1);
            }
        }
    }
    __syncthreads();
    if (tid < 32) atomicAdd((unsigned*)(ws + WS_CTL) + cw_cnt + tid, (unsigned)hist[tid]);
#if X1_BF16
    if (!rows_first) p5_rows(a, vcu, G, wave, lane);
#endif
}

DI void moe_table(const Args& a, LAS unsigned char* lds, int tid) {
    LAS int* cnt = (LAS int*)(lds + LCNT_OFF); LAS int* base = cnt + 32; LAS int* misc = cnt + 64; LAS int* tab = (LAS int*)(lds + LTAB_OFF);
    __syncthreads();
    if (tid < 32) cnt[tid] = (int)__hip_atomic_load((unsigned*)(a.ws + WS_CTL) + CW_CNT + tid, RLX_AGENT);
    __syncthreads();
    if (tid == 0) { int ti = 0; for (int e = 0; e < 32; ++e) { base[e] = ti * 256; const int nt = (cnt[e] + 255) >> 8; for (int q = 0; q < nt; ++q) tab[ti + q] = e; ti += nt; } misc[0] = ti; }
    __syncthreads();
}
DI void p6_slots(const Args& a, LAS unsigned char* lds, int vcu, int G, int tid, int wave, int lane, int cw_cur) {
    unsigned char* ws = a.ws;
    LAS int* cnt = (LAS int*)(lds + LCNT_OFF); LAS int* base = cnt + 32;
    LAS int* lh = (LAS int*)(lds + 0); LAS int* wb = lh + 32; LAS int* pslot = lh + 64;
    moe_table(a, lds, tid);
    int* SD = (int*)(ws + WS_SDST); float* SW = (float*)(ws + WS_SW);
    for (int e = vcu; e < 32; e += G) { const int lo = base[e] + cnt[e], hi = base[e] + (((cnt[e] + 255) >> 8) << 8); for (int s = lo + tid; s < hi; s += 512) { SD[s] = -1; ((float*)(ws + WS_SR))[s] = 0.f; } }
    const int* TE = (const int*)(ws + WS_TOKE); const float* TW = (const float*)(ws + WS_TOKW);
    const bf16* H2 = (const bf16*)(ws + WS_H); bf16* XS = (bf16*)(ws + WS_XS);
    for (int tb = vcu; tb < T / 128; tb += G) {
        __syncthreads();
        if (tid < 32) lh[tid] = 0;
        __syncthreads();
        const int pair = tb * 512 + tid; const int e = TE[pair];
        const int rank = lds_add(&lh[e], 1);
        __syncthreads();
        if (tid < 32) wb[tid] = (int)atomicAdd((unsigned*)(ws + WS_CTL) + cw_cur + tid, (unsigned)lh[tid]);
        __syncthreads();
        const int slot = base[e] + wb[e] + rank;
        SD[slot] = pair; SW[slot] = TW[pair]; ((int*)(ws + WS_TSLOT))[pair] = slot;
#if ROUTER_FUSED
        ((float*)(ws + WS_SR))[slot] = ((const float*)(ws + WS_RSTD))[pair >> 2] * ACC8_SCALE;
#endif
    }
    __syncthreads();
}

struct MoeOrder {
    const LAS int* tab; int ntiles, npn, G, c; long bstride;
    DI bool next(int i, pg8::Unit& u) const {
        const long L = (long)i * G + c; const int per = 8 * npn; const int grp = (int)(L / per), within = (int)(L % per);
        const int rt = grp * 8 + (within & 7);
        if (rt >= ntiles) return false;
        const int e = __builtin_amdgcn_readfirstlane(tab[rt]);
        u.pm = rt; u.pn = within >> 3; u.aoff = 0; u.boff = (long)e * bstride; u.tag = e; return true;
    }
};
struct EpiSwiGLU {
    static constexpr bool PERM = true; static constexpr bool CHAIN = false; static constexpr bool PREFETCH = false;
    static constexpr float OSC = MOE_FP8 ? A8_SCALE : 1.f;
    bf16* ACT; const float* bgu; int skip; const float* SR;
    DI void operator()(const f32x4 (&acc)[2][2][4][2], const pg8::Unit& u, int wr, int wc, int fr, int fq) const {
        if (skip == 1) { f32x4 s_ = {0.f, 0.f, 0.f, 0.f}; _Pragma("unroll") for (int a_ = 0; a_ < 2; ++a_) _Pragma("unroll") for (int b_ = 0; b_ < 2; ++b_) _Pragma("unroll") for (int m_ = 0; m_ < 4; ++m_) _Pragma("unroll") for (int n_ = 0; n_ < 2; ++n_) s_ += acc[a_][b_][m_][n_]; if (s_.x + s_.y + s_.z + s_.w == 123.456f) ACT[0] = 0; return; }
        int fr_ = fr, fq_ = fq; asm volatile("" : "+v"(fr_), "+v"(fq_));
        const int row0 = u.pm * 256 + wr * 64 + fr_, j0 = u.pn * 128 + wc * 32 + 8 * fq_;
        const float* bp = bgu + (size_t)u.tag * 2048 + j0;
        const f32x4 bg0 = *(const f32x4*)(bp), bg1 = *(const f32x4*)(bp + 4), bu0 = *(const f32x4*)(bp + 1024), bu1 = *(const f32x4*)(bp + 1028);
        const f32x4 bu0s = bu0 * OSC + OSC, bu1s = bu1 * OSC + OSC; (void)bu0s; (void)bu1s;
#pragma unroll
        for (int ai = 0; ai < 2; ++ai)
#pragma unroll
            for (int m = 0; m < 4; ++m) {
#if MOE_FP8 && ROUTER_FUSED
                const float rs_ = SR[row0 + ai * 128 + m * 16];
                f32x4 g0 = acc[ai][0][m][0] * rs_ + bg0, g1 = acc[ai][0][m][1] * rs_ + bg1, u0 = acc[ai][1][m][0] * rs_ + bu0, u1 = acc[ai][1][m][1] * rs_ + bu1;
#elif MOE_FP8
                f32x4 g0 = acc[ai][0][m][0] * ACC8_SCALE + bg0, g1 = acc[ai][0][m][1] * ACC8_SCALE + bg1, u0 = acc[ai][1][m][0] * (ACC8_SCALE * OSC) + bu0s, u1 = acc[ai][1][m][1] * (ACC8_SCALE * OSC) + bu1s;
#else
                f32x4 g0 = acc[ai][0][m][0] + bg0, g1 = acc[ai][0][m][1] + bg1, u0 = acc[ai][1][m][0] + bu0, u1 = acc[ai][1][m][1] + bu1;
#endif
                float o[8];
#pragma unroll
#if MOE_FP8 && !ROUTER_FUSED
                for (int q = 0; q < 4; ++q) { float g = fminf(g0[q], 7.f), up = __builtin_amdgcn_fmed3f(u0[q], -6.f * OSC, 8.f * OSC); o[q] = up * g * __builtin_amdgcn_rcpf(1.f + __builtin_amdgcn_exp2f(g * (-1.702f * LOG2E)));
                    g = fminf(g1[q], 7.f); up = __builtin_amdgcn_fmed3f(u1[q], -6.f * OSC, 8.f * OSC); o[4 + q] = up * g * __builtin_amdgcn_rcpf(1.f + __builtin_amdgcn_exp2f(g * (-1.702f * LOG2E))); }
#else
                for (int q = 0; q < 4; ++q) { float g = fminf(g0[q], 7.f), up = fminf(fmaxf(u0[q], -7.f), 7.f); o[q] = (up * OSC + OSC) * g * sigmoidf_(1.702f * g);
                    g = fminf(g1[q], 7.f); up = fminf(fmaxf(u1[q], -7.f), 7.f); o[4 + q] = (up * OSC + OSC) * g * sigmoidf_(1.702f * g); }
#endif
#if MOE_FP8
                v2u w; w.x = pk4f8(o[0], o[1], o[2], o[3]); w.y = pk4f8(o[4], o[5], o[6], o[7]);
                if (skip != 2 || w.x == 0x12345678u) *(v2u*)((unsigned char*)ACT + (size_t)(row0 + ai * 128 + m * 16) * 1024 + j0) = w; }
#else
                v4u w; w.x = pk2(o[0], o[1]); w.y = pk2(o[2], o[3]); w.z = pk2(o[4], o[5]); w.w = pk2(o[6], o[7]);
                if (skip != 2 || w.x == 0x12345678u) *(v4u*)(ACT + (size_t)(row0 + ai * 128 + m * 16) * 1024 + j0) = w; }
#endif
    }
};
#ifndef Y_FP8
#define Y_FP8 1
#endif
constexpr float Y8_SCALE = 16.f;
DI float clamp8(float v) { return __builtin_amdgcn_fmed3f(v, -448.f, 448.f); }
struct EpiDown {
    static constexpr bool PERM = true; static constexpr bool CHAIN = false; static constexpr bool PREFETCH = false;
    bf16* Y2; const float* bd; const int* SD; const float* SW;
    DI void operator()(const f32x4 (&acc)[2][2][4][2], const pg8::Unit& u, int wr, int wc, int fr, int fq) const {
        int fr_ = fr, fq_ = fq; asm volatile("" : "+v"(fr_), "+v"(fq_));
        const int row0 = u.pm * 256 + wr * 64 + fr_, col0 = u.pn * 256 + wc * 32 + 8 * fq_;
        const float* bp = bd + (size_t)u.tag * 1024 + col0;
        f32x4 bv[2][2];
#pragma unroll
        for (int bj = 0; bj < 2; ++bj)
#pragma unroll
            for (int n = 0; n < 2; ++n) bv[bj][n] = *(const f32x4*)(bp + bj * 128 + 4 * n);
        float sws[2][4];
#pragma unroll
        for (int ai = 0; ai < 2; ++ai)
#pragma unroll
            for (int m = 0; m < 4; ++m) sws[ai][m] = SW[row0 + ai * 128 + m * 16];
#pragma unroll
        for (int ai = 0; ai < 2; ++ai)
#pragma unroll
            for (int m = 0; m < 4; ++m) {
#if Y_FP8
                const float sw = sws[ai][m] * Y8_SCALE; unsigned char* rowp = (unsigned char*)Y2 + (size_t)(row0 + ai * 128 + m * 16) * 1024 + col0;
#else
                const float sw = sws[ai][m]; bf16* rowp = Y2 + (size_t)(row0 + ai * 128 + m * 16) * 1024 + col0;
#endif
#pragma unroll
                for (int bj = 0; bj < 2; ++bj) {
#if MOE_FP8
                    const f32x4 v0 = (acc[ai][bj][m][0] * ACC8_SCALE + bv[bj][0]) * sw, v1 = (acc[ai][bj][m][1] * ACC8_SCALE + bv[bj][1]) * sw;
#else
                    const f32x4 v0 = (acc[ai][bj][m][0] + bv[bj][0]) * sw, v1 = (acc[ai][bj][m][1] + bv[bj][1]) * sw;
#endif
#if Y_FP8
                    v2u w; w.x = pk4f8(clamp8(v0.x), clamp8(v0.y), clamp8(v0.z), clamp8(v0.w)); w.y = pk4f8(clamp8(v1.x), clamp8(v1.y), clamp8(v1.z), clamp8(v1.w));
                    *(v2u*)(rowp + bj * 128) = w; } }
#else
                    v4u w; w.x = pk2(v0.x, v0.y); w.y = pk2(v0.z, v0.w); w.z = pk2(v1.x, v1.y); w.w = pk2(v1.z, v1.w);
                    *(v4u*)(rowp + bj * 128) = w; } }
#endif
    }
};

#if X1_BF16 && Y_FP8
DI void p9_combine(const Args& a, int vcu, int G, int wave, int lane) {
    unsigned char* ws = a.ws; const int gw = vcu * 8 + wave, NGW = G * 8;
    const unsigned char* Y2 = ws + WS_XS; constexpr float IS = 1.f / Y8_SCALE;
    for (int m0 = gw; m0 < T; m0 += 4 * NGW) {
        int ts[4][4]; v4u xw[4][2], yw[4][4];
#pragma unroll
        for (int q = 0; q < 4; ++q) { const size_t m = (size_t)(m0 + q * NGW); const int* tp = (const int*)(ws + WS_TSLOT) + m * 4; ts[q][0] = tp[0]; ts[q][1] = tp[1]; ts[q][2] = tp[2]; ts[q][3] = tp[3];
            const v4u* xp = (const v4u*)((const bf16*)(ws + WS_X1B) + m * D + 16 * lane); xw[q][0] = xp[0]; xw[q][1] = xp[1]; }
#pragma unroll
        for (int q = 0; q < 4; ++q)
#pragma unroll
            for (int k = 0; k < 4; ++k) yw[q][k] = *(const v4u*)(Y2 + (size_t)ts[q][k] * 1024 + 16 * lane);
#pragma unroll
        for (int q = 0; q < 4; ++q) {
            float o[16]; { float t[8]; bf8_to_f(xw[q][0], t); _Pragma("unroll") for (int i = 0; i < 8; ++i) o[i] = t[i]; bf8_to_f(xw[q][1], t); _Pragma("unroll") for (int i = 0; i < 8; ++i) o[8 + i] = t[i]; }
#pragma unroll
            for (int k = 0; k < 4; ++k) { const v4u w = yw[q][k]; f32x2_t_ c;
                c = __builtin_amdgcn_cvt_pk_f32_fp8((int)w.x, false); o[0] += c.x * IS; o[1] += c.y * IS; c = __builtin_amdgcn_cvt_pk_f32_fp8((int)w.x, true); o[2] += c.x * IS; o[3] += c.y * IS;
                c = __builtin_amdgcn_cvt_pk_f32_fp8((int)w.y, false); o[4] += c.x * IS; o[5] += c.y * IS; c = __builtin_amdgcn_cvt_pk_f32_fp8((int)w.y, true); o[6] += c.x * IS; o[7] += c.y * IS;
                c = __builtin_amdgcn_cvt_pk_f32_fp8((int)w.z, false); o[8] += c.x * IS; o[9] += c.y * IS; c = __builtin_amdgcn_cvt_pk_f32_fp8((int)w.z, true); o[10] += c.x * IS; o[11] += c.y * IS;
                c = __builtin_amdgcn_cvt_pk_f32_fp8((int)w.w, false); o[12] += c.x * IS; o[13] += c.y * IS; c = __builtin_amdgcn_cvt_pk_f32_fp8((int)w.w, true); o[14] += c.x * IS; o[15] += c.y * IS; }
            f32x4* op = (f32x4*)(a.out + (size_t)(m0 + q * NGW) * D + 16 * lane);
            op[0] = (f32x4){o[0], o[1], o[2], o[3]}; op[1] = (f32x4){o[4], o[5], o[6], o[7]}; op[2] = (f32x4){o[8], o[9], o[10], o[11]}; op[3] = (f32x4){o[12], o[13], o[14], o[15]};
        }
    }
}
#else
DI void p9_combine(const Args& a, int vcu, int G, int wave, int lane) {
    unsigned char* ws = a.ws; const int gw = vcu * 8 + wave, NGW = G * 8;
    const bf16* Y2 = (const bf16*)(ws + WS_XS);
    for (int m = gw; m < T; m += NGW) {
        f32x4* op = (f32x4*)(a.out + (size_t)m * D + 16 * lane);
#if X1_BF16
        f32x4 o0, o1, o2, o3; { const v4u* xp = (const v4u*)((const bf16*)(ws + WS_X1B) + (size_t)m * D + 16 * lane); const v4u w0 = xp[0], w1 = xp[1];
            o0.x = bflo(w0.x); o0.y = bfhi(w0.x); o0.z = bflo(w0.y); o0.w = bfhi(w0.y); o1.x = bflo(w0.z); o1.y = bfhi(w0.z); o1.z = bflo(w0.w); o1.w = bfhi(w0.w);
            o2.x = bflo(w1.x); o2.y = bfhi(w1.x); o2.z = bflo(w1.y); o2.w = bfhi(w1.y); o3.x = bflo(w1.z); o3.y = bfhi(w1.z); o3.z = bflo(w1.w); o3.w = bfhi(w1.w); }
#else
        f32x4 o0 = op[0], o1 = op[1], o2 = op[2], o3 = op[3];
#endif
        int ts[4]; { const int* tp = (const int*)(ws + WS_TSLOT) + (size_t)m * 4; ts[0] = tp[0]; ts[1] = tp[1]; ts[2] = tp[2]; ts[3] = tp[3]; }
#pragma unroll
#if Y_FP8
        for (int k = 0; k < 4; ++k) { const v4u w = *(const v4u*)((const unsigned char*)Y2 + (size_t)ts[k] * 1024 + 16 * lane); constexpr float IS = 1.f / Y8_SCALE;
            f32x2_t_ a;
            a = __builtin_amdgcn_cvt_pk_f32_fp8((int)w.x, false); o0.x += a.x * IS; o0.y += a.y * IS; a = __builtin_amdgcn_cvt_pk_f32_fp8((int)w.x, true); o0.z += a.x * IS; o0.w += a.y * IS;
            a = __builtin_amdgcn_cvt_pk_f32_fp8((int)w.y, false); o1.x += a.x * IS; o1.y += a.y * IS; a = __builtin_amdgcn_cvt_pk_f32_fp8((int)w.y, true); o1.z += a.x * IS; o1.w += a.y * IS;
            a = __builtin_amdgcn_cvt_pk_f32_fp8((int)w.z, false); o2.x += a.x * IS; o2.y += a.y * IS; a = __builtin_amdgcn_cvt_pk_f32_fp8((int)w.z, true); o2.z += a.x * IS; o2.w += a.y * IS;
            a = __builtin_amdgcn_cvt_pk_f32_fp8((int)w.w, false); o3.x += a.x * IS; o3.y += a.y * IS; a = __builtin_amdgcn_cvt_pk_f32_fp8((int)w.w, true); o3.z += a.x * IS; o3.w += a.y * IS; }
#else
        for (int k = 0; k < 4; ++k) { const v4u* yp = (const v4u*)(Y2 + (size_t)ts[k] * 1024 + 16 * lane); const v4u w0 = yp[0], w1 = yp[1];
            o0.x += bflo(w0.x); o0.y += bfhi(w0.x); o0.z += bflo(w0.y); o0.w += bfhi(w0.y); o1.x += bflo(w0.z); o1.y += bfhi(w0.z); o1.z += bflo(w0.w); o1.w += bfhi(w0.w);
            o2.x += bflo(w1.x); o2.y += bfhi(w1.x); o2.z += bflo(w1.y); o2.w += bfhi(w1.y); o3.x += bflo(w1.z); o3.y += bfhi(w1.z); o3.z += bflo(w1.w); o3.w += bfhi(w1.w); }
#endif
        op[0] = o0; op[1] = o1; op[2] = o2; op[3] = o3;
    }
}
#endif
constexpr int NPHASE = 12;
#ifndef P1_SPLIT
#define P1_SPLIT 1
#endif
constexpr int N_ATT_ITEMS = 1024, N_MX_ITEMS = 512, N_SCAN_WG = 32, N_TR_WG = 64;
DI void stagger(int bx, int step_ticks) {
#ifdef STAGGER
    const unsigned long long t0 = __builtin_amdgcn_s_memrealtime(); const unsigned long long d = (unsigned long long)(((bx >> 3) & 7) * step_ticks);
    while (__builtin_amdgcn_s_memrealtime() - t0 < d) __builtin_amdgcn_s_sleep(8);
#endif
}
typedef const Args __attribute__((address_space(4))) CArgs;
#if defined(__HIP_DEVICE_COMPILE__)
DI CArgs* fresh_args() { unsigned long long v = (unsigned long long)__builtin_amdgcn_kernarg_segment_ptr(); asm volatile("" : "+s"(v)); return (CArgs*)v; }
#else
__device__ CArgs* fresh_args();
#endif
DI Args load_args() { CArgs* p = fresh_args(); Args a;
#pragma unroll
    for (int i = 0; i < 27; ++i) a.in[i] = p->in[i];
    a.out = p->out; a.ws = p->ws; a.ph_lo = p->ph_lo; a.ph_hi = p->ph_hi; a.li = p->li; a.pad = 0; return a; }
#ifndef MK_N_LAUNCHES
#define MK_N_LAUNCHES 1
#endif
__global__ void __launch_bounds__(512, 2) mk_fwd(Args args_unused) {
    extern __shared__ __attribute__((aligned(16))) unsigned char lds_raw[];
    LAS unsigned char* lds = (LAS unsigned char*)lds_raw;
    volatile LAS unsigned* MISC = (volatile LAS unsigned*)(lds + MISC_OFF);
    for (int u = threadIdx.x; u < (LDS_BYTES - LDSCTL_OFF) / 4; u += 512) ((LAS unsigned*)(lds + LDSCTL_OFF))[u] = 0u;
    __syncthreads();
    { const Args A0 = load_args(); (void)xcd_barrier_post((unsigned*)(A0.ws + WS_CTL) + CW_BAR, MISC + 8); }
#ifdef ONLY_PHASE
#define IN(k) ((k) == ONLY_PHASE)
#elif MK_N_LAUNCHES == 1
#define IN(k) true
#else
#define IN(k) (fresh_args()->ph_lo <= (k) && (k) < fresh_args()->ph_hi)
#endif
#define FRESH() const Args A_ = load_args(); unsigned char* const ws = A_.ws; (void)ws; const int tid_ = fresh_tid(), lane_ = tid_ & 63, wave_ = __builtin_amdgcn_readfirstlane(tid_ >> 6); (void)lane_; (void)wave_; \
    const int G = gridDim.x, bx = blockIdx.x, vcu = (G % 8 == 0) ? (bx % 8) * (G / 8) + bx / 8 : bx; (void)vcu
#ifndef REPEAT_PHASE
#define REPEAT_PHASE -1
#endif
#define NREP(k) ((k) == REPEAT_PHASE ? 2 : 1)
#define GBAR() do { XcdBarrier b_; b_.bar = (unsigned*)(fresh_args()->ws + WS_CTL) + CW_BAR; b_.x = xb_xcc_id(); b_.st = MISC + 8; xcd_barrier(b_); } while (0)
#define SEAM(k) do { if (IN(k) && IN((k) + 1)) { XcdBarrier b_; b_.bar = (unsigned*)(fresh_args()->ws + WS_CTL) + CW_BAR; b_.x = xb_xcc_id(); b_.st = MISC + 8; xcd_barrier(b_); } } while (0)

    if (IN(0)) _Pragma("unroll") for (int rep_ = 0; rep_ < NREP(0); ++rep_) { if (rep_) GBAR(); FRESH();
#ifdef PROBE_P0
        p0_prologue(A_, lds, vcu, G, wave_, lane_, rep_ == 0 ? PROBE_P0 : 0); }
#else
        p0_prologue(A_, lds, vcu, G, wave_, lane_); }
#endif
    SEAM(0);
    if (IN(1)) _Pragma("unroll") for (int rep_ = 0; rep_ < NREP(1); ++rep_) { if (rep_) GBAR();
        FRESH();
        const int cls_ = P1_SPLIT ? (__builtin_amdgcn_readfirstlane((int)blockIdx.x) & 3) : 0;
#define P1_F8_PART(I0, NI) {   \
          pg8::Gemm g{(const bf16*)(ws + WS_H8), (const bf16*)(ws + WS_WIN8), 512, 512, 512, nullptr, 0}; \
          OffOrder S; S.S.init(T, (12 + (P1_FA1 - P1_FA0)) * 256, G, bx); S.n0 = P1_FA1 - P1_FA0; S.a0 = P1_FA0; S.a1 = 16; S.i0 = (I0); S.ni = (NI); \
          EpiPT<true> E{(bf16*)(ws + WS_P), A_.in[I_BGATE], 0, (bf16*)(ws + WS_GF), (LAS float*)(lds + 128 * 1024), A_.in[I_DAQN], A_.in[I_DAKN], A_.in[I_MXQN]}; \
          pg8::gemm_phase<EpiPT<true>, OffOrder, false, true>(lds, g, S, E, tid_); }
#define P1_BF_PART(I0, NI) { \
          pg8::Gemm g{(const bf16*)(ws + WS_H), (const bf16*)(ws + WS_WIN), 1024, 1024, 1024, nullptr, 0}; \
          OffOrder S; S.S.init(T, (16 - (P1_FA1 - P1_FA0)) * 256, G, bx); S.n0 = P1_FA0; S.a0 = 0; S.a1 = P1_FA1; S.i0 = (I0); S.ni = (NI); \
          EpiP E{(bf16*)(ws + WS_P), A_.in[I_BGATE], 0, (bf16*)(ws + WS_GF), (LAS float*)(lds + 128 * 1024), A_.in[I_DAQN], A_.in[I_DAKN], A_.in[I_MXQN]}; \
          pg8::gemm_phase<EpiP, OffOrder>(lds, g, S, E, tid_); }
        const int f8a_ = cls_ == 1 ? 1000 : cls_ == 3 ? 3 : 0;
        const int bfa_ = cls_ == 2 ? 4 : 1000;
        if (f8a_ > 0) P1_F8_PART(0, f8a_)
        P1_BF_PART(0, bfa_)
        if (f8a_ < 1000) P1_F8_PART(f8a_, 1000)
        if (bfa_ < 1000) P1_BF_PART(bfa_, 1000)
#undef P1_F8_PART
#undef P1_BF_PART
    }
    SEAM(1);
    if (IN(2)) _Pragma("unroll") for (int rep_ = 0; rep_ < NREP(2); ++rep_) { if (rep_) GBAR();
        FRESH();
#ifndef NO_PREP
        { PrepPre pp; if (vcu < NCHUNK) prep_prefetch(A_, vcu, tid_, wave_, pp);
          for (int ck = vcu; ck < NCHUNK; ck += G) dn_prep_unit<0>(A_, lds, ck, ck + G, pp, wave_); }
#endif
#if !defined(NO_NORM) && !NORM_IN_EPI
        if (rep_ == 0) p2_norm_rows(A_, vcu, G, wave_, lane_);
#endif
    }
    SEAM(2);
    if (IN(3)) _Pragma("unroll") for (int rep_ = 0; rep_ < NREP(3); ++rep_) { if (rep_) GBAR();
#ifndef NO_SCAN
        if (blockIdx.x >= N_SCAN_WG && blockIdx.x < N_SCAN_WG + N_TR_WG) { FRESH(); moe_transposes(A_, lds, bx - N_SCAN_WG, N_TR_WG, wave_, lane_); p3_small_copies(A_, lds, bx - N_SCAN_WG, N_TR_WG, wave_, lane_); __syncthreads(); }
        if (blockIdx.x >= N_SCAN_WG + N_TR_WG && blockIdx.x < N_SCAN_WG + N_TR_WG + 16) { FRESH();
            pg8::Gemm g{(const bf16*)(ws + WS_MEMN), (const bf16*)(ws + WS_WMKV), 1024, 1024, 1024, nullptr, 0}; pg8::StaticOrder S; S.init(BATCH * NMEM, 1024, 16, bx - (N_SCAN_WG + N_TR_WG));
            EpiPlain E{(bf16*)(ws + WS_MKV), 1024};
            pg8::gemm_phase<EpiPlain, pg8::StaticOrder>(lds, g, S, E, tid_);
            asm volatile("s_waitcnt vmcnt(0)" ::: "memory"); __syncthreads();
            if (tid_ == 0) { __builtin_amdgcn_fence(__ATOMIC_RELEASE, "agent"); asm volatile("s_waitcnt vmcnt(0)" ::: "memory"); __hip_atomic_fetch_add((unsigned*)(ws + WS_CTL) + CW_MKV + 1024 * rep_, 1u, RLX_AGENT); }
            __syncthreads(); }
#ifdef PROBE_ATT
        if (rep_ == 1)
#endif
        if (blockIdx.x < N_SCAN_WG) { FRESH(); dn_scan(A_, lds, bx, wave_, lane_); }
#ifdef PROBE_SCAN_ALONE
        GBAR();
#endif
#ifdef PROBE_SCAN_TWICE
        if (blockIdx.x < N_SCAN_WG) { FRESH(); dn_scan(A_, lds, bx, wave_, lane_); }
#endif
#endif
#ifndef NO_ATT
        for (;;) {
            CArgs* ap = fresh_args(); unsigned char* ws = ap->ws; const int tid_ = fresh_tid();
            if (tid_ == 0) MISC[16] = __hip_atomic_fetch_add((unsigned*)(ws + WS_CTL) + CW_QHEAD + 1024 * rep_, 1u, RLX_AGENT);
            __syncthreads();
            const int item = __builtin_amdgcn_readfirstlane((int)MISC[16]);
            __syncthreads();
            if (item >= N_ATT_ITEMS) break;
            const int qb = 31 - (item >> 5), rest = item & 31, b = rest >> 3, h = (rest >> 1) & 3, map = rest & 1;
            const attn_body::bf16* Pb = (const attn_body::bf16*)(ws + WS_P) + (size_t)b * SEQ * PW;
            attn_body::bf16* Ob = (attn_body::bf16*)(ws + (map ? WS_O2 : WS_O1)) + (size_t)b * SEQ * 512 + h * 128;
            attn_body::attn_unit<8, false>(qb, Pb + P_DAQ + h * 128 + map * 64, Pb + P_DAK + h * 128 + map * 64, Pb + P_DAV + h * 128, Ob, ap->in[I_REL], h, (char*)lds_raw, tid_);
        }
#endif
#ifndef NO_MX
        { FRESH();
          if (tid_ == 0) { unsigned sp = 0; while (__hip_atomic_load((unsigned*)(ws + WS_CTL) + CW_MKV + 1024 * rep_, RLX_AGENT) < 16u) { __builtin_amdgcn_s_sleep(2); if (++sp > (1u << 22)) break; }
              __builtin_amdgcn_fence(__ATOMIC_ACQUIRE, "agent"); asm volatile("s_waitcnt vmcnt(0)" ::: "memory"); }
          __syncthreads(); }
        for (;;) {
            FRESH();
            if (tid_ == 0) MISC[16] = __hip_atomic_fetch_add((unsigned*)(ws + WS_CTL) + CW_QHEAD + 16 + 1024 * rep_, 1u, RLX_AGENT);
            __syncthreads();
            const int idx = __builtin_amdgcn_readfirstlane((int)MISC[16]);
            __syncthreads();
            if (idx >= N_MX_ITEMS) break;
            mx_unit(A_, lds, idx >> 5, idx & 31, tid_, wave_, lane_);
        }
#endif
    }
    SEAM(3);
    if (IN(4)) _Pragma("unroll") for (int rep_ = 0; rep_ < NREP(4); ++rep_) { if (rep_) GBAR(); FRESH(); p4_norm_rows(A_, vcu, G, wave_, lane_); }
    SEAM(4);
    if (IN(5)) _Pragma("unroll") for (int rep_ = 0; rep_ < NREP(5); ++rep_) { if (rep_) GBAR();
        FRESH();
        pg8::Gemm g{(const bf16*)(ws + WS_ODNF), (const bf16*)(ws + WS_WB), 512, 512, 512, nullptr, 0};
        BranchOrder S; S.so.init(T, 1024, G, bx); S.a1 = (long)(WS_ODAF - WS_ODNF); S.a2 = (long)(WS_OMX - WS_ODNF);
        EpiMerge E{(bf16*)(ws + WS_MRG), (const bf16*)(ws + WS_GF), (bf16*)(ws + WS_MF)};
        pg8::gemm_phase<EpiMerge, BranchOrder>(lds, g, S, E, tid_);
    }
    SEAM(5);
    if (IN(6)) _Pragma("unroll") for (int rep_ = 0; rep_ < NREP(6); ++rep_) { if (rep_) GBAR();
        FRESH();
        pg8::Gemm g{(const bf16*)(ws + WS_MRG), (const bf16*)(ws + WS_WOUT), 1024, 1024, 1024, nullptr, 0}; pg8::StaticOrder S; S.init(T, 1024, G, bx);
#if X1_BF16
        EpiResB E{(bf16*)(ws + WS_X1B), A_.in[I_X]};
        pg8::gemm_phase<EpiResB, pg8::StaticOrder>(lds, g, S, E, tid_);
#else
        EpiResF32 E{A_.out, A_.in[I_X], ws + WS_H, A_.in[I_FNORM]};
        pg8::gemm_phase<EpiResF32, pg8::StaticOrder>(lds, g, S, E, tid_);
#endif
    }
    SEAM(6);
    if (IN(7)) _Pragma("unroll") for (int rep_ = 0; rep_ < NREP(7); ++rep_) { if (rep_) GBAR(); FRESH(); p5_router(A_, lds, vcu, G, tid_, wave_, lane_, CW_CNT + 256 * rep_); }
    SEAM(7);
    if (IN(8)) _Pragma("unroll") for (int rep_ = 0; rep_ < NREP(8); ++rep_) { if (rep_) GBAR(); FRESH(); p6_slots(A_, lds, vcu, G, tid_, wave_, lane_, CW_CUR + 256 * rep_); }
    SEAM(8);
    if (IN(9)) _Pragma("unroll") for (int rep_ = 0; rep_ < NREP(9); ++rep_) { if (rep_) GBAR();
        FRESH();
        moe_table(A_, lds, tid_);
#if MOE_FP8
        pg8::Gemm g{(const bf16*)(ws + WS_H), (const bf16*)(ws + WS_WGU), 512, 512, 512, (const int*)(ws + WS_SDST), 0};
        MoeOrder S{(const LAS int*)(lds + LTAB_OFF), ((const LAS int*)(lds + LCNT_OFF))[64], 8, G, bx, (long)2048 * 1024};
#else
        pg8::Gemm g{(const bf16*)(ws + WS_H), (const bf16*)(ws + WS_WGU), 1024, 1024, 1024, (const int*)(ws + WS_SDST), 0};
        MoeOrder S{(const LAS int*)(lds + LTAB_OFF), ((const LAS int*)(lds + LCNT_OFF))[64], 8, G, bx, (long)2048 * 1024 * 2};
#endif
#ifdef PROBE_NOEPI
        EpiSwiGLU E{(bf16*)(ws + WS_ACT), A_.in[I_BGU], (REPEAT_PHASE == 9 && rep_ == 0) ? PROBE_NOEPI : 0, (const float*)(ws + WS_SR)};
#else
        EpiSwiGLU E{(bf16*)(ws + WS_ACT), A_.in[I_BGU], 0, (const float*)(ws + WS_SR)};
#endif
        pg8::gemm_phase<EpiSwiGLU, MoeOrder, true, MOE_FP8 != 0>(lds, g, S, E, tid_);
    }
    SEAM(9);
    if (IN(10)) _Pragma("unroll") for (int rep_ = 0; rep_ < NREP(10); ++rep_) { if (rep_) GBAR();
        FRESH();
        moe_table(A_, lds, tid_);
#if MOE_FP8
        pg8::Gemm g{(const bf16*)(ws + WS_ACT), (const bf16*)(ws + WS_WD), 512, 512, 512, nullptr, 0};
        MoeOrder S{(const LAS int*)(lds + LTAB_OFF), ((const LAS int*)(lds + LCNT_OFF))[64], 4, G, bx, (long)1024 * 1024};
#else
        pg8::Gemm g{(const bf16*)(ws + WS_ACT), (const bf16*)(ws + WS_WD), 1024, 1024, 1024, nullptr, 0};
        MoeOrder S{(const LAS int*)(lds + LTAB_OFF), ((const LAS int*)(lds + LCNT_OFF))[64], 4, G, bx, (long)1024 * 1024 * 2};
#endif
        EpiDown E{(bf16*)(ws + WS_XS), A_.in[I_BD], (const int*)(ws + WS_SDST), (const float*)(ws + WS_SW)};
        pg8::gemm_phase<EpiDown, MoeOrder, false, MOE_FP8 != 0>(lds, g, S, E, tid_);
    }
    SEAM(10);
    if (IN(11)) {
        FRESH();
#ifdef PROBE_P11
        p9_combine_probe(A_, vcu, G, wave_, lane_); GBAR();
#endif
        p9_combine(A_, vcu, G, wave_, lane_);
        if (bx == 0 && tid_ == 0) { if (__hip_atomic_load((unsigned*)(ws + WS_CTL) + CW_BAR + XB_TMO, RLX_AGENT) != 0u) A_.out[0] = __builtin_nanf(""); }
    }
#undef IN
#undef SEAM
#undef FRESH
}

extern "C" void kernel_launch(void* const* d_in, const int* in_sizes, int n_in, void* d_out, int out_size, void* d_ws, size_t ws_size, hipStream_t stream) {
    static int grid = 0;
    if (grid == 0) {
        if (n_in != 27 || in_sizes[0] != T * D || out_size != T * D || ws_size < WS_END) {
            fprintf(stderr, "kernel_launch: unexpected shapes (n_in %d, in0 %d, out %d, ws %zu < %zu); nothing launched\n", n_in, n_in > 0 ? in_sizes[0] : -1, out_size, ws_size, (size_t)WS_END); grid = -1; return; }
        int dev = 0, cus = 0, per_cu = 0;
        if (hipGetDevice(&dev) != hipSuccess || hipDeviceGetAttribute(&cus, hipDeviceAttributeMultiprocessorCount, dev) != hipSuccess) { grid = -1; return; }
        if (hipFuncSetAttribute((const void*)mk_fwd, hipFuncAttributeMaxDynamicSharedMemorySize, LDS_BYTES) != hipSuccess) { fprintf(stderr, "kernel_launch: hipFuncSetAttribute failed\n"); grid = -1; return; }
        if (hipOccupancyMaxActiveBlocksPerMultiprocessor(&per_cu, (const void*)mk_fwd, 512, LDS_BYTES) != hipSuccess || per_cu < 1)
            fprintf(stderr, "kernel_launch: note: occupancy query reports %d workgroups per CU\n", per_cu);
        (void)hipGetLastError();
        grid = cus;
        if (grid > 256) grid = 256;
    }
    if (grid < 0) return;
    if (hipMemsetAsync((char*)d_ws + WS_CTL, 0, CTL_ZERO_BYTES, stream) != hipSuccess) return;
    Args a{};
    for (int i = 0; i < 27; ++i) a.in[i] = (const float*)d_in[i];
    a.out = (float*)d_out; a.ws = (unsigned char*)d_ws;
#if MK_N_LAUNCHES == 1
    a.ph_lo = 0; a.ph_hi = NPHASE; a.li = 0; a.pad = 0;
    hipLaunchKernelGGL(mk_fwd, dim3(grid), dim3(512), LDS_BYTES, stream, a);
#else
    for (int p = 0; p < NPHASE; ++p) { a.ph_lo = p; a.ph_hi = p + 1; a.li = 0; a.pad = 0; hipLaunchKernelGGL(mk_fwd, dim3(grid), dim3(512), LDS_BYTES, stream, a); }
#endif
}
```

```cpp
#include <hip/hip_runtime.h>
#include <hip/hip_bf16.h>
#include <cstdio>
#include <cstdint>
#include <cmath>

#define GAS __attribute__((address_space(1)))
#define LAS __attribute__((address_space(3)))
typedef unsigned short bf16;
typedef unsigned v4u __attribute__((ext_vector_type(4)));
typedef unsigned v2u __attribute__((ext_vector_type(2)));
typedef float f32x4 __attribute__((ext_vector_type(4)));
typedef float f32x16 __attribute__((ext_vector_type(16)));
typedef short bf16x8 __attribute__((ext_vector_type(8)));
typedef short s16x4 __attribute__((ext_vector_type(4)));
typedef GAS unsigned gu32;
#define RLX_AGENT __ATOMIC_RELAXED, __HIP_MEMORY_SCOPE_AGENT
#define LDS_WAIT() asm volatile("s_waitcnt lgkmcnt(0)" ::: "memory")
#define VM_WAIT() asm volatile("s_waitcnt vmcnt(0)" ::: "memory")
#define DI __device__ __forceinline__

DI unsigned f2bf(float f) { unsigned u = __builtin_bit_cast(unsigned, f); return (u + 0x7fffu + ((u >> 16) & 1u)) >> 16; }
typedef float f32x2_t_ __attribute__((ext_vector_type(2))); typedef __bf16 bf16x2_t_ __attribute__((ext_vector_type(2)));
DI unsigned pk2(float lo, float hi) { f32x2_t_ v = {lo, hi}; bf16x2_t_ b = __builtin_convertvector(v, bf16x2_t_); return __builtin_bit_cast(unsigned, b); }
typedef int v8i_ __attribute__((ext_vector_type(8))); typedef int v4i_ __attribute__((ext_vector_type(4)));
DI unsigned pk4f8(float a, float b, float c, float d) { int w = __builtin_amdgcn_cvt_pk_fp8_f32(a, b, 0, false); w = __builtin_amdgcn_cvt_pk_fp8_f32(c, d, w, true); return (unsigned)w; }
DI v8i_ cat8(bf16x8 lo, bf16x8 hi) { return __builtin_shufflevector(__builtin_bit_cast(v4i_, lo), __builtin_bit_cast(v4i_, hi), 0, 1, 2, 3, 4, 5, 6, 7); }
DI void mfma_f8(f32x4& c, v8i_ a, v8i_ b) { asm volatile("v_mfma_f32_16x16x128_f8f6f4 %0, %1, %2, %0" : "+v"(c) : "v"(a), "v"(b)); }
DI float bflo(unsigned w) { return __builtin_bit_cast(float, w << 16); }
DI float bfhi(unsigned w) { return __builtin_bit_cast(float, w & 0xffff0000u); }
DI float bf2f(bf16 b) { return __builtin_bit_cast(float, (unsigned)b << 16); }
DI float wave_sum(float v) {
#pragma unroll
    for (int o = 1; o < 64; o <<= 1) v += __shfl_xor(v, o);
    return v;
}
DI float fast_exp(float x) { return __builtin_amdgcn_exp2f(x * 1.4426950408889634f); }
DI float sigmoidf_(float x) { return __builtin_amdgcn_rcpf(1.f + fast_exp(-x)); }
DI int lds_add(LAS int* p, int v) { return __hip_atomic_fetch_add(p, v, __ATOMIC_RELAXED, __HIP_MEMORY_SCOPE_WORKGROUP); }
DI int fresh_tid() { int t; asm volatile("v_mov_b32 %0, %1" : "=v"(t) : "v"((int)threadIdx.x)); return t; }
DI int crow(int r, int hi) { return (r & 3) + 8 * (r >> 2) + 4 * hi; }

constexpr int BATCH = 4, SEQ = 8192, T = BATCH * SEQ, D = 1024, INW = 7176, NPROJ = 7168, PW = 4096, NMEM = 256;
constexpr float EPS = 1e-6f;
constexpr int P_DNQ = 0, P_DNK = 512, P_DNV = 1024, P_DNZ = 1536, P_DAQ = 2048, P_DAK = 2560, P_DAV = 3072, P_MXQ = 3584, P_GATE = 4096;
constexpr int NEXP = 32, DFF = 1024, NSLOT_MAX = T * 4 + NEXP * 256, NTILE_MAX = NSLOT_MAX / 256;
constexpr int NCHUNK = BATCH * 4 * (SEQ / 64);
constexpr float LOG2E = 1.4426950408889634f;

constexpr size_t MiB = 1u << 20;
constexpr size_t WS_CTL = 0, CTL_ZERO_BYTES = 1 * MiB;
constexpr size_t WS_G = 1 * MiB;
constexpr size_t WS_BETA = WS_G + 512 * 1024;
constexpr size_t WS_TOKE = 2 * MiB;
constexpr size_t WS_TOKW = WS_TOKE + 512 * 1024;
constexpr size_t WS_SDST = 3 * MiB;
constexpr size_t WS_SW = 4 * MiB;
constexpr size_t WS_EGL = 5 * MiB;
constexpr size_t WS_RSTD = 5 * MiB + 64 * 1024;
constexpr size_t WS_SR = 31 * MiB;
constexpr size_t WS_TSLOT = 5 * MiB + 512 * 1024;
constexpr size_t WS_WB = 6 * MiB;
constexpr size_t WS_WOUT = 9 * MiB;
constexpr size_t WS_WMKV = 11 * MiB;
constexpr size_t WS_MEMN = 13 * MiB;
constexpr size_t WS_MKV = 15 * MiB;
constexpr size_t WS_WIN = 17 * MiB;
constexpr size_t WS_WGU = 32 * MiB;
constexpr size_t WS_WD = 160 * MiB;
constexpr size_t WS_H8 = 96 * MiB;
constexpr size_t WS_WIN8 = 128 * MiB;
constexpr size_t WS_H = 224 * MiB;
constexpr size_t WS_P = 288 * MiB;
constexpr size_t WS_GF = 544 * MiB;
constexpr size_t WS_MF = 864 * MiB;
constexpr size_t WS_NW = 736 * MiB;
constexpr size_t WS_QD = 768 * MiB;
constexpr size_t WS_KDT = 800 * MiB;
constexpr size_t WS_U = 832 * MiB;
constexpr size_t WS_QK = 864 * MiB;
constexpr size_t WS_ODN = 880 * MiB;
constexpr size_t WS_O1 = 912 * MiB;
constexpr size_t WS_O2 = 944 * MiB;
constexpr size_t WS_OMX = 976 * MiB;
constexpr size_t WS_ODNF = 736 * MiB;
constexpr size_t WS_ODAF = 768 * MiB;
constexpr size_t WS_X1B = 736 * MiB;
constexpr size_t WS_MRG = 800 * MiB;
constexpr size_t WS_XS = 288 * MiB;
constexpr size_t WS_ACT = 560 * MiB;
constexpr size_t WS_END = 1024 * MiB;
static_assert(WS_OMX + (size_t)T * 512 * 2 <= WS_END && WS_ACT + (size_t)NSLOT_MAX * 1024 * 2 <= WS_END && WS_XS + (size_t)NSLOT_MAX * 1024 * 2 <= WS_ACT, "ws map");

constexpr int CW_QHEAD = 1024;
constexpr int CW_CNT = 128;
constexpr int CW_CUR = 192;
constexpr int CW_MKV = 2560;
constexpr int CW_BAR = 4096;

constexpr int RING_BYTES = 136 * 1024;
constexpr int LDSCTL_OFF = RING_BYTES;
constexpr int MISC_OFF = LDSCTL_OFF;
constexpr int LTAB_OFF = LDSCTL_OFF + 128;
constexpr int LCNT_OFF = LTAB_OFF + NTILE_MAX * 4;
constexpr int LWSC_OFF = LCNT_OFF + 512;
constexpr int LDS_BYTES = 144 * 1024;
static_assert(LWSC_OFF + 8 * 256 <= LDS_BYTES, "LDS map");

namespace pg8 {
constexpr int BM = 256, BK = 64, HALF = 128, HTB = HALF * BK * 2, STAGE_BYTES = 8 * HTB, NXCD = 8, WGM = 8;
DI int lds_byte(int r, int c) { const int st = (r >> 4) * 2 + (c >> 5), rr = r & 15, cc = c & 31, ob = rr * 64 + cc * 2; return st * 1024 + (ob ^ (((ob >> 9) & 1) << 5)); }
DI void stage_rc(int b, int& R, int& C) { const int st = b / 1024, sb = b % 1024, swz = sb ^ (((sb >> 9) & 1) << 5); R = (st >> 1) * 16 + swz / 64; C = (st & 1) * 32 + (swz % 64) / 2; }
DI int perm32(int rho) { const int n = rho >> 4, i = rho & 15; return 8 * (i >> 2) + 4 * n + (i & 3); }

struct Unit { int pm, pn; long aoff, boff; int tag; };
struct Gemm { const bf16* A; const bf16* Bt; int lda, ldb, K; const int* rowmap; int probe; };

struct StaticOrder {
    int nM, nN, nwg, G, c;
    DI void init(int M, int N, int G_, int c_) { nM = M / BM; nN = N / BM; nwg = nM * nN; G = G_; c = c_; }
    DI bool tile(long L, int& pm, int& pn) const {
        if (L >= nwg) return false;
        int wgid = (int)L; { const int q = nwg / NXCD, r = nwg % NXCD, xcd = wgid % NXCD, off = wgid / NXCD; wgid = (xcd < r ? xcd * (q + 1) : r * (q + 1) + (xcd - r) * q) + off; }
        const int nig = WGM * nN, gid = wgid / nig, fm = gid * WGM, gsz = (nM - fm) < WGM ? (nM - fm) : WGM;
        pm = fm + ((wgid % nig) % gsz); pn = (wgid % nig) / gsz; return true;
    }
    DI bool next(int i, Unit& u) const { u.aoff = 0; u.boff = 0; u.tag = 0; return tile((long)i * G + c, u.pm, u.pn); }
};

template <class Epi, class Sched, bool GATHER = false, bool FP8 = false>
DI void gemm_phase(LAS unsigned char* lds, const Gemm g, const Sched& S, const Epi& E, const int tid) {
    const int wid = __builtin_amdgcn_readfirstlane(tid >> 6), lane = tid & 63, wr = wid >> 2, wc = wid & 3, fr = lane & 15, fq = lane >> 4;
    int nt = g.K / BK; asm volatile("" : "+s"(nt));
    unsigned voffA[2], voffB[2];
#pragma unroll
    for (int i = 0; i < 2; ++i) { int R, C; stage_rc(tid * 16 + i * 8192, R, C); const int Rb = Epi::PERM ? ((R & ~31) + perm32(R & 31)) : R;
        voffA[i] = (unsigned)(R * g.lda + C) * 2u; voffB[i] = (unsigned)(Rb * g.ldb + C) * 2u; }
    const size_t kstep = (size_t)(BK * 2);
    const size_t hstepA = (size_t)HALF * g.lda * 2, hstepB = (size_t)HALF * g.ldb * 2;
    const size_t tstepA = (GATHER || (g.probe & 1)) ? 0 : 2 * hstepA, tstepB = (g.probe & 2) ? 0 : 2 * hstepB;
    unsigned cA0[2], cA1[2], nA0[2], nA1[2];
#define PG8_AOFFS(dst0, dst1, unit) do { if constexpr (GATHER) { _Pragma("unroll") for (int _i = 0; _i < 2; ++_i) { int R_, C_; stage_rc(tid * 16 + _i * 8192, R_, C_); \
            const int s0_ = g.rowmap[(unit).pm * BM + R_], s1_ = g.rowmap[(unit).pm * BM + HALF + R_]; \
            const unsigned c2_ = (unsigned)C_ * 2u; \
            dst0[_i] = (unsigned)((s0_ < 0 ? 0 : s0_ >> 2) * g.lda) * 2u + c2_; dst1[_i] = (unsigned)((s1_ < 0 ? 0 : s1_ >> 2) * g.lda) * 2u + c2_; } } \
        else { _Pragma("unroll") for (int _i = 0; _i < 2; ++_i) { dst0[_i] = voffA[_i]; dst1[_i] = voffA[_i] + (unsigned)hstepA; } } } while (0)
    const unsigned ldsw = (unsigned)wid * 1024u;
    const int aoff = lds_byte(wr * 64 + fr, fq * 8), boff = lds_byte(wc * 32 + fr, fq * 8);
#define PG8_SA(b, h) (((b) * 2 + (h)) * HTB)
#define PG8_SB(b, h) ((4 + (b) * 2 + (h)) * HTB)
#define PG8_STAGE(bufoff, gbase, voff) do { _Pragma("unroll") for (int _i = 0; _i < 2; ++_i) \
        __builtin_amdgcn_global_load_lds((const unsigned*)((const char*)(gbase) + (voff)[_i]), (LAS unsigned*)(lds + (bufoff) + ldsw + _i * 8192), 16, 0, 0); } while (0)
#define PG8_LDA(dst, b, h) do { _Pragma("unroll") for (int m = 0; m < 4; ++m) _Pragma("unroll") for (int k = 0; k < 2; ++k) dst[m][k] = *(const LAS bf16x8*)(lds + PG8_SA(b, h) + aoff + m * 2048 + k * 1024); } while (0)
#define PG8_LDB(dst, b, h) do { _Pragma("unroll") for (int n = 0; n < 2; ++n) _Pragma("unroll") for (int k = 0; k < 2; ++k) dst[n][k] = *(const LAS bf16x8*)(lds + PG8_SB(b, h) + boff + n * 2048 + k * 1024); } while (0)
#define PG8_MMA(ai, bj, At, Bt) do { __builtin_amdgcn_s_setprio(1); _Pragma("unroll") for (int m = 0; m < 4; ++m) _Pragma("unroll") for (int n = 0; n < 2; ++n) { \
        if constexpr (FP8) mfma_f8(acc[ai][bj][m][n], cat8(Bt[n][0], Bt[n][1]), cat8(At[m][0], At[m][1])); \
        else { _Pragma("unroll") for (int k = 0; k < 2; ++k) acc[ai][bj][m][n] = __builtin_amdgcn_mfma_f32_16x16x32_bf16(Bt[n][k], At[m][k], acc[ai][bj][m][n], 0, 0, 0); } } __builtin_amdgcn_s_setprio(0); } while (0)
#define PG8_WAIT_V(n) asm volatile("s_waitcnt vmcnt(" #n ")" ::: "memory")
#define PG8_WAIT_L(n) asm volatile("s_waitcnt lgkmcnt(" #n ")" ::: "memory")
#define PG8_BAR __builtin_amdgcn_s_barrier()
#define PG8_SCHED __builtin_amdgcn_sched_barrier(0)
    Unit cur, nxt; int ui = 0;
    if (!S.next(0, cur)) return;
    f32x4 acc[2][2][4][2];
#pragma unroll
    for (int a = 0; a < 2; ++a)
#pragma unroll
        for (int b = 0; b < 2; ++b)
#pragma unroll
            for (int m = 0; m < 4; ++m)
#pragma unroll
                for (int n = 0; n < 2; ++n) acc[a][b][m][n] = (f32x4){0.f, 0.f, 0.f, 0.f};
    bf16x8 At[4][2], B0[2][2], B1[2][2];
    const char* cA = (const char*)g.A + (size_t)cur.pm * tstepA + cur.aoff; const char* cB = (const char*)g.Bt + (size_t)cur.pn * tstepB + cur.boff;
    PG8_AOFFS(cA0, cA1, cur);
    PG8_STAGE(PG8_SB(0, 0), cB, voffB); PG8_STAGE(PG8_SB(0, 1), cB + hstepB, voffB); PG8_STAGE(PG8_SA(0, 0), cA, cA0); PG8_STAGE(PG8_SA(0, 1), cA, cA1);
    if (wr == 1) PG8_BAR;
    PG8_WAIT_V(2); PG8_BAR;
    PG8_STAGE(PG8_SB(1, 0), cB + kstep, voffB); PG8_STAGE(PG8_SA(1, 0), cA + kstep, cA0); PG8_STAGE(PG8_SB(1, 1), cB + hstepB + kstep, voffB);
    PG8_WAIT_V(6); PG8_BAR;
    for (;;) {
        const bool has_next = S.next(ui + 1, nxt);
        const char* nA = has_next ? (const char*)g.A + (size_t)nxt.pm * tstepA + nxt.aoff : cA; const char* nB = has_next ? (const char*)g.Bt + (size_t)nxt.pn * tstepB + nxt.boff : cB;
        if (has_next) PG8_AOFFS(nA0, nA1, nxt); else { _Pragma("unroll") for (int _i = 0; _i < 2; ++_i) { nA0[_i] = cA0[_i]; nA1[_i] = cA1[_i]; } }
        unsigned pf0_ = 0u, pf1_ = 0u, pf2_ = 0u, pf3_ = 0u;
#pragma nounroll
        for (int t = 0; t < nt; t += 2) {
            const bool last = (t == nt - 2);
            if constexpr (Epi::PREFETCH) { if (t == nt - 4) E.prefetch(cur, wr, wc, fr, fq, pf0_, pf1_, pf2_, pf3_); }
            const char* a1 = cA + (size_t)(t + 1) * kstep;
            const char* a2 = last ? nA : cA + (size_t)(t + 2) * kstep; const char* b2 = last ? nB : cB + (size_t)(t + 2) * kstep;
            const char* a3 = a2 + kstep; const char* b3 = b2 + kstep;
            unsigned sA0[2], sA1[2];
#pragma unroll
            for (int _i = 0; _i < 2; ++_i) { sA0[_i] = last ? nA0[_i] : cA0[_i]; sA1[_i] = last ? nA1[_i] : cA1[_i]; }
            PG8_LDB(B0, 0, 0); PG8_LDB(B1, 0, 1); PG8_SCHED; PG8_LDA(At, 0, 0); PG8_STAGE(PG8_SA(1, 1), a1, cA1);
            PG8_WAIT_V(8); PG8_WAIT_L(0); PG8_BAR; PG8_MMA(0, 0, At, B0); PG8_MMA(0, 1, At, B1); PG8_BAR; PG8_SCHED;
            PG8_LDA(At, 0, 1); PG8_STAGE(PG8_SB(0, 0), b2, voffB); PG8_STAGE(PG8_SB(0, 1), b2 + hstepB, voffB); PG8_STAGE(PG8_SA(0, 0), a2, sA0);
            PG8_WAIT_V(8); PG8_WAIT_L(0); PG8_BAR; PG8_MMA(1, 0, At, B0); PG8_MMA(1, 1, At, B1); PG8_BAR; PG8_SCHED;
            PG8_LDB(B0, 1, 0); PG8_LDB(B1, 1, 1); PG8_SCHED; PG8_LDA(At, 1, 0); PG8_STAGE(PG8_SA(0, 1), a2, sA1);
            PG8_WAIT_V(8); PG8_WAIT_L(0); PG8_BAR; PG8_MMA(0, 0, At, B0); PG8_MMA(0, 1, At, B1); PG8_BAR; PG8_SCHED;
            PG8_LDA(At, 1, 1); PG8_STAGE(PG8_SB(1, 0), b3, voffB); PG8_STAGE(PG8_SB(1, 1), b3 + hstepB, voffB); PG8_STAGE(PG8_SA(1, 0), a3, sA0);
            PG8_WAIT_V(8); PG8_WAIT_L(0); PG8_BAR; PG8_MMA(1, 0, At, B0); PG8_MMA(1, 1, At, B1); PG8_BAR; PG8_SCHED;
        }
        if constexpr (Epi::PREFETCH) asm volatile("" :: "v"(pf0_), "v"(pf1_), "v"(pf2_), "v"(pf3_));
        if constexpr (FP8) asm volatile("s_nop 15" ::: "memory");
        if (wr == 0) PG8_BAR;
        bool keep = false;
        if constexpr (Epi::CHAIN) keep = E.chain(acc, cur, wr, wc, fr, fq); else E(acc, cur, wr, wc, fr, fq);
        if (!has_next) break;
        if (!keep) {
#pragma unroll
        for (int a = 0; a < 2; ++a)
#pragma unroll
            for (int b = 0; b < 2; ++b)
#pragma unroll
                for (int m = 0; m < 4; ++m)
#pragma unroll
                    for (int n = 0; n < 2; ++n) acc[a][b][m][n] = (f32x4){0.f, 0.f, 0.f, 0.f};
        }
        cur = nxt; cA = nA; cB = nB; ++ui;
#pragma unroll
        for (int _i = 0; _i < 2; ++_i) { cA0[_i] = nA0[_i]; cA1[_i] = nA1[_i]; }
        if (wr == 1) PG8_BAR;
    }
    PG8_WAIT_V(0);
    PG8_BAR;
#undef PG8_AOFFS
#undef PG8_SA
#undef PG8_SB
#undef PG8_STAGE
#undef PG8_LDA
#undef PG8_LDB
#undef PG8_MMA
#undef PG8_WAIT_V
#undef PG8_WAIT_L
#undef PG8_BAR
#undef PG8_SCHED
}
}
namespace attn_body {
using bf16=__hip_bfloat16;
using bf16x8=__attribute__((ext_vector_type(8)))short;
using s16x4=__attribute__((ext_vector_type(4)))short;
using f32x16=__attribute__((ext_vector_type(16)))float;
using u32x4=__attribute__((ext_vector_type(4)))unsigned;
constexpr int SEQ=8192,D=64,DM=4096,OPITCH=512;
constexpr int NW=8,QBLK=32,QB=QBLK*NW,KVBLK=64,NQB=SEQ/QB;
constexpr int ATTN_UNIT_ROWS=QB;
__device__ __forceinline__ int crow(int r,int hi){return (r&3)+8*(r>>2)+4*hi;}
#define SBAR() __builtin_amdgcn_sched_barrier(0)
__device__ __forceinline__ void cmask(f32x16&p0,f32x16&p1,int jb,int qrel,int hi){
  const float NEG=-INFINITY; int kb=64*jb+4*hi;
  #pragma unroll
  for(int r=0;r<16;++r){int kv=kb+(r&3)+8*(r>>2); if(kv>qrel)p0[r]=NEG; if(kv+32>qrel)p1[r]=NEG;}
}

__device__ __forceinline__ void biasadd(f32x16&p0,f32x16&p1,const float*lp){
  #pragma unroll
  for(int r=0;r<16;r+=2){ const float a0=lp[59-((r&3)+8*(r>>2))],a1=lp[59-(((r+1)&3)+8*((r+1)>>2))],b0=lp[59-32-((r&3)+8*(r>>2))],b1=lp[59-32-(((r+1)&3)+8*((r+1)>>2))];
    p0[r]+=a0; p0[r+1]+=a1; p1[r]+=b0; p1[r+1]+=b1; __builtin_amdgcn_sched_barrier(0); }
}
constexpr int NSLOT=3, SLOTB=8192;
constexpr int LDS_K=0, LDS_V=NSLOT*SLOTB, LDS_WS=3*NSLOT*SLOTB, LDS_OST=LDS_WS+NW*64*4, LDS_LUT=LDS_OST+NW*4096, LDS_BYTES=LDS_LUT+640*4;
constexpr float C2=0.125f*1.4426950408889634f;
__device__ __forceinline__ void glds16(const void*gsrc,unsigned lds_dst){unsigned keep;
  asm volatile("s_mov_b32 %0, m0\n\ts_mov_b32 m0, %2\n\ts_nop 0\n\tglobal_load_lds_dwordx4 %1, off\n\ts_mov_b32 m0, %0":"=&s"(keep):"v"(gsrc),"s"(lds_dst):"memory");}
__device__ __forceinline__ void glds16s(const void*sbase,unsigned voff,unsigned lds_dst){unsigned keep;
  asm volatile("s_mov_b32 %0, m0\n\ts_mov_b32 m0, %3\n\ts_nop 0\n\tglobal_load_lds_dwordx4 %1, %2\n\ts_mov_b32 m0, %0":"=&s"(keep):"v"(voff),"s"(sbase),"s"(lds_dst):"memory");}
__device__ __forceinline__ float max3f(float a,float b,float c){float r;asm("v_max3_f32 %0, %1, %2, %3":"=v"(r):"v"(a),"v"(b),"v"(c));return r;}
__device__ __forceinline__ float max2f(float a,float b){float r;asm("v_max_f32_e32 %0, %1, %2":"=v"(r):"v"(a),"v"(b));return r;}
__device__ __forceinline__ float fadd_s(float a,float b){float r;asm("v_add_f32_e32 %0, %1, %2":"=v"(r):"v"(a),"v"(b));return r;}
__device__ __forceinline__ float fsub_s(float a,float b){float r;asm("v_sub_f32_e32 %0, %1, %2":"=v"(r):"v"(a),"v"(b));return r;}
typedef float f32x2_t __attribute__((ext_vector_type(2))); typedef __bf16 bf16x2_t __attribute__((ext_vector_type(2)));
__device__ __forceinline__ unsigned cvtpk_s(float lo,float hi){f32x2_t v={lo,hi};bf16x2_t b=__builtin_convertvector(v,bf16x2_t);return __builtin_bit_cast(unsigned,b);}
#define WAIT_BAR(N) asm volatile("s_waitcnt vmcnt(" #N ") lgkmcnt(0)\n\ts_barrier":::"memory")

__device__ __forceinline__ void qkt(f32x16&p0,f32x16&p1,const char*Kslot,const bf16x8*qr,const f32x16&negm,int r32,int hi){
  const char*kb=Kslot+hi*1024+r32*16;
  #pragma unroll
  for(int d0=0;d0<4;++d0){
    const bf16x8 b0=*reinterpret_cast<const bf16x8*>(kb+d0*2048);
    const bf16x8 b1=*reinterpret_cast<const bf16x8*>(kb+d0*2048+512);
    if(d0==0){p0=__builtin_amdgcn_mfma_f32_32x32x16_bf16(b0,qr[0],negm,0,0,0);p1=__builtin_amdgcn_mfma_f32_32x32x16_bf16(b1,qr[0],negm,0,0,0);}
    else{p0=__builtin_amdgcn_mfma_f32_32x32x16_bf16(b0,qr[d0],p0,0,0,0);p1=__builtin_amdgcn_mfma_f32_32x32x16_bf16(b1,qr[d0],p1,0,0,0);}}
}
typedef __attribute__((address_space(3))) const char* lds_cptr;
typedef short v4i16_t __attribute__((ext_vector_type(4)));
__device__ __forceinline__ void kload8(bf16x8*kf,lds_cptr kp){
  kf[0]=*(const __attribute__((address_space(3))) bf16x8*)(kp);      kf[1]=*(const __attribute__((address_space(3))) bf16x8*)(kp+512);
  kf[2]=*(const __attribute__((address_space(3))) bf16x8*)(kp+2048); kf[3]=*(const __attribute__((address_space(3))) bf16x8*)(kp+2560);
  kf[4]=*(const __attribute__((address_space(3))) bf16x8*)(kp+4096); kf[5]=*(const __attribute__((address_space(3))) bf16x8*)(kp+4608);
  kf[6]=*(const __attribute__((address_space(3))) bf16x8*)(kp+6144); kf[7]=*(const __attribute__((address_space(3))) bf16x8*)(kp+6656);
}
__device__ __forceinline__ void kload2(bf16x8*kf,lds_cptr kp,int j){ kf[2*j]=*(const __attribute__((address_space(3))) bf16x8*)(kp+j*2048); kf[2*j+1]=*(const __attribute__((address_space(3))) bf16x8*)(kp+j*2048+512); }
__device__ __forceinline__ s16x4 vtr(lds_cptr p){ return __builtin_bit_cast(s16x4,__builtin_amdgcn_ds_read_tr16_b64_v4i16((__attribute__((address_space(3))) v4i16_t*)p)); }
__device__ __forceinline__ float rowmax(const f32x16&p0,const f32x16&p1){
  float a=max3f(p0[0],p0[1],p1[0]),b=max3f(p0[2],p0[3],p1[1]);a=max3f(a,p1[2],p1[3]);
  #pragma unroll
  for(int r=4;r<16;r+=4){a=max3f(a,p0[r],p0[r+1]);b=max3f(b,p0[r+2],p0[r+3]);a=max3f(a,p1[r],p1[r+1]);b=max3f(b,p1[r+2],p1[r+3]);}
  const float m=max2f(a,b);
  auto rr=__builtin_amdgcn_permlane32_swap(__float_as_uint(m),__float_as_uint(m),false,false);
  return max2f(__uint_as_float(rr[0]),__uint_as_float(rr[1]));
}
__device__ __forceinline__ void pv(f32x16*o,int vb,bf16x8 pa0,bf16x8 pa1,bf16x8 pa2,bf16x8 pa3){
  #pragma unroll
  for(int d0=0;d0<4;++d0){s16x4 lo[4],hi[4];
    #pragma unroll
    for(int ks=0;ks<4;++ks){
      asm volatile("ds_read_b64_tr_b16 %0,%1 offset:%c2":"=&v"(lo[ks]):"v"(vb),"i"(d0*4096+ks*1024):"memory");
      asm volatile("ds_read_b64_tr_b16 %0,%1 offset:%c2":"=&v"(hi[ks]):"v"(vb),"i"(d0*4096+ks*1024+512):"memory");}
    asm volatile("s_waitcnt lgkmcnt(0)":::"memory");SBAR();
    #define PK(k) (bf16x8){lo[k][0],lo[k][1],lo[k][2],lo[k][3],hi[k][0],hi[k][1],hi[k][2],hi[k][3]}
    o[d0]=__builtin_amdgcn_mfma_f32_32x32x16_bf16(pa0,PK(0),o[d0],0,0,0);
    o[d0]=__builtin_amdgcn_mfma_f32_32x32x16_bf16(pa1,PK(1),o[d0],0,0,0);
    o[d0]=__builtin_amdgcn_mfma_f32_32x32x16_bf16(pa2,PK(2),o[d0],0,0,0);
    o[d0]=__builtin_amdgcn_mfma_f32_32x32x16_bf16(pa3,PK(3),o[d0],0,0,0);
    #undef PK
  }
}

#ifndef ATTN_STORE16
#define ATTN_STORE16(p,v) (*(u32x4*)(p)=(v))
#endif
template<int THRL,bool NOBIAS=false> __device__ __forceinline__ void attn_unit(int qb,const bf16*Qh,const bf16*__restrict__ Kh,const bf16*__restrict__ Vh,bf16*Oh,const float* __restrict__ rel_table,int head,char*shm,const int tid){
  const int lane=tid&63,r32=lane&31,hi=lane>>5; const int wid=__builtin_amdgcn_readfirstlane(tid>>6);
  const int q0=qb*QB;
  const bf16*Qw=Qh+(long)(q0+wid*QBLK)*DM;
  const unsigned lds0=(unsigned)(uintptr_t)shm;
  float*wsf=(float*)(shm+LDS_WS)+wid*64;
  const unsigned koff=(unsigned)(lane*DM+wid*8)*2u;
  const unsigned voff=(unsigned)((16*(wid&3)+(lane>>2))*DM+(wid>>2)*32+(lane&3)*8)*2u;
  const unsigned kdst=lds0+LDS_K+wid*1024, vdst=lds0+LDS_V+wid*1024;
  #define DMA_K(t,slot) glds16s(Kh+(long)(t)*KVBLK*DM,koff,(unsigned)__builtin_amdgcn_readfirstlane(kdst+(slot)))
  #define DMA_V(t,slot) do{ glds16s(Vh+(long)(t)*KVBLK*DM,voff,(unsigned)__builtin_amdgcn_readfirstlane(vdst+2*(slot))); glds16s(Vh+64+(long)(t)*KVBLK*DM,voff,(unsigned)__builtin_amdgcn_readfirstlane(vdst+2*(slot)+8192)); }while(0)
  const int vb0=(int)(lds0+LDS_V)+((lane>>4)&1)*32+(lane&3)*8+(4*hi+((lane&15)>>2))*64;
  const char*Kbase=shm+LDS_K; bf16x8 kf[8];
  const lds_cptr shm3=(lds_cptr)shm; const lds_cptr kp0=shm3+LDS_K+hi*1024+r32*16; const lds_cptr vp0=shm3+LDS_V+((lane>>4)&1)*32+(lane&3)*8+(4*hi+((lane&15)>>2))*64;
  const int NT=(q0+QB)/KVBLK;
  { float*lut=(float*)(shm+LDS_LUT); const float t31=rel_table[31*4+head];
    for(int i=tid;i<640;i+=512){ const int d=i-256; float v=0.f;
      if(d>=0&&d<128){ int bk; if(d<16)bk=d; else { bk=16+(int)(logf((float)d*(1.f/16.f))/logf(8.f)*16.f); bk=bk<31?bk:31; } v=(rel_table[bk*4+head]-t31)*1.4426950408889634f; }
      lut[i]=v; } }
  DMA_K(0,0);DMA_V(0,0);DMA_K(1,SLOTB);
  bf16x8 qr[4];
  #pragma unroll
  for(int d0=0;d0<4;++d0)qr[d0]=*reinterpret_cast<const bf16x8*>(&Qw[(long)r32*DM+d0*16+hi*8]);
  float mhat=0.f,l_reg=0.f;f32x16 o[4];o[0]=f32x16{};o[1]=f32x16{};o[2]=f32x16{};o[3]=f32x16{};f32x16 negm=f32x16{};asm volatile("":"+v"(negm));
  const int qrel=wid*QBLK+r32;
  #define CMASK(P0,P1,t) do{int jb_=(t)-(NT-4); if(!NOBIAS&&jb_>=-2)biasadd(P0,P1,(const float*)(shm+LDS_LUT)+(wid*QBLK+r32-4*hi+256-59)-64*jb_); if(jb_>=0)cmask(P0,P1,jb_,qrel,hi);}while(0)
  bool resc=false;
  #define START(P0,P1) do{ const float rm=rowmax(P0,P1); resc=false; \
    { const float dl=rm; mhat=fadd_s(mhat,dl); \
      _Pragma("unroll") for(int r=0;r<16;++r){P0[r]=fsub_s(P0[r],dl);P1[r]=fsub_s(P1[r],dl);} \
      _Pragma("unroll") for(int r=0;r<16;++r)negm[r]=-mhat; asm volatile("":"+v"(negm)); } \
    _Pragma("unroll") for(int r=0;r<16;++r)P0[r]=__builtin_amdgcn_exp2f(P0[r]); }while(0)
  #define RESC() do{ if(resc){ asm volatile("s_waitcnt lgkmcnt(0)":::"memory"); \
      _Pragma("unroll") for(int d_=0;d_<4;++d_) _Pragma("unroll") for(int r=0;r<16;++r)o[d_][r]*=wsf[crow(r,hi)]; } }while(0)
  f32x16 pA0,pA1,pB0,pB1;
  int sl_prev=0,sl_cur=0,sl_next=SLOTB;
  #define ROT() do{sl_prev=sl_cur;sl_cur=sl_next;sl_next=(sl_next==(NSLOT-1)*SLOTB)?0:sl_next+SLOTB;}while(0)
  DMA_K(2,2*SLOTB);
  WAIT_BAR(3);
  qkt(pA0,pA1,Kbase,qr,negm,r32,hi);asm volatile("s_nop 15\n\ts_nop 7":"+v"(pA0),"+v"(pA1));CMASK(pA0,pA1,0);
  START(pA0,pA1);
  _Pragma("unroll") for(int r=0;r<16;++r)pA1[r]=__builtin_amdgcn_exp2f(pA1[r]);
  WAIT_BAR(0);
  DMA_K(3,0);DMA_V(1,SLOTB);
  ROT();
  kload8(kf,kp0+sl_cur);
  WAIT_BAR(3);
  s16x4 vlo[4],vhi[4]; u32x4 pw0,pw1,pw2,pw3;
  #define PKW(P,B) cvtpk_s(P[B],P[B+1])
  #define PAF(k) __builtin_bit_cast(bf16x8,pw##k)
  #define VFR(i) (bf16x8){vlo[i][0],vlo[i][1],vlo[i][2],vlo[i][3],vhi[i][0],vhi[i][1],vhi[i][2],vhi[i][3]}
  #define PIN(x) asm volatile("":"+v"(x))
  #define MX3(a,b,c) __builtin_fmaxf(__builtin_fmaxf((a),(b)),(c))
  #define GAPA(MF,A0,A1,A2,A3,W0,W1,PW) do{ MF; sacc+=A0; sacc+=A1; sacc+=A2; sacc+=A3; PIN(sacc); W0; W1; PIN(PW); SBAR(); }while(0)
  #define EX(v) __builtin_amdgcn_exp2f(v)
  #define GAPB(MF,X,B) do{ MF; X[B]=EX(X[B]); X[B+1]=EX(X[B+1]); X[B+2]=EX(X[B+2]); X[B+3]=EX(X[B+3]); PIN(X); SBAR(); }while(0)
  #define GAPB2(MF,X,B) do{ MF; X[B]=EX(X[B]); X[B+1]=EX(X[B+1]); PIN(X); SBAR(); }while(0)
  #define VRDS(i,f) do{ vlo[i]=vtr(vp_+(((f)>>2)*4096+((f)&3)*1024)); vhi[i]=vtr(vp_+(((f)>>2)*4096+((f)&3)*1024+512)); SBAR(); }while(0)
  #define VRD(i) do{ vlo[i]=vtr(vp_+(((i)>>2)*4096+((i)&3)*1024)); vhi[i]=vtr(vp_+(((i)>>2)*4096+((i)&3)*1024+512)); }while(0)
  #define KRD(G,j) do{ if(G){ kload2(kf,kp0+sl_next,j); SBAR(); } }while(0)
  #define STEP(C0,C1,P0,P1,t,GK,GV,GL) do{ SBAR(); \
    const lds_cptr vp_=vp0+2*sl_prev; \
    VRDS(0,0);  float sacc=(P0[0]+P0[1]); \
    GAPA(C0=__builtin_amdgcn_mfma_f32_32x32x16_bf16(kf[0],qr[0],negm,0,0,0), P0[2],P0[3],P0[4],P0[5],     pw0[0]=PKW(P0,0), pw0[1]=PKW(P0,2), pw0); \
    VRDS(1,4);  GAPA(C1=__builtin_amdgcn_mfma_f32_32x32x16_bf16(kf[1],qr[0],negm,0,0,0), P0[6],P0[7],P0[8],P0[9],     pw0[2]=PKW(P0,4), pw0[3]=PKW(P0,6), pw0); \
    VRDS(2,1);  GAPA(C0=__builtin_amdgcn_mfma_f32_32x32x16_bf16(kf[2],qr[1],C0,0,0,0),   P0[10],P0[11],P0[12],P0[13], pw1[0]=PKW(P0,8), pw1[1]=PKW(P0,10), pw1); \
    VRDS(3,5);  GAPA(C1=__builtin_amdgcn_mfma_f32_32x32x16_bf16(kf[3],qr[1],C1,0,0,0),   P0[14],P0[15],P1[0],P1[1],   pw1[2]=PKW(P0,12),pw1[3]=PKW(P0,14), pw1); \
     GAPA(C0=__builtin_amdgcn_mfma_f32_32x32x16_bf16(kf[4],qr[2],C0,0,0,0),   P1[2],P1[3],P1[4],P1[5],     pw2[0]=PKW(P1,0), pw2[1]=PKW(P1,2), pw2); \
     GAPA(C1=__builtin_amdgcn_mfma_f32_32x32x16_bf16(kf[5],qr[2],C1,0,0,0),   P1[6],P1[7],P1[8],P1[9],     pw2[2]=PKW(P1,4), pw2[3]=PKW(P1,6), pw2); \
     GAPA(C0=__builtin_amdgcn_mfma_f32_32x32x16_bf16(kf[6],qr[3],C0,0,0,0),   P1[10],P1[11],P1[12],P1[13], pw3[0]=PKW(P1,8), pw3[1]=PKW(P1,10), pw3); \
     GAPA(C1=__builtin_amdgcn_mfma_f32_32x32x16_bf16(kf[7],qr[3],C1,0,0,0),   P1[14],P1[15],0.f,0.f,       pw3[2]=PKW(P1,12),pw3[3]=PKW(P1,14), pw3); \
    l_reg+=sacc; \
    if(GK){DMA_K((t)+3,sl_cur);} if(GV){DMA_V((t)+1,sl_next);} \
    CMASK(C0,C1,t); \
    { float a=MX3(C0[0],C0[1],C1[0]),b=MX3(C0[2],C0[3],C1[1]); a=MX3(a,C1[2],C1[3]); \
      _Pragma("unroll") for(int r=4;r<16;r+=4){a=MX3(a,C0[r],C0[r+1]);b=MX3(b,C0[r+2],C0[r+3]);a=MX3(a,C1[r],C1[r+1]);b=MX3(b,C1[r+2],C1[r+3]);} \
      float rm=__builtin_fmaxf(a,b); { auto rr=__builtin_amdgcn_permlane32_swap(__float_as_uint(rm),__float_as_uint(rm),false,false); rm=__builtin_fmaxf(__uint_as_float(rr[0]),__uint_as_float(rr[1])); } \
      resc=false; \
      if(__builtin_expect(__any(rm>(float)THRL),0)){ const float dl=__builtin_fmaxf(rm,0.f); mhat+=dl; \
        _Pragma("unroll") for(int r=0;r<16;++r){C0[r]-=dl;C1[r]-=dl;} \
        _Pragma("unroll") for(int r=0;r<16;++r)negm[r]=-mhat; asm volatile("":"+v"(negm)); \
        const float f=__builtin_amdgcn_exp2f(-dl); l_reg*=f; if(hi==0)wsf[r32]=f; resc=true; } } \
    SBAR(); \
    GAPB2(o[0]=__builtin_amdgcn_mfma_f32_32x32x16_bf16(PAF(0),VFR(0),o[0],0,0,0), C0,0); VRDS(0,2); \
    GAPB2(o[1]=__builtin_amdgcn_mfma_f32_32x32x16_bf16(PAF(0),VFR(1),o[1],0,0,0), C0,2); VRDS(1,6); \
    KRD(GL,0); GAPB2(o[0]=__builtin_amdgcn_mfma_f32_32x32x16_bf16(PAF(1),VFR(2),o[0],0,0,0), C0,4); VRDS(2,3); \
    KRD(GL,1); GAPB2(o[1]=__builtin_amdgcn_mfma_f32_32x32x16_bf16(PAF(1),VFR(3),o[1],0,0,0), C0,6); VRDS(3,7); \
    KRD(GL,2); GAPB2(o[0]=__builtin_amdgcn_mfma_f32_32x32x16_bf16(PAF(2),VFR(0),o[0],0,0,0), C0,8); VRDS(0,8); \
    KRD(GL,3); GAPB2(o[1]=__builtin_amdgcn_mfma_f32_32x32x16_bf16(PAF(2),VFR(1),o[1],0,0,0), C0,10); VRDS(1,12); \
    GAPB2(o[0]=__builtin_amdgcn_mfma_f32_32x32x16_bf16(PAF(3),VFR(2),o[0],0,0,0), C0,12); VRDS(2,9); \
    GAPB2(o[1]=__builtin_amdgcn_mfma_f32_32x32x16_bf16(PAF(3),VFR(3),o[1],0,0,0), C0,14); VRDS(3,13); \
    GAPB2(o[2]=__builtin_amdgcn_mfma_f32_32x32x16_bf16(PAF(0),VFR(0),o[2],0,0,0), C1,0); VRDS(0,10); \
    GAPB2(o[3]=__builtin_amdgcn_mfma_f32_32x32x16_bf16(PAF(0),VFR(1),o[3],0,0,0), C1,2); VRDS(1,14); \
    GAPB2(o[2]=__builtin_amdgcn_mfma_f32_32x32x16_bf16(PAF(1),VFR(2),o[2],0,0,0), C1,4); VRDS(2,11); \
    GAPB2(o[3]=__builtin_amdgcn_mfma_f32_32x32x16_bf16(PAF(1),VFR(3),o[3],0,0,0), C1,6); VRDS(3,15); \
    GAPB2(o[2]=__builtin_amdgcn_mfma_f32_32x32x16_bf16(PAF(2),VFR(0),o[2],0,0,0), C1,8); \
    GAPB2(o[3]=__builtin_amdgcn_mfma_f32_32x32x16_bf16(PAF(2),VFR(1),o[3],0,0,0), C1,10); \
    GAPB2(o[2]=__builtin_amdgcn_mfma_f32_32x32x16_bf16(PAF(3),VFR(2),o[2],0,0,0), C1,12); \
    GAPB2(o[3]=__builtin_amdgcn_mfma_f32_32x32x16_bf16(PAF(3),VFR(3),o[3],0,0,0), C1,14); \
    }while(0)
  int t=1;
  #undef CMASK
  #define CMASK(P0,P1,t) do{}while(0)
  for(;t+(NOBIAS?5:7)<NT;t+=2){
    STEP(pB0,pB1,pA0,pA1,t,true,true,true);     WAIT_BAR(3); RESC(); ROT();
    STEP(pA0,pA1,pB0,pB1,t+1,true,true,true);   WAIT_BAR(3); RESC(); ROT();
  }
  #undef CMASK
  #define CMASK(P0,P1,t) do{int jb_=(t)-(NT-4); if(!NOBIAS&&jb_>=-2)biasadd(P0,P1,(const float*)(shm+LDS_LUT)+(wid*QBLK+r32-4*hi+256-59)-64*jb_); if(jb_>=0)cmask(P0,P1,jb_,qrel,hi);}while(0)
  #define ENDW(tt) do{ if((tt)+3<NT){WAIT_BAR(3);} else if((tt)+2<NT){WAIT_BAR(2);} else {WAIT_BAR(0);} }while(0)
  for(;t+1<NT;t+=2){
    STEP(pB0,pB1,pA0,pA1,t,(t+3<NT),(t+1<NT),(t+1<NT));       ENDW(t);   RESC(); ROT();
    STEP(pA0,pA1,pB0,pB1,t+1,(t+4<NT),(t+2<NT),(t+2<NT));     ENDW(t+1); RESC(); ROT();
  }
  STEP(pB0,pB1,pA0,pA1,NT-1,false,false,false); RESC();
  { float sacc=pB0[0]+pB0[1]; _Pragma("unroll") for(int r=2;r<16;++r)sacc+=pB0[r]; _Pragma("unroll") for(int r=0;r<16;++r)sacc+=pB1[r]; l_reg+=sacc;
    pw0=(u32x4){PKW(pB0,0),PKW(pB0,2),PKW(pB0,4),PKW(pB0,6)};pw1=(u32x4){PKW(pB0,8),PKW(pB0,10),PKW(pB0,12),PKW(pB0,14)};pw2=(u32x4){PKW(pB1,0),PKW(pB1,2),PKW(pB1,4),PKW(pB1,6)};pw3=(u32x4){PKW(pB1,8),PKW(pB1,10),PKW(pB1,12),PKW(pB1,14)};
    SBAR(); pv(o,vb0+2*sl_cur,PAF(0),PAF(1),PAF(2),PAF(3)); }
  #undef PKW
  #undef PAF
  #undef VFR
  #undef PIN
  #undef MX3
  #undef GAPA
  #undef GAPB
  #undef GAPB2
  #undef VRDS
  #undef EX
  #undef VRD
  #undef KRD
  #undef STEP
  #undef ENDW
  {auto rr=__builtin_amdgcn_permlane32_swap(__float_as_uint(l_reg),__float_as_uint(l_reg),false,false);l_reg=__uint_as_float(rr[0])+__uint_as_float(rr[1]);}
  if(hi==0)wsf[32+r32]=l_reg;asm volatile("s_waitcnt lgkmcnt(0)":::"memory");
  float rli[16];
  #pragma unroll
  for(int r=0;r<16;++r)rli[r]=__builtin_amdgcn_rcpf(wsf[32+crow(r,hi)]);
  bf16*Ow=Oh+(long)(q0+wid*QBLK)*OPITCH;
  { bf16*stg=(bf16*)(shm+LDS_OST)+wid*2048;
    #pragma unroll
    for(int p=0;p<2;++p){
      #pragma unroll
      for(int r=0;r<16;++r){const int orow=crow(r,hi);
        #pragma unroll
        for(int d0=0;d0<2;++d0)stg[orow*64+d0*32+r32]=__float2bfloat16(o[2*p+d0][r]*rli[r]);}
      asm volatile("s_waitcnt lgkmcnt(0)":::"memory");
      #pragma unroll
      for(int i=0;i<4;++i){const int row=i*8+(lane>>3),ch=lane&7; const u32x4 v=*(const u32x4*)(stg+row*64+ch*8); ATTN_STORE16(Ow+(long)row*OPITCH+p*64+ch*8,v);}
      asm volatile("s_waitcnt lgkmcnt(0)":::"memory"); } }
  asm volatile("s_waitcnt lgkmcnt(0)\n\ts_barrier":::"memory");
  #undef DMA_K
  #undef DMA_V
  #undef CMASK
  #undef START
  #undef RESC
  #undef ROT
}
constexpr int ATTN_LDS_BYTES=LDS_BYTES;
#undef SBAR
#undef WAIT_BAR
}
#define XB_TMO      128
#define XB_XCNT(j)  (256  + 64 * (j))
#define XB_XSUB(j)  (1280 + 64 * (j))
#define XB_XGEN(j)  (2304 + 64 * (j))
#define XB_TOP      3328
#define XB_TOPGEN   3392
#define XCD_BAR_WORDS 3456
#define XB_SPIN_CAP (1u << 18)

__device__ __forceinline__ unsigned xb_ld(unsigned* p)              { return __hip_atomic_load(p, __ATOMIC_RELAXED, __HIP_MEMORY_SCOPE_AGENT); }
__device__ __forceinline__ unsigned xb_add(unsigned* p, unsigned v) { return __hip_atomic_fetch_add(p, v, __ATOMIC_RELAXED, __HIP_MEMORY_SCOPE_AGENT); }
__device__ __forceinline__ unsigned xb_xcc_id() { return (unsigned)__builtin_amdgcn_s_getreg((3 << 11) | 20) & 0xFu; }
#define XB_SPIN(cond, bar) do { unsigned _sp = 0; while (cond) { __builtin_amdgcn_s_sleep(1); \
    if ((++_sp & 255u) == 0u) { if (xb_ld(&(bar)[XB_TMO])) break; if (_sp > XB_SPIN_CAP) { atomicAdd(&(bar)[XB_TMO], 1u); break; } } } } while (0)

struct XcdBarrier {
    unsigned* bar; unsigned x;
    volatile LAS unsigned* st;
};

__device__ __forceinline__ XcdBarrier xcd_barrier_post(unsigned* bar, volatile LAS unsigned* st) {
    XcdBarrier b; b.bar = bar; b.x = xb_xcc_id(); b.st = st;
    if (threadIdx.x == 0) (void)xb_add(&bar[XB_XCNT(b.x)], 1u);
    return b;
}
__device__ __forceinline__ void xcd_barrier_complete(unsigned* bar, unsigned x, unsigned& nloc, unsigned& nx) {
    const unsigned G = gridDim.x * gridDim.y * gridDim.z;
    unsigned sum, cnt, mine, sp = 0u;
    for (;;) {
        sum = 0u; cnt = 0u; mine = 0u;
#pragma unroll
        for (unsigned j = 0; j < 16; ++j) { const unsigned c = xb_ld(&bar[XB_XCNT(j)]); sum += c; cnt += (c > 0u) ? 1u : 0u; mine = (j == x) ? c : mine; }
        if (sum == G) break;
        __builtin_amdgcn_s_sleep(1);
        if ((++sp & 255u) == 0u) { if (xb_ld(&bar[XB_TMO])) break; if (sp > XB_SPIN_CAP) { atomicAdd(&bar[XB_TMO], 1u); break; } }
    }
    nloc = mine > 0u ? mine : 1u; nx = cnt > 0u ? cnt : 1u;
}

__device__ __forceinline__ void xcd_barrier(const XcdBarrier& b) {
    asm volatile("s_waitcnt vmcnt(0)" ::: "memory");
    __syncthreads();
    if (threadIdx.x == 0) {
        unsigned* bar = b.bar;
        __builtin_amdgcn_s_waitcnt(0);
        unsigned nloc = b.st[0], nx = b.st[1];
        if (nloc == 0u) { xcd_barrier_complete(bar, b.x, nloc, nx); b.st[0] = nloc; b.st[1] = nx; }
        const unsigned old = xb_add(&bar[XB_XSUB(b.x)], 1u);
        const unsigned gen = old / nloc;
        if (old + 1u == (gen + 1u) * nloc) {
            __builtin_amdgcn_fence(__ATOMIC_RELEASE, "agent");
            asm volatile("s_waitcnt vmcnt(0)" ::: "memory");
            const unsigned og = xb_add(&bar[XB_TOP], 1u);
            const unsigned tg = og / nx;
            if (og + 1u == (tg + 1u) * nx) xb_add(&bar[XB_TOPGEN], 1u);
            else XB_SPIN(xb_ld(&bar[XB_TOPGEN]) == tg, bar);
            __builtin_amdgcn_fence(__ATOMIC_ACQUIRE, "agent");
            xb_add(&bar[XB_XGEN(b.x)], 1u);
            asm volatile("s_waitcnt vmcnt(0)" ::: "memory");
        } else {
            XB_SPIN(xb_ld(&bar[XB_XGEN(b.x)]) == gen, bar);
            __builtin_amdgcn_fence(__ATOMIC_ACQUIRE, "agent");
            asm volatile("s_waitcnt vmcnt(0)" ::: "memory");
        }
    }
    __syncthreads();
}
struct Args { const float* in[27]; float* out; unsigned char* ws; int ph_lo, ph_hi, li, pad; };
enum { I_X = 0, I_MEM, I_REL, I_ANORM, I_WIN, I_BGATE, I_CONV, I_ALOG, I_DTB, I_DNON, I_DAQN, I_DAKN, I_LAM, I_SUBLN, I_MEMNORM, I_WMKV, I_MXQN, I_MXKN, I_WBR, I_WOUT, I_FNORM,
       I_WR, I_BR, I_WGU, I_BGU, I_WD, I_BD };

#ifndef MOE_FP8
#define MOE_FP8 1
#endif
constexpr float W8_SCALE = 64.f, A8_SCALE = 4.f, ACC8_SCALE = 1.f / (W8_SCALE * A8_SCALE);
#ifndef TR_DEPTH3
#define TR_DEPTH3 0
#endif
#ifndef NORM_IN_EPI
#define NORM_IN_EPI 1
#endif
#ifndef GATE_U8
#define GATE_U8 1
#endif
DI unsigned pk4u8(float a, float b, float c, float d) {
    const unsigned fa = __builtin_bit_cast(unsigned, __builtin_fmaf(a, 255.f, 8388608.f)), fb = __builtin_bit_cast(unsigned, __builtin_fmaf(b, 255.f, 8388608.f));
    const unsigned fc = __builtin_bit_cast(unsigned, __builtin_fmaf(c, 255.f, 8388608.f)), fd = __builtin_bit_cast(unsigned, __builtin_fmaf(d, 255.f, 8388608.f));
    return __builtin_amdgcn_perm(fb, fa, 0x0c0c0400u) | __builtin_amdgcn_perm(fd, fc, 0x04000c0cu);
}
#ifndef P1_FA0
#define P1_FA0 0
#define P1_FA1 0
#endif
DI constexpr bool p1_isf8(int pn) { return pn >= 16 || (pn >= P1_FA0 && pn < P1_FA1); }
DI void tr_item(const float* __restrict__ W, size_t ldw, int k0, int c0, bf16* WT, int K, size_t drow0, LAS float* scr, int lane, float sc = 1.f) {
    float v[64];
    const float* wp = W + (size_t)k0 * ldw + c0 + lane;
#pragma unroll
    for (int k = 0; k < 64; ++k) v[k] = wp[(size_t)k * ldw];
#pragma unroll
    for (int k = 0; k < 64; ++k) scr[k * 65 + lane] = v[k] * sc;
    LDS_WAIT();
    const int c = lane & 7;
#pragma unroll
    for (int j = 0; j < 8; ++j) { const int n = (lane >> 3) + 8 * j; const LAS float* s = scr + (8 * c) * 65 + n;
        v4u o; o.x = pk2(s[0 * 65], s[1 * 65]); o.y = pk2(s[2 * 65], s[3 * 65]); o.z = pk2(s[4 * 65], s[5 * 65]); o.w = pk2(s[6 * 65], s[7 * 65]);
        *(v4u*)(WT + (drow0 + n) * K + k0 + 8 * c) = o; }
    LDS_WAIT();
}

DI void tr_item8(const float* __restrict__ W, size_t ldw, int k0, int c0, unsigned char* WT, int K, size_t drow0, LAS float* scr, int lane) {
    float v[64];
    const float* wp = W + (size_t)k0 * ldw + c0 + lane;
#pragma unroll
    for (int k = 0; k < 64; ++k) v[k] = wp[(size_t)k * ldw];
#pragma unroll
    for (int k = 0; k < 64; ++k) scr[k * 65 + lane] = v[k] * W8_SCALE;
    LDS_WAIT();
    const int c = lane & 7;
#pragma unroll
    for (int j = 0; j < 8; ++j) { const int n = (lane >> 3) + 8 * j; const LAS float* s = scr + (8 * c) * 65 + n;
        v2u o; o.x = pk4f8(s[0 * 65], s[1 * 65], s[2 * 65], s[3 * 65]); o.y = pk4f8(s[4 * 65], s[5 * 65], s[6 * 65], s[7 * 65]);
        *(v2u*)(WT + (drow0 + n) * K + k0 + 8 * c) = o; }
    LDS_WAIT();
}
#if MOE_FP8
struct TrDesc { const float* wp; size_t ldw; unsigned char* dst; int K; };
DI TrDesc moe_tr_desc(const Args& a, int it, int lane) {
    constexpr int I_GU = 16 * 32 * NEXP;
    unsigned char* ws = a.ws; TrDesc d;
    if (it < I_GU) { const int e = it / 512, q = it % 512, kb = q / 32, nb = q % 32; const int n0 = nb * 64, pn = n0 >> 8, bj = (n0 >> 7) & 1, i0 = n0 & 127;
        d.wp = a.in[I_WGU] + (size_t)e * 1024 * 2048 + (size_t)(kb * 64) * 2048 + (bj * 1024 + 128 * pn + i0) + lane; d.ldw = 2048;
        d.dst = (ws + WS_WGU) + ((size_t)e * 2048 + n0) * 1024 + kb * 64; d.K = 1024; }
    else { const int r = it - I_GU; const int e = r / 256, q = r % 256, kb = q / 16, nb = q % 16;
        d.wp = a.in[I_WD] + (size_t)e * 1024 * 1024 + (size_t)(kb * 64) * 1024 + nb * 64 + lane; d.ldw = 1024;
        d.dst = (ws + WS_WD) + ((size_t)e * 1024 + nb * 64) * 1024 + kb * 64; d.K = 1024; }
    return d;
}
#define TR_LOAD(v, d) do { _Pragma("unroll") for (int k_ = 0; k_ < 64; ++k_) v[k_] = __builtin_nontemporal_load((d).wp + (size_t)k_ * (d).ldw); } while (0)
#define TR_STORE(v, d) do { _Pragma("unroll") for (int k_ = 0; k_ < 64; ++k_) scr[k_ * 65 + lane] = v[k_] * W8_SCALE; \
        LDS_WAIT(); const int c_ = lane & 7; \
        _Pragma("unroll") for (int j_ = 0; j_ < 8; ++j_) { const int n_ = (lane >> 3) + 8 * j_; const LAS float* s_ = scr + (8 * c_) * 65 + n_; \
            v2u o_; o_.x = pk4f8(s_[0 * 65], s_[1 * 65], s_[2 * 65], s_[3 * 65]); o_.y = pk4f8(s_[4 * 65], s_[5 * 65], s_[6 * 65], s_[7 * 65]); \
            __builtin_nontemporal_store(o_, (v2u*)((d).dst + (size_t)n_ * (d).K + 8 * c_)); } \
        LDS_WAIT(); } while (0)
#else
struct TrDesc { const float* wp; size_t ldw; bf16* dst; int K; };
DI TrDesc moe_tr_desc(const Args& a, int it, int lane) {
    constexpr int I_GU = 16 * 32 * NEXP;
    unsigned char* ws = a.ws; TrDesc d;
    if (it < I_GU) { const int e = it / 512, q = it % 512, kb = q / 32, nb = q % 32; const int n0 = nb * 64, pn = n0 >> 8, bj = (n0 >> 7) & 1, i0 = n0 & 127;
        d.wp = a.in[I_WGU] + (size_t)e * 1024 * 2048 + (size_t)(kb * 64) * 2048 + (bj * 1024 + 128 * pn + i0) + lane; d.ldw = 2048;
        d.dst = (bf16*)(ws + WS_WGU) + ((size_t)e * 2048 + n0) * 1024 + kb * 64; d.K = 1024; }
    else { const int r = it - I_GU; const int e = r / 256, q = r % 256, kb = q / 16, nb = q % 16;
        d.wp = a.in[I_WD] + (size_t)e * 1024 * 1024 + (size_t)(kb * 64) * 1024 + nb * 64 + lane; d.ldw = 1024;
        d.dst = (bf16*)(ws + WS_WD) + ((size_t)e * 1024 + nb * 64) * 1024 + kb * 64; d.K = 1024; }
    return d;
}
#define TR_LOAD(v, d) do { _Pragma("unroll") for (int k_ = 0; k_ < 64; ++k_) v[k_] = (d).wp[(size_t)k_ * (d).ldw]; } while (0)
#define TR_STORE(v, d) do { _Pragma("unroll") for (int k_ = 0; k_ < 64; ++k_) scr[k_ * 65 + lane] = v[k_]; \
        LDS_WAIT(); const int c_ = lane & 7; \
        _Pragma("unroll") for (int j_ = 0; j_ < 8; ++j_) { const int n_ = (lane >> 3) + 8 * j_; const LAS float* s_ = scr + (8 * c_) * 65 + n_; \
            v4u o_; o_.x = pk2(s_[0 * 65], s_[1 * 65]); o_.y = pk2(s_[2 * 65], s_[3 * 65]); o_.z = pk2(s_[4 * 65], s_[5 * 65]); o_.w = pk2(s_[6 * 65], s_[7 * 65]); \
            *(v4u*)((d).dst + (size_t)n_ * (d).K + 8 * c_) = o_; } \
        LDS_WAIT(); } while (0)
#endif
DI void moe_transposes(const Args& a, LAS unsigned char* lds, int part, int nparts, int wave, int lane) {
    LAS float* scr = (LAS float*)(lds + wave * 16640);
    constexpr int NIT = 16 * 32 * NEXP + 16 * 16 * NEXP;
    const int per = (NIT + nparts * 8 - 1) / (nparts * 8), stride = 1;
    int it = (part * 8 + wave) * per; const int it_end = (it + per < NIT) ? it + per : NIT;
    if (it >= it_end) return;
#if TR_DEPTH3
    float vA[64], vB[64], vC[64];
    TrDesc dA = moe_tr_desc(a, it, lane), dB = dA, dC = dA;
    TR_LOAD(vA, dA);
    if (it + 1 < it_end) { dB = moe_tr_desc(a, it + 1, lane); TR_LOAD(vB, dB); }
    for (;;) {
        if (it + 2 < it_end) { dC = moe_tr_desc(a, it + 2, lane); TR_LOAD(vC, dC); }
        TR_STORE(vA, dA);
        if (it + 1 >= it_end) break;
        if (it + 3 < it_end) { dA = moe_tr_desc(a, it + 3, lane); TR_LOAD(vA, dA); }
        TR_STORE(vB, dB);
        if (it + 2 >= it_end) break;
        if (it + 4 < it_end) { dB = moe_tr_desc(a, it + 4, lane); TR_LOAD(vB, dB); }
        TR_STORE(vC, dC);
        if (it + 3 >= it_end) break;
        it += 3;
    }
#else
    float vA[64], vB[64];
    TrDesc dA = moe_tr_desc(a, it, lane), dB = dA;
    TR_LOAD(vA, dA);
    for (;;) {
        const bool hb = it + stride < it_end;
        if (hb) { dB = moe_tr_desc(a, it + stride, lane); TR_LOAD(vB, dB); }
        TR_STORE(vA, dA);
        if (!hb) break;
        it += stride;
        const bool ha = it + stride < it_end;
        if (ha) { dA = moe_tr_desc(a, it + stride, lane); TR_LOAD(vA, dA); }
        TR_STORE(vB, dB);
        if (!ha) break;
        it += stride;
    }
#endif
}
DI void p3_small_copies(const Args& a, LAS unsigned char* lds, int part, int nparts, int wave, int lane) {
    unsigned char* ws = a.ws; LAS float* scr = (LAS float*)(lds + wave * 16640);
    constexpr int I_BRI = 3 * 8 * 16, I_OUT = 16 * 16;
    for (int it = part * 8 + wave; it < I_BRI + I_OUT; it += nparts * 8) {
        int r = it;
        if (r < I_BRI) { const int br = r / 128, q = r % 128, kb = q / 16, nb = q % 16;
            tr_item(a.in[I_WBR] + (size_t)br * 512 * 1024, 1024, kb * 64, nb * 64, (bf16*)(ws + WS_WB), 512, (size_t)br * 1024 + nb * 64, scr, lane, GATE_U8 ? (1.f / 255.f) : 1.f); continue; } r -= I_BRI;
        { const int kb = r / 16, nb = r % 16;
            tr_item(a.in[I_WOUT], 1024, kb * 64, nb * 64, (bf16*)(ws + WS_WOUT), 1024, (size_t)nb * 64, scr, lane); }
    }
}
DI void p0_prologue(const Args& a, LAS unsigned char* lds, int vcu, int G, int wave, int lane, int pmode = 0) {
    unsigned char* ws = a.ws;
    LAS float* scr = (LAS float*)(lds + wave * 16640);
    const int gw = vcu * 8 + wave, NGW = G * 8;
    constexpr int I_IN = 16 * 112, I_GU = 16 * 32 * NEXP, I_DN = 16 * 16 * NEXP, I_BRI = 3 * 8 * 16, I_OUT = 16 * 16, I_MK = 16 * 16;
    constexpr int NITEMS = I_IN + I_MK; (void)I_GU; (void)I_DN; (void)I_BRI; (void)I_OUT;
#define P0_ITEMS() do {     for (int it = gw; it < ((pmode & 1) ? 0 : NITEMS); it += NGW) { \
        int r = it; \
        if (r < I_IN) { const int kb = r / 112, nb = r % 112; const int n0 = nb * 64; \
            if (p1_isf8(n0 >> 8)) tr_item8(a.in[I_WIN], INW, kb * 64, n0 < 2048 ? n0 : n0 + 8, ws + WS_WIN8, 1024, (size_t)n0, scr, lane); \
            else tr_item(a.in[I_WIN], INW, kb * 64, n0 < 2048 ? n0 : n0 + 8, (bf16*)(ws + WS_WIN), 1024, (size_t)n0, scr, lane); \
            continue; } r -= I_IN; \
        { const int kb = r / 16, nb = r % 16; \
            tr_item(a.in[I_WMKV], 1024, kb * 64, nb * 64, (bf16*)(ws + WS_WMKV), 1024, (size_t)nb * 64, scr, lane); } \
    } } while (0)
    const bool items_first = (__builtin_amdgcn_readfirstlane((int)blockIdx.x) & 1) == 0;
    if (items_first) P0_ITEMS();
    if (!(pmode & 2)) {
        const float* win = a.in[I_WIN];
        f32x4 gv[4];
#pragma unroll
        for (int j = 0; j < 4; ++j) gv[j] = ((const f32x4*)a.in[I_ANORM])[lane + 64 * j];
        f32x4 wa[4][4], wb[4][4];
#pragma unroll
        for (int j = 0; j < 4; ++j)
#pragma unroll
            for (int c = 0; c < 4; ++c) { const f32x4* p = (const f32x4*)(win + (size_t)(4 * lane + 256 * j + c) * INW + 2048); wa[j][c] = p[0]; wb[j][c] = p[1]; }
        const float alog = a.in[I_ALOG][lane & 3], dtb = a.in[I_DTB][lane & 3];
        float* G_ = (float*)(ws + WS_G); float* B_ = (float*)(ws + WS_BETA);
        bf16* H = (bf16*)(ws + WS_H);
        f32x4 nv[4];
        { const f32x4* xr = (const f32x4*)(a.in[I_X] + (size_t)gw * D) + lane;
#pragma unroll
          for (int j = 0; j < 4; ++j) nv[j] = __builtin_nontemporal_load(xr + 64 * j); }
        for (int m = gw; m < T; m += NGW) {
            f32x4 v[4]; float ss = 0.f;
#pragma unroll
            for (int j = 0; j < 4; ++j) { v[j] = nv[j]; ss += (v[j].x * v[j].x + v[j].y * v[j].y) + (v[j].z * v[j].z + v[j].w * v[j].w); }
            { const int mn = (m + NGW < T) ? m + NGW : m; const f32x4* xr = (const f32x4*)(a.in[I_X] + (size_t)mn * D) + lane;
#pragma unroll
              for (int j = 0; j < 4; ++j) nv[j] = __builtin_nontemporal_load(xr + 64 * j); }
            const float rstd = rsqrtf(wave_sum(ss) * (1.f / D) + EPS);
            f32x4 pa = {0.f, 0.f, 0.f, 0.f}, pb = {0.f, 0.f, 0.f, 0.f};
            unsigned* o4 = (unsigned*)(ws + WS_H8 + (size_t)m * D) + lane;
            unsigned long long* o8 = (unsigned long long*)(H + (size_t)m * D) + lane;
#pragma unroll
            for (int j = 0; j < 4; ++j) { v[j] = v[j] * rstd * gv[j];
                o4[64 * j] = pk4f8(v[j].x * A8_SCALE, v[j].y * A8_SCALE, v[j].z * A8_SCALE, v[j].w * A8_SCALE);
                o8[64 * j] = (unsigned long long)pk2(v[j].x, v[j].y) | ((unsigned long long)pk2(v[j].z, v[j].w) << 32);
                pa += wa[j][0] * v[j].x + wa[j][1] * v[j].y + wa[j][2] * v[j].z + wa[j][3] * v[j].w;
                pb += wb[j][0] * v[j].x + wb[j][1] * v[j].y + wb[j][2] * v[j].z + wb[j][3] * v[j].w; }
            pa.x = wave_sum(pa.x); pa.y = wave_sum(pa.y); pa.z = wave_sum(pa.z); pa.w = wave_sum(pa.w);
            pb.x = wave_sum(pb.x); pb.y = wave_sum(pb.y); pb.z = wave_sum(pb.z); pb.w = wave_sum(pb.w);
            if (lane < 4) {
                const float av = lane == 0 ? pa.x : lane == 1 ? pa.y : lane == 2 ? pa.z : pa.w;
                const float bv = lane == 0 ? pb.x : lane == 1 ? pb.y : lane == 2 ? pb.z : pb.w;
                const float z = av + dtb; const float sp = z > 20.f ? z : log1pf(expf(z));
                G_[(size_t)m * 4 + lane] = -expf(alog) * sp;
                B_[(size_t)m * 4 + lane] = 1.f / (1.f + expf(-bv));
            }
        }
    }
    {
        f32x4 gv[4];
#pragma unroll
        for (int j = 0; j < 4; ++j) gv[j] = ((const f32x4*)a.in[I_MEMNORM])[lane + 64 * j];
        bf16* MN = (bf16*)(ws + WS_MEMN);
        for (int m = gw; m < BATCH * NMEM; m += NGW) {
            const f32x4* xr = (const f32x4*)(a.in[I_MEM] + (size_t)m * D) + lane;
            f32x4 v[4]; float ss = 0.f;
#pragma unroll
            for (int j = 0; j < 4; ++j) { v[j] = xr[64 * j]; ss += (v[j].x * v[j].x + v[j].y * v[j].y) + (v[j].z * v[j].z + v[j].w * v[j].w); }
            const float rstd = rsqrtf(wave_sum(ss) * (1.f / D) + EPS);
            unsigned long long* o8 = (unsigned long long*)(MN + (size_t)m * D) + lane;
#pragma unroll
            for (int j = 0; j < 4; ++j) { v[j] = v[j] * rstd * gv[j]; o8[64 * j] = (unsigned long long)pk2(v[j].x, v[j].y) | ((unsigned long long)pk2(v[j].z, v[j].w) << 32); }
        }
    }
    if (!items_first) P0_ITEMS();
#undef P0_ITEMS
}

template <bool F8>
struct EpiPT {
    static constexpr bool PERM = true; static constexpr bool CHAIN = false; static constexpr bool PREFETCH = false;
    bf16* O; const float* b_gate; int skip; bf16* GF;
    LAS float* EX; const float* daqn; const float* dakn; const float* mxqn;
    DI void operator()(const f32x4 (&acc)[2][2][4][2], const pg8::Unit& u, int wr, int wc, int fr, int fq) const {
        if (skip == 1) { f32x4 s_ = {0.f, 0.f, 0.f, 0.f}; _Pragma("unroll") for (int a_ = 0; a_ < 2; ++a_) _Pragma("unroll") for (int b_ = 0; b_ < 2; ++b_) _Pragma("unroll") for (int m_ = 0; m_ < 4; ++m_) _Pragma("unroll") for (int n_ = 0; n_ < 2; ++n_) s_ += acc[a_][b_][m_][n_]; if (s_.x + s_.y + s_.z + s_.w == 123.456f) O[0] = 0; return; }
        const int row0 = u.pm * 256 + wr * 64 + fr, col0 = u.pn * 256 + wc * 32 + 8 * fq;
        const bool isg = u.pn >= 16;
        f32x4 bv[2][2];
#pragma unroll
        for (int bj = 0; bj < 2; ++bj)
#pragma unroll
            for (int n = 0; n < 2; ++n) bv[bj][n] = isg ? *(const f32x4*)(b_gate + (col0 - 4096) + bj * 128 + 4 * n) : (f32x4){0.f, 0.f, 0.f, 0.f};
        const size_t gtile = isg ? ((size_t)(((u.pn - 16) >> 2) * 128 + u.pm) * 4 + ((u.pn - 16) & 3)) : 0;
        const int wl = (wr * 4 + wc) * 64 + fq * 16 + fr;
#if NORM_IN_EPI
        if (!F8 && ((u.pn >= 8 && u.pn < 12) || (u.pn >= 14 && u.pn < 16))) {
            const bool mx = u.pn >= 14;
            int fr_ = fr, fq_ = fq; asm volatile("" : "+v"(fr_), "+v"(fq_));
            LAS float* e0 = EX + (wr * 4 + wc) * 256 + fr_; const LAS float* e1 = EX + (wr * 4 + (wc ^ 1)) * 256 + fr_;
            const LAS float* e2 = EX + (wr * 4 + (wc ^ 2)) * 256 + fr_; const LAS float* e3 = EX + (wr * 4 + (wc ^ 3)) * 256 + fr_;
#pragma unroll
            for (int ai = 0; ai < 2; ++ai)
#pragma unroll
                for (int m = 0; m < 4; ++m)
#pragma unroll
                    for (int bj = 0; bj < 2; ++bj) { const f32x4 v0 = acc[ai][bj][m][0], v1 = acc[ai][bj][m][1];
                        float ss = (v0.x * v0.x + v0.y * v0.y) + (v0.z * v0.z + v0.w * v0.w) + (v1.x * v1.x + v1.y * v1.y) + (v1.z * v1.z + v1.w * v1.w);
                        ss += __shfl_xor(ss, 16); ss += __shfl_xor(ss, 32);
                        if (fq_ == 0) e0[((ai * 4 + m) * 2 + bj) * 16] = ss; }
            LDS_WAIT(); __builtin_amdgcn_s_barrier();
            const float* pq_ = daqn; const float* pk_ = dakn; const float* px_ = mxqn; asm volatile("" : "+s"(pq_), "+s"(pk_), "+s"(px_));
            const float* gp = (u.pn < 10 ? pq_ : u.pn < 12 ? pk_ : px_) + (mx ? wc * 32 : (wc & 1) * 32) + 8 * fq_;
            const f32x4 g0 = *(const f32x4*)gp, g1 = *(const f32x4*)(gp + 4);
            const float sc = u.pn < 10 ? 0.125f * LOG2E : u.pn < 12 ? 1.f : 0.08838834764831845f * LOG2E, idim = mx ? (1.f / 128.f) : (1.f / 64.f);
#pragma unroll
            for (int ai = 0; ai < 2; ++ai)
#pragma unroll
                for (int m = 0; m < 4; ++m) { bf16* rowp = O + (size_t)(u.pm * 256 + wr * 64 + fr_ + ai * 128 + m * 16) * PW + (u.pn * 256 + wc * 32 + 8 * fq_);
#pragma unroll
                    for (int bj = 0; bj < 2; ++bj) { const int f = (ai * 4 + m) * 2 + bj;
                        float t = e0[f * 16] + e1[f * 16];
                        if (mx) t += e2[f * 16] + e3[f * 16];
                        const float r = rsqrtf(t * idim + EPS) * sc;
                        const f32x4 v0 = acc[ai][bj][m][0] * r * g0, v1 = acc[ai][bj][m][1] * r * g1;
                        v4u w; w.x = pk2(v0.x, v0.y); w.y = pk2(v0.z, v0.w); w.z = pk2(v1.x, v1.y); w.w = pk2(v1.z, v1.w);
                        *(v4u*)(rowp + bj * 128) = w; } }
            return;
        }
#endif
#pragma unroll
        for (int ai = 0; ai < 2; ++ai)
#pragma unroll
            for (int m = 0; m < 4; ++m) { bf16* rowp = O + (size_t)(row0 + ai * 128 + m * 16) * PW + col0;
                v4u g8;
#pragma unroll
                for (int bj = 0; bj < 2; ++bj) {
                    f32x4 v0, v1;
                    if constexpr (F8) { v0 = acc[ai][bj][m][0] * ACC8_SCALE + bv[bj][0]; v1 = acc[ai][bj][m][1] * ACC8_SCALE + bv[bj][1]; }
                    else { v0 = acc[ai][bj][m][0] + bv[bj][0]; v1 = acc[ai][bj][m][1] + bv[bj][1]; }
                    if (isg) { v0.x = sigmoidf_(v0.x); v0.y = sigmoidf_(v0.y); v0.z = sigmoidf_(v0.z); v0.w = sigmoidf_(v0.w);
                               v1.x = sigmoidf_(v1.x); v1.y = sigmoidf_(v1.y); v1.z = sigmoidf_(v1.z); v1.w = sigmoidf_(v1.w); }
#if GATE_U8
                    if (isg) { const unsigned lo = pk4u8(v0.x, v0.y, v0.z, v0.w), hi = pk4u8(v1.x, v1.y, v1.z, v1.w); if (bj == 0) { g8.x = lo; g8.y = hi; } else { g8.z = lo; g8.w = hi; } }
                    else { v4u w; w.x = pk2(v0.x, v0.y); w.y = pk2(v0.z, v0.w); w.z = pk2(v1.x, v1.y); w.w = pk2(v1.z, v1.w); *(v4u*)(rowp + bj * 128) = w; }
#else
                    v4u w; w.x = pk2(v0.x, v0.y); w.y = pk2(v0.z, v0.w); w.z = pk2(v1.x, v1.y); w.w = pk2(v1.z, v1.w);
                    if (isg) *(v4u*)(GF + (((gtile * 16 + (ai * 4 + m) * 2 + bj) * 512) + wl) * 8) = w;
                    else *(v4u*)(rowp + bj * 128) = w;
#endif
                }
#if GATE_U8
                if (isg) __builtin_nontemporal_store(g8, (v4u*)((unsigned char*)GF + ((gtile * 8 + (ai * 4 + m)) * 512 + wl) * 16));
#endif
            }
    }
};
typedef EpiPT<false> EpiP;
struct OffOrder { pg8::StaticOrder S; int n0, a0, a1; int i0 = 0, ni = 1 << 30;
    DI bool next(int i, pg8::Unit& u) const { if (i >= ni) return false; const bool ok = S.next(i + i0, u); u.pn = u.pn < n0 ? a0 + u.pn : a1 + (u.pn - n0); return ok; } };
struct EpiPlain {
    static constexpr bool PERM = true; static constexpr bool CHAIN = false; static constexpr bool PREFETCH = false;
    bf16* O; int ldc;
    DI void operator()(const f32x4 (&acc)[2][2][4][2], const pg8::Unit& u, int wr, int wc, int fr, int fq) const {
        const int row0 = u.pm * 256 + wr * 64 + fr, col0 = u.pn * 256 + wc * 32 + 8 * fq;
#pragma unroll
        for (int ai = 0; ai < 2; ++ai)
#pragma unroll
            for (int m = 0; m < 4; ++m) { bf16* rowp = O + (size_t)(row0 + ai * 128 + m * 16) * ldc + col0;
#pragma unroll
                for (int bj = 0; bj < 2; ++bj) { const f32x4 v0 = acc[ai][bj][m][0], v1 = acc[ai][bj][m][1];
                    v4u w; w.x = pk2(v0.x, v0.y); w.y = pk2(v0.z, v0.w); w.z = pk2(v1.x, v1.y); w.w = pk2(v1.z, v1.w);
                    *(v4u*)(rowp + bj * 128) = w; } }
    }
};

DI void p2_norm_rows(const Args& a, int vcu, int G, int wave, int lane) {
    unsigned char* ws = a.ws; bf16* P = (bf16*)(ws + WS_P);
    const int gw = vcu * 8 + wave, NGW = G * 8;
    float gda[16], gmx[8], gmk[8];
    { const float* gsrc = (lane < 32 ? a.in[I_DAQN] : a.in[I_DAKN]) + 16 * (lane & 3);
#pragma unroll
      for (int i = 0; i < 16; ++i) gda[i] = gsrc[i];
#pragma unroll
      for (int i = 0; i < 8; ++i) { gmx[i] = a.in[I_MXQN][8 * (lane & 15) + i]; gmk[i] = a.in[I_MXKN][8 * (lane & 15) + i]; } }
    const float sc_da = lane < 32 ? 0.125f * LOG2E : 1.f;
    const float sc_mx = 0.08838834764831845f * LOG2E;
    for (int m = gw; m < T; m += NGW) {
        { v4u* p = (v4u*)(P + (size_t)m * PW + P_DAQ + 16 * lane); v4u w0 = p[0], w1 = p[1];
          float f[16]; f[0] = bflo(w0.x); f[1] = bfhi(w0.x); f[2] = bflo(w0.y); f[3] = bfhi(w0.y); f[4] = bflo(w0.z); f[5] = bfhi(w0.z); f[6] = bflo(w0.w); f[7] = bfhi(w0.w);
          f[8] = bflo(w1.x); f[9] = bfhi(w1.x); f[10] = bflo(w1.y); f[11] = bfhi(w1.y); f[12] = bflo(w1.z); f[13] = bfhi(w1.z); f[14] = bflo(w1.w); f[15] = bfhi(w1.w);
          float ss = 0.f;
#pragma unroll
          for (int i = 0; i < 16; ++i) ss += f[i] * f[i];
          ss += __shfl_xor(ss, 1); ss += __shfl_xor(ss, 2);
          const float r = rsqrtf(ss * (1.f / 64.f) + EPS) * sc_da;
#pragma unroll
          for (int i = 0; i < 16; ++i) f[i] = f[i] * r * gda[i];
          w0.x = pk2(f[0], f[1]); w0.y = pk2(f[2], f[3]); w0.z = pk2(f[4], f[5]); w0.w = pk2(f[6], f[7]);
          w1.x = pk2(f[8], f[9]); w1.y = pk2(f[10], f[11]); w1.z = pk2(f[12], f[13]); w1.w = pk2(f[14], f[15]);
          p[0] = w0; p[1] = w1; }
        { v4u* p = (v4u*)(P + (size_t)m * PW + P_MXQ + 8 * lane); v4u w0 = p[0];
          float f[8]; f[0] = bflo(w0.x); f[1] = bfhi(w0.x); f[2] = bflo(w0.y); f[3] = bfhi(w0.y); f[4] = bflo(w0.z); f[5] = bfhi(w0.z); f[6] = bflo(w0.w); f[7] = bfhi(w0.w);
          float ss = 0.f;
#pragma unroll
          for (int i = 0; i < 8; ++i) ss += f[i] * f[i];
          ss += __shfl_xor(ss, 1); ss += __shfl_xor(ss, 2); ss += __shfl_xor(ss, 4); ss += __shfl_xor(ss, 8);
          const float r = rsqrtf(ss * (1.f / 128.f) + EPS) * sc_mx;
#pragma unroll
          for (int i = 0; i < 8; ++i) f[i] = f[i] * r * gmx[i];
          w0.x = pk2(f[0], f[1]); w0.y = pk2(f[2], f[3]); w0.z = pk2(f[4], f[5]); w0.w = pk2(f[6], f[7]);
          p[0] = w0; }
    }
}

constexpr int LMS = 65;
constexpr int PREP_GC = 0, PREP_BETA = 256, PREP_QS = 1024, PREP_KS = PREP_QS + 64 * 272, PREP_LM = PREP_KS + 64 * 272, PREP_TM = PREP_LM + 64 * LMS * 4, PREP_RHS = PREP_TM + 4 * 16 * 17 * 4 + 64, PREP_END = PREP_RHS + 64 * 256 * 4;
static_assert(PREP_RHS % 16 == 0, "prep LDS alignment");
static_assert(PREP_END <= RING_BYTES, "prep LDS");
struct PrepPre { float g, be; v4u xin[11]; };
DI void prep_prefetch(const Args& a, int ck, int tid, int wave, PrepPre& pp) {
    unsigned char* ws = a.ws; const bf16* P = (const bf16*)(ws + WS_P);
    const int lane = tid & 63, n = ck & 127, h = (ck >> 7) & 3, b = ck >> 9;
    const size_t t0 = (size_t)b * SEQ + (size_t)n * 64;
    if (wave == 0) { pp.g = ((const float*)(ws + WS_G))[(t0 + lane) * 4 + h]; pp.be = ((const float*)(ws + WS_BETA))[(t0 + lane) * 4 + h]; }
    if (wave < 6) {
        const int part = wave >> 1, rg = (tid >> 4) & 7, cg = tid & 15, i0 = rg * 8;
        const int ch0 = part * 512 + h * 128 + cg * 8;
        const bf16* xp = P + ((long)b * SEQ + n * 64 + i0 - 3) * PW + ch0;
        asm volatile("" : "+v"(xp));
#pragma unroll
        for (int jj = 0; jj < 11; ++jj) { const int s = n * 64 + i0 - 3 + jj;
            pp.xin[jj] = (s >= 0) ? *(const GAS v4u*)(xp + (long)jj * PW) : (v4u){0u, 0u, 0u, 0u}; }
    }
}
template <int PROBE_SKIP = 0>
DI void dn_prep_unit(const Args& a, LAS unsigned char* lds, int ck, int ck_next, PrepPre& pp, int wave) {
    const int tid = fresh_tid(), lane = tid & 63;
    unsigned char* ws = a.ws; const bf16* P = (const bf16*)(ws + WS_P);
    const int n = ck & 127, h = (ck >> 7) & 3, b = ck >> 9;
    const size_t t0 = (size_t)b * SEQ + (size_t)n * 64;
    LAS float* gc = (LAS float*)(lds + PREP_GC); LAS float* bet = (LAS float*)(lds + PREP_BETA);
    LAS float* Lm = (LAS float*)(lds + PREP_LM); LAS float* RHS = (LAS float*)(lds + PREP_RHS);
    if (wave == 0) {
        float v = pp.g;
#pragma unroll
        for (int o = 1; o < 64; o <<= 1) { const float u = __shfl_up(v, o); if (lane >= o) v += u; }
        gc[lane] = v; bet[lane] = pp.be;
    }
    __syncthreads();
    if (wave < 6) {
        const int part = wave >> 1, rg = (tid >> 4) & 7, cg = tid & 15, i0 = rg * 8;
        const int ch0 = part * 512 + h * 128 + cg * 8;
        float w[4][8];
#pragma unroll
        for (int j = 0; j < 4; ++j) { const f32x4* p = (const f32x4*)(a.in[I_CONV] + j * 1536 + ch0); const f32x4 w0 = p[0], w1 = p[1];
            w[j][0] = w0.x; w[j][1] = w0.y; w[j][2] = w0.z; w[j][3] = w0.w; w[j][4] = w1.x; w[j][5] = w1.y; w[j][6] = w1.z; w[j][7] = w1.w; }
        v4u xin[11];
#pragma unroll
        for (int jj = 0; jj < 11; ++jj) xin[jj] = pp.xin[jj];
        float o[8][8];
#pragma unroll
        for (int ri = 0; ri < 8; ++ri) {
            float acc[8];
#pragma unroll
            for (int c = 0; c < 8; ++c) acc[c] = 0.f;
#pragma unroll
            for (int j = 0; j < 4; ++j) { const v4u x = xin[ri + j];
                acc[0] += w[j][0] * bflo(x.x); acc[1] += w[j][1] * bfhi(x.x); acc[2] += w[j][2] * bflo(x.y); acc[3] += w[j][3] * bfhi(x.y);
                acc[4] += w[j][4] * bflo(x.z); acc[5] += w[j][5] * bfhi(x.z); acc[6] += w[j][6] * bflo(x.w); acc[7] += w[j][7] * bfhi(x.w); }
            float ss = 0.f;
#pragma unroll
            for (int c = 0; c < 8; ++c) { const float s_ = acc[c] * sigmoidf_(acc[c]); o[ri][c] = s_; ss += s_ * s_; }
            ss += __shfl_xor(ss, 1); ss += __shfl_xor(ss, 2); ss += __shfl_xor(ss, 4); ss += __shfl_xor(ss, 8);
            const float nrm = part == 0 ? rsqrtf(ss + EPS) * 0.08838834764831845f : part == 1 ? rsqrtf(ss + EPS) : 1.f;
#pragma unroll
            for (int c = 0; c < 8; ++c) o[ri][c] *= nrm;
        }
        bf16* qdp = (bf16*)(ws + WS_QD) + (size_t)ck * 8192 + (size_t)(((i0 >> 5) * 8 + (cg >> 1)) * 64 + (i0 & 31) + 32 * (cg & 1)) * 8;
        asm volatile("" : "+v"(qdp));
#pragma unroll
        for (int ri = 0; ri < 8; ++ri) {
            const int row = i0 + ri; const float g_ = gc[row], be = bet[row];
            if (part == 0) {
                v4u wq; wq.x = pk2(o[ri][0], o[ri][1]); wq.y = pk2(o[ri][2], o[ri][3]); wq.z = pk2(o[ri][4], o[ri][5]); wq.w = pk2(o[ri][6], o[ri][7]);
                *(LAS v4u*)(lds + PREP_QS + row * 272 + cg * 16) = wq;
                const float eg = fast_exp(g_);
                v4u wd; wd.x = pk2(o[ri][0] * eg, o[ri][1] * eg); wd.y = pk2(o[ri][2] * eg, o[ri][3] * eg); wd.z = pk2(o[ri][4] * eg, o[ri][5] * eg); wd.w = pk2(o[ri][6] * eg, o[ri][7] * eg);
                *(GAS v4u*)(qdp + ri * 8) = wd;
            } else if (part == 1) {
                v4u wq; wq.x = pk2(o[ri][0], o[ri][1]); wq.y = pk2(o[ri][2], o[ri][3]); wq.z = pk2(o[ri][4], o[ri][5]); wq.w = pk2(o[ri][6], o[ri][7]);
                *(LAS v4u*)(lds + PREP_KS + row * 272 + cg * 16) = wq;
                const float f = be * fast_exp(g_);
                LAS f32x4* r4 = (LAS f32x4*)(RHS + row * 256 + 128 + cg * 8);
                r4[0] = (f32x4){o[ri][0] * f, o[ri][1] * f, o[ri][2] * f, o[ri][3] * f}; r4[1] = (f32x4){o[ri][4] * f, o[ri][5] * f, o[ri][6] * f, o[ri][7] * f};
            } else {
                LAS f32x4* r4 = (LAS f32x4*)(RHS + row * 256 + cg * 8);
                r4[0] = (f32x4){o[ri][0] * be, o[ri][1] * be, o[ri][2] * be, o[ri][3] * be}; r4[1] = (f32x4){o[ri][4] * be, o[ri][5] * be, o[ri][6] * be, o[ri][7] * be};
            }
        }
    }
    __syncthreads();
    if (ck_next < NCHUNK) prep_prefetch(a, ck_next, tid, wave, pp);
    {
        const int sel = wave >> 2, it = (wave >> 1) & 1, jt = wave & 1, r = lane & 31, hh = lane >> 5;
        const LAS unsigned char* Ab = lds + (sel ? PREP_QS : PREP_KS) + (32 * it + r) * 272 + hh * 16;
        const LAS unsigned char* Bb = lds + PREP_KS + (32 * jt + r) * 272 + hh * 16;
        f32x16 acc = {};
#pragma unroll
        for (int s = 0; s < 8; ++s) { const bf16x8 av = *(const LAS bf16x8*)(Ab + s * 32), bv = *(const LAS bf16x8*)(Bb + s * 32);
            acc = __builtin_amdgcn_mfma_f32_32x32x16_bf16(av, bv, acc, 0, 0, 0); }
        const int col = 32 * jt + r; const float gcol = gc[col];
        bf16* QKB = (bf16*)(ws + WS_QK) + (size_t)ck * 4096;
#pragma unroll
        for (int i = 0; i < 16; ++i) { const int row = 32 * it + crow(i, hh);
            const float dec = fast_exp(col <= row ? gc[row] - gcol : 0.f);
            if (sel == 0) Lm[row * LMS + col] = (col < row) ? acc[i] * dec * bet[row] : 0.f;
            else QKB[(((row >> 5) * 4 + (col >> 4)) * 64 + (row & 31) + 32 * ((col >> 3) & 1)) * 8 + (col & 7)] = (bf16)f2bf((col <= row) ? acc[i] * dec : 0.f); }
    }
    __syncthreads();
    LAS float* Tm = (LAS float*)(lds + PREP_TM);
    if (wave == 0) {
        const int blk = lane >> 4, c = lane & 15;
        const LAS float* Db = Lm + (16 * blk) * LMS + 16 * blk;
        float t[16];
#pragma unroll
        for (int r = 0; r < 16; ++r) { float acc = (r == c) ? 1.f : 0.f;
#pragma unroll
            for (int jj = 0; jj < r; ++jj) acc -= Db[r * LMS + jj] * t[jj];
            t[r] = acc; }
#pragma unroll
        for (int r = 0; r < 16; ++r) Tm[(blk * 16 + r) * 17 + c] = t[r];
    } else if (wave >= 4) {
        const int q = tid - 256, kd = q & 127, half = q >> 7;
        const float gl = gc[63];
        bf16* KDT = (bf16*)(ws + WS_KDT) + (size_t)ck * 8192;
#pragma unroll
        for (int c8 = 0; c8 < 4; ++c8) { float f[8];
#pragma unroll
            for (int jj = 0; jj < 8; ++jj) { const int c = 32 * half + 8 * c8 + jj; f[jj] = bf2f(*(const LAS bf16*)(lds + PREP_KS + c * 272 + kd * 2)) * fast_exp(gl - gc[c]); }
            v4u w; w.x = pk2(f[0], f[1]); w.y = pk2(f[2], f[3]); w.z = pk2(f[4], f[5]); w.w = pk2(f[6], f[7]);
            *(v4u*)(KDT + (size_t)((((kd >> 5) * 4 + 2 * half + (c8 >> 1)) * 64) + (kd & 31) + 32 * (c8 & 1)) * 8) = w; }
        if (q == 0) ((float*)(ws + WS_EGL))[ck] = fast_exp(gl);
    }
    __syncthreads();
    if (PROBE_SKIP != 1) {
        const int lr = lane & 15, lq = lane >> 4;
#pragma unroll
        for (int tt = 0; tt < 2; ++tt) {
            const int ct = wave * 2 + tt;
            f32x4 X[4];
#pragma unroll
            for (int b = 0; b < 4; ++b) {
                f32x4 acc;
#pragma unroll
                for (int rg = 0; rg < 4; ++rg) acc[rg] = RHS[(16 * b + 4 * lq + rg) * 256 + ct * 16 + lr];
#pragma unroll
                for (int jb = 0; jb < b; ++jb)
#pragma unroll
                    for (int rg = 0; rg < 4; ++rg) acc = __builtin_amdgcn_mfma_f32_16x16x4f32(-Lm[(16 * b + lr) * LMS + 16 * jb + 4 * lq + rg], X[jb][rg], acc, 0, 0, 0);
                f32x4 xb = {0.f, 0.f, 0.f, 0.f};
#pragma unroll
                for (int rg = 0; rg < 4; ++rg) xb = __builtin_amdgcn_mfma_f32_16x16x4f32(Tm[(b * 16 + lr) * 17 + 4 * lq + rg], acc[rg], xb, 0, 0, 0);
                X[b] = xb;
            }
#pragma unroll
            for (int b = 0; b < 4; ++b)
#pragma unroll
                for (int rg = 0; rg < 4; ++rg) RHS[(16 * b + 4 * lq + rg) * 256 + ct * 16 + lr] = X[b][rg];
        }
    }
    __syncthreads();
    {
        const int row = tid >> 3, seg = tid & 7;
        const LAS f32x4* s4 = (const LAS f32x4*)(RHS + row * 256 + seg * 32);
        const float sg = seg < 4 ? 1.f : -1.f;
        bf16* dst = (bf16*)(ws + (seg < 4 ? WS_U : WS_NW)) + (size_t)ck * 8192;
        const int ctr = row >> 5, rr = row & 31;
#pragma unroll
        for (int q = 0; q < 4; ++q) { const f32x4 x0 = s4[2 * q] * sg, x1 = s4[2 * q + 1] * sg;
            v4u w; w.x = pk2(x0.x, x0.y); w.y = pk2(x0.z, x0.w); w.z = pk2(x1.x, x1.y); w.w = pk2(x1.z, x1.w);
            const int fi = seg < 4 ? ((ctr * 4 + seg) * 2 + (q >> 1)) : (ctr * 8 + (seg - 4) * 2 + (q >> 1));
            *(v4u*)(dst + (size_t)(fi * 64 + rr + 32 * (q & 1)) * 8) = w; }
    }
    __syncthreads();
}

constexpr int SCAN_ST = 0, SCAN_VN = 2 * 32 * 272, SCAN_END = SCAN_VN + 2 * 32 * 144;
struct ScanFrag { bf16x8 a0[8]; bf16x8 a1[4]; bf16x8 a3[4]; float egl; };
DI void dn_scan(const Args& a, LAS unsigned char* lds, int j, int wave, int lane) {
    unsigned char* ws = a.ws;
    const int grp = wave >> 2, w4 = wave & 3, task = 2 * j + grp, bh = task >> 2, vs = task & 3, b = bh >> 2, h = bh & 3;
    const int r = lane & 31, hh = lane >> 5;
    LAS unsigned char* ST = lds + SCAN_ST + grp * (32 * 272); LAS unsigned char* VN = lds + SCAN_VN + grp * (32 * 144);
    const bf16* A0 = (const bf16*)(ws + (w4 < 2 ? WS_NW : WS_QD)); const bf16* U = (const bf16*)(ws + WS_U);
    const bf16* KDT = (const bf16*)(ws + WS_KDT); const bf16* QKB = (const bf16*)(ws + WS_QK); const float* EGL = (const float*)(ws + WS_EGL);
    bf16* ODN = (bf16*)(ws + WS_ODN);
    bf16x8 bI[2];
#pragma unroll
    for (int s = 0; s < 2; ++s)
#pragma unroll
        for (int jj = 0; jj < 8; ++jj) bI[s][jj] = (16 * s + 8 * hh + jj == r) ? (short)0x3F80 : (short)0;
    f32x16 sacc = {};
    const int ct = w4 & 1;
#define SCAN_LOAD(F, n_) do { const int n__ = (n_) < SEQ / 64 ? (n_) : SEQ / 64 - 1; const size_t ck_ = (size_t)(bh * 128 + n__); \
        _Pragma("unroll") for (int s = 0; s < 8; ++s) F.a0[s] = *(const bf16x8*)(A0 + ck_ * 8192 + (size_t)((ct * 8 + s) * 64 + lane) * 8); \
        if (w4 < 2) { _Pragma("unroll") for (int s = 0; s < 2; ++s) F.a1[s] = *(const bf16x8*)(U + ck_ * 8192 + (size_t)(((ct * 4 + vs) * 2 + s) * 64 + lane) * 8); } \
        else { _Pragma("unroll") for (int s = 0; s < 4; ++s) F.a1[s] = *(const bf16x8*)(QKB + ck_ * 4096 + (size_t)((ct * 4 + s) * 64 + lane) * 8); } \
        _Pragma("unroll") for (int s = 0; s < 4; ++s) F.a3[s] = *(const bf16x8*)(KDT + ck_ * 8192 + (size_t)((w4 * 4 + s) * 64 + lane) * 8); \
        F.egl = EGL[ck_]; } while (0)
#define SCAN_STEP(F, n_) do { const size_t t0_ = (size_t)b * SEQ + (size_t)(n_) * 64; \
        _Pragma("unroll") for (int g = 0; g < 4; ++g) { v2u w; w.x = pk2(sacc[4 * g], sacc[4 * g + 1]); w.y = pk2(sacc[4 * g + 2], sacc[4 * g + 3]); \
            *(LAS v2u*)(ST + r * 272 + (32 * w4 + 8 * g + 4 * hh) * 2) = w; } \
        LDS_WAIT(); __builtin_amdgcn_s_barrier(); \
        f32x16 acc = {}, acc2 = {}; \
        if (w4 < 2) { acc = __builtin_amdgcn_mfma_f32_32x32x16_bf16(F.a1[0], bI[0], acc, 0, 0, 0); acc2 = __builtin_amdgcn_mfma_f32_32x32x16_bf16(F.a1[1], bI[1], acc2, 0, 0, 0); } \
        _Pragma("unroll") for (int s = 0; s < 8; s += 2) { const bf16x8 b0 = *(const LAS bf16x8*)(ST + r * 272 + (16 * s + 8 * hh) * 2), b1 = *(const LAS bf16x8*)(ST + r * 272 + (16 * s + 16 + 8 * hh) * 2); \
            acc = __builtin_amdgcn_mfma_f32_32x32x16_bf16(F.a0[s], b0, acc, 0, 0, 0); acc2 = __builtin_amdgcn_mfma_f32_32x32x16_bf16(F.a0[s + 1], b1, acc2, 0, 0, 0); } \
        acc += acc2; \
        if (w4 < 2) { _Pragma("unroll") for (int g = 0; g < 4; ++g) { v2u w; w.x = pk2(acc[4 * g], acc[4 * g + 1]); w.y = pk2(acc[4 * g + 2], acc[4 * g + 3]); \
            *(LAS v2u*)(VN + r * 144 + (32 * ct + 8 * g + 4 * hh) * 2) = w; } } \
        LDS_WAIT(); __builtin_amdgcn_s_barrier(); \
        bf16x8 bv[4]; _Pragma("unroll") for (int s = 0; s < 4; ++s) bv[s] = *(const LAS bf16x8*)(VN + r * 144 + (16 * s + 8 * hh) * 2); \
        _Pragma("unroll") for (int i = 0; i < 16; ++i) sacc[i] *= F.egl; \
        _Pragma("unroll") for (int s = 0; s < 4; ++s) sacc = __builtin_amdgcn_mfma_f32_32x32x16_bf16(F.a3[s], bv[s], sacc, 0, 0, 0); \
        if (w4 >= 2) { _Pragma("unroll") for (int s = 0; s < 4; ++s) acc = __builtin_amdgcn_mfma_f32_32x32x16_bf16(F.a1[s], bv[s], acc, 0, 0, 0); \
            _Pragma("unroll") for (int i = 0; i < 16; ++i) ODN[(t0_ + 32 * ct + crow(i, hh)) * 512 + h * 128 + vs * 32 + r] = (bf16)f2bf(acc[i]); } \
    } while (0)
    ScanFrag FA, FB;
    SCAN_LOAD(FA, 0);
    for (int n = 0; n < SEQ / 64; n += 2) {
        SCAN_LOAD(FB, n + 1);
        SCAN_STEP(FA, n);
        SCAN_LOAD(FA, n + 2);
        SCAN_STEP(FB, n + 1);
    }
#undef SCAN_LOAD
#undef SCAN_STEP
    __syncthreads();
}
constexpr int MX_K = 0, MX_V = 65536;
DI void mx_unit(const Args& a, LAS unsigned char* lds, int bh, int qb, int tid, int wave, int lane) {
    unsigned char* ws = a.ws; const int b = bh >> 2, h = bh & 3;
    const bf16* MKV = (const bf16*)(ws + WS_MKV) + (size_t)b * NMEM * 1024 + h * 128;
    float gk[8];
#pragma unroll
    for (int i = 0; i < 8; ++i) gk[i] = a.in[I_MXKN][8 * (tid & 15) + i];
#pragma unroll
    for (int i = 0; i < 8; ++i) { const int q = tid + 512 * i, row = q >> 4, ch = q & 15;
        v4u kv = *(const v4u*)(MKV + (size_t)row * 1024 + ch * 8); const v4u vv = *(const v4u*)(MKV + (size_t)row * 1024 + 512 + ch * 8);
        float f[8]; f[0] = bflo(kv.x); f[1] = bfhi(kv.x); f[2] = bflo(kv.y); f[3] = bfhi(kv.y); f[4] = bflo(kv.z); f[5] = bfhi(kv.z); f[6] = bflo(kv.w); f[7] = bfhi(kv.w);
        float ss = 0.f;
#pragma unroll
        for (int jx = 0; jx < 8; ++jx) ss += f[jx] * f[jx];
        ss += __shfl_xor(ss, 1); ss += __shfl_xor(ss, 2); ss += __shfl_xor(ss, 4); ss += __shfl_xor(ss, 8);
        const float rn = rsqrtf(ss * (1.f / 128.f) + EPS);
        kv.x = pk2(f[0] * rn * gk[0], f[1] * rn * gk[1]); kv.y = pk2(f[2] * rn * gk[2], f[3] * rn * gk[3]); kv.z = pk2(f[4] * rn * gk[4], f[5] * rn * gk[5]); kv.w = pk2(f[6] * rn * gk[6], f[7] * rn * gk[7]);
        *(LAS v4u*)(lds + MX_K + row * 256 + ((ch ^ (row & 7)) * 16)) = kv; *(LAS v4u*)(lds + MX_V + row * 256 + ch * 16) = vv; }
    const int r = lane & 31, hh = lane >> 5;
    const size_t qrow = (size_t)b * SEQ + (size_t)qb * 256 + wave * 32;
    const bf16* Q = (const bf16*)(ws + WS_P) + (qrow + r) * PW + P_MXQ + h * 128;
    bf16x8 qf[8];
#pragma unroll
    for (int s = 0; s < 8; ++s) qf[s] = *(const bf16x8*)(Q + 16 * s + 8 * hh);
    __syncthreads();
    float mx = -INFINITY;
#pragma unroll 1
    for (int kt = 0; kt < 8; ++kt) { f32x16 acc = {}; const int row = 32 * kt + r;
#pragma unroll
        for (int s = 0; s < 8; ++s) { const bf16x8 kf = *(const LAS bf16x8*)(lds + MX_K + row * 256 + (((2 * s + hh) ^ (row & 7)) * 16));
            acc = __builtin_amdgcn_mfma_f32_32x32x16_bf16(kf, qf[s], acc, 0, 0, 0); }
#pragma unroll
        for (int i = 0; i < 16; ++i) mx = fmaxf(mx, acc[i]); }
    mx = fmaxf(mx, __shfl_xor(mx, 32));
    float sum = 0.f;
    f32x16 o[4] = {};
    const int g16 = lane >> 4, i16 = lane & 15, qq = i16 >> 2, pp = i16 & 3;
    const LAS unsigned char* vb = lds + MX_V + (4 * hh + qq) * 256 + (16 * (g16 & 1) + 4 * pp) * 2;
#pragma unroll 1
    for (int kt = 0; kt < 8; ++kt) { f32x16 st = {}; const int row = 32 * kt + r;
#pragma unroll
        for (int s = 0; s < 8; ++s) { const bf16x8 kf = *(const LAS bf16x8*)(lds + MX_K + row * 256 + (((2 * s + hh) ^ (row & 7)) * 16));
            st = __builtin_amdgcn_mfma_f32_32x32x16_bf16(kf, qf[s], st, 0, 0, 0); }
#pragma unroll
        for (int i = 0; i < 16; ++i) { const float p = __builtin_amdgcn_exp2f(st[i] - mx); st[i] = p; sum += p; }
#pragma unroll
        for (int s2 = 0; s2 < 2; ++s2) {
            v4u pw; pw.x = pk2(st[8 * s2 + 0], st[8 * s2 + 1]); pw.y = pk2(st[8 * s2 + 2], st[8 * s2 + 3]); pw.z = pk2(st[8 * s2 + 4], st[8 * s2 + 5]); pw.w = pk2(st[8 * s2 + 6], st[8 * s2 + 7]);
            const bf16x8 pa = __builtin_bit_cast(bf16x8, pw);
#pragma unroll
            for (int dt = 0; dt < 4; ++dt) {
                const LAS unsigned char* vp = vb + (32 * kt + 16 * s2) * 256 + dt * 64;
                const s16x4 lo = __builtin_bit_cast(s16x4, __builtin_amdgcn_ds_read_tr16_b64_v4i16((LAS s16x4*)vp));
                const s16x4 hi = __builtin_bit_cast(s16x4, __builtin_amdgcn_ds_read_tr16_b64_v4i16((LAS s16x4*)(vp + 8 * 256)));
                const bf16x8 vf = {lo[0], lo[1], lo[2], lo[3], hi[0], hi[1], hi[2], hi[3]};
                o[dt] = __builtin_amdgcn_mfma_f32_32x32x16_bf16(pa, vf, o[dt], 0, 0, 0);
            }
        }
    }
    sum += __shfl_xor(sum, 32);
    LAS float* wsc = (LAS float*)(lds + LWSC_OFF + wave * 256);
    if (hh == 0) wsc[r] = __builtin_amdgcn_rcpf(sum);
    LDS_WAIT();
    bf16* O = (bf16*)(ws + WS_OMX) + qrow * 512 + h * 128;
#pragma unroll
    for (int i = 0; i < 16; ++i) { const int qr_ = crow(i, hh); const float rl = wsc[qr_];
#pragma unroll
        for (int dt = 0; dt < 4; ++dt) O[(size_t)qr_ * 512 + dt * 32 + r] = (bf16)f2bf(o[dt][i] * rl); }
    __syncthreads();
}

DI void p4_norm_rows(const Args& a, int vcu, int G, int wave, int lane) {
    unsigned char* ws = a.ws; const int gw = vcu * 8 + wave, NGW = G * 8;
    const float* lp = a.in[I_LAM];
    const float l1 = wave_sum(lp[lane] * lp[64 + lane]), l2 = wave_sum(lp[128 + lane] * lp[192 + lane]);
    const float lam_init = 0.2f, lam = expf(l1) - expf(l2) + lam_init;
    float gdn[8], gda[8];
#pragma unroll
    for (int i = 0; i < 8; ++i) { gdn[i] = a.in[I_DNON][8 * (lane & 15) + i]; gda[i] = a.in[I_SUBLN][8 * (lane & 15) + i] * (1.f - lam_init); }
    const bf16* P = (const bf16*)(ws + WS_P);
    for (int m0 = gw; m0 < T; m0 += 4 * NGW) {
        v4u lw0[4], lz0[4], lw1[4], lw2[4];
#pragma unroll
        for (int q = 0; q < 4; ++q) { const size_t m = (size_t)(m0 + q * NGW);
            lw0[q] = *(const v4u*)((const bf16*)(ws + WS_ODN) + m * 512 + 8 * lane); lz0[q] = *(const v4u*)(P + m * PW + P_DNZ + 8 * lane);
            lw1[q] = *(const v4u*)((const bf16*)(ws + WS_O1) + m * 512 + 8 * lane); lw2[q] = *(const v4u*)((const bf16*)(ws + WS_O2) + m * 512 + 8 * lane); }
#pragma unroll
        for (int q = 0; q < 4; ++q) { const size_t m = (size_t)(m0 + q * NGW);
        { const v4u w0 = lw0[q], z0 = lz0[q];
          float f[8], z[8]; f[0] = bflo(w0.x); f[1] = bfhi(w0.x); f[2] = bflo(w0.y); f[3] = bfhi(w0.y); f[4] = bflo(w0.z); f[5] = bfhi(w0.z); f[6] = bflo(w0.w); f[7] = bfhi(w0.w);
          z[0] = bflo(z0.x); z[1] = bfhi(z0.x); z[2] = bflo(z0.y); z[3] = bfhi(z0.y); z[4] = bflo(z0.z); z[5] = bfhi(z0.z); z[6] = bflo(z0.w); z[7] = bfhi(z0.w);
          float ss = 0.f;
#pragma unroll
          for (int i = 0; i < 8; ++i) ss += f[i] * f[i];
          ss += __shfl_xor(ss, 1); ss += __shfl_xor(ss, 2); ss += __shfl_xor(ss, 4); ss += __shfl_xor(ss, 8);
          const float r = rsqrtf(ss * (1.f / 128.f) + EPS);
#pragma unroll
          for (int i = 0; i < 8; ++i) f[i] = f[i] * r * gdn[i] * (z[i] * sigmoidf_(z[i]));
          v4u o; o.x = pk2(f[0], f[1]); o.y = pk2(f[2], f[3]); o.z = pk2(f[4], f[5]); o.w = pk2(f[6], f[7]);
          *(v4u*)((bf16*)(ws + WS_ODNF) + m * 512 + 8 * lane) = o; }
        { const v4u w1 = lw1[q], w2 = lw2[q];
          float f[8]; f[0] = bflo(w1.x) - lam * bflo(w2.x); f[1] = bfhi(w1.x) - lam * bfhi(w2.x); f[2] = bflo(w1.y) - lam * bflo(w2.y); f[3] = bfhi(w1.y) - lam * bfhi(w2.y);
          f[4] = bflo(w1.z) - lam * bflo(w2.z); f[5] = bfhi(w1.z) - lam * bfhi(w2.z); f[6] = bflo(w1.w) - lam * bflo(w2.w); f[7] = bfhi(w1.w) - lam * bfhi(w2.w);
          float ss = 0.f;
#pragma unroll
          for (int i = 0; i < 8; ++i) ss += f[i] * f[i];
          ss += __shfl_xor(ss, 1); ss += __shfl_xor(ss, 2); ss += __shfl_xor(ss, 4); ss += __shfl_xor(ss, 8);
          const float r = rsqrtf(ss * (1.f / 128.f) + EPS);
#pragma unroll
          for (int i = 0; i < 8; ++i) f[i] = f[i] * r * gda[i];
          v4u o; o.x = pk2(f[0], f[1]); o.y = pk2(f[2], f[3]); o.z = pk2(f[4], f[5]); o.w = pk2(f[6], f[7]);
          *(v4u*)((bf16*)(ws + WS_ODAF) + m * 512 + 8 * lane) = o; }
        }
    }
}

struct BranchOrder {
    pg8::StaticOrder so; long a1, a2;
    DI bool next(int i, pg8::Unit& u) const {
        const int tl = i / 3, r = i - 3 * tl;
        if (!so.tile((long)tl * so.G + so.c, u.pm, u.pn)) return false;
        u.aoff = r == 0 ? 0 : (r == 1 ? a1 : a2); u.boff = (long)r * 1024 * 512 * 2; u.tag = r; return true;
    }
};
#ifndef MERGE_CHAIN
#define MERGE_CHAIN 1
#endif
#if MERGE_CHAIN && GATE_U8
struct EpiMerge {
    static constexpr bool PERM = true; static constexpr bool CHAIN = true; static constexpr bool PREFETCH = false;
    bf16* MRG; const bf16* GF; bf16* MF;
    DI static float gc(unsigned w, int b) { return fmaxf((float)((w >> (8 * b)) & 0xffu), 0.5f); }
    DI bool chain(f32x4 (&acc)[2][2][4][2], const pg8::Unit& u, int wr, int wc, int fr, int fq) const {
        int fr_ = fr, fq_ = fq; asm volatile("" : "+v"(fr_), "+v"(fq_));
        const int r = u.tag;
        const int wl = (wr * 4 + wc) * 64 + fq_ * 16 + fr_;
        const unsigned char* gfp = (const unsigned char*)GF + (((size_t)(r * 128 + u.pm) * 4 + u.pn) * 8 * 512 + wl) * 16;
        if (r < 2) {
#pragma unroll
            for (int ai = 0; ai < 2; ++ai) {
                v4u qa[4], qb[4];
#pragma unroll
                for (int m = 0; m < 4; ++m) { qa[m] = __builtin_nontemporal_load((const v4u*)(gfp + (size_t)(ai * 4 + m) * 8192)); qb[m] = __builtin_nontemporal_load((const v4u*)(gfp + (size_t)(ai * 4 + m) * 8192 + (size_t)128 * 4 * 65536)); }
#pragma unroll
                for (int m = 0; m < 4; ++m)
#pragma unroll
                    for (int bj = 0; bj < 2; ++bj) { const unsigned a0 = bj == 0 ? qa[m].x : qa[m].z, a1 = bj == 0 ? qa[m].y : qa[m].w, b0 = bj == 0 ? qb[m].x : qb[m].z, b1 = bj == 0 ? qb[m].y : qb[m].w;
                        f32x4 s0, s1;
                        s0.x = gc(a0, 0) * __builtin_amdgcn_rcpf(gc(b0, 0)); s0.y = gc(a0, 1) * __builtin_amdgcn_rcpf(gc(b0, 1)); s0.z = gc(a0, 2) * __builtin_amdgcn_rcpf(gc(b0, 2)); s0.w = gc(a0, 3) * __builtin_amdgcn_rcpf(gc(b0, 3));
                        s1.x = gc(a1, 0) * __builtin_amdgcn_rcpf(gc(b1, 0)); s1.y = gc(a1, 1) * __builtin_amdgcn_rcpf(gc(b1, 1)); s1.z = gc(a1, 2) * __builtin_amdgcn_rcpf(gc(b1, 2)); s1.w = gc(a1, 3) * __builtin_amdgcn_rcpf(gc(b1, 3));
                        acc[ai][bj][m][0] *= s0; acc[ai][bj][m][1] *= s1; }
            }
            return true;
        }
        const int row0 = u.pm * 256 + wr * 64 + fr_, col0 = u.pn * 256 + wc * 32 + 8 * fq_;
#pragma unroll
        for (int ai = 0; ai < 2; ++ai) {
            v4u qa[4];
#pragma unroll
            for (int m = 0; m < 4; ++m) qa[m] = __builtin_nontemporal_load((const v4u*)(gfp + (size_t)(ai * 4 + m) * 8192));
#pragma unroll
            for (int m = 0; m < 4; ++m)
#pragma unroll
                for (int bj = 0; bj < 2; ++bj) { const unsigned a0 = bj == 0 ? qa[m].x : qa[m].z, a1 = bj == 0 ? qa[m].y : qa[m].w;
                    const f32x4 v0 = acc[ai][bj][m][0], v1 = acc[ai][bj][m][1];
                    v4u w; w.x = pk2(v0.x * gc(a0, 0), v0.y * gc(a0, 1)); w.y = pk2(v0.z * gc(a0, 2), v0.w * gc(a0, 3)); w.z = pk2(v1.x * gc(a1, 0), v1.y * gc(a1, 1)); w.w = pk2(v1.z * gc(a1, 2), v1.w * gc(a1, 3));
                    *(v4u*)(MRG + (size_t)(row0 + ai * 128 + m * 16) * 1024 + col0 + bj * 128) = w; }
        }
        return false;
    }
};
#else
struct EpiMerge {
    static constexpr bool PERM = true; static constexpr bool CHAIN = false; static constexpr bool PREFETCH = false;
    bf16* MRG; const bf16* GF; bf16* MF;
    DI void operator()(const f32x4 (&acc)[2][2][4][2], const pg8::Unit& u, int wr, int wc, int fr, int fq) const {
        const int row0 = u.pm * 256 + wr * 64 + fr, col0 = u.pn * 256 + wc * 32 + 8 * fq; const int r = u.tag;
        const int wl = (wr * 4 + wc) * 64 + fq * 16 + fr;
#if GATE_U8
        const unsigned char* gfp = (const unsigned char*)GF + (((size_t)(r * 128 + u.pm) * 4 + u.pn) * 8 * 512 + wl) * 16;
#else
        const bf16* gfp = GF + (((size_t)(r * 128 + u.pm) * 4 + u.pn) * 16 * 512 + wl) * 8;
#endif
        bf16* mfp = MF + (((size_t)u.pm * 4 + u.pn) * 16 * 512 + wl) * 8;
#pragma unroll
        for (int ai = 0; ai < 2; ++ai) {
#if GATE_U8
            v4u gq[4], ow[4][2];
#pragma unroll
            for (int m = 0; m < 4; ++m) { gq[m] = *(const v4u*)(gfp + (size_t)(ai * 4 + m) * 8192);
#pragma unroll
                for (int bj = 0; bj < 2; ++bj) { const int f = (ai * 4 + m) * 2 + bj; ow[m][bj] = (r > 0) ? *(const v4u*)(mfp + (size_t)f * 4096) : (v4u){0u, 0u, 0u, 0u}; } }
#else
            v4u gw[4][2], ow[4][2];
#pragma unroll
            for (int m = 0; m < 4; ++m)
#pragma unroll
                for (int bj = 0; bj < 2; ++bj) { const int f = (ai * 4 + m) * 2 + bj;
                    gw[m][bj] = *(const v4u*)(gfp + (size_t)f * 4096);
                    ow[m][bj] = (r > 0) ? *(const v4u*)(mfp + (size_t)f * 4096) : (v4u){0u, 0u, 0u, 0u}; }
#endif
#pragma unroll
            for (int m = 0; m < 4; ++m)
#pragma unroll
                for (int bj = 0; bj < 2; ++bj) { const size_t row = (size_t)(row0 + ai * 128 + m * 16); const int col = col0 + bj * 128; const int f = (ai * 4 + m) * 2 + bj;
                    const v4u o = ow[m][bj];
                    f32x4 v0 = acc[ai][bj][m][0], v1 = acc[ai][bj][m][1];
#if GATE_U8
                    const unsigned ga = bj == 0 ? gq[m].x : gq[m].z, gb = bj == 0 ? gq[m].y : gq[m].w;
                    v0.x = v0.x * (float)(ga & 0xffu) + bflo(o.x); v0.y = v0.y * (float)((ga >> 8) & 0xffu) + bfhi(o.x); v0.z = v0.z * (float)((ga >> 16) & 0xffu) + bflo(o.y); v0.w = v0.w * (float)(ga >> 24) + bfhi(o.y);
                    v1.x = v1.x * (float)(gb & 0xffu) + bflo(o.z); v1.y = v1.y * (float)((gb >> 8) & 0xffu) + bfhi(o.z); v1.z = v1.z * (float)((gb >> 16) & 0xffu) + bflo(o.w); v1.w = v1.w * (float)(gb >> 24) + bfhi(o.w);
#else
                    const v4u g = gw[m][bj];
                    v0.x = v0.x * bflo(g.x) + bflo(o.x); v0.y = v0.y * bfhi(g.x) + bfhi(o.x); v0.z = v0.z * bflo(g.y) + bflo(o.y); v0.w = v0.w * bfhi(g.y) + bfhi(o.y);
                    v1.x = v1.x * bflo(g.z) + bflo(o.z); v1.y = v1.y * bfhi(g.z) + bfhi(o.z); v1.z = v1.z * bflo(g.w) + bflo(o.w); v1.w = v1.w * bfhi(g.w) + bfhi(o.w);
#endif
                    v4u w; w.x = pk2(v0.x, v0.y); w.y = pk2(v0.z, v0.w); w.z = pk2(v1.x, v1.y); w.w = pk2(v1.z, v1.w);
                    if (r < 2) *(v4u*)(mfp + (size_t)f * 4096) = w;
                    else *(v4u*)(MRG + row * 1024 + col) = w; }
        }
    }
};
#endif
#ifndef ROUTER_FUSED
#define ROUTER_FUSED 0
#endif
struct EpiResF32 {
    static constexpr bool PERM = false; static constexpr bool CHAIN = false; static constexpr bool PREFETCH = false;
    float* C; const float* X; unsigned char* H2; const float* fn;
    DI void operator()(const f32x4 (&acc)[2][2][4][2], const pg8::Unit& u, int wr, int wc, int fr, int fq) const {
        const int row0 = u.pm * 256 + wr * 64 + fr, col0 = u.pn * 256 + wc * 32 + 4 * fq;
#pragma unroll
        for (int ai = 0; ai < 2; ++ai) {
            f32x4 xv[4][2][2];
#pragma unroll
            for (int m = 0; m < 4; ++m) { const size_t ro = (size_t)(row0 + ai * 128 + m * 16) * 1024 + col0;
#pragma unroll
                for (int bj = 0; bj < 2; ++bj)
#pragma unroll
                    for (int n = 0; n < 2; ++n) xv[m][bj][n] = *(const f32x4*)(X + ro + bj * 128 + n * 16); }
#pragma unroll
            for (int m = 0; m < 4; ++m) { const size_t ro = (size_t)(row0 + ai * 128 + m * 16) * 1024 + col0;
#pragma unroll
                for (int bj = 0; bj < 2; ++bj)
#pragma unroll
                    for (int n = 0; n < 2; ++n) { const f32x4 v = acc[ai][bj][m][n] + xv[m][bj][n]; *(f32x4*)(C + ro + bj * 128 + n * 16) = v;
#if ROUTER_FUSED
                        const f32x4 g = *(const f32x4*)(fn + col0 + bj * 128 + n * 16) * A8_SCALE;
                        *(unsigned*)(H2 + ro + bj * 128 + n * 16) = pk4f8(v.x * g.x, v.y * g.y, v.z * g.z, v.w * g.w);
#endif
                    } }
        }
    }
};

#ifndef X1_BF16
#define X1_BF16 1
#endif
struct EpiResB {
    static constexpr bool PERM = true; static constexpr bool CHAIN = false; static constexpr bool PREFETCH = false;
    bf16* C; const float* X;
    DI void prefetch(const pg8::Unit& u, int wr, int wc, int fr, int fq, unsigned& d0, unsigned& d1, unsigned& d2, unsigned& d3) const {
        const float* p = X + (size_t)(u.pm * 256 + wr * 64 + fr + fq * 16) * 1024 + u.pn * 256 + wc * 32;
        asm volatile("global_load_dword %0, %1, off" : "=v"(d0) : "v"(p) : "memory");
        asm volatile("global_load_dword %0, %1, off" : "=v"(d1) : "v"(p + 128) : "memory");
        asm volatile("global_load_dword %0, %1, off" : "=v"(d2) : "v"(p + 128 * 1024) : "memory");
        asm volatile("global_load_dword %0, %1, off" : "=v"(d3) : "v"(p + 128 * 1024 + 128) : "memory");
    }
    DI void operator()(const f32x4 (&acc)[2][2][4][2], const pg8::Unit& u, int wr, int wc, int fr, int fq) const {
        int fr_ = fr, fq_ = fq; asm volatile("" : "+v"(fr_), "+v"(fq_));
        const int row0 = u.pm * 256 + wr * 64 + fr_, col0 = u.pn * 256 + wc * 32 + 8 * fq_;
#pragma unroll
        for (int ai = 0; ai < 2; ++ai) {
            f32x4 xv[4][2][2];
#pragma unroll
            for (int m = 0; m < 4; ++m) { const float* xp = X + (size_t)(row0 + ai * 128 + m * 16) * 1024 + col0;
#pragma unroll
                for (int bj = 0; bj < 2; ++bj) { xv[m][bj][0] = __builtin_nontemporal_load((const f32x4*)(xp + bj * 128)); xv[m][bj][1] = __builtin_nontemporal_load((const f32x4*)(xp + bj * 128 + 4)); } }
#pragma unroll
            for (int m = 0; m < 4; ++m) { bf16* cp = C + (size_t)(row0 + ai * 128 + m * 16) * 1024 + col0;
#pragma unroll
                for (int bj = 0; bj < 2; ++bj) { const f32x4 v0 = acc[ai][bj][m][0] + xv[m][bj][0], v1 = acc[ai][bj][m][1] + xv[m][bj][1];
                    v4u w; w.x = pk2(v0.x, v0.y); w.y = pk2(v0.z, v0.w); w.z = pk2(v1.x, v1.y); w.w = pk2(v1.z, v1.w);
                    *(v4u*)(cp + bj * 128) = w; } }
        }
    }
};
DI void bf8_to_f(const v4u w, float (&f)[8]) { f[0] = bflo(w.x); f[1] = bfhi(w.x); f[2] = bflo(w.y); f[3] = bfhi(w.y); f[4] = bflo(w.z); f[5] = bfhi(w.z); f[6] = bflo(w.w); f[7] = bfhi(w.w); }

#ifndef ROUTER_SPLIT3
#define ROUTER_SPLIT3 1
#endif
#if ROUTER_SPLIT3 && X1_BF16
constexpr int RT_WP = 1040, RT_WH = 0, RT_WM = 33280, RT_WL = 66560, RT_LG = 102400;
#else
constexpr int RT_W = 0, RT_LG = 65536;
#endif
#if X1_BF16
DI void p5_rows(const Args& a, int vcu, int G, int wave, int lane) {
    unsigned char* ws = a.ws; const int gw = vcu * 8 + wave, NGW = G * 8;
    const bf16* X1B = (const bf16*)(ws + WS_X1B);
    {
        float gv[16];
#pragma unroll
        for (int j = 0; j < 4; ++j) { const f32x4 g = ((const f32x4*)(a.in[I_FNORM] + 16 * lane))[j]; gv[4 * j] = g.x; gv[4 * j + 1] = g.y; gv[4 * j + 2] = g.z; gv[4 * j + 3] = g.w; }
        unsigned char* H2 = ws + WS_H;
        for (int m0 = gw; m0 < T; m0 += 4 * NGW) {
            v4u xw[4][2];
#pragma unroll
            for (int q = 0; q < 4; ++q) { const v4u* xr = (const v4u*)(X1B + (size_t)(m0 + q * NGW) * D + 16 * lane); xw[q][0] = xr[0]; xw[q][1] = xr[1]; }
#pragma unroll
            for (int q = 0; q < 4; ++q) {
                float f[16]; { float t[8]; bf8_to_f(xw[q][0], t); _Pragma("unroll") for (int i = 0; i < 8; ++i) f[i] = t[i]; bf8_to_f(xw[q][1], t); _Pragma("unroll") for (int i = 0; i < 8; ++i) f[8 + i] = t[i]; }
                float ss = 0.f;
#pragma unroll
                for (int i = 0; i < 16; ++i) ss += f[i] * f[i];
                const float rstd = rsqrtf(wave_sum(ss) * (1.f / D) + EPS) * A8_SCALE;
#pragma unroll
                for (int i = 0; i < 16; ++i) f[i] = f[i] * rstd * gv[i];
                v4u o; o.x = pk4f8(f[0], f[1], f[2], f[3]); o.y = pk4f8(f[4], f[5], f[6], f[7]); o.z = pk4f8(f[8], f[9], f[10], f[11]); o.w = pk4f8(f[12], f[13], f[14], f[15]);
                *(v4u*)(H2 + (size_t)(m0 + q * NGW) * D + 16 * lane) = o; }
        }
    }
}
#endif
DI void p5_router(const Args& a, LAS unsigned char* lds, int vcu, int G, int tid, int wave, int lane, int cw_cnt) {
    unsigned char* ws = a.ws; const int gw = vcu * 8 + wave, NGW = G * 8;
    const float* X1 = a.out;
#if X1_BF16
    const bf16* X1B = (const bf16*)(ws + WS_X1B);
    const bool rows_first = (__builtin_amdgcn_readfirstlane((int)blockIdx.x) & 1) == 0;
    if (rows_first) p5_rows(a, vcu, G, wave, lane);
#elif !ROUTER_FUSED
    {
        f32x4 gv[4];
#pragma unroll
        for (int j = 0; j < 4; ++j) gv[j] = ((const f32x4*)a.in[I_FNORM])[lane + 64 * j];
#if MOE_FP8
        unsigned char* H2 = ws + WS_H;
        for (int m = gw; m < T; m += NGW) {
            const f32x4* xr = (const f32x4*)(X1 + (size_t)m * D) + lane;
            f32x4 v[4]; float ss = 0.f;
#pragma unroll
            for (int j = 0; j < 4; ++j) { v[j] = xr[64 * j]; ss += (v[j].x * v[j].x + v[j].y * v[j].y) + (v[j].z * v[j].z + v[j].w * v[j].w); }
            const float rstd = rsqrtf(wave_sum(ss) * (1.f / D) + EPS) * A8_SCALE;
            unsigned* o4 = (unsigned*)(H2 + (size_t)m * D) + lane;
#pragma unroll
            for (int j = 0; j < 4; ++j) { v[j] = v[j] * rstd * gv[j]; o4[64 * j] = pk4f8(v[j].x, v[j].y, v[j].z, v[j].w); }
        }
#else
        bf16* H2 = (bf16*)(ws + WS_H);
        for (int m = gw; m < T; m += NGW) {
            const f32x4* xr = (const f32x4*)(X1 + (size_t)m * D) + lane;
            f32x4 v[4]; float ss = 0.f;
#pragma unroll
            for (int j = 0; j < 4; ++j) { v[j] = xr[64 * j]; ss += (v[j].x * v[j].x + v[j].y * v[j].y) + (v[j].z * v[j].z + v[j].w * v[j].w); }
            const float rstd = rsqrtf(wave_sum(ss) * (1.f / D) + EPS);
            unsigned long long* o8 = (unsigned long long*)(H2 + (size_t)m * D) + lane;
#pragma unroll
            for (int j = 0; j < 4; ++j) { v[j] = v[j] * rstd * gv[j]; o8[64 * j] = (unsigned long long)pk2(v[j].x, v[j].y) | ((unsigned long long)pk2(v[j].z, v[j].w) << 32); }
        }
#endif
    }
#endif
    LAS int* hist = (LAS int*)(lds + LCNT_OFF);
    if (tid < 32) hist[tid] = 0;
    const int r = lane & 31, hh = lane >> 5;
    for (int tb = vcu; tb < T / 128; tb += G) {
        const int tok0 = tb * 128 + wave * 32;
        f32x16 acc = {}; float ssq = 0.f;
        for (int kh = 0; kh < 2; ++kh) {
#if ROUTER_SPLIT3 && X1_BF16
            __syncthreads();
#pragma unroll
            for (int i = 0; i < 8; ++i) { const int q = tid + 512 * i, k = q >> 3, e4 = (q & 7) * 4;
                const float gk = a.in[I_FNORM][kh * 512 + k]; const f32x4 w = *(const f32x4*)(a.in[I_WR] + (size_t)(kh * 512 + k) * 32 + e4) * gk;
#pragma unroll
                for (int c = 0; c < 4; ++c) { const float v = w[c];
                    const unsigned h_ = f2bf(v); const float r1 = v - __builtin_bit_cast(float, h_ << 16);
                    const unsigned m_ = f2bf(r1); const float r2 = r1 - __builtin_bit_cast(float, m_ << 16);
                    const unsigned l_ = f2bf(r2);
                    LAS unsigned char* wp_ = lds + (e4 + c) * RT_WP + k * 2;
                    *(LAS unsigned short*)(wp_ + RT_WH) = (unsigned short)h_; *(LAS unsigned short*)(wp_ + RT_WM) = (unsigned short)m_; *(LAS unsigned short*)(wp_ + RT_WL) = (unsigned short)l_; } }
            __syncthreads();
            if (wave < 4) {
                const bf16* xp = X1B + (size_t)(tok0 + r) * D + kh * 512 + 8 * hh;
                const LAS unsigned char* bp_ = lds + r * RT_WP + 16 * hh;
                for (int s8 = 0; s8 < 32; s8 += 8) { v4u xq[8];
#pragma unroll
                  for (int u = 0; u < 8; ++u) xq[u] = *(const v4u*)(xp + 16 * (s8 + u));
#pragma unroll
                  for (int u = 0; u < 8; ++u) { const v4u xw = xq[u]; const bf16x8 av = __builtin_bit_cast(bf16x8, xw);
                    const LAS unsigned char* bq_ = bp_ + 32 * (s8 + u);
                    acc = __builtin_amdgcn_mfma_f32_32x32x16_bf16(av, *(const LAS bf16x8*)(bq_ + RT_WL), acc, 0, 0, 0);
                    acc = __builtin_amdgcn_mfma_f32_32x32x16_bf16(av, *(const LAS bf16x8*)(bq_ + RT_WM), acc, 0, 0, 0);
                    acc = __builtin_amdgcn_mfma_f32_32x32x16_bf16(av, *(const LAS bf16x8*)(bq_ + RT_WH), acc, 0, 0, 0);
                    float t[8]; bf8_to_f(xw, t);
                    ssq += (t[0] * t[0] + t[1] * t[1]) + (t[2] * t[2] + t[3] * t[3]) + ((t[4] * t[4] + t[5] * t[5]) + (t[6] * t[6] + t[7] * t[7])); }
                }
            }
        }
#else
            __syncthreads();
#pragma unroll
            for (int i = 0; i < 8; ++i) { const int q = tid + 512 * i, k = q >> 3, e4 = (q & 7) * 4;
                const float gk = a.in[I_FNORM][kh * 512 + k]; f32x4 w = *(const f32x4*)(a.in[I_WR] + (size_t)(kh * 512 + k) * 32 + e4);
                *(LAS f32x4*)(lds + RT_W + (k * 32 + e4) * 4) = w * gk; }
            __syncthreads();
            if (wave < 4) {
#if X1_BF16
                const bf16* xp = X1B + (size_t)(tok0 + r) * D + kh * 512 + 4 * hh;
                for (int i8 = 0; i8 < 64; i8 += 8) { v2u xq[8];
#pragma unroll
                  for (int u = 0; u < 8; ++u) xq[u] = *(const v2u*)(xp + 8 * (i8 + u));
#pragma unroll
                  for (int u = 0; u < 8; ++u) { const int i = i8 + u; const v2u xw = xq[u]; f32x4 xv; xv.x = bflo(xw.x); xv.y = bfhi(xw.x); xv.z = bflo(xw.y); xv.w = bfhi(xw.y);
#else
                const float* xp = X1 + (size_t)(tok0 + r) * D + kh * 512 + 4 * hh;
                for (int i = 0; i < 64; ++i) { const f32x4 xv = *(const f32x4*)(xp + 8 * i);
#endif
                    ssq += (xv.x * xv.x + xv.y * xv.y) + (xv.z * xv.z + xv.w * xv.w);
                    const LAS float* wp = (const LAS float*)(lds + RT_W) + (8 * i + 4 * hh) * 32 + r;
                    acc = __builtin_amdgcn_mfma_f32_32x32x2f32(xv.x, wp[0], acc, 0, 0, 0);
                    acc = __builtin_amdgcn_mfma_f32_32x32x2f32(xv.y, wp[32], acc, 0, 0, 0);
                    acc = __builtin_amdgcn_mfma_f32_32x32x2f32(xv.z, wp[64], acc, 0, 0, 0);
                    acc = __builtin_amdgcn_mfma_f32_32x32x2f32(xv.w, wp[96], acc, 0, 0, 0); }
#if X1_BF16
                }
#endif
            }
        }
#endif
        if (wave < 4) {
            ssq += __shfl_xor(ssq, 32);
            LAS float* wsc = (LAS float*)(lds + LWSC_OFF + wave * 256);
            if (hh == 0) { const float rs_ = rsqrtf(ssq * (1.f / D) + EPS); wsc[r] = rs_;
#if ROUTER_FUSED
                ((float*)(ws + WS_RSTD))[tok0 + r] = rs_;
#endif
            }
            LDS_WAIT();
            LAS float* LG = (LAS float*)(lds + RT_LG + wave * (32 * 33 * 4));
            const float br = a.in[I_BR][r];
#pragma unroll
            for (int i = 0; i < 16; ++i) { const int tk = crow(i, hh); LG[tk * 33 + r] = acc[i] * wsc[tk] + br; }
            LDS_WAIT();
            if (lane < 32) {
                const LAS float* row = LG + lane * 33;
                float best[4]; int bi[4];
                unsigned taken = 0u;
#pragma unroll
                for (int k = 0; k < 4; ++k) { float bv = -INFINITY; int be = 0;
                    for (int e = 0; e < 32; ++e) { const float v = row[e]; const bool ok = !((taken >> e) & 1u) && v > bv; bv = ok ? v : bv; be = ok ? e : be; }
                    best[k] = bv; bi[k] = be; taken |= 1u << be; }
                const float e0 = 1.f, e1 = expf(best[1] - best[0]), e2 = expf(best[2] - best[0]), e3 = expf(best[3] - best[0]);
                const float inv = 1.f / (e0 + e1 + e2 + e3);
                int* TE = (int*)(ws + WS_TOKE) + (size_t)(tok0 + lane) * 4; float* TW = (float*)(ws + WS_TOKW) + (size_t)(tok0 + lane) * 4;
                TE[0] = bi[0]; TE[1] = bi[1]; TE[2] = bi[2]; TE[3] = bi[3];
                TW[0] = e0 * inv; TW[1] = e1 * inv; TW[2] = e2 * inv; TW[3] = e3 * inv;
                lds_add(&hist[bi[0]], 1); lds_add(&hist[bi[1]], 1); lds_add(&hist[bi[2]], 1); lds_add(&hist[bi[3]], 1);
            }
        }
    }
    __syncthreads();
    if (tid < 32) atomicAdd((unsigned*)(ws + WS_CTL) + cw_cnt + tid, (unsigned)hist[tid]);
#if X1_BF16
    if (!rows_first) p5_rows(a, vcu, G, wave, lane);
#endif
}

DI void moe_table(const Args& a, LAS unsigned char* lds, int tid) {
    LAS int* cnt = (LAS int*)(lds + LCNT_OFF); LAS int* base = cnt + 32; LAS int* misc = cnt + 64; LAS int* tab = (LAS int*)(lds + LTAB_OFF);
    __syncthreads();
    if (tid < 32) cnt[tid] = (int)__hip_atomic_load((unsigned*)(a.ws + WS_CTL) + CW_CNT + tid, RLX_AGENT);
    __syncthreads();
    if (tid == 0) { int ti = 0; for (int e = 0; e < 32; ++e) { base[e] = ti * 256; const int nt = (cnt[e] + 255) >> 8; for (int q = 0; q < nt; ++q) tab[ti + q] = e; ti += nt; } misc[0] = ti; }
    __syncthreads();
}
DI void p6_slots(const Args& a, LAS unsigned char* lds, int vcu, int G, int tid, int wave, int lane, int cw_cur) {
    unsigned char* ws = a.ws;
    LAS int* cnt = (LAS int*)(lds + LCNT_OFF); LAS int* base = cnt + 32;
    LAS int* lh = (LAS int*)(lds + 0); LAS int* wb = lh + 32; LAS int* pslot = lh + 64;
    moe_table(a, lds, tid);
    int* SD = (int*)(ws + WS_SDST); float* SW = (float*)(ws + WS_SW);
    for (int e = vcu; e < 32; e += G) { const int lo = base[e] + cnt[e], hi = base[e] + (((cnt[e] + 255) >> 8) << 8); for (int s = lo + tid; s < hi; s += 512) { SD[s] = -1; ((float*)(ws + WS_SR))[s] = 0.f; } }
    const int* TE = (const int*)(ws + WS_TOKE); const float* TW = (const float*)(ws + WS_TOKW);
    const bf16* H2 = (const bf16*)(ws + WS_H); bf16* XS = (bf16*)(ws + WS_XS);
    for (int tb = vcu; tb < T / 128; tb += G) {
        __syncthreads();
        if (tid < 32) lh[tid] = 0;
        __syncthreads();
        const int pair = tb * 512 + tid; const int e = TE[pair];
        const int rank = lds_add(&lh[e], 1);
        __syncthreads();
        if (tid < 32) wb[tid] = (int)atomicAdd((unsigned*)(ws + WS_CTL) + cw_cur + tid, (unsigned)lh[tid]);
        __syncthreads();
        const int slot = base[e] + wb[e] + rank;
        SD[slot] = pair; SW[slot] = TW[pair]; ((int*)(ws + WS_TSLOT))[pair] = slot;
#if ROUTER_FUSED
        ((float*)(ws + WS_SR))[slot] = ((const float*)(ws + WS_RSTD))[pair >> 2] * ACC8_SCALE;
#endif
    }
    __syncthreads();
}

struct MoeOrder {
    const LAS int* tab; int ntiles, npn, G, c; long bstride;
    DI bool next(int i, pg8::Unit& u) const {
        const long L = (long)i * G + c; const int per = 8 * npn; const int grp = (int)(L / per), within = (int)(L % per);
        const int rt = grp * 8 + (within & 7);
        if (rt >= ntiles) return false;
        const int e = __builtin_amdgcn_readfirstlane(tab[rt]);
        u.pm = rt; u.pn = within >> 3; u.aoff = 0; u.boff = (long)e * bstride; u.tag = e; return true;
    }
};
struct EpiSwiGLU {
    static constexpr bool PERM = true; static constexpr bool CHAIN = false; static constexpr bool PREFETCH = false;
    static constexpr float OSC = MOE_FP8 ? A8_SCALE : 1.f;
    bf16* ACT; const float* bgu; int skip; const float* SR;
    DI void operator()(const f32x4 (&acc)[2][2][4][2], const pg8::Unit& u, int wr, int wc, int fr, int fq) const {
        if (skip == 1) { f32x4 s_ = {0.f, 0.f, 0.f, 0.f}; _Pragma("unroll") for (int a_ = 0; a_ < 2; ++a_) _Pragma("unroll") for (int b_ = 0; b_ < 2; ++b_) _Pragma("unroll") for (int m_ = 0; m_ < 4; ++m_) _Pragma("unroll") for (int n_ = 0; n_ < 2; ++n_) s_ += acc[a_][b_][m_][n_]; if (s_.x + s_.y + s_.z + s_.w == 123.456f) ACT[0] = 0; return; }
        int fr_ = fr, fq_ = fq; asm volatile("" : "+v"(fr_), "+v"(fq_));
        const int row0 = u.pm * 256 + wr * 64 + fr_, j0 = u.pn * 128 + wc * 32 + 8 * fq_;
        const float* bp = bgu + (size_t)u.tag * 2048 + j0;
        const f32x4 bg0 = *(const f32x4*)(bp), bg1 = *(const f32x4*)(bp + 4), bu0 = *(const f32x4*)(bp + 1024), bu1 = *(const f32x4*)(bp + 1028);
        const f32x4 bu0s = bu0 * OSC + OSC, bu1s = bu1 * OSC + OSC; (void)bu0s; (void)bu1s;
#pragma unroll
        for (int ai = 0; ai < 2; ++ai)
#pragma unroll
            for (int m = 0; m < 4; ++m) {
#if MOE_FP8 && ROUTER_FUSED
                const float rs_ = SR[row0 + ai * 128 + m * 16];
                f32x4 g0 = acc[ai][0][m][0] * rs_ + bg0, g1 = acc[ai][0][m][1] * rs_ + bg1, u0 = acc[ai][1][m][0] * rs_ + bu0, u1 = acc[ai][1][m][1] * rs_ + bu1;
#elif MOE_FP8
                f32x4 g0 = acc[ai][0][m][0] * ACC8_SCALE + bg0, g1 = acc[ai][0][m][1] * ACC8_SCALE + bg1, u0 = acc[ai][1][m][0] * (ACC8_SCALE * OSC) + bu0s, u1 = acc[ai][1][m][1] * (ACC8_SCALE * OSC) + bu1s;
#else
                f32x4 g0 = acc[ai][0][m][0] + bg0, g1 = acc[ai][0][m][1] + bg1, u0 = acc[ai][1][m][0] + bu0, u1 = acc[ai][1][m][1] + bu1;
#endif
                float o[8];
#pragma unroll
#if MOE_FP8 && !ROUTER_FUSED
                for (int q = 0; q < 4; ++q) { float g = fminf(g0[q], 7.f), up = __builtin_amdgcn_fmed3f(u0[q], -6.f * OSC, 8.f * OSC); o[q] = up * g * __builtin_amdgcn_rcpf(1.f + __builtin_amdgcn_exp2f(g * (-1.702f * LOG2E)));
                    g = fminf(g1[q], 7.f); up = __builtin_amdgcn_fmed3f(u1[q], -6.f * OSC, 8.f * OSC); o[4 + q] = up * g * __builtin_amdgcn_rcpf(1.f + __builtin_amdgcn_exp2f(g * (-1.702f * LOG2E))); }
#else
                for (int q = 0; q < 4; ++q) { float g = fminf(g0[q], 7.f), up = fminf(fmaxf(u0[q], -7.f), 7.f); o[q] = (up * OSC + OSC) * g * sigmoidf_(1.702f * g);
                    g = fminf(g1[q], 7.f); up = fminf(fmaxf(u1[q], -7.f), 7.f); o[4 + q] = (up * OSC + OSC) * g * sigmoidf_(1.702f * g); }
#endif
#if MOE_FP8
                v2u w; w.x = pk4f8(o[0], o[1], o[2], o[3]); w.y = pk4f8(o[4], o[5], o[6], o[7]);
                if (skip != 2 || w.x == 0x12345678u) *(v2u*)((unsigned char*)ACT + (size_t)(row0 + ai * 128 + m * 16) * 1024 + j0) = w; }
#else
                v4u w; w.x = pk2(o[0], o[1]); w.y = pk2(o[2], o[3]); w.z = pk2(o[4], o[5]); w.w = pk2(o[6], o[7]);
                if (skip != 2 || w.x == 0x12345678u) *(v4u*)(ACT + (size_t)(row0 + ai * 128 + m * 16) * 1024 + j0) = w; }
#endif
    }
};
#ifndef Y_FP8
#define Y_FP8 1
#endif
constexpr float Y8_SCALE = 16.f;
DI float clamp8(float v) { return __builtin_amdgcn_fmed3f(v, -448.f, 448.f); }
struct EpiDown {
    static constexpr bool PERM = true; static constexpr bool CHAIN = false; static constexpr bool PREFETCH = false;
    bf16* Y2; const float* bd; const int* SD; const float* SW;
    DI void operator()(const f32x4 (&acc)[2][2][4][2], const pg8::Unit& u, int wr, int wc, int fr, int fq) const {
        int fr_ = fr, fq_ = fq; asm volatile("" : "+v"(fr_), "+v"(fq_));
        const int row0 = u.pm * 256 + wr * 64 + fr_, col0 = u.pn * 256 + wc * 32 + 8 * fq_;
        const float* bp = bd + (size_t)u.tag * 1024 + col0;
        f32x4 bv[2][2];
#pragma unroll
        for (int bj = 0; bj < 2; ++bj)
#pragma unroll
            for (int n = 0; n < 2; ++n) bv[bj][n] = *(const f32x4*)(bp + bj * 128 + 4 * n);
        float sws[2][4];
#pragma unroll
        for (int ai = 0; ai < 2; ++ai)
#pragma unroll
            for (int m = 0; m < 4; ++m) sws[ai][m] = SW[row0 + ai * 128 + m * 16];
#pragma unroll
        for (int ai = 0; ai < 2; ++ai)
#pragma unroll
            for (int m = 0; m < 4; ++m) {
#if Y_FP8
                const float sw = sws[ai][m] * Y8_SCALE; unsigned char* rowp = (unsigned char*)Y2 + (size_t)(row0 + ai * 128 + m * 16) * 1024 + col0;
#else
                const float sw = sws[ai][m]; bf16* rowp = Y2 + (size_t)(row0 + ai * 128 + m * 16) * 1024 + col0;
#endif
#pragma unroll
                for (int bj = 0; bj < 2; ++bj) {
#if MOE_FP8
                    const f32x4 v0 = (acc[ai][bj][m][0] * ACC8_SCALE + bv[bj][0]) * sw, v1 = (acc[ai][bj][m][1] * ACC8_SCALE + bv[bj][1]) * sw;
#else
                    const f32x4 v0 = (acc[ai][bj][m][0] + bv[bj][0]) * sw, v1 = (acc[ai][bj][m][1] + bv[bj][1]) * sw;
#endif
#if Y_FP8
                    v2u w; w.x = pk4f8(clamp8(v0.x), clamp8(v0.y), clamp8(v0.z), clamp8(v0.w)); w.y = pk4f8(clamp8(v1.x), clamp8(v1.y), clamp8(v1.z), clamp8(v1.w));
                    *(v2u*)(rowp + bj * 128) = w; } }
#else
                    v4u w; w.x = pk2(v0.x, v0.y); w.y = pk2(v0.z, v0.w); w.z = pk2(v1.x, v1.y); w.w = pk2(v1.z, v1.w);
                    *(v4u*)(rowp + bj * 128) = w; } }
#endif
    }
};

#if X1_BF16 && Y_FP8
DI void p9_combine(const Args& a, int vcu, int G, int wave, int lane) {
    unsigned char* ws = a.ws; const int gw = vcu * 8 + wave, NGW = G * 8;
    const unsigned char* Y2 = ws + WS_XS; constexpr float IS = 1.f / Y8_SCALE;
    for (int m0 = gw; m0 < T; m0 += 4 * NGW) {
        int ts[4][4]; v4u xw[4][2], yw[4][4];
#pragma unroll
        for (int q = 0; q < 4; ++q) { const size_t m = (size_t)(m0 + q * NGW); const int* tp = (const int*)(ws + WS_TSLOT) + m * 4; ts[q][0] = tp[0]; ts[q][1] = tp[1]; ts[q][2] = tp[2]; ts[q][3] = tp[3];
            const v4u* xp = (const v4u*)((const bf16*)(ws + WS_X1B) + m * D + 16 * lane); xw[q][0] = xp[0]; xw[q][1] = xp[1]; }
#pragma unroll
        for (int q = 0; q < 4; ++q)
#pragma unroll
            for (int k = 0; k < 4; ++k) yw[q][k] = *(const v4u*)(Y2 + (size_t)ts[q][k] * 1024 + 16 * lane);
#pragma unroll
        for (int q = 0; q < 4; ++q) {
            float o[16]; { float t[8]; bf8_to_f(xw[q][0], t); _Pragma("unroll") for (int i = 0; i < 8; ++i) o[i] = t[i]; bf8_to_f(xw[q][1], t); _Pragma("unroll") for (int i = 0; i < 8; ++i) o[8 + i] = t[i]; }
#pragma unroll
            for (int k = 0; k < 4; ++k) { const v4u w = yw[q][k]; f32x2_t_ c;
                c = __builtin_amdgcn_cvt_pk_f32_fp8((int)w.x, false); o[0] += c.x * IS; o[1] += c.y * IS; c = __builtin_amdgcn_cvt_pk_f32_fp8((int)w.x, true); o[2] += c.x * IS; o[3] += c.y * IS;
                c = __builtin_amdgcn_cvt_pk_f32_fp8((int)w.y, false); o[4] += c.x * IS; o[5] += c.y * IS; c = __builtin_amdgcn_cvt_pk_f32_fp8((int)w.y, true); o[6] += c.x * IS; o[7] += c.y * IS;
                c = __builtin_amdgcn_cvt_pk_f32_fp8((int)w.z, false); o[8] += c.x * IS; o[9] += c.y * IS; c = __builtin_amdgcn_cvt_pk_f32_fp8((int)w.z, true); o[10] += c.x * IS; o[11] += c.y * IS;
                c = __builtin_amdgcn_cvt_pk_f32_fp8((int)w.w, false); o[12] += c.x * IS; o[13] += c.y * IS; c = __builtin_amdgcn_cvt_pk_f32_fp8((int)w.w, true); o[14] += c.x * IS; o[15] += c.y * IS; }
            f32x4* op = (f32x4*)(a.out + (size_t)(m0 + q * NGW) * D + 16 * lane);
            op[0] = (f32x4){o[0], o[1], o[2], o[3]}; op[1] = (f32x4){o[4], o[5], o[6], o[7]}; op[2] = (f32x4){o[8], o[9], o[10], o[11]}; op[3] = (f32x4){o[12], o[13], o[14], o[15]};
        }
    }
}
#else
DI void p9_combine(const Args& a, int vcu, int G, int wave, int lane) {
    unsigned char* ws = a.ws; const int gw = vcu * 8 + wave, NGW = G * 8;
    const bf16* Y2 = (const bf16*)(ws + WS_XS);
    for (int m = gw; m < T; m += NGW) {
        f32x4* op = (f32x4*)(a.out + (size_t)m * D + 16 * lane);
#if X1_BF16
        f32x4 o0, o1, o2, o3; { const v4u* xp = (const v4u*)((const bf16*)(ws + WS_X1B) + (size_t)m * D + 16 * lane); const v4u w0 = xp[0], w1 = xp[1];
            o0.x = bflo(w0.x); o0.y = bfhi(w0.x); o0.z = bflo(w0.y); o0.w = bfhi(w0.y); o1.x = bflo(w0.z); o1.y = bfhi(w0.z); o1.z = bflo(w0.w); o1.w = bfhi(w0.w);
            o2.x = bflo(w1.x); o2.y = bfhi(w1.x); o2.z = bflo(w1.y); o2.w = bfhi(w1.y); o3.x = bflo(w1.z); o3.y = bfhi(w1.z); o3.z = bflo(w1.w); o3.w = bfhi(w1.w); }
#else
        f32x4 o0 = op[0], o1 = op[1], o2 = op[2], o3 = op[3];
#endif
        int ts[4]; { const int* tp = (const int*)(ws + WS_TSLOT) + (size_t)m * 4; ts[0] = tp[0]; ts[1] = tp[1]; ts[2] = tp[2]; ts[3] = tp[3]; }
#pragma unroll
#if Y_FP8
        for (int k = 0; k < 4; ++k) { const v4u w = *(const v4u*)((const unsigned char*)Y2 + (size_t)ts[k] * 1024 + 16 * lane); constexpr float IS = 1.f / Y8_SCALE;
            f32x2_t_ a;
            a = __builtin_amdgcn_cvt_pk_f32_fp8((int)w.x, false); o0.x += a.x * IS; o0.y += a.y * IS; a = __builtin_amdgcn_cvt_pk_f32_fp8((int)w.x, true); o0.z += a.x * IS; o0.w += a.y * IS;
            a = __builtin_amdgcn_cvt_pk_f32_fp8((int)w.y, false); o1.x += a.x * IS; o1.y += a.y * IS; a = __builtin_amdgcn_cvt_pk_f32_fp8((int)w.y, true); o1.z += a.x * IS; o1.w += a.y * IS;
            a = __builtin_amdgcn_cvt_pk_f32_fp8((int)w.z, false); o2.x += a.x * IS; o2.y += a.y * IS; a = __builtin_amdgcn_cvt_pk_f32_fp8((int)w.z, true); o2.z += a.x * IS; o2.w += a.y * IS;
            a = __builtin_amdgcn_cvt_pk_f32_fp8((int)w.w, false); o3.x += a.x * IS; o3.y += a.y * IS; a = __builtin_amdgcn_cvt_pk_f32_fp8((int)w.w, true); o3.z += a.x * IS; o3.w += a.y * IS; }
#else
        for (int k = 0; k < 4; ++k) { const v4u* yp = (const v4u*)(Y2 + (size_t)ts[k] * 1024 + 16 * lane); const v4u w0 = yp[0], w1 = yp[1];
            o0.x += bflo(w0.x); o0.y += bfhi(w0.x); o0.z += bflo(w0.y); o0.w += bfhi(w0.y); o1.x += bflo(w0.z); o1.y += bfhi(w0.z); o1.z += bflo(w0.w); o1.w += bfhi(w0.w);
            o2.x += bflo(w1.x); o2.y += bfhi(w1.x); o2.z += bflo(w1.y); o2.w += bfhi(w1.y); o3.x += bflo(w1.z); o3.y += bfhi(w1.z); o3.z += bflo(w1.w); o3.w += bfhi(w1.w); }
#endif
        op[0] = o0; op[1] = o1; op[2] = o2; op[3] = o3;
    }
}
#endif
constexpr int NPHASE = 12;
#ifndef P1_SPLIT
#define P1_SPLIT 1
#endif
constexpr int N_ATT_ITEMS = 1024, N_MX_ITEMS = 512, N_SCAN_WG = 32, N_TR_WG = 64;
DI void stagger(int bx, int step_ticks) {
#ifdef STAGGER
    const unsigned long long t0 = __builtin_amdgcn_s_memrealtime(); const unsigned long long d = (unsigned long long)(((bx >> 3) & 7) * step_ticks);
    while (__builtin_amdgcn_s_memrealtime() - t0 < d) __builtin_amdgcn_s_sleep(8);
#endif
}
typedef const Args __attribute__((address_space(4))) CArgs;
#if defined(__HIP_DEVICE_COMPILE__)
DI CArgs* fresh_args() { unsigned long long v = (unsigned long long)__builtin_amdgcn_kernarg_segment_ptr(); asm volatile("" : "+s"(v)); return (CArgs*)v; }
#else
__device__ CArgs* fresh_args();
#endif
DI Args load_args() { CArgs* p = fresh_args(); Args a;
#pragma unroll
    for (int i = 0; i < 27; ++i) a.in[i] = p->in[i];
    a.out = p->out; a.ws = p->ws; a.ph_lo = p->ph_lo; a.ph_hi = p->ph_hi; a.li = p->li; a.pad = 0; return a; }
#ifndef MK_N_LAUNCHES
#define MK_N_LAUNCHES 1
#endif
__global__ void __launch_bounds__(512, 2) mk_fwd(Args args_unused) {
    extern __shared__ __attribute__((aligned(16))) unsigned char lds_raw[];
    LAS unsigned char* lds = (LAS unsigned char*)lds_raw;
    volatile LAS unsigned* MISC = (volatile LAS unsigned*)(lds + MISC_OFF);
    for (int u = threadIdx.x; u < (LDS_BYTES - LDSCTL_OFF) / 4; u += 512) ((LAS unsigned*)(lds + LDSCTL_OFF))[u] = 0u;
    __syncthreads();
    { const Args A0 = load_args(); (void)xcd_barrier_post((unsigned*)(A0.ws + WS_CTL) + CW_BAR, MISC + 8); }
#ifdef ONLY_PHASE
#define IN(k) ((k) == ONLY_PHASE)
#elif MK_N_LAUNCHES == 1
#define IN(k) true
#else
#define IN(k) (fresh_args()->ph_lo <= (k) && (k) < fresh_args()->ph_hi)
#endif
#define FRESH() const Args A_ = load_args(); unsigned char* const ws = A_.ws; (void)ws; const int tid_ = fresh_tid(), lane_ = tid_ & 63, wave_ = __builtin_amdgcn_readfirstlane(tid_ >> 6); (void)lane_; (void)wave_; \
    const int G = gridDim.x, bx = blockIdx.x, vcu = (G % 8 == 0) ? (bx % 8) * (G / 8) + bx / 8 : bx; (void)vcu
#ifndef REPEAT_PHASE
#define REPEAT_PHASE -1
#endif
#define NREP(k) ((k) == REPEAT_PHASE ? 2 : 1)
#define GBAR() do { XcdBarrier b_; b_.bar = (unsigned*)(fresh_args()->ws + WS_CTL) + CW_BAR; b_.x = xb_xcc_id(); b_.st = MISC + 8; xcd_barrier(b_); } while (0)
#define SEAM(k) do { if (IN(k) && IN((k) + 1)) { XcdBarrier b_; b_.bar = (unsigned*)(fresh_args()->ws + WS_CTL) + CW_BAR; b_.x = xb_xcc_id(); b_.st = MISC + 8; xcd_barrier(b_); } } while (0)

    if (IN(0)) _Pragma("unroll") for (int rep_ = 0; rep_ < NREP(0); ++rep_) { if (rep_) GBAR(); FRESH();
#ifdef PROBE_P0
        p0_prologue(A_, lds, vcu, G, wave_, lane_, rep_ == 0 ? PROBE_P0 : 0); }
#else
        p0_prologue(A_, lds, vcu, G, wave_, lane_); }
#endif
    SEAM(0);
    if (IN(1)) _Pragma("unroll") for (int rep_ = 0; rep_ < NREP(1); ++rep_) { if (rep_) GBAR();
        FRESH();
        const int cls_ = P1_SPLIT ? (__builtin_amdgcn_readfirstlane((int)blockIdx.x) & 3) : 0;
#define P1_F8_PART(I0, NI) {   \
          pg8::Gemm g{(const bf16*)(ws + WS_H8), (const bf16*)(ws + WS_WIN8), 512, 512, 512, nullptr, 0}; \
          OffOrder S; S.S.init(T, (12 + (P1_FA1 - P1_FA0)) * 256, G, bx); S.n0 = P1_FA1 - P1_FA0; S.a0 = P1_FA0; S.a1 = 16; S.i0 = (I0); S.ni = (NI); \
          EpiPT<true> E{(bf16*)(ws + WS_P), A_.in[I_BGATE], 0, (bf16*)(ws + WS_GF), (LAS float*)(lds + 128 * 1024), A_.in[I_DAQN], A_.in[I_DAKN], A_.in[I_MXQN]}; \
          pg8::gemm_phase<EpiPT<true>, OffOrder, false, true>(lds, g, S, E, tid_); }
#define P1_BF_PART(I0, NI) { \
          pg8::Gemm g{(const bf16*)(ws + WS_H), (const bf16*)(ws + WS_WIN), 1024, 1024, 1024, nullptr, 0}; \
          OffOrder S; S.S.init(T, (16 - (P1_FA1 - P1_FA0)) * 256, G, bx); S.n0 = P1_FA0; S.a0 = 0; S.a1 = P1_FA1; S.i0 = (I0); S.ni = (NI); \
          EpiP E{(bf16*)(ws + WS_P), A_.in[I_BGATE], 0, (bf16*)(ws + WS_GF), (LAS float*)(lds + 128 * 1024), A_.in[I_DAQN], A_.in[I_DAKN], A_.in[I_MXQN]}; \
          pg8::gemm_phase<EpiP, OffOrder>(lds, g, S, E, tid_); }
        const int f8a_ = cls_ == 1 ? 1000 : cls_ == 3 ? 3 : 0;
        const int bfa_ = cls_ == 2 ? 4 : 1000;
        if (f8a_ > 0) P1_F8_PART(0, f8a_)
        P1_BF_PART(0, bfa_)
        if (f8a_ < 1000) P1_F8_PART(f8a_, 1000)
        if (bfa_ < 1000) P1_BF_PART(bfa_, 1000)
#undef P1_F8_PART
#undef P1_BF_PART
    }
    SEAM(1);
    if (IN(2)) _Pragma("unroll") for (int rep_ = 0; rep_ < NREP(2); ++rep_) { if (rep_) GBAR();
        FRESH();
#ifndef NO_PREP
        { PrepPre pp; if (vcu < NCHUNK) prep_prefetch(A_, vcu, tid_, wave_, pp);
          for (int ck = vcu; ck < NCHUNK; ck += G) dn_prep_unit<0>(A_, lds, ck, ck + G, pp, wave_); }
#endif
#if !defined(NO_NORM) && !NORM_IN_EPI
        if (rep_ == 0) p2_norm_rows(A_, vcu, G, wave_, lane_);
#endif
    }
    SEAM(2);
    if (IN(3)) _Pragma("unroll") for (int rep_ = 0; rep_ < NREP(3); ++rep_) { if (rep_) GBAR();
#ifndef NO_SCAN
        if (blockIdx.x >= N_SCAN_WG && blockIdx.x < N_SCAN_WG + N_TR_WG) { FRESH(); moe_transposes(A_, lds, bx - N_SCAN_WG, N_TR_WG, wave_, lane_); p3_small_copies(A_, lds, bx - N_SCAN_WG, N_TR_WG, wave_, lane_); __syncthreads(); }
        if (blockIdx.x >= N_SCAN_WG + N_TR_WG && blockIdx.x < N_SCAN_WG + N_TR_WG + 16) { FRESH();
            pg8::Gemm g{(const bf16*)(ws + WS_MEMN), (const bf16*)(ws + WS_WMKV), 1024, 1024, 1024, nullptr, 0}; pg8::StaticOrder S; S.init(BATCH * NMEM, 1024, 16, bx - (N_SCAN_WG + N_TR_WG));
            EpiPlain E{(bf16*)(ws + WS_MKV), 1024};
            pg8::gemm_phase<EpiPlain, pg8::StaticOrder>(lds, g, S, E, tid_);
            asm volatile("s_waitcnt vmcnt(0)" ::: "memory"); __syncthreads();
            if (tid_ == 0) { __builtin_amdgcn_fence(__ATOMIC_RELEASE, "agent"); asm volatile("s_waitcnt vmcnt(0)" ::: "memory"); __hip_atomic_fetch_add((unsigned*)(ws + WS_CTL) + CW_MKV + 1024 * rep_, 1u, RLX_AGENT); }
            __syncthreads(); }
#ifdef PROBE_ATT
        if (rep_ == 1)
#endif
        if (blockIdx.x < N_SCAN_WG) { FRESH(); dn_scan(A_, lds, bx, wave_, lane_); }
#ifdef PROBE_SCAN_ALONE
        GBAR();
#endif
#ifdef PROBE_SCAN_TWICE
        if (blockIdx.x < N_SCAN_WG) { FRESH(); dn_scan(A_, lds, bx, wave_, lane_); }
#endif
#endif
#ifndef NO_ATT
        for (;;) {
            CArgs* ap = fresh_args(); unsigned char* ws = ap->ws; const int tid_ = fresh_tid();
            if (tid_ == 0) MISC[16] = __hip_atomic_fetch_add((unsigned*)(ws + WS_CTL) + CW_QHEAD + 1024 * rep_, 1u, RLX_AGENT);
            __syncthreads();
            const int item = __builtin_amdgcn_readfirstlane((int)MISC[16]);
            __syncthreads();
            if (item >= N_ATT_ITEMS) break;
            const int qb = 31 - (item >> 5), rest = item & 31, b = rest >> 3, h = (rest >> 1) & 3, map = rest & 1;
            const attn_body::bf16* Pb = (const attn_body::bf16*)(ws + WS_P) + (size_t)b * SEQ * PW;
            attn_body::bf16* Ob = (attn_body::bf16*)(ws + (map ? WS_O2 : WS_O1)) + (size_t)b * SEQ * 512 + h * 128;
            attn_body::attn_unit<8, false>(qb, Pb + P_DAQ + h * 128 + map * 64, Pb + P_DAK + h * 128 + map * 64, Pb + P_DAV + h * 128, Ob, ap->in[I_REL], h, (char*)lds_raw, tid_);
        }
#endif
#ifndef NO_MX
        { FRESH();
          if (tid_ == 0) { unsigned sp = 0; while (__hip_atomic_load((unsigned*)(ws + WS_CTL) + CW_MKV + 1024 * rep_, RLX_AGENT) < 16u) { __builtin_amdgcn_s_sleep(2); if (++sp > (1u << 22)) break; }
              __builtin_amdgcn_fence(__ATOMIC_ACQUIRE, "agent"); asm volatile("s_waitcnt vmcnt(0)" ::: "memory"); }
          __syncthreads(); }
        for (;;) {
            FRESH();
            if (tid_ == 0) MISC[16] = __hip_atomic_fetch_add((unsigned*)(ws + WS_CTL) + CW_QHEAD + 16 + 1024 * rep_, 1u, RLX_AGENT);
            __syncthreads();
            const int idx = __builtin_amdgcn_readfirstlane((int)MISC[16]);
            __syncthreads();
            if (idx >= N_MX_ITEMS) break;
            mx_unit(A_, lds, idx >> 5, idx & 31, tid_, wave_, lane_);
        }
#endif
    }
    SEAM(3);
    if (IN(4)) _Pragma("unroll") for (int rep_ = 0; rep_ < NREP(4); ++rep_) { if (rep_) GBAR(); FRESH(); p4_norm_rows(A_, vcu, G, wave_, lane_); }
    SEAM(4);
    if (IN(5)) _Pragma("unroll") for (int rep_ = 0; rep_ < NREP(5); ++rep_) { if (rep_) GBAR();
        FRESH();
        pg8::Gemm g{(const bf16*)(ws + WS_ODNF), (const bf16*)(ws + WS_WB), 512, 512, 512, nullptr, 0};
        BranchOrder S; S.so.init(T, 1024, G, bx); S.a1 = (long)(WS_ODAF - WS_ODNF); S.a2 = (long)(WS_OMX - WS_ODNF);
        EpiMerge E{(bf16*)(ws + WS_MRG), (const bf16*)(ws + WS_GF), (bf16*)(ws + WS_MF)};
        pg8::gemm_phase<EpiMerge, BranchOrder>(lds, g, S, E, tid_);
    }
    SEAM(5);
    if (IN(6)) _Pragma("unroll") for (int rep_ = 0; rep_ < NREP(6); ++rep_) { if (rep_) GBAR();
        FRESH();
        pg8::Gemm g{(const bf16*)(ws + WS_MRG), (const bf16*)(ws + WS_WOUT), 1024, 1024, 1024, nullptr, 0}; pg8::StaticOrder S; S.init(T, 1024, G, bx);
#if X1_BF16
        EpiResB E{(bf16*)(ws + WS_X1B), A_.in[I_X]};
        pg8::gemm_phase<EpiResB, pg8::StaticOrder>(lds, g, S, E, tid_);
#else
        EpiResF32 E{A_.out, A_.in[I_X], ws + WS_H, A_.in[I_FNORM]};
        pg8::gemm_phase<EpiResF32, pg8::StaticOrder>(lds, g, S, E, tid_);
#endif
    }
    SEAM(6);
    if (IN(7)) _Pragma("unroll") for (int rep_ = 0; rep_ < NREP(7); ++rep_) { if (rep_) GBAR(); FRESH(); p5_router(A_, lds, vcu, G, tid_, wave_, lane_, CW_CNT + 256 * rep_); }
    SEAM(7);
    if (IN(8)) _Pragma("unroll") for (int rep_ = 0; rep_ < NREP(8); ++rep_) { if (rep_) GBAR(); FRESH(); p6_slots(A_, lds, vcu, G, tid_, wave_, lane_, CW_CUR + 256 * rep_); }
    SEAM(8);
    if (IN(9)) _Pragma("unroll") for (int rep_ = 0; rep_ < NREP(9); ++rep_) { if (rep_) GBAR();
        FRESH();
        moe_table(A_, lds, tid_);
#if MOE_FP8
        pg8::Gemm g{(const bf16*)(ws + WS_H), (const bf16*)(ws + WS_WGU), 512, 512, 512, (const int*)(ws + WS_SDST), 0};
        MoeOrder S{(const LAS int*)(lds + LTAB_OFF), ((const LAS int*)(lds + LCNT_OFF))[64], 8, G, bx, (long)2048 * 1024};
#else
        pg8::Gemm g{(const bf16*)(ws + WS_H), (const bf16*)(ws + WS_WGU), 1024, 1024, 1024, (const int*)(ws + WS_SDST), 0};
        MoeOrder S{(const LAS int*)(lds + LTAB_OFF), ((const LAS int*)(lds + LCNT_OFF))[64], 8, G, bx, (long)2048 * 1024 * 2};
#endif
#ifdef PROBE_NOEPI
        EpiSwiGLU E{(bf16*)(ws + WS_ACT), A_.in[I_BGU], (REPEAT_PHASE == 9 && rep_ == 0) ? PROBE_NOEPI : 0, (const float*)(ws + WS_SR)};
#else
        EpiSwiGLU E{(bf16*)(ws + WS_ACT), A_.in[I_BGU], 0, (const float*)(ws + WS_SR)};
#endif
        pg8::gemm_phase<EpiSwiGLU, MoeOrder, true, MOE_FP8 != 0>(lds, g, S, E, tid_);
    }
    SEAM(9);
    if (IN(10)) _Pragma("unroll") for (int rep_ = 0; rep_ < NREP(10); ++rep_) { if (rep_) GBAR();
        FRESH();
        moe_table(A_, lds, tid_);
#if MOE_FP8
        pg8::Gemm g{(const bf16*)(ws + WS_ACT), (const bf16*)(ws + WS_WD), 512, 512, 512, nullptr, 0};
        MoeOrder S{(const LAS int*)(lds + LTAB_OFF), ((const LAS int*)(lds + LCNT_OFF))[64], 4, G, bx, (long)1024 * 1024};
#else
        pg8::Gemm g{(const bf16*)(ws + WS_ACT), (const bf16*)(ws + WS_WD), 1024, 1024, 1024, nullptr, 0};
        MoeOrder S{(const LAS int*)(lds + LTAB_OFF), ((const LAS int*)(lds + LCNT_OFF))[64], 4, G, bx, (long)1024 * 1024 * 2};
#endif
        EpiDown E{(bf16*)(ws + WS_XS), A_.in[I_BD], (const int*)(ws + WS_SDST), (const float*)(ws + WS_SW)};
        pg8::gemm_phase<EpiDown, MoeOrder, false, MOE_FP8 != 0>(lds, g, S, E, tid_);
    }
    SEAM(10);
    if (IN(11)) {
        FRESH();
#ifdef PROBE_P11
        p9_combine_probe(A_, vcu, G, wave_, lane_); GBAR();
#endif
        p9_combine(A_, vcu, G, wave_, lane_);
        if (bx == 0 && tid_ == 0) { if (__hip_atomic_load((unsigned*)(ws + WS_CTL) + CW_BAR + XB_TMO, RLX_AGENT) != 0u) A_.out[0] = __builtin_nanf(""); }
    }
#undef IN
#undef SEAM
#undef FRESH
}

extern "C" void kernel_launch(void* const* d_in, const int* in_sizes, int n_in, void* d_out, int out_size, void* d_ws, size_t ws_size, hipStream_t stream) {
    static int grid = 0;
    if (grid == 0) {
        if (n_in != 27 || in_sizes[0] != T * D || out_size != T * D || ws_size < WS_END) {
            fprintf(stderr, "kernel_launch: unexpected shapes (n_in %d, in0 %d, out %d, ws %zu < %zu); nothing launched\n", n_in, n_in > 0 ? in_sizes[0] : -1, out_size, ws_size, (size_t)WS_END); grid = -1; return; }
        int dev = 0, cus = 0, per_cu = 0;
        if (hipGetDevice(&dev) != hipSuccess || hipDeviceGetAttribute(&cus, hipDeviceAttributeMultiprocessorCount, dev) != hipSuccess) { grid = -1; return; }
        if (hipFuncSetAttribute((const void*)mk_fwd, hipFuncAttributeMaxDynamicSharedMemorySize, LDS_BYTES) != hipSuccess) { fprintf(stderr, "kernel_launch: hipFuncSetAttribute failed\n"); grid = -1; return; }
        if (hipOccupancyMaxActiveBlocksPerMultiprocessor(&per_cu, (const void*)mk_fwd, 512, LDS_BYTES) != hipSuccess || per_cu < 1)
            fprintf(stderr, "kernel_launch: note: occupancy query reports %d workgroups per CU\n", per_cu);
        (void)hipGetLastError();
        grid = cus;
        if (grid > 256) grid = 256;
    }
    if (grid < 0) return;
    if (hipMemsetAsync((char*)d_ws + WS_CTL, 0, CTL_ZERO_BYTES, stream) != hipSuccess) return;
    Args a{};
    for (int i = 0; i < 27; ++i) a.in[i] = (const float*)d_in[i];
    a.out = (float*)d_out; a.ws = (unsigned char*)d_ws;
#if MK_N_LAUNCHES == 1
    a.ph_lo = 0; a.ph_hi = NPHASE; a.li = 0; a.pad = 0;
    hipLaunchKernelGGL(mk_fwd, dim3(grid), dim3(512), LDS_BYTES, stream, a);
#else
    for (int p = 0; p < NPHASE; ++p) { a.ph_lo = p; a.ph_hi = p + 1; a.li = 0; a.pad = 0; hipLaunchKernelGGL(mk_fwd, dim3(grid), dim3(512), LDS_BYTES, stream, a); }
#endif
}
```

```cpp
#include <hip/hip_runtime.h>
#include <hip/hip_bf16.h>
#include <cstdio>
#include <cstdint>
#include <cmath>

#define GAS __attribute__((address_space(1)))
#define LAS __attribute__((address_space(3)))
typedef unsigned short bf16;
typedef unsigned v4u __attribute__((ext_vector_type(4)));
typedef unsigned v2u __attribute__((ext_vector_type(2)));
typedef float f32x4 __attribute__((ext_vector_type(4)));
typedef float f32x16 __attribute__((ext_vector_type(16)));
typedef short bf16x8 __attribute__((ext_vector_type(8)));
typedef short s16x4 __attribute__((ext_vector_type(4)));
typedef GAS unsigned gu32;
#define RLX_AGENT __ATOMIC_RELAXED, __HIP_MEMORY_SCOPE_AGENT
#define LDS_WAIT() asm volatile("s_waitcnt lgkmcnt(0)" ::: "memory")
#define VM_WAIT() asm volatile("s_waitcnt vmcnt(0)" ::: "memory")
#define DI __device__ __forceinline__

DI unsigned f2bf(float f) { unsigned u = __builtin_bit_cast(unsigned, f); return (u + 0x7fffu + ((u >> 16) & 1u)) >> 16; }
typedef float f32x2_t_ __attribute__((ext_vector_type(2))); typedef __bf16 bf16x2_t_ __attribute__((ext_vector_type(2)));
DI unsigned pk2(float lo, float hi) { f32x2_t_ v = {lo, hi}; bf16x2_t_ b = __builtin_convertvector(v, bf16x2_t_); return __builtin_bit_cast(unsigned, b); }
typedef int v8i_ __attribute__((ext_vector_type(8))); typedef int v4i_ __attribute__((ext_vector_type(4)));
DI unsigned pk4f8(float a, float b, float c, float d) { int w = __builtin_amdgcn_cvt_pk_fp8_f32(a, b, 0, false); w = __builtin_amdgcn_cvt_pk_fp8_f32(c, d, w, true); return (unsigned)w; }
DI v8i_ cat8(bf16x8 lo, bf16x8 hi) { return __builtin_shufflevector(__builtin_bit_cast(v4i_, lo), __builtin_bit_cast(v4i_, hi), 0, 1, 2, 3, 4, 5, 6, 7); }
DI void mfma_f8(f32x4& c, v8i_ a, v8i_ b) { asm volatile("v_mfma_f32_16x16x128_f8f6f4 %0, %1, %2, %0" : "+v"(c) : "v"(a), "v"(b)); }
DI float bflo(unsigned w) { return __builtin_bit_cast(float, w << 16); }
DI float bfhi(unsigned w) { return __builtin_bit_cast(float, w & 0xffff0000u); }
DI float bf2f(bf16 b) { return __builtin_bit_cast(float, (unsigned)b << 16); }
template <int C> DI float dppf(float v) { return __builtin_bit_cast(float, __builtin_amdgcn_update_dpp(0, __builtin_bit_cast(int, v), C, 0xf, 0xf, true)); }
DI float sum16(float v) { v += dppf<0xB1>(v); v += dppf<0x4E>(v); v += dppf<0x141>(v); v += dppf<0x140>(v); return v; }
DI float wave_sum(float v) {
    v = sum16(v); v += __shfl_xor(v, 16); v += __shfl_xor(v, 32);
    return v;
}
DI float fast_exp(float x) { return __builtin_amdgcn_exp2f(x * 1.4426950408889634f); }
DI float sigmoidf_(float x) { return __builtin_amdgcn_rcpf(1.f + fast_exp(-x)); }
DI int lds_add(LAS int* p, int v) { return __hip_atomic_fetch_add(p, v, __ATOMIC_RELAXED, __HIP_MEMORY_SCOPE_WORKGROUP); }
DI int fresh_tid() { int t; asm volatile("v_mov_b32 %0, %1" : "=v"(t) : "v"((int)threadIdx.x)); return t; }
DI int crow(int r, int hi) { return (r & 3) + 8 * (r >> 2) + 4 * hi; }

constexpr int BATCH = 4, SEQ = 8192, T = BATCH * SEQ, D = 1024, INW = 7176, NPROJ = 7168, PW = 4096, NMEM = 256;
constexpr float EPS = 1e-6f;
constexpr int P_DNQ = 0, P_DNK = 512, P_DNV = 1024, P_DNZ = 1536, P_DAQ = 2048, P_DAK = 2560, P_DAV = 3072, P_MXQ = 3584, P_GATE = 4096;
constexpr int NEXP = 32, DFF = 1024, NSLOT_MAX = T * 4 + NEXP * 256, NTILE_MAX = NSLOT_MAX / 256;
constexpr int NCHUNK = BATCH * 4 * (SEQ / 64);
constexpr float LOG2E = 1.4426950408889634f;

constexpr size_t MiB = 1u << 20;
constexpr size_t WS_CTL = 0, CTL_ZERO_BYTES = 64 * 1024;
constexpr size_t WS_G = 1 * MiB;
constexpr size_t WS_BETA = WS_G + 512 * 1024;
constexpr size_t WS_TOKE = 2 * MiB;
constexpr size_t WS_TOKW = WS_TOKE + 512 * 1024;
constexpr size_t WS_SDST = 3 * MiB;
constexpr size_t WS_SW = 4 * MiB;
constexpr size_t WS_EGL = 5 * MiB;
constexpr size_t WS_RSTD = 5 * MiB + 64 * 1024;
constexpr size_t WS_SR = 31 * MiB;
constexpr size_t WS_TSLOT = 5 * MiB + 512 * 1024;
constexpr size_t WS_WB = 6 * MiB;
constexpr size_t WS_WOUT = 9 * MiB;
constexpr size_t WS_WMKV = 11 * MiB;
constexpr size_t WS_MEMN = 13 * MiB;
constexpr size_t WS_MKV = 15 * MiB;
constexpr size_t WS_WIN = 17 * MiB;
constexpr size_t WS_WGU = 32 * MiB;
constexpr size_t WS_WD = 160 * MiB;
constexpr size_t WS_H8 = 96 * MiB;
constexpr size_t WS_WIN8 = 128 * MiB;
constexpr size_t WS_H = 224 * MiB;
constexpr size_t WS_P = 288 * MiB;
constexpr size_t WS_GF = 544 * MiB;
constexpr size_t WS_MF = 864 * MiB;
constexpr size_t WS_NW = 736 * MiB;
constexpr size_t WS_QD = 768 * MiB;
constexpr size_t WS_KDT = 800 * MiB;
constexpr size_t WS_U = 832 * MiB;
constexpr size_t WS_QK = 864 * MiB;
constexpr size_t WS_ODN = 880 * MiB;
constexpr size_t WS_O1 = 912 * MiB;
constexpr size_t WS_O2 = 944 * MiB;
constexpr size_t WS_OMX = 976 * MiB;
constexpr size_t WS_ODNF = 736 * MiB;
constexpr size_t WS_ODAF = 768 * MiB;
constexpr size_t WS_V8 = 640 * MiB;
constexpr size_t WS_Q8 = 656 * MiB;
constexpr size_t WS_K8 = 672 * MiB;
constexpr size_t WS_X1B = 736 * MiB;
constexpr size_t WS_MRG = 800 * MiB;
constexpr size_t WS_XS = 288 * MiB;
constexpr size_t WS_ACT = 560 * MiB;
constexpr size_t WS_END = 1024 * MiB;
static_assert(WS_OMX + (size_t)T * 512 * 2 <= WS_END && WS_ACT + (size_t)NSLOT_MAX * 1024 * 2 <= WS_END && WS_XS + (size_t)NSLOT_MAX * 1024 * 2 <= WS_ACT, "ws map");

constexpr int CW_QHEAD = 1024;
constexpr int CW_CNT = 128;
constexpr int CW_CUR = 192;
constexpr int CW_MKV = 2560;
constexpr int CW_BAR = 4096;

constexpr int RING_BYTES = 136 * 1024;
constexpr int LDSCTL_OFF = RING_BYTES;
constexpr int MISC_OFF = LDSCTL_OFF;
constexpr int LTAB_OFF = LDSCTL_OFF + 128;
constexpr int LCNT_OFF = LTAB_OFF + NTILE_MAX * 4;
constexpr int LWSC_OFF = LCNT_OFF + 512;
constexpr int LDS_BYTES = 144 * 1024;
static_assert(LWSC_OFF + 8 * 256 <= LDS_BYTES, "LDS map");

namespace pg8 {
constexpr int BM = 256, BK = 64, HALF = 128, HTB = HALF * BK * 2, STAGE_BYTES = 8 * HTB, NXCD = 8, WGM = 8;
DI int lds_byte(int r, int c) { const int st = (r >> 4) * 2 + (c >> 5), rr = r & 15, cc = c & 31, ob = rr * 64 + cc * 2; return st * 1024 + (ob ^ (((ob >> 9) & 1) << 5)); }
DI void stage_rc(int b, int& R, int& C) { const int st = b / 1024, sb = b % 1024, swz = sb ^ (((sb >> 9) & 1) << 5); R = (st >> 1) * 16 + swz / 64; C = (st & 1) * 32 + (swz % 64) / 2; }
DI int perm32(int rho) { const int n = rho >> 4, i = rho & 15; return 8 * (i >> 2) + 4 * n + (i & 3); }

struct Unit { int pm, pn; long aoff, boff; int tag; };
struct Gemm { const bf16* A; const bf16* Bt; int lda, ldb, K; const int* rowmap; int probe; };

struct StaticOrder {
    int nM, nN, nwg, G, c;
    DI void init(int M, int N, int G_, int c_) { nM = M / BM; nN = N / BM; nwg = nM * nN; G = G_; c = c_; }
    DI bool tile(long L, int& pm, int& pn) const {
        if (L >= nwg) return false;
        int wgid = (int)L; { const int q = nwg / NXCD, r = nwg % NXCD, xcd = wgid % NXCD, off = wgid / NXCD; wgid = (xcd < r ? xcd * (q + 1) : r * (q + 1) + (xcd - r) * q) + off; }
        const int nig = WGM * nN, gid = wgid / nig, fm = gid * WGM, gsz = (nM - fm) < WGM ? (nM - fm) : WGM;
        pm = fm + ((wgid % nig) % gsz); pn = (wgid % nig) / gsz; return true;
    }
    DI bool next(int i, Unit& u) const { u.aoff = 0; u.boff = 0; u.tag = 0; return tile((long)i * G + c, u.pm, u.pn); }
};

template <class Epi, class Sched, bool GATHER = false, bool FP8 = false, bool SWAP = false>
DI void gemm_phase(LAS unsigned char* lds, const Gemm g, const Sched& S, const Epi& E, const int tid) {
    const int wid = __builtin_amdgcn_readfirstlane(tid >> 6), lane = tid & 63, wr = wid >> 2, wc = wid & 3, fr = lane & 15, fq = lane >> 4;
    int nt = g.K / BK; asm volatile("" : "+s"(nt));
    unsigned voffA[2], voffB[2];
#pragma unroll
    for (int i = 0; i < 2; ++i) { int R, C; stage_rc(tid * 16 + i * 8192, R, C); const int Rb = Epi::PERM ? ((R & ~31) + perm32(R & 31)) : R;
        voffA[i] = (unsigned)(R * g.lda + C) * 2u; voffB[i] = (unsigned)(Rb * g.ldb + C) * 2u; }
    const size_t kstep = (size_t)(BK * 2);
    const size_t hstepA = (size_t)HALF * g.lda * 2, hstepB = (size_t)HALF * g.ldb * 2;
    const size_t tstepA = (GATHER || (g.probe & 1)) ? 0 : 2 * hstepA, tstepB = (g.probe & 2) ? 0 : 2 * hstepB;
    unsigned cA0[2], cA1[2], nA0[2], nA1[2];
#define PG8_AOFFS(dst0, dst1, unit) do { if constexpr (GATHER) { _Pragma("unroll") for (int _i = 0; _i < 2; ++_i) { int R_, C_; stage_rc(tid * 16 + _i * 8192, R_, C_); \
            const int s0_ = g.rowmap[(unit).pm * BM + R_], s1_ = g.rowmap[(unit).pm * BM + HALF + R_]; \
            const unsigned c2_ = (unsigned)C_ * 2u; \
            dst0[_i] = (unsigned)((s0_ < 0 ? 0 : s0_ >> 2) * g.lda) * 2u + c2_; dst1[_i] = (unsigned)((s1_ < 0 ? 0 : s1_ >> 2) * g.lda) * 2u + c2_; } } \
        else { _Pragma("unroll") for (int _i = 0; _i < 2; ++_i) { dst0[_i] = voffA[_i]; dst1[_i] = voffA[_i] + (unsigned)hstepA; } } } while (0)
    const unsigned ldsw = (unsigned)wid * 1024u;
    const int aoff = lds_byte(wr * 64 + fr, fq * 8), boff = lds_byte(wc * 32 + fr, fq * 8);
#define PG8_SA(b, h) (((b) * 2 + (h)) * HTB)
#define PG8_SB(b, h) ((4 + (b) * 2 + (h)) * HTB)
#define PG8_STAGE(bufoff, gbase, voff) do { _Pragma("unroll") for (int _i = 0; _i < 2; ++_i) \
        __builtin_amdgcn_global_load_lds((const unsigned*)((const char*)(gbase) + (voff)[_i]), (LAS unsigned*)(lds + (bufoff) + ldsw + _i * 8192), 16, 0, 0); } while (0)
#define PG8_LDA(dst, b, h) do { _Pragma("unroll") for (int m = 0; m < 4; ++m) _Pragma("unroll") for (int k = 0; k < 2; ++k) dst[m][k] = *(const LAS bf16x8*)(lds + PG8_SA(b, h) + aoff + m * 2048 + k * 1024); } while (0)
#define PG8_LDB(dst, b, h) do { _Pragma("unroll") for (int n = 0; n < 2; ++n) _Pragma("unroll") for (int k = 0; k < 2; ++k) dst[n][k] = *(const LAS bf16x8*)(lds + PG8_SB(b, h) + boff + n * 2048 + k * 1024); } while (0)
#define PG8_MMA(ai, bj, At, Bt) do { __builtin_amdgcn_s_setprio(1); _Pragma("unroll") for (int m = 0; m < 4; ++m) _Pragma("unroll") for (int n = 0; n < 2; ++n) { \
        if constexpr (FP8) mfma_f8(acc[ai][bj][m][n], cat8(Bt[n][0], Bt[n][1]), cat8(At[m][0], At[m][1])); \
        else { _Pragma("unroll") for (int k = 0; k < 2; ++k) acc[ai][bj][m][n] = SWAP ? __builtin_amdgcn_mfma_f32_16x16x32_bf16(At[m][k], Bt[n][k], acc[ai][bj][m][n], 0, 0, 0) : __builtin_amdgcn_mfma_f32_16x16x32_bf16(Bt[n][k], At[m][k], acc[ai][bj][m][n], 0, 0, 0); } } __builtin_amdgcn_s_setprio(0); } while (0)
#define PG8_WAIT_V(n) asm volatile("s_waitcnt vmcnt(" #n ")" ::: "memory")
#define PG8_WAIT_L(n) asm volatile("s_waitcnt lgkmcnt(" #n ")" ::: "memory")
#define PG8_BAR __builtin_amdgcn_s_barrier()
#define PG8_SCHED __builtin_amdgcn_sched_barrier(0)
    Unit cur, nxt; int ui = 0;
    if (!S.next(0, cur)) return;
    f32x4 acc[2][2][4][2];
#pragma unroll
    for (int a = 0; a < 2; ++a)
#pragma unroll
        for (int b = 0; b < 2; ++b)
#pragma unroll
            for (int m = 0; m < 4; ++m)
#pragma unroll
                for (int n = 0; n < 2; ++n) acc[a][b][m][n] = (f32x4){0.f, 0.f, 0.f, 0.f};
    bf16x8 At[4][2], B0[2][2], B1[2][2];
    const char* cA = (const char*)g.A + (size_t)cur.pm * tstepA + cur.aoff; const char* cB = (const char*)g.Bt + (size_t)cur.pn * tstepB + cur.boff;
    PG8_AOFFS(cA0, cA1, cur);
    PG8_STAGE(PG8_SB(0, 0), cB, voffB); PG8_STAGE(PG8_SB(0, 1), cB + hstepB, voffB); PG8_STAGE(PG8_SA(0, 0), cA, cA0); PG8_STAGE(PG8_SA(0, 1), cA, cA1);
    if (wr == 1) PG8_BAR;
    PG8_WAIT_V(2); PG8_BAR;
    PG8_STAGE(PG8_SB(1, 0), cB + kstep, voffB); PG8_STAGE(PG8_SA(1, 0), cA + kstep, cA0); PG8_STAGE(PG8_SB(1, 1), cB + hstepB + kstep, voffB);
    PG8_WAIT_V(6); PG8_BAR;
    for (;;) {
        const bool has_next = S.next(ui + 1, nxt);
        const char* nA = has_next ? (const char*)g.A + (size_t)nxt.pm * tstepA + nxt.aoff : cA; const char* nB = has_next ? (const char*)g.Bt + (size_t)nxt.pn * tstepB + nxt.boff : cB;
        if (has_next) PG8_AOFFS(nA0, nA1, nxt); else { _Pragma("unroll") for (int _i = 0; _i < 2; ++_i) { nA0[_i] = cA0[_i]; nA1[_i] = cA1[_i]; } }
        unsigned pf0_ = 0u, pf1_ = 0u, pf2_ = 0u, pf3_ = 0u;
#pragma nounroll
        for (int t = 0; t < nt; t += 2) {
            const bool last = (t == nt - 2);
            if constexpr (Epi::PREFETCH) { if (t == nt - 4) E.prefetch(cur, wr, wc, fr, fq, pf0_, pf1_, pf2_, pf3_); }
            const char* a1 = cA + (size_t)(t + 1) * kstep;
            const char* a2 = last ? nA : cA + (size_t)(t + 2) * kstep; const char* b2 = last ? nB : cB + (size_t)(t + 2) * kstep;
            const char* a3 = a2 + kstep; const char* b3 = b2 + kstep;
            unsigned sA0[2], sA1[2];
#pragma unroll
            for (int _i = 0; _i < 2; ++_i) { sA0[_i] = last ? nA0[_i] : cA0[_i]; sA1[_i] = last ? nA1[_i] : cA1[_i]; }
            PG8_LDB(B0, 0, 0); PG8_LDB(B1, 0, 1); PG8_SCHED; PG8_LDA(At, 0, 0); PG8_STAGE(PG8_SA(1, 1), a1, cA1);
            PG8_WAIT_V(8); PG8_WAIT_L(0); PG8_BAR; PG8_MMA(0, 0, At, B0); PG8_MMA(0, 1, At, B1); PG8_BAR; PG8_SCHED;
            PG8_LDA(At, 0, 1); PG8_STAGE(PG8_SB(0, 0), b2, voffB); PG8_STAGE(PG8_SB(0, 1), b2 + hstepB, voffB); PG8_STAGE(PG8_SA(0, 0), a2, sA0);
            PG8_WAIT_V(8); PG8_WAIT_L(0); PG8_BAR; PG8_MMA(1, 0, At, B0); PG8_MMA(1, 1, At, B1); PG8_BAR; PG8_SCHED;
            PG8_LDB(B0, 1, 0); PG8_LDB(B1, 1, 1); PG8_SCHED; PG8_LDA(At, 1, 0); PG8_STAGE(PG8_SA(0, 1), a2, sA1);
            PG8_WAIT_V(8); PG8_WAIT_L(0); PG8_BAR; PG8_MMA(0, 0, At, B0); PG8_MMA(0, 1, At, B1); PG8_BAR; PG8_SCHED;
            PG8_LDA(At, 1, 1); PG8_STAGE(PG8_SB(1, 0), b3, voffB); PG8_STAGE(PG8_SB(1, 1), b3 + hstepB, voffB); PG8_STAGE(PG8_SA(1, 0), a3, sA0);
            PG8_WAIT_V(8); PG8_WAIT_L(0); PG8_BAR; PG8_MMA(1, 0, At, B0); PG8_MMA(1, 1, At, B1); PG8_BAR; PG8_SCHED;
        }
        if constexpr (Epi::PREFETCH) asm volatile("" :: "v"(pf0_), "v"(pf1_), "v"(pf2_), "v"(pf3_));
        if constexpr (FP8) asm volatile("s_nop 15" ::: "memory");
        if (wr == 0) PG8_BAR;
        bool keep = false;
        if constexpr (Epi::CHAIN) keep = E.chain(acc, cur, wr, wc, fr, fq); else E(acc, cur, wr, wc, fr, fq);
        if (!has_next) break;
        if (!keep) {
#pragma unroll
        for (int a = 0; a < 2; ++a)
#pragma unroll
            for (int b = 0; b < 2; ++b)
#pragma unroll
                for (int m = 0; m < 4; ++m)
#pragma unroll
                    for (int n = 0; n < 2; ++n) acc[a][b][m][n] = (f32x4){0.f, 0.f, 0.f, 0.f};
        }
        cur = nxt; cA = nA; cB = nB; ++ui;
#pragma unroll
        for (int _i = 0; _i < 2; ++_i) { cA0[_i] = nA0[_i]; cA1[_i] = nA1[_i]; }
        if (wr == 1) PG8_BAR;
    }
    PG8_WAIT_V(0);
    PG8_BAR;
#undef PG8_AOFFS
#undef PG8_SA
#undef PG8_SB
#undef PG8_STAGE
#undef PG8_LDA
#undef PG8_LDB
#undef PG8_MMA
#undef PG8_WAIT_V
#undef PG8_WAIT_L
#undef PG8_BAR
#undef PG8_SCHED
}
}
#ifndef ATTN_FP8PV
#define ATTN_FP8PV 1
#endif
#ifndef ATTN_FP8QK
#define ATTN_FP8QK 1
#endif
#ifndef ATTN_MFMASUM
#define ATTN_MFMASUM 1
#endif
#ifndef ATTN_BOUNDREF
#define ATTN_BOUNDREF 1
#endif
namespace attn_body {
using bf16=__hip_bfloat16;
using bf16x8=__attribute__((ext_vector_type(8)))short;
using s16x4=__attribute__((ext_vector_type(4)))short;
using f32x16=__attribute__((ext_vector_type(16)))float;
using u32x4=__attribute__((ext_vector_type(4)))unsigned;
constexpr int SEQ=8192,D=64,DM=4096,OPITCH=512;
constexpr int NW=8,QBLK=32,QB=QBLK*NW,KVBLK=64,NQB=SEQ/QB;
constexpr int ATTN_UNIT_ROWS=QB;
__device__ __forceinline__ int crow(int r,int hi){return (r&3)+8*(r>>2)+4*hi;}
#define SBAR() __builtin_amdgcn_sched_barrier(0)
__device__ __forceinline__ void cmask(f32x16&p0,f32x16&p1,int jb,int qrel,int hi){
  const float NEG=-INFINITY; int kb=64*jb+4*hi;
  #pragma unroll
  for(int r=0;r<16;++r){int kv=kb+(r&3)+8*(r>>2); if(kv>qrel)p0[r]=NEG; if(kv+32>qrel)p1[r]=NEG;}
}

__device__ __forceinline__ void biasadd(f32x16&p0,f32x16&p1,const float*lp){
  #pragma unroll
  for(int r=0;r<16;r+=2){ const float a0=lp[59-((r&3)+8*(r>>2))],a1=lp[59-(((r+1)&3)+8*((r+1)>>2))],b0=lp[59-32-((r&3)+8*(r>>2))],b1=lp[59-32-(((r+1)&3)+8*((r+1)>>2))];
    p0[r]+=a0; p0[r+1]+=a1; p1[r]+=b0; p1[r+1]+=b1; __builtin_amdgcn_sched_barrier(0); }
}
constexpr int NSLOT=3, SLOTB=8192;
constexpr int LDS_K=0, LDS_V=NSLOT*SLOTB, LDS_WS=3*NSLOT*SLOTB, LDS_OST=LDS_WS+NW*64*4, LDS_LUT=LDS_OST+NW*4096, LDS_BYTES=LDS_LUT+640*4;
constexpr float C2=0.125f*1.4426950408889634f;
__device__ __forceinline__ void glds16(const void*gsrc,unsigned lds_dst){unsigned keep;
  asm volatile("s_mov_b32 %0, m0\n\ts_mov_b32 m0, %2\n\ts_nop 0\n\tglobal_load_lds_dwordx4 %1, off\n\ts_mov_b32 m0, %0":"=&s"(keep):"v"(gsrc),"s"(lds_dst):"memory");}
__device__ __forceinline__ void glds16s(const void*sbase,unsigned voff,unsigned lds_dst){unsigned keep;
  asm volatile("s_mov_b32 %0, m0\n\ts_mov_b32 m0, %3\n\ts_nop 0\n\tglobal_load_lds_dwordx4 %1, %2\n\ts_mov_b32 m0, %0":"=&s"(keep):"v"(voff),"s"(sbase),"s"(lds_dst):"memory");}
__device__ __forceinline__ void glds4s(const void*sbase,unsigned voff,unsigned lds_dst){unsigned keep;
  asm volatile("s_mov_b32 %0, m0\n\ts_mov_b32 m0, %3\n\ts_nop 0\n\tglobal_load_lds_dword %1, %2\n\ts_mov_b32 m0, %0":"=&s"(keep):"v"(voff),"s"(sbase),"s"(lds_dst):"memory");}
__device__ __forceinline__ float max3f(float a,float b,float c){float r;asm("v_max3_f32 %0, %1, %2, %3":"=v"(r):"v"(a),"v"(b),"v"(c));return r;}
__device__ __forceinline__ float max2f(float a,float b){float r;asm("v_max_f32_e32 %0, %1, %2":"=v"(r):"v"(a),"v"(b));return r;}
__device__ __forceinline__ float fadd_s(float a,float b){float r;asm("v_add_f32_e32 %0, %1, %2":"=v"(r):"v"(a),"v"(b));return r;}
__device__ __forceinline__ float fsub_s(float a,float b){float r;asm("v_sub_f32_e32 %0, %1, %2":"=v"(r):"v"(a),"v"(b));return r;}
typedef float f32x2_t __attribute__((ext_vector_type(2))); typedef __bf16 bf16x2_t __attribute__((ext_vector_type(2)));
__device__ __forceinline__ unsigned cvtpk_s(float lo,float hi){f32x2_t v={lo,hi};bf16x2_t b=__builtin_convertvector(v,bf16x2_t);return __builtin_bit_cast(unsigned,b);}
#define WAIT_BAR_(N) asm volatile("s_waitcnt vmcnt(" #N ") lgkmcnt(0)\n\ts_barrier":::"memory")
#define WAIT_BAR(N) WAIT_BAR_(N)
#ifndef ATTN_V3AHEAD
#define ATTN_V3AHEAD 1
#endif
#if ATTN_FP8PV && ATTN_FP8QK
#if ATTN_V3AHEAD
#define WB_P1 5
#define WB_KV 4
#else
#define WB_P1 3
#define WB_KV 3
#endif
#define WB_V 1
#define WB_P0 5
#elif ATTN_FP8PV
#define WB_P0 3
#define WB_P1 2
#define WB_KV 2
#define WB_V 1
#else
#define WB_P0 3
#define WB_P1 3
#define WB_KV 3
#define WB_V 2
#endif
typedef int v8i_t __attribute__((ext_vector_type(8)));
__device__ __forceinline__ int pk4f8_s(float a,float b,float c,float d){ int w=__builtin_amdgcn_cvt_pk_fp8_f32(a,b,0,false); return __builtin_amdgcn_cvt_pk_fp8_f32(c,d,w,true); }

__device__ __forceinline__ void qkt(f32x16&p0,f32x16&p1,const char*Kslot,const bf16x8*qr,const f32x16&negm,int r32,int hi){
  const char*kb=Kslot+hi*1024+r32*16;
  #pragma unroll
  for(int d0=0;d0<4;++d0){
    const bf16x8 b0=*reinterpret_cast<const bf16x8*>(kb+d0*2048);
    const bf16x8 b1=*reinterpret_cast<const bf16x8*>(kb+d0*2048+512);
    if(d0==0){p0=__builtin_amdgcn_mfma_f32_32x32x16_bf16(b0,qr[0],negm,0,0,0);p1=__builtin_amdgcn_mfma_f32_32x32x16_bf16(b1,qr[0],negm,0,0,0);}
    else{p0=__builtin_amdgcn_mfma_f32_32x32x16_bf16(b0,qr[d0],p0,0,0,0);p1=__builtin_amdgcn_mfma_f32_32x32x16_bf16(b1,qr[d0],p1,0,0,0);}}
}
typedef __attribute__((address_space(3))) const char* lds_cptr;
typedef short v4i16_t __attribute__((ext_vector_type(4)));
__device__ __forceinline__ void kload8(bf16x8*kf,lds_cptr kp){
  kf[0]=*(const __attribute__((address_space(3))) bf16x8*)(kp);      kf[1]=*(const __attribute__((address_space(3))) bf16x8*)(kp+512);
  kf[2]=*(const __attribute__((address_space(3))) bf16x8*)(kp+2048); kf[3]=*(const __attribute__((address_space(3))) bf16x8*)(kp+2560);
  kf[4]=*(const __attribute__((address_space(3))) bf16x8*)(kp+4096); kf[5]=*(const __attribute__((address_space(3))) bf16x8*)(kp+4608);
  kf[6]=*(const __attribute__((address_space(3))) bf16x8*)(kp+6144); kf[7]=*(const __attribute__((address_space(3))) bf16x8*)(kp+6656);
}
__device__ __forceinline__ void kload2(bf16x8*kf,lds_cptr kp,int j){ kf[2*j]=*(const __attribute__((address_space(3))) bf16x8*)(kp+j*2048); kf[2*j+1]=*(const __attribute__((address_space(3))) bf16x8*)(kp+j*2048+512); }
__device__ __forceinline__ s16x4 vtr(lds_cptr p){ return __builtin_bit_cast(s16x4,__builtin_amdgcn_ds_read_tr16_b64_v4i16((__attribute__((address_space(3))) v4i16_t*)p)); }
__device__ __forceinline__ float rowmax(const f32x16&p0,const f32x16&p1){
  float a=max3f(p0[0],p0[1],p1[0]),b=max3f(p0[2],p0[3],p1[1]);a=max3f(a,p1[2],p1[3]);
  #pragma unroll
  for(int r=4;r<16;r+=4){a=max3f(a,p0[r],p0[r+1]);b=max3f(b,p0[r+2],p0[r+3]);a=max3f(a,p1[r],p1[r+1]);b=max3f(b,p1[r+2],p1[r+3]);}
  const float m=max2f(a,b);
  auto rr=__builtin_amdgcn_permlane32_swap(__float_as_uint(m),__float_as_uint(m),false,false);
  return max2f(__uint_as_float(rr[0]),__uint_as_float(rr[1]));
}
__device__ __forceinline__ void pv(f32x16*o,int vb,bf16x8 pa0,bf16x8 pa1,bf16x8 pa2,bf16x8 pa3){
  #pragma unroll
  for(int d0=0;d0<4;++d0){s16x4 lo[4],hi[4];
    #pragma unroll
    for(int ks=0;ks<4;++ks){
      asm volatile("ds_read_b64_tr_b16 %0,%1 offset:%c2":"=&v"(lo[ks]):"v"(vb),"i"(d0*4096+ks*1024):"memory");
      asm volatile("ds_read_b64_tr_b16 %0,%1 offset:%c2":"=&v"(hi[ks]):"v"(vb),"i"(d0*4096+ks*1024+512):"memory");}
    asm volatile("s_waitcnt lgkmcnt(0)":::"memory");SBAR();
    #define PK(k) (bf16x8){lo[k][0],lo[k][1],lo[k][2],lo[k][3],hi[k][0],hi[k][1],hi[k][2],hi[k][3]}
    o[d0]=__builtin_amdgcn_mfma_f32_32x32x16_bf16(pa0,PK(0),o[d0],0,0,0);
    o[d0]=__builtin_amdgcn_mfma_f32_32x32x16_bf16(pa1,PK(1),o[d0],0,0,0);
    o[d0]=__builtin_amdgcn_mfma_f32_32x32x16_bf16(pa2,PK(2),o[d0],0,0,0);
    o[d0]=__builtin_amdgcn_mfma_f32_32x32x16_bf16(pa3,PK(3),o[d0],0,0,0);
    #undef PK
  }
}

#ifndef ATTN_STORE16
#define ATTN_STORE16(p,v) (*(u32x4*)(p)=(v))
#endif
template<int THRL,bool NOBIAS=false> __device__ __forceinline__ void attn_unit(int qb,const bf16*Qh,const bf16*__restrict__ Kh,const bf16*__restrict__ Vh,bf16*Oh,const float* __restrict__ rel_table,int head,char*shm,const int tid,const float kbound=0.f,const unsigned char*V8h=nullptr,const unsigned char*Q8h=nullptr,const unsigned char*K8h=nullptr){
  const int lane=tid&63,r32=lane&31,hi=lane>>5; const int wid=__builtin_amdgcn_readfirstlane(tid>>6);
  const int q0=qb*QB;
  const bf16*Qw=Qh+(long)(q0+wid*QBLK)*DM;
  const unsigned lds0=(unsigned)(uintptr_t)shm;
  float*wsf=(float*)(shm+LDS_WS)+wid*64;
  const unsigned koff=(unsigned)(lane*DM+wid*8)*2u;
  const unsigned voff=(unsigned)((16*(wid&3)+(lane>>2))*DM+(wid>>2)*32+(lane&3)*8)*2u;
  const unsigned kdst=lds0+LDS_K+wid*1024, vdst=lds0+LDS_V+wid*1024;
#if ATTN_FP8PV && ATTN_FP8QK
  const unsigned koff8=(unsigned)(wid*512+lane*4); const unsigned kdst8=lds0+LDS_K+wid*512;
  #define DMA_K(t,slot) do{ glds4s(K8h+(long)(t)*32768,koff8,(unsigned)__builtin_amdgcn_readfirstlane(kdst8+(slot))); glds4s(K8h+(long)(t)*32768+256,koff8,(unsigned)__builtin_amdgcn_readfirstlane(kdst8+(slot)+256)); }while(0)
  (void)koff; (void)kdst;
#else
  #define DMA_K(t,slot) glds16s(Kh+(long)(t)*KVBLK*DM,koff,(unsigned)__builtin_amdgcn_readfirstlane(kdst+(slot)))
#endif
#if ATTN_FP8PV
  const unsigned voff8=(unsigned)(wid*1024+lane*16);
  #define DMA_V(t,slot) glds16s(V8h+(long)(t)*32768,voff8,(unsigned)__builtin_amdgcn_readfirstlane(vdst+(slot)))
  (void)voff;
#else
  #define DMA_V(t,slot) do{ glds16s(Vh+(long)(t)*KVBLK*DM,voff,(unsigned)__builtin_amdgcn_readfirstlane(vdst+2*(slot))); glds16s(Vh+64+(long)(t)*KVBLK*DM,voff,(unsigned)__builtin_amdgcn_readfirstlane(vdst+2*(slot)+8192)); }while(0)
#endif
  const int vb0=(int)(lds0+LDS_V)+((lane>>4)&1)*32+(lane&3)*8+(4*hi+((lane&15)>>2))*64;
  const char*Kbase=shm+LDS_K; bf16x8 kf[8];
  const lds_cptr shm3=(lds_cptr)shm; const lds_cptr kp0=shm3+LDS_K+hi*1024+r32*16; const lds_cptr vp0=shm3+LDS_V+((lane>>4)&1)*32+(lane&3)*8+(4*hi+((lane&15)>>2))*64;
  const int NT=(q0+QB)/KVBLK;
  { float*lut=(float*)(shm+LDS_LUT); const float t31=rel_table[31*4+head];
    for(int i=tid;i<640;i+=512){ const int d=i-256; float v=0.f;
      if(d>=0&&d<128){ int bk; if(d<16)bk=d; else { bk=16+(int)(logf((float)d*(1.f/16.f))/logf(8.f)*16.f); bk=bk<31?bk:31; } v=(rel_table[bk*4+head]-t31)*1.4426950408889634f; }
      lut[i]=v; } }
  DMA_K(0,0);DMA_V(0,0);DMA_K(1,SLOTB);
  bf16x8 qr[4];
#if ATTN_FP8PV && ATTN_FP8QK
  v8i_t q8;
  { const u32x4*qp_=(const u32x4*)(Q8h+(long)(q0+wid*QBLK+r32)*512+hi*32); const u32x4 a_=qp_[0],b_=qp_[1]; q8=(v8i_t){(int)a_[0],(int)a_[1],(int)a_[2],(int)a_[3],(int)b_[0],(int)b_[1],(int)b_[2],(int)b_[3]}; }
  (void)Qw; (void)qr;
#else
  #pragma unroll
  for(int d0=0;d0<4;++d0)qr[d0]=*reinterpret_cast<const bf16x8*>(&Qw[(long)r32*DM+d0*16+hi*8]);
#endif
#if ATTN_BOUNDREF
  float bref;
  { float ss=0.f;
#if ATTN_FP8PV && ATTN_FP8QK
    #pragma unroll
    for(int j=0;j<8;++j){ const f32x2_t a_=__builtin_amdgcn_cvt_pk_f32_fp8(q8[j],false),b_=__builtin_amdgcn_cvt_pk_f32_fp8(q8[j],true); ss+=(a_.x*a_.x+a_.y*a_.y)+(b_.x*b_.x+b_.y*b_.y); }
    ss*=(1.f/16.f)*1.25f;
#else
    #pragma unroll
    for(int d0=0;d0<4;++d0){ _Pragma("unroll") for(int j=0;j<8;++j){ const float f=__uint_as_float(((unsigned)(unsigned short)qr[d0][j])<<16); ss+=f*f; } }
#endif
    ss+=__shfl_xor(ss,32);
    float bm=NOBIAS?0.f:(rel_table[(lane&31)*4+head]-rel_table[31*4+head])*1.4426950408889634f;
    #pragma unroll
    for(int o_=1;o_<64;o_<<=1)bm=__builtin_fmaxf(bm,__shfl_xor(bm,o_));
    bref=__builtin_sqrtf(ss)*kbound*1.01f+__builtin_fmaxf(bm,0.f)+0.01f-(ATTN_FP8PV?8.f:0.f); }
#endif
  float mhat=0.f,l_reg=0.f;f32x16 o[4];o[0]=f32x16{};o[1]=f32x16{};o[2]=f32x16{};o[3]=f32x16{};f32x16 negm=f32x16{};asm volatile("":"+v"(negm));
  const int qrel=wid*QBLK+r32;
  #define CMASK(P0,P1,t) do{int jb_=(t)-(NT-4); if(!NOBIAS&&jb_>=-2)biasadd(P0,P1,(const float*)(shm+LDS_LUT)+(wid*QBLK+r32-4*hi+256-59)-64*jb_); if(jb_>=0)cmask(P0,P1,jb_,qrel,hi);}while(0)
  bool resc=false;
#if ATTN_BOUNDREF
  #define START_RM(P0,P1) bref
#else
  #define START_RM(P0,P1) rowmax(P0,P1)
#endif
  #define START(P0,P1) do{ const float rm=START_RM(P0,P1); resc=false; \
    { const float dl=rm; mhat=fadd_s(mhat,dl); \
      _Pragma("unroll") for(int r=0;r<16;++r){P0[r]=fsub_s(P0[r],dl);P1[r]=fsub_s(P1[r],dl);} \
      _Pragma("unroll") for(int r=0;r<16;++r)negm[r]=-mhat; asm volatile("":"+v"(negm)); } \
    _Pragma("unroll") for(int r=0;r<16;++r)P0[r]=__builtin_amdgcn_exp2f(P0[r]); }while(0)
  #define RESC() do{ if(resc){ asm volatile("s_waitcnt lgkmcnt(0)":::"memory"); \
      _Pragma("unroll") for(int d_=0;d_<4;++d_) _Pragma("unroll") for(int r=0;r<16;++r)o[d_][r]*=wsf[crow(r,hi)]; } }while(0)
  f32x16 pA0,pA1,pB0,pB1;
  int sl_prev=0,sl_cur=0,sl_next=SLOTB;
#if ATTN_V3AHEAD
  #define STEP_DMA(t,GK,GV) do{ if(GK){DMA_K((t)+3,sl_cur); DMA_V((t)+3,vs_wr);} }while(0)
  #define VS_RD vs_rd
  #define VS_LAST VNEXT(vs_rd)
  int vs_rd=5*SLOTB,vs_wr=3*SLOTB;
  #define VNEXT(x) (((x)==5*SLOTB)?0:(x)+SLOTB)
  #define ROT() do{sl_prev=sl_cur;sl_cur=sl_next;sl_next=(sl_next==(NSLOT-1)*SLOTB)?0:sl_next+SLOTB; vs_rd=VNEXT(vs_rd); vs_wr=VNEXT(vs_wr);}while(0)
#else
  #define STEP_DMA(t,GK,GV) do{ if(GK){DMA_K((t)+3,sl_cur);} if(GV){DMA_V((t)+1,sl_next);} }while(0)
  #define VS_RD sl_prev
  #define VS_LAST sl_cur
  #define ROT() do{sl_prev=sl_cur;sl_cur=sl_next;sl_next=(sl_next==(NSLOT-1)*SLOTB)?0:sl_next+SLOTB;}while(0)
#endif
  DMA_K(2,2*SLOTB);
  WAIT_BAR(WB_P0);
#if ATTN_FP8PV && ATTN_FP8QK
  const lds_cptr kq0=shm3+LDS_K+lane*16; v8i_t kf8[2];
  typedef __attribute__((address_space(3))) const u32x4* lds_u4q;
  #define KF8(dst,base,hf) do{ const u32x4 a_=*(lds_u4q)((base)+(hf)*2048), b_=*(lds_u4q)((base)+(hf)*2048+1024); dst=(v8i_t){(int)a_[0],(int)a_[1],(int)a_[2],(int)a_[3],(int)b_[0],(int)b_[1],(int)b_[2],(int)b_[3]}; }while(0)
  #define MFQK(KF,CIN) __builtin_amdgcn_mfma_scale_f32_32x32x64_f8f6f4(KF,q8,CIN,0,0,0,0,0,0)
  KF8(kf8[0],kq0,0); KF8(kf8[1],kq0,1);
  pA0=MFQK(kf8[0],negm); pA1=MFQK(kf8[1],negm); CMASK(pA0,pA1,0);
  (void)Kbase; (void)kp0;
#else
  qkt(pA0,pA1,Kbase,qr,negm,r32,hi);asm volatile("s_nop 15\n\ts_nop 7":"+v"(pA0),"+v"(pA1));CMASK(pA0,pA1,0);
#endif
  START(pA0,pA1);
  _Pragma("unroll") for(int r=0;r<16;++r)pA1[r]=__builtin_amdgcn_exp2f(pA1[r]);
  WAIT_BAR(0);
#if ATTN_V3AHEAD
  DMA_K(3,0);DMA_V(1,SLOTB);DMA_V(2,2*SLOTB);DMA_V(3,3*SLOTB);
#else
  DMA_K(3,0);DMA_V(1,SLOTB);
#endif
  ROT();
#if ATTN_FP8PV && ATTN_FP8QK
  KF8(kf8[0],kq0+sl_cur,0); KF8(kf8[1],kq0+sl_cur,1);
#else
  kload8(kf,kp0+sl_cur);
#endif
  WAIT_BAR(WB_P1);
  s16x4 vlo[4],vhi[4]; u32x4 pw0,pw1,pw2,pw3;
  #define PKW(P,B) cvtpk_s(P[B],P[B+1])
  #define PAF(k) __builtin_bit_cast(bf16x8,pw##k)
  #define VFR(i) (bf16x8){vlo[i][0],vlo[i][1],vlo[i][2],vlo[i][3],vhi[i][0],vhi[i][1],vhi[i][2],vhi[i][3]}
  #define PIN(x) asm volatile("":"+v"(x))
  #define MX3(a,b,c) __builtin_fmaxf(__builtin_fmaxf((a),(b)),(c))
  #define GAPA(MF,A0,A1,A2,A3,W0,W1,PW) do{ MF; sacc+=A0; sacc+=A1; sacc+=A2; sacc+=A3; PIN(sacc); W0; W1; PIN(PW); SBAR(); }while(0)
  #define EX(v) __builtin_amdgcn_exp2f(v)
  #define GAPB(MF,X,B) do{ MF; X[B]=EX(X[B]); X[B+1]=EX(X[B+1]); X[B+2]=EX(X[B+2]); X[B+3]=EX(X[B+3]); PIN(X); SBAR(); }while(0)
  #define GAPB2(MF,X,B) do{ MF; X[B]=EX(X[B]); X[B+1]=EX(X[B+1]); PIN(X); SBAR(); }while(0)
  #define VRDS(i,f) do{ vlo[i]=vtr(vp_+(((f)>>2)*4096+((f)&3)*1024)); vhi[i]=vtr(vp_+(((f)>>2)*4096+((f)&3)*1024+512)); SBAR(); }while(0)
  #define VRD(i) do{ vlo[i]=vtr(vp_+(((i)>>2)*4096+((i)&3)*1024)); vhi[i]=vtr(vp_+(((i)>>2)*4096+((i)&3)*1024+512)); }while(0)
#if ATTN_FP8PV && ATTN_FP8QK
  #define KRD(G,j) do{ if((G)&&(j)<2){ KF8(kf8[(j)&1],kq0+sl_next,(j)&1); SBAR(); } }while(0)
#else
  #define KRD(G,j) do{ if(G){ kload2(kf,kp0+sl_next,j); SBAR(); } }while(0)
#endif
#if ATTN_BOUNDREF
  #define STEP_MAX(C0,C1) do{ resc=false; }while(0)
#else
  #define STEP_MAX(C0,C1) do{ \
    { float a=MX3(C0[0],C0[1],C1[0]),b=MX3(C0[2],C0[3],C1[1]); a=MX3(a,C1[2],C1[3]); \
      _Pragma("unroll") for(int r=4;r<16;r+=4){a=MX3(a,C0[r],C0[r+1]);b=MX3(b,C0[r+2],C0[r+3]);a=MX3(a,C1[r],C1[r+1]);b=MX3(b,C1[r+2],C1[r+3]);} \
      float rm=__builtin_fmaxf(a,b); { auto rr=__builtin_amdgcn_permlane32_swap(__float_as_uint(rm),__float_as_uint(rm),false,false); rm=__builtin_fmaxf(__uint_as_float(rr[0]),__uint_as_float(rr[1])); } \
      resc=false; \
      if(__builtin_expect(__any(rm>(float)THRL),0)){ const float dl=__builtin_fmaxf(rm,0.f); mhat+=dl; \
        _Pragma("unroll") for(int r=0;r<16;++r){C0[r]-=dl;C1[r]-=dl;} \
        _Pragma("unroll") for(int r=0;r<16;++r)negm[r]=-mhat; asm volatile("":"+v"(negm)); \
        const float f=__builtin_amdgcn_exp2f(-dl); l_reg*=f; if(hi==0)wsf[r32]=f; resc=true; } } }while(0)
#endif
#if ATTN_FP8PV
  const lds_cptr vq0=shm3+LDS_V+lane*16;
  v8i_t p8=(v8i_t){0,0,0,0,0,0,0,0},F0,F1;
  typedef __attribute__((address_space(3))) const u32x4* lds_u4p;
  #define VF8(dst,d) do{ const u32x4 a_=*(lds_u4p)(vq_+(d)*2048), b_=*(lds_u4p)(vq_+(d)*2048+1024); dst=(v8i_t){(int)a_[0],(int)a_[1],(int)a_[2],(int)a_[3],(int)b_[0],(int)b_[1],(int)b_[2],(int)b_[3]}; }while(0)
  #define MF8(O,F) O=__builtin_amdgcn_mfma_scale_f32_32x32x64_f8f6f4(p8,F,O,0,0,0,0,0,0)
#define ATTN_MSUM (ATTN_MFMASUM && ATTN_BOUNDREF)
#if ATTN_MSUM
  f32x16 osum=f32x16{};
  #define ONES8(v) int c38_=0x38383838; asm volatile("":"+s"(c38_)); const v8i_t v=(v8i_t){c38_,c38_,c38_,c38_,c38_,c38_,c38_,c38_}
  #define GAPA8(MF,A0,A1,A2,A3,G,X0,X1,X2,X3) do{ MF; p8[G]=pk4f8_s(X0,X1,X2,X3); PIN(p8); SBAR(); }while(0)
  #define SACC_INIT(P0) do{}while(0)
  #define SACC_DONE() do{}while(0)
#else
  #define GAPA8(MF,A0,A1,A2,A3,G,X0,X1,X2,X3) do{ MF; sacc+=A0; sacc+=A1; sacc+=A2; sacc+=A3; PIN(sacc); p8[G]=pk4f8_s(X0,X1,X2,X3); PIN(p8); SBAR(); }while(0)
  #define SACC_INIT(P0) float sacc=(P0[0]+P0[1])
  #define SACC_DONE() l_reg+=sacc
#endif
  #define EXN(X,B,N) do{ _Pragma("unroll") for(int e_=0;e_<(N);++e_) X[(B)+e_]=EX(X[(B)+e_]); PIN(X); }while(0)
  #define GAPB8(MF,X,B) do{ MF; EXN(X,B,8); SBAR(); }while(0)
#if ATTN_FP8QK
  #define STEP_QK(C0,C1,P0,P1) do{ \
    C0=MFQK(kf8[0],negm); \
    p8[0]=pk4f8_s(P0[0],P0[1],P0[2],P0[3]); p8[1]=pk4f8_s(P0[4],P0[5],P0[6],P0[7]); p8[2]=pk4f8_s(P0[8],P0[9],P0[10],P0[11]); p8[3]=pk4f8_s(P0[12],P0[13],P0[14],P0[15]); PIN(p8); SBAR(); \
    VF8(F0,0); SBAR(); \
    C1=MFQK(kf8[1],negm); \
    p8[4]=pk4f8_s(P1[0],P1[1],P1[2],P1[3]); p8[5]=pk4f8_s(P1[4],P1[5],P1[6],P1[7]); p8[6]=pk4f8_s(P1[8],P1[9],P1[10],P1[11]); p8[7]=pk4f8_s(P1[12],P1[13],P1[14],P1[15]); PIN(p8); SBAR(); \
    }while(0)
#else
  #define STEP_QK(C0,C1,P0,P1) do{ \
    GAPA8(C0=__builtin_amdgcn_mfma_f32_32x32x16_bf16(kf[0],qr[0],negm,0,0,0), P0[2],P0[3],P0[4],P0[5],     0, P0[0],P0[1],P0[2],P0[3]); \
    GAPA8(C1=__builtin_amdgcn_mfma_f32_32x32x16_bf16(kf[1],qr[0],negm,0,0,0), P0[6],P0[7],P0[8],P0[9],     1, P0[4],P0[5],P0[6],P0[7]); \
    GAPA8(C0=__builtin_amdgcn_mfma_f32_32x32x16_bf16(kf[2],qr[1],C0,0,0,0),   P0[10],P0[11],P0[12],P0[13], 2, P0[8],P0[9],P0[10],P0[11]); \
    GAPA8(C1=__builtin_amdgcn_mfma_f32_32x32x16_bf16(kf[3],qr[1],C1,0,0,0),   P0[14],P0[15],P1[0],P1[1],   3, P0[12],P0[13],P0[14],P0[15]); \
    VF8(F0,0); SBAR(); \
    GAPA8(C0=__builtin_amdgcn_mfma_f32_32x32x16_bf16(kf[4],qr[2],C0,0,0,0),   P1[2],P1[3],P1[4],P1[5],     4, P1[0],P1[1],P1[2],P1[3]); \
    GAPA8(C1=__builtin_amdgcn_mfma_f32_32x32x16_bf16(kf[5],qr[2],C1,0,0,0),   P1[6],P1[7],P1[8],P1[9],     5, P1[4],P1[5],P1[6],P1[7]); \
    GAPA8(C0=__builtin_amdgcn_mfma_f32_32x32x16_bf16(kf[6],qr[3],C0,0,0,0),   P1[10],P1[11],P1[12],P1[13], 6, P1[8],P1[9],P1[10],P1[11]); \
    GAPA8(C1=__builtin_amdgcn_mfma_f32_32x32x16_bf16(kf[7],qr[3],C1,0,0,0),   P1[14],P1[15],0.f,0.f,       7, P1[12],P1[13],P1[14],P1[15]); \
    }while(0)
#endif
  #define STEP(C0,C1,P0,P1,t,GK,GV,GL) do{ SBAR(); \
    const lds_cptr vq_=vq0+VS_RD; \
    SACC_INIT(P0); \
    STEP_QK(C0,C1,P0,P1); \
    SACC_DONE(); VF8(F1,1); SBAR(); \
    STEP_DMA(t,GK,GV); \
    CMASK(C0,C1,t); \
    STEP_MAX(C0,C1); \
    SBAR(); \
    STEP_PV(C0,C1,GL); \
    }while(0)
#if ATTN_MSUM
  #define STEP_PV(C0,C1,GL) do{ \
    MF8(o[0],F0); EXN(C0,0,7); SBAR(); VF8(F0,2); SBAR(); KRD(GL,0); KRD(GL,1); \
    MF8(o[1],F1); EXN(C0,7,7); SBAR(); VF8(F1,3); SBAR(); KRD(GL,2); KRD(GL,3); \
    MF8(o[2],F0); EXN(C0,14,2); EXN(C1,0,4); SBAR(); \
    MF8(o[3],F1); EXN(C1,4,6); SBAR(); \
    { ONES8(on_); MF8(osum,on_); } EXN(C1,10,6); SBAR(); }while(0)
#else
  #define STEP_PV(C0,C1,GL) do{ \
    GAPB8(MF8(o[0],F0), C0,0); VF8(F0,2); SBAR(); KRD(GL,0); KRD(GL,1); \
    GAPB8(MF8(o[1],F1), C0,8); VF8(F1,3); SBAR(); KRD(GL,2); KRD(GL,3); \
    GAPB8(MF8(o[2],F0), C1,0); \
    GAPB8(MF8(o[3],F1), C1,8); }while(0)
#endif
#else
  #define STEP(C0,C1,P0,P1,t,GK,GV,GL) do{ SBAR(); \
    const lds_cptr vp_=vp0+2*sl_prev; \
    VRDS(0,0);  float sacc=(P0[0]+P0[1]); \
    GAPA(C0=__builtin_amdgcn_mfma_f32_32x32x16_bf16(kf[0],qr[0],negm,0,0,0), P0[2],P0[3],P0[4],P0[5],     pw0[0]=PKW(P0,0), pw0[1]=PKW(P0,2), pw0); \
    VRDS(1,4);  GAPA(C1=__builtin_amdgcn_mfma_f32_32x32x16_bf16(kf[1],qr[0],negm,0,0,0), P0[6],P0[7],P0[8],P0[9],     pw0[2]=PKW(P0,4), pw0[3]=PKW(P0,6), pw0); \
    VRDS(2,1);  GAPA(C0=__builtin_amdgcn_mfma_f32_32x32x16_bf16(kf[2],qr[1],C0,0,0,0),   P0[10],P0[11],P0[12],P0[13], pw1[0]=PKW(P0,8), pw1[1]=PKW(P0,10), pw1); \
    VRDS(3,5);  GAPA(C1=__builtin_amdgcn_mfma_f32_32x32x16_bf16(kf[3],qr[1],C1,0,0,0),   P0[14],P0[15],P1[0],P1[1],   pw1[2]=PKW(P0,12),pw1[3]=PKW(P0,14), pw1); \
     GAPA(C0=__builtin_amdgcn_mfma_f32_32x32x16_bf16(kf[4],qr[2],C0,0,0,0),   P1[2],P1[3],P1[4],P1[5],     pw2[0]=PKW(P1,0), pw2[1]=PKW(P1,2), pw2); \
     GAPA(C1=__builtin_amdgcn_mfma_f32_32x32x16_bf16(kf[5],qr[2],C1,0,0,0),   P1[6],P1[7],P1[8],P1[9],     pw2[2]=PKW(P1,4), pw2[3]=PKW(P1,6), pw2); \
     GAPA(C0=__builtin_amdgcn_mfma_f32_32x32x16_bf16(kf[6],qr[3],C0,0,0,0),   P1[10],P1[11],P1[12],P1[13], pw3[0]=PKW(P1,8), pw3[1]=PKW(P1,10), pw3); \
     GAPA(C1=__builtin_amdgcn_mfma_f32_32x32x16_bf16(kf[7],qr[3],C1,0,0,0),   P1[14],P1[15],0.f,0.f,       pw3[2]=PKW(P1,12),pw3[3]=PKW(P1,14), pw3); \
    l_reg+=sacc; \
    if(GK){DMA_K((t)+3,sl_cur);} if(GV){DMA_V((t)+1,sl_next);} \
    CMASK(C0,C1,t); \
    STEP_MAX(C0,C1); \
    SBAR(); \
    GAPB2(o[0]=__builtin_amdgcn_mfma_f32_32x32x16_bf16(PAF(0),VFR(0),o[0],0,0,0), C0,0); VRDS(0,2); \
    GAPB2(o[1]=__builtin_amdgcn_mfma_f32_32x32x16_bf16(PAF(0),VFR(1),o[1],0,0,0), C0,2); VRDS(1,6); \
    KRD(GL,0); GAPB2(o[0]=__builtin_amdgcn_mfma_f32_32x32x16_bf16(PAF(1),VFR(2),o[0],0,0,0), C0,4); VRDS(2,3); \
    KRD(GL,1); GAPB2(o[1]=__builtin_amdgcn_mfma_f32_32x32x16_bf16(PAF(1),VFR(3),o[1],0,0,0), C0,6); VRDS(3,7); \
    KRD(GL,2); GAPB2(o[0]=__builtin_amdgcn_mfma_f32_32x32x16_bf16(PAF(2),VFR(0),o[0],0,0,0), C0,8); VRDS(0,8); \
    KRD(GL,3); GAPB2(o[1]=__builtin_amdgcn_mfma_f32_32x32x16_bf16(PAF(2),VFR(1),o[1],0,0,0), C0,10); VRDS(1,12); \
    GAPB2(o[0]=__builtin_amdgcn_mfma_f32_32x32x16_bf16(PAF(3),VFR(2),o[0],0,0,0), C0,12); VRDS(2,9); \
    GAPB2(o[1]=__builtin_amdgcn_mfma_f32_32x32x16_bf16(PAF(3),VFR(3),o[1],0,0,0), C0,14); VRDS(3,13); \
    GAPB2(o[2]=__builtin_amdgcn_mfma_f32_32x32x16_bf16(PAF(0),VFR(0),o[2],0,0,0), C1,0); VRDS(0,10); \
    GAPB2(o[3]=__builtin_amdgcn_mfma_f32_32x32x16_bf16(PAF(0),VFR(1),o[3],0,0,0), C1,2); VRDS(1,14); \
    GAPB2(o[2]=__builtin_amdgcn_mfma_f32_32x32x16_bf16(PAF(1),VFR(2),o[2],0,0,0), C1,4); VRDS(2,11); \
    GAPB2(o[3]=__builtin_amdgcn_mfma_f32_32x32x16_bf16(PAF(1),VFR(3),o[3],0,0,0), C1,6); VRDS(3,15); \
    GAPB2(o[2]=__builtin_amdgcn_mfma_f32_32x32x16_bf16(PAF(2),VFR(0),o[2],0,0,0), C1,8); \
    GAPB2(o[3]=__builtin_amdgcn_mfma_f32_32x32x16_bf16(PAF(2),VFR(1),o[3],0,0,0), C1,10); \
    GAPB2(o[2]=__builtin_amdgcn_mfma_f32_32x32x16_bf16(PAF(3),VFR(2),o[2],0,0,0), C1,12); \
    GAPB2(o[3]=__builtin_amdgcn_mfma_f32_32x32x16_bf16(PAF(3),VFR(3),o[3],0,0,0), C1,14); \
    }while(0)
#endif
  int t=1;
  #undef CMASK
  #define CMASK(P0,P1,t) do{}while(0)
  for(;t+(NOBIAS?5:7)<NT;t+=2){
    STEP(pB0,pB1,pA0,pA1,t,true,true,true);     WAIT_BAR(WB_KV); RESC(); ROT();
    STEP(pA0,pA1,pB0,pB1,t+1,true,true,true);   WAIT_BAR(WB_KV); RESC(); ROT();
  }
  #undef CMASK
  #define CMASK(P0,P1,t) do{int jb_=(t)-(NT-4); if(!NOBIAS&&jb_>=-2)biasadd(P0,P1,(const float*)(shm+LDS_LUT)+(wid*QBLK+r32-4*hi+256-59)-64*jb_); if(jb_>=0)cmask(P0,P1,jb_,qrel,hi);}while(0)
  #define ENDW(tt) do{ if((tt)+3<NT){WAIT_BAR(WB_KV);} else if((tt)+2<NT){WAIT_BAR(WB_V);} else {WAIT_BAR(0);} }while(0)
  for(;t+1<NT;t+=2){
    STEP(pB0,pB1,pA0,pA1,t,(t+3<NT),(t+1<NT),(t+1<NT));       ENDW(t);   RESC(); ROT();
    STEP(pA0,pA1,pB0,pB1,t+1,(t+4<NT),(t+2<NT),(t+2<NT));     ENDW(t+1); RESC(); ROT();
  }
  STEP(pB0,pB1,pA0,pA1,NT-1,false,false,false); RESC();
  {
#if !(ATTN_FP8PV && ATTN_MFMASUM && ATTN_BOUNDREF)
    { float sacc=pB0[0]+pB0[1]; _Pragma("unroll") for(int r=2;r<16;++r)sacc+=pB0[r]; _Pragma("unroll") for(int r=0;r<16;++r)sacc+=pB1[r]; l_reg+=sacc; }
#endif
    pw0=(u32x4){PKW(pB0,0),PKW(pB0,2),PKW(pB0,4),PKW(pB0,6)};pw1=(u32x4){PKW(pB0,8),PKW(pB0,10),PKW(pB0,12),PKW(pB0,14)};pw2=(u32x4){PKW(pB1,0),PKW(pB1,2),PKW(pB1,4),PKW(pB1,6)};pw3=(u32x4){PKW(pB1,8),PKW(pB1,10),PKW(pB1,12),PKW(pB1,14)};
#if ATTN_FP8PV
    p8=(v8i_t){pk4f8_s(pB0[0],pB0[1],pB0[2],pB0[3]),pk4f8_s(pB0[4],pB0[5],pB0[6],pB0[7]),pk4f8_s(pB0[8],pB0[9],pB0[10],pB0[11]),pk4f8_s(pB0[12],pB0[13],pB0[14],pB0[15]),
               pk4f8_s(pB1[0],pB1[1],pB1[2],pB1[3]),pk4f8_s(pB1[4],pB1[5],pB1[6],pB1[7]),pk4f8_s(pB1[8],pB1[9],pB1[10],pB1[11]),pk4f8_s(pB1[12],pB1[13],pB1[14],pB1[15])};
    SBAR(); { const lds_cptr vq_=vq0+VS_LAST; VF8(F0,0); VF8(F1,1); MF8(o[0],F0); MF8(o[1],F1); VF8(F0,2); VF8(F1,3); MF8(o[2],F0); MF8(o[3],F1);
#if ATTN_MFMASUM && ATTN_BOUNDREF
      { ONES8(on_); MF8(osum,on_); }
#endif
    } }
#else
    SBAR(); pv(o,vb0+2*sl_cur,PAF(0),PAF(1),PAF(2),PAF(3)); }
#endif
  #undef PKW
  #undef PAF
  #undef VFR
  #undef PIN
  #undef MX3
  #undef GAPA
  #undef GAPB
  #undef GAPB2
  #undef VRDS
  #undef EX
  #undef VRD
  #undef KRD
  #undef STEP
  #undef STEP_MAX
  #undef ENDW
  float rli[16];
#if ATTN_FP8PV && ATTN_MFMASUM && ATTN_BOUNDREF
  #pragma unroll
  for(int r=0;r<16;++r)rli[r]=__builtin_amdgcn_rcpf(__builtin_fmaxf(osum[r],1e-30f));
  (void)l_reg;
#else
  {auto rr=__builtin_amdgcn_permlane32_swap(__float_as_uint(l_reg),__float_as_uint(l_reg),false,false);l_reg=__uint_as_float(rr[0])+__uint_as_float(rr[1]);}
  if(hi==0)wsf[32+r32]=l_reg;asm volatile("s_waitcnt lgkmcnt(0)":::"memory");
  #pragma unroll
  for(int r=0;r<16;++r)rli[r]=__builtin_amdgcn_rcpf(wsf[32+crow(r,hi)]);
#endif
  bf16*Ow=Oh+(long)(q0+wid*QBLK)*OPITCH;
  { bf16*stg=(bf16*)(shm+LDS_OST)+wid*2048;
    #pragma unroll
    for(int p=0;p<2;++p){
      #pragma unroll
      for(int r=0;r<16;++r){const int orow=crow(r,hi);
        #pragma unroll
        for(int d0=0;d0<2;++d0)stg[orow*64+d0*32+r32]=__float2bfloat16(o[2*p+d0][r]*rli[r]);}
      asm volatile("s_waitcnt lgkmcnt(0)":::"memory");
      #pragma unroll
      for(int i=0;i<4;++i){const int row=i*8+(lane>>3),ch=lane&7; const u32x4 v=*(const u32x4*)(stg+row*64+ch*8); ATTN_STORE16(Ow+(long)row*OPITCH+p*64+ch*8,v);}
      asm volatile("s_waitcnt lgkmcnt(0)":::"memory"); } }
  asm volatile("s_waitcnt lgkmcnt(0)\n\ts_barrier":::"memory");
  #undef DMA_K
  #undef DMA_V
  #undef CMASK
  #undef START
  #undef RESC
  #undef ROT
}
constexpr int ATTN_LDS_BYTES=LDS_BYTES;
#undef SBAR
#undef WAIT_BAR
}
#define XB_TMO      128
#define XB_XCNT(j)  (256  + 64 * (j))
#define XB_XSUB(j)  (1280 + 64 * (j))
#define XB_XGEN(j)  (2304 + 64 * (j))
#define XB_TOP      3328
#define XB_TOPGEN   3392
#define XCD_BAR_WORDS 3456
#define XB_SPIN_CAP (1u << 18)

__device__ __forceinline__ unsigned xb_ld(unsigned* p)              { return __hip_atomic_load(p, __ATOMIC_RELAXED, __HIP_MEMORY_SCOPE_AGENT); }
__device__ __forceinline__ unsigned xb_add(unsigned* p, unsigned v) { return __hip_atomic_fetch_add(p, v, __ATOMIC_RELAXED, __HIP_MEMORY_SCOPE_AGENT); }
__device__ __forceinline__ unsigned xb_xcc_id() { return (unsigned)__builtin_amdgcn_s_getreg((3 << 11) | 20) & 0xFu; }
#define XB_SPIN(cond, bar) do { unsigned _sp = 0; while (cond) { __builtin_amdgcn_s_sleep(1); \
    if ((++_sp & 255u) == 0u) { if (xb_ld(&(bar)[XB_TMO])) break; if (_sp > XB_SPIN_CAP) { atomicAdd(&(bar)[XB_TMO], 1u); break; } } } } while (0)

struct XcdBarrier {
    unsigned* bar; unsigned x;
    volatile LAS unsigned* st;
};

__device__ __forceinline__ XcdBarrier xcd_barrier_post(unsigned* bar, volatile LAS unsigned* st) {
    XcdBarrier b; b.bar = bar; b.x = xb_xcc_id(); b.st = st;
    if (threadIdx.x == 0) (void)xb_add(&bar[XB_XCNT(b.x)], 1u);
    return b;
}
__device__ __forceinline__ void xcd_barrier_complete(unsigned* bar, unsigned x, unsigned& nloc, unsigned& nx) {
    const unsigned G = gridDim.x * gridDim.y * gridDim.z;
    unsigned sum, cnt, mine, sp = 0u;
    for (;;) {
        sum = 0u; cnt = 0u; mine = 0u;
#pragma unroll
        for (unsigned j = 0; j < 16; ++j) { const unsigned c = xb_ld(&bar[XB_XCNT(j)]); sum += c; cnt += (c > 0u) ? 1u : 0u; mine = (j == x) ? c : mine; }
        if (sum == G) break;
        __builtin_amdgcn_s_sleep(1);
        if ((++sp & 255u) == 0u) { if (xb_ld(&bar[XB_TMO])) break; if (sp > XB_SPIN_CAP) { atomicAdd(&bar[XB_TMO], 1u); break; } }
    }
    nloc = mine > 0u ? mine : 1u; nx = cnt > 0u ? cnt : 1u;
}

__device__ __forceinline__ void xcd_barrier(const XcdBarrier& b) {
    asm volatile("s_waitcnt vmcnt(0)" ::: "memory");
    __syncthreads();
    if (threadIdx.x == 0) {
        unsigned* bar = b.bar;
        __builtin_amdgcn_s_waitcnt(0);
        unsigned nloc = b.st[0], nx = b.st[1];
        if (nloc == 0u) { xcd_barrier_complete(bar, b.x, nloc, nx); b.st[0] = nloc; b.st[1] = nx; }
        const unsigned old = xb_add(&bar[XB_XSUB(b.x)], 1u);
        const unsigned gen = old / nloc;
        if (old + 1u == (gen + 1u) * nloc) {
            __builtin_amdgcn_fence(__ATOMIC_RELEASE, "agent");
            asm volatile("s_waitcnt vmcnt(0)" ::: "memory");
            const unsigned og = xb_add(&bar[XB_TOP], 1u);
            const unsigned tg = og / nx;
            if (og + 1u == (tg + 1u) * nx) xb_add(&bar[XB_TOPGEN], 1u);
            else XB_SPIN(xb_ld(&bar[XB_TOPGEN]) == tg, bar);
            __builtin_amdgcn_fence(__ATOMIC_ACQUIRE, "agent");
            xb_add(&bar[XB_XGEN(b.x)], 1u);
            asm volatile("s_waitcnt vmcnt(0)" ::: "memory");
        } else {
            XB_SPIN(xb_ld(&bar[XB_XGEN(b.x)]) == gen, bar);
            __builtin_amdgcn_fence(__ATOMIC_ACQUIRE, "agent");
            asm volatile("s_waitcnt vmcnt(0)" ::: "memory");
        }
    }
    __syncthreads();
}
struct Args { const float* in[27]; float* out; unsigned char* ws; int ph_lo, ph_hi, li, pad; };
enum { I_X = 0, I_MEM, I_REL, I_ANORM, I_WIN, I_BGATE, I_CONV, I_ALOG, I_DTB, I_DNON, I_DAQN, I_DAKN, I_LAM, I_SUBLN, I_MEMNORM, I_WMKV, I_MXQN, I_MXKN, I_WBR, I_WOUT, I_FNORM,
       I_WR, I_BR, I_WGU, I_BGU, I_WD, I_BD };

#ifndef MOE_FP8
#define MOE_FP8 1
#endif
constexpr float W8_SCALE = 64.f, A8_SCALE = 4.f, ACC8_SCALE = 1.f / (W8_SCALE * A8_SCALE);
#ifndef TR_DEPTH3
#define TR_DEPTH3 1
#endif
#ifndef NORM_IN_EPI
#define NORM_IN_EPI 1
#endif
#ifndef GATE_U8
#define GATE_U8 1
#endif
DI unsigned pk4u8(float a, float b, float c, float d) {
    const unsigned fa = __builtin_bit_cast(unsigned, __builtin_fmaf(a, 255.f, 8388608.f)), fb = __builtin_bit_cast(unsigned, __builtin_fmaf(b, 255.f, 8388608.f));
    const unsigned fc = __builtin_bit_cast(unsigned, __builtin_fmaf(c, 255.f, 8388608.f)), fd = __builtin_bit_cast(unsigned, __builtin_fmaf(d, 255.f, 8388608.f));
    return __builtin_amdgcn_perm(fb, fa, 0x0c0c0400u) | __builtin_amdgcn_perm(fd, fc, 0x04000c0cu);
}
#ifndef P1_FA0
#define P1_FA0 0
#define P1_FA1 0
#endif
DI constexpr bool p1_isf8(int pn) { return pn >= 16 || (pn >= P1_FA0 && pn < P1_FA1); }
DI void tr_item(const float* __restrict__ W, size_t ldw, int k0, int c0, bf16* WT, int K, size_t drow0, LAS float* scr, int lane, float sc = 1.f) {
    float v[64];
    const float* wp = W + (size_t)k0 * ldw + c0 + lane;
#pragma unroll
    for (int k = 0; k < 64; ++k) v[k] = wp[(size_t)k * ldw];
#pragma unroll
    for (int k = 0; k < 64; ++k) scr[k * 65 + lane] = v[k] * sc;
    LDS_WAIT();
    const int c = lane & 7;
#pragma unroll
    for (int j = 0; j < 8; ++j) { const int n = (lane >> 3) + 8 * j; const LAS float* s = scr + (8 * c) * 65 + n;
        v4u o; o.x = pk2(s[0 * 65], s[1 * 65]); o.y = pk2(s[2 * 65], s[3 * 65]); o.z = pk2(s[4 * 65], s[5 * 65]); o.w = pk2(s[6 * 65], s[7 * 65]);
        *(v4u*)(WT + (drow0 + n) * K + k0 + 8 * c) = o; }
    LDS_WAIT();
}

DI void tr_item8(const float* __restrict__ W, size_t ldw, int k0, int c0, unsigned char* WT, int K, size_t drow0, LAS float* scr, int lane) {
    float v[64];
    const float* wp = W + (size_t)k0 * ldw + c0 + lane;
#pragma unroll
    for (int k = 0; k < 64; ++k) v[k] = wp[(size_t)k * ldw];
#pragma unroll
    for (int k = 0; k < 64; ++k) scr[k * 65 + lane] = v[k] * W8_SCALE;
    LDS_WAIT();
    const int c = lane & 7;
#pragma unroll
    for (int j = 0; j < 8; ++j) { const int n = (lane >> 3) + 8 * j; const LAS float* s = scr + (8 * c) * 65 + n;
        v2u o; o.x = pk4f8(s[0 * 65], s[1 * 65], s[2 * 65], s[3 * 65]); o.y = pk4f8(s[4 * 65], s[5 * 65], s[6 * 65], s[7 * 65]);
        *(v2u*)(WT + (drow0 + n) * K + k0 + 8 * c) = o; }
    LDS_WAIT();
}
#if MOE_FP8
struct TrDesc { const float* wp; size_t ldw; unsigned char* dst; int K; };
DI TrDesc moe_tr_desc(const Args& a, int it, int lane) {
    constexpr int I_GU = 16 * 32 * NEXP;
    unsigned char* ws = a.ws; TrDesc d;
    if (it < I_GU) { const int e = it / 512, q = it % 512, kb = q / 32, nb = q % 32; const int n0 = nb * 64, pn = n0 >> 8, bj = (n0 >> 7) & 1, i0 = n0 & 127;
        d.wp = a.in[I_WGU] + (size_t)e * 1024 * 2048 + (size_t)(kb * 64) * 2048 + (bj * 1024 + 128 * pn + i0) + lane; d.ldw = 2048;
        d.dst = (ws + WS_WGU) + ((size_t)e * 2048 + n0) * 1024 + kb * 64; d.K = 1024; }
    else { const int r = it - I_GU; const int e = r / 256, q = r % 256, kb = q / 16, nb = q % 16;
        d.wp = a.in[I_WD] + (size_t)e * 1024 * 1024 + (size_t)(kb * 64) * 1024 + nb * 64 + lane; d.ldw = 1024;
        d.dst = (ws + WS_WD) + ((size_t)e * 1024 + nb * 64) * 1024 + kb * 64; d.K = 1024; }
    return d;
}
#define TR_LOAD(v, d) do { _Pragma("unroll") for (int k_ = 0; k_ < 64; ++k_) v[k_] = __builtin_nontemporal_load((d).wp + (size_t)k_ * (d).ldw); } while (0)
#define TR_STORE(v, d) do { _Pragma("unroll") for (int k_ = 0; k_ < 64; ++k_) scr[k_ * 65 + lane] = v[k_] * W8_SCALE; \
        LDS_WAIT(); const int c_ = lane & 7; \
        _Pragma("unroll") for (int j_ = 0; j_ < 8; ++j_) { const int n_ = (lane >> 3) + 8 * j_; const LAS float* s_ = scr + (8 * c_) * 65 + n_; \
            v2u o_; o_.x = pk4f8(s_[0 * 65], s_[1 * 65], s_[2 * 65], s_[3 * 65]); o_.y = pk4f8(s_[4 * 65], s_[5 * 65], s_[6 * 65], s_[7 * 65]); \
            __builtin_nontemporal_store(o_, (v2u*)((d).dst + (size_t)n_ * (d).K + 8 * c_)); } \
        LDS_WAIT(); } while (0)
#else
struct TrDesc { const float* wp; size_t ldw; bf16* dst; int K; };
DI TrDesc moe_tr_desc(const Args& a, int it, int lane) {
    constexpr int I_GU = 16 * 32 * NEXP;
    unsigned char* ws = a.ws; TrDesc d;
    if (it < I_GU) { const int e = it / 512, q = it % 512, kb = q / 32, nb = q % 32; const int n0 = nb * 64, pn = n0 >> 8, bj = (n0 >> 7) & 1, i0 = n0 & 127;
        d.wp = a.in[I_WGU] + (size_t)e * 1024 * 2048 + (size_t)(kb * 64) * 2048 + (bj * 1024 + 128 * pn + i0) + lane; d.ldw = 2048;
        d.dst = (bf16*)(ws + WS_WGU) + ((size_t)e * 2048 + n0) * 1024 + kb * 64; d.K = 1024; }
    else { const int r = it - I_GU; const int e = r / 256, q = r % 256, kb = q / 16, nb = q % 16;
        d.wp = a.in[I_WD] + (size_t)e * 1024 * 1024 + (size_t)(kb * 64) * 1024 + nb * 64 + lane; d.ldw = 1024;
        d.dst = (bf16*)(ws + WS_WD) + ((size_t)e * 1024 + nb * 64) * 1024 + kb * 64; d.K = 1024; }
    return d;
}
#define TR_LOAD(v, d) do { _Pragma("unroll") for (int k_ = 0; k_ < 64; ++k_) v[k_] = (d).wp[(size_t)k_ * (d).ldw]; } while (0)
#define TR_STORE(v, d) do { _Pragma("unroll") for (int k_ = 0; k_ < 64; ++k_) scr[k_ * 65 + lane] = v[k_]; \
        LDS_WAIT(); const int c_ = lane & 7; \
        _Pragma("unroll") for (int j_ = 0; j_ < 8; ++j_) { const int n_ = (lane >> 3) + 8 * j_; const LAS float* s_ = scr + (8 * c_) * 65 + n_; \
            v4u o_; o_.x = pk2(s_[0 * 65], s_[1 * 65]); o_.y = pk2(s_[2 * 65], s_[3 * 65]); o_.z = pk2(s_[4 * 65], s_[5 * 65]); o_.w = pk2(s_[6 * 65], s_[7 * 65]); \
            *(v4u*)((d).dst + (size_t)n_ * (d).K + 8 * c_) = o_; } \
        LDS_WAIT(); } while (0)
#endif
DI void moe_transposes(const Args& a, LAS unsigned char* lds, int part, int nparts, int wave, int lane) {
    LAS float* scr = (LAS float*)(lds + wave * 16640);
    constexpr int NIT = 16 * 32 * NEXP + 16 * 16 * NEXP;
    const int per = (NIT + nparts * 8 - 1) / (nparts * 8), stride = 1;
    int it = (part * 8 + wave) * per; const int it_end = (it + per < NIT) ? it + per : NIT;
    if (it >= it_end) return;
#if TR_DEPTH3
    float vA[64], vB[64], vC[64];
    TrDesc dA = moe_tr_desc(a, it, lane), dB = dA, dC = dA;
    TR_LOAD(vA, dA);
    if (it + 1 < it_end) { dB = moe_tr_desc(a, it + 1, lane); TR_LOAD(vB, dB); }
    for (;;) {
        if (it + 2 < it_end) { dC = moe_tr_desc(a, it + 2, lane); TR_LOAD(vC, dC); }
        TR_STORE(vA, dA);
        if (it + 1 >= it_end) break;
        if (it + 3 < it_end) { dA = moe_tr_desc(a, it + 3, lane); TR_LOAD(vA, dA); }
        TR_STORE(vB, dB);
        if (it + 2 >= it_end) break;
        if (it + 4 < it_end) { dB = moe_tr_desc(a, it + 4, lane); TR_LOAD(vB, dB); }
        TR_STORE(vC, dC);
        if (it + 3 >= it_end) break;
        it += 3;
    }
#else
    float vA[64], vB[64];
    TrDesc dA = moe_tr_desc(a, it, lane), dB = dA;
    TR_LOAD(vA, dA);
    for (;;) {
        const bool hb = it + stride < it_end;
        if (hb) { dB = moe_tr_desc(a, it + stride, lane); TR_LOAD(vB, dB); }
        TR_STORE(vA, dA);
        if (!hb) break;
        it += stride;
        const bool ha = it + stride < it_end;
        if (ha) { dA = moe_tr_desc(a, it + stride, lane); TR_LOAD(vA, dA); }
        TR_STORE(vB, dB);
        if (!ha) break;
        it += stride;
    }
#endif
}
DI void p3_small_copies(const Args& a, LAS unsigned char* lds, int part, int nparts, int wave, int lane) {
    unsigned char* ws = a.ws; LAS float* scr = (LAS float*)(lds + wave * 16640);
    constexpr int I_BRI = 3 * 8 * 16, I_OUT = 16 * 16;
    for (int it = part * 8 + wave; it < I_BRI + I_OUT; it += nparts * 8) {
        int r = it;
        if (r < I_BRI) { const int br = r / 128, q = r % 128, kb = q / 16, nb = q % 16;
            tr_item(a.in[I_WBR] + (size_t)br * 512 * 1024, 1024, kb * 64, nb * 64, (bf16*)(ws + WS_WB), 512, (size_t)br * 1024 + nb * 64, scr, lane, GATE_U8 ? (1.f / 255.f) : 1.f); continue; } r -= I_BRI;
        { const int kb = r / 16, nb = r % 16;
            tr_item(a.in[I_WOUT], 1024, kb * 64, nb * 64, (bf16*)(ws + WS_WOUT), 1024, (size_t)nb * 64, scr, lane); }
    }
}
DI void p0_prologue(const Args& a, LAS unsigned char* lds, int vcu, int G, int wave, int lane, int pmode = 0) {
    unsigned char* ws = a.ws;
    LAS float* scr = (LAS float*)(lds + wave * 16640);
    const int gw = vcu * 8 + wave, NGW = G * 8;
    constexpr int I_IN = 16 * 112, I_GU = 16 * 32 * NEXP, I_DN = 16 * 16 * NEXP, I_BRI = 3 * 8 * 16, I_OUT = 16 * 16, I_MK = 16 * 16;
    constexpr int NITEMS = I_IN + I_MK; (void)I_GU; (void)I_DN; (void)I_BRI; (void)I_OUT;
#define P0_ITEMS() do {     for (int it = gw; it < ((pmode & 1) ? 0 : NITEMS); it += NGW) { \
        int r = it; \
        if (r < I_IN) { const int kb = r / 112, nb = r % 112; const int n0 = nb * 64; \
            if (p1_isf8(n0 >> 8)) tr_item8(a.in[I_WIN], INW, kb * 64, n0 < 2048 ? n0 : n0 + 8, ws + WS_WIN8, 1024, (size_t)n0, scr, lane); \
            else tr_item(a.in[I_WIN], INW, kb * 64, n0 < 2048 ? n0 : n0 + 8, (bf16*)(ws + WS_WIN), 1024, (size_t)n0, scr, lane); \
            continue; } r -= I_IN; \
        { const int kb = r / 16, nb = r % 16; \
            tr_item(a.in[I_WMKV], 1024, kb * 64, nb * 64, (bf16*)(ws + WS_WMKV), 1024, (size_t)nb * 64, scr, lane); } \
    } } while (0)
    const bool items_first = (__builtin_amdgcn_readfirstlane((int)blockIdx.x) & 1) == 0;
    if (items_first) P0_ITEMS();
    if (!(pmode & 2)) {
        const float* win = a.in[I_WIN];
        f32x4 gv[4];
#pragma unroll
        for (int j = 0; j < 4; ++j) gv[j] = ((const f32x4*)a.in[I_ANORM])[lane + 64 * j];
        f32x4 wa[4][4], wb[4][4];
#pragma unroll
        for (int j = 0; j < 4; ++j)
#pragma unroll
            for (int c = 0; c < 4; ++c) { const f32x4* p = (const f32x4*)(win + (size_t)(4 * lane + 256 * j + c) * INW + 2048); wa[j][c] = p[0]; wb[j][c] = p[1]; }
        const int hq_ = ((lane >> 1) & 1) * 2 + ((lane >> 2) & 1);
        const float alog = a.in[I_ALOG][hq_], dtb = a.in[I_DTB][hq_];
        float* G_ = (float*)(ws + WS_G); float* B_ = (float*)(ws + WS_BETA);
        bf16* H = (bf16*)(ws + WS_H);
        f32x4 nv[4];
        { const f32x4* xr = (const f32x4*)(a.in[I_X] + (size_t)gw * D) + lane;
#pragma unroll
          for (int j = 0; j < 4; ++j) nv[j] = __builtin_nontemporal_load(xr + 64 * j); }
        for (int m = gw; m < T; m += NGW) {
            f32x4 v[4]; float ss = 0.f;
#pragma unroll
            for (int j = 0; j < 4; ++j) { v[j] = nv[j]; ss += (v[j].x * v[j].x + v[j].y * v[j].y) + (v[j].z * v[j].z + v[j].w * v[j].w); }
            { const int mn = (m + NGW < T) ? m + NGW : m; const f32x4* xr = (const f32x4*)(a.in[I_X] + (size_t)mn * D) + lane;
#pragma unroll
              for (int j = 0; j < 4; ++j) nv[j] = __builtin_nontemporal_load(xr + 64 * j); }
            const float rstd = rsqrtf(wave_sum(ss) * (1.f / D) + EPS);
            f32x4 pa = {0.f, 0.f, 0.f, 0.f}, pb = {0.f, 0.f, 0.f, 0.f};
            unsigned* o4 = (unsigned*)(ws + WS_H8 + (size_t)m * D) + lane;
            unsigned long long* o8 = (unsigned long long*)(H + (size_t)m * D) + lane;
#pragma unroll
            for (int j = 0; j < 4; ++j) { v[j] = v[j] * rstd * gv[j];
                o4[64 * j] = pk4f8(v[j].x * A8_SCALE, v[j].y * A8_SCALE, v[j].z * A8_SCALE, v[j].w * A8_SCALE);
                o8[64 * j] = (unsigned long long)pk2(v[j].x, v[j].y) | ((unsigned long long)pk2(v[j].z, v[j].w) << 32);
                pa += wa[j][0] * v[j].x + wa[j][1] * v[j].y + wa[j][2] * v[j].z + wa[j][3] * v[j].w;
                pb += wb[j][0] * v[j].x + wb[j][1] * v[j].y + wb[j][2] * v[j].z + wb[j][3] * v[j].w; }
            float tot_;
            { const bool b0 = (lane & 1) != 0, b1 = (lane & 2) != 0, b2 = (lane & 4) != 0;
              f32x4 keep = b0 ? pb : pa; const f32x4 send = b0 ? pa : pb;
              keep.x += __shfl_xor(send.x, 1); keep.y += __shfl_xor(send.y, 1); keep.z += __shfl_xor(send.z, 1); keep.w += __shfl_xor(send.w, 1);
              float k0 = b1 ? keep.z : keep.x, k1 = b1 ? keep.w : keep.y; const float s0 = b1 ? keep.x : keep.z, s1 = b1 ? keep.y : keep.w;
              k0 += __shfl_xor(s0, 2); k1 += __shfl_xor(s1, 2);
              float k = b2 ? k1 : k0; const float sx = b2 ? k0 : k1; k += __shfl_xor(sx, 4);
              k += __shfl_xor(k, 8); k += __shfl_xor(k, 16); k += __shfl_xor(k, 32); tot_ = k; }
            if (lane < 8) {
                if (!(lane & 1)) { const float z = tot_ + dtb; const float sp = z > 20.f ? z : log1pf(expf(z)); G_[(size_t)m * 4 + hq_] = -expf(alog) * sp; }
                else B_[(size_t)m * 4 + hq_] = 1.f / (1.f + expf(-tot_));
            }
        }
    }
    {
        f32x4 gv[4];
#pragma unroll
        for (int j = 0; j < 4; ++j) gv[j] = ((const f32x4*)a.in[I_MEMNORM])[lane + 64 * j];
        bf16* MN = (bf16*)(ws + WS_MEMN);
        for (int m = gw; m < BATCH * NMEM; m += NGW) {
            const f32x4* xr = (const f32x4*)(a.in[I_MEM] + (size_t)m * D) + lane;
            f32x4 v[4]; float ss = 0.f;
#pragma unroll
            for (int j = 0; j < 4; ++j) { v[j] = xr[64 * j]; ss += (v[j].x * v[j].x + v[j].y * v[j].y) + (v[j].z * v[j].z + v[j].w * v[j].w); }
            const float rstd = rsqrtf(wave_sum(ss) * (1.f / D) + EPS);
            unsigned long long* o8 = (unsigned long long*)(MN + (size_t)m * D) + lane;
#pragma unroll
            for (int j = 0; j < 4; ++j) { v[j] = v[j] * rstd * gv[j]; o8[64 * j] = (unsigned long long)pk2(v[j].x, v[j].y) | ((unsigned long long)pk2(v[j].z, v[j].w) << 32); }
        }
    }
    if (!items_first) P0_ITEMS();
#undef P0_ITEMS
}

template <bool F8>
struct EpiPT {
    static constexpr bool PERM = true; static constexpr bool CHAIN = false; static constexpr bool PREFETCH = false;
    bf16* O; const float* b_gate; int skip; bf16* GF;
    LAS float* EX; const float* daqn; const float* dakn; const float* mxqn;
    unsigned char* Q8; unsigned char* K8;
    DI void operator()(const f32x4 (&acc)[2][2][4][2], const pg8::Unit& u, int wr, int wc, int fr, int fq) const {
        if (skip == 1) { f32x4 s_ = {0.f, 0.f, 0.f, 0.f}; _Pragma("unroll") for (int a_ = 0; a_ < 2; ++a_) _Pragma("unroll") for (int b_ = 0; b_ < 2; ++b_) _Pragma("unroll") for (int m_ = 0; m_ < 4; ++m_) _Pragma("unroll") for (int n_ = 0; n_ < 2; ++n_) s_ += acc[a_][b_][m_][n_]; if (s_.x + s_.y + s_.z + s_.w == 123.456f) O[0] = 0; return; }
        const int row0 = u.pm * 256 + wr * 64 + fr, col0 = u.pn * 256 + wc * 32 + 8 * fq;
        const bool isg = u.pn >= 16;
        f32x4 bv[2][2];
#pragma unroll
        for (int bj = 0; bj < 2; ++bj)
#pragma unroll
            for (int n = 0; n < 2; ++n) bv[bj][n] = isg ? *(const f32x4*)(b_gate + (col0 - 4096) + bj * 128 + 4 * n) : (f32x4){0.f, 0.f, 0.f, 0.f};
        const size_t gtile = isg ? ((size_t)(((u.pn - 16) >> 2) * 128 + u.pm) * 4 + ((u.pn - 16) & 3)) : 0;
        const int wl = (wr * 4 + wc) * 64 + fq * 16 + fr;
#if NORM_IN_EPI
        if (!F8 && ((u.pn >= 8 && u.pn < 12) || (u.pn >= 14 && u.pn < 16))) {
            const bool mx = u.pn >= 14;
            int fr_ = fr, fq_ = fq; asm volatile("" : "+v"(fr_), "+v"(fq_));
            LAS float* e0 = EX + (wr * 4 + wc) * 256 + fr_; const LAS float* e1 = EX + (wr * 4 + (wc ^ 1)) * 256 + fr_;
            const LAS float* e2 = EX + (wr * 4 + (wc ^ 2)) * 256 + fr_; const LAS float* e3 = EX + (wr * 4 + (wc ^ 3)) * 256 + fr_;
#pragma unroll
            for (int ai = 0; ai < 2; ++ai)
#pragma unroll
                for (int m = 0; m < 4; ++m)
#pragma unroll
                    for (int bj = 0; bj < 2; ++bj) { const f32x4 v0 = acc[ai][bj][m][0], v1 = acc[ai][bj][m][1];
                        float ss = (v0.x * v0.x + v0.y * v0.y) + (v0.z * v0.z + v0.w * v0.w) + (v1.x * v1.x + v1.y * v1.y) + (v1.z * v1.z + v1.w * v1.w);
                        ss += __shfl_xor(ss, 16); ss += __shfl_xor(ss, 32);
                        if (fq_ == 0) e0[((ai * 4 + m) * 2 + bj) * 16] = ss; }
            LDS_WAIT(); __builtin_amdgcn_s_barrier();
            const float* pq_ = daqn; const float* pk_ = dakn; const float* px_ = mxqn; asm volatile("" : "+s"(pq_), "+s"(pk_), "+s"(px_));
            const float* gp = (u.pn < 10 ? pq_ : u.pn < 12 ? pk_ : px_) + (mx ? wc * 32 : (wc & 1) * 32) + 8 * fq_;
            const f32x4 g0 = *(const f32x4*)gp, g1 = *(const f32x4*)(gp + 4);
#if ATTN_FP8QK
            const float sc = u.pn < 10 ? 0.125f * LOG2E * 4.f : u.pn < 12 ? 0.25f : 0.08838834764831845f * LOG2E, idim = mx ? (1.f / 128.f) : (1.f / 64.f);
#else
            const float sc = u.pn < 10 ? 0.125f * LOG2E : u.pn < 12 ? 1.f : 0.08838834764831845f * LOG2E, idim = mx ? (1.f / 128.f) : (1.f / 64.f);
#endif
#pragma unroll
            for (int ai = 0; ai < 2; ++ai)
#pragma unroll
                for (int m = 0; m < 4; ++m) { bf16* rowp = O + (size_t)(u.pm * 256 + wr * 64 + fr_ + ai * 128 + m * 16) * PW + (u.pn * 256 + wc * 32 + 8 * fq_);
#pragma unroll
                    for (int bj = 0; bj < 2; ++bj) { const int f = (ai * 4 + m) * 2 + bj;
                        float t = e0[f * 16] + e1[f * 16];
                        if (mx) t += e2[f * 16] + e3[f * 16];
                        const float r = rsqrtf(t * idim + EPS) * sc;
                        const f32x4 a0_ = acc[ai][bj][m][0], a1_ = acc[ai][bj][m][1];
                        f32x4 v0, v1; v0.xy = (a0_.xy * r) * g0.xy; v0.zw = (a0_.zw * r) * g0.zw; v1.xy = (a1_.xy * r) * g1.xy; v1.zw = (a1_.zw * r) * g1.zw;
#if ATTN_FP8QK
                        if (u.pn < 12) {
                            v2u w8; w8.x = pk4f8(v0.x, v0.y, v0.z, v0.w); w8.y = pk4f8(v1.x, v1.y, v1.z, v1.w);
                            const int t_ = u.pm * 256 + wr * 64 + fr_ + ai * 128 + m * 16, c_ = (u.pn & 1) * 256 + wc * 32 + 8 * fq_ + bj * 128;
                            if (u.pn < 10) *(v2u*)(Q8 + (size_t)t_ * 512 + c_) = w8;
                            else { const int mh_ = c_ >> 6, d0_ = c_ & 63, kk_ = t_ & 63;
                                *(v2u*)(K8 + ((size_t)(t_ >> 6) * 8 + mh_) * 4096 + ((((kk_ >> 5) * 2 + ((d0_ >> 4) & 1)) * 64 + (kk_ & 31) + 32 * (d0_ >> 5)) * 16 + (d0_ & 15))) = w8; }
                            continue; }
#endif
                        v4u w; w.x = pk2(v0.x, v0.y); w.y = pk2(v0.z, v0.w); w.z = pk2(v1.x, v1.y); w.w = pk2(v1.z, v1.w);
                        *(v4u*)(rowp + bj * 128) = w; } }
            return;
        }
#endif
#pragma unroll
        for (int ai = 0; ai < 2; ++ai)
#pragma unroll
            for (int m = 0; m < 4; ++m) { bf16* rowp = O + (size_t)(row0 + ai * 128 + m * 16) * PW + col0;
                v4u g8;
#pragma unroll
                for (int bj = 0; bj < 2; ++bj) {
                    f32x4 v0, v1;
                    if (F8 && isg) {
                        const f32x4 t0 = acc[ai][bj][m][0] * (-ACC8_SCALE * LOG2E) - bv[bj][0] * LOG2E, t1 = acc[ai][bj][m][1] * (-ACC8_SCALE * LOG2E) - bv[bj][1] * LOG2E;
                        v0.x = __builtin_amdgcn_rcpf(1.f + __builtin_amdgcn_exp2f(t0.x)); v0.y = __builtin_amdgcn_rcpf(1.f + __builtin_amdgcn_exp2f(t0.y)); v0.z = __builtin_amdgcn_rcpf(1.f + __builtin_amdgcn_exp2f(t0.z)); v0.w = __builtin_amdgcn_rcpf(1.f + __builtin_amdgcn_exp2f(t0.w));
                        v1.x = __builtin_amdgcn_rcpf(1.f + __builtin_amdgcn_exp2f(t1.x)); v1.y = __builtin_amdgcn_rcpf(1.f + __builtin_amdgcn_exp2f(t1.y)); v1.z = __builtin_amdgcn_rcpf(1.f + __builtin_amdgcn_exp2f(t1.z)); v1.w = __builtin_amdgcn_rcpf(1.f + __builtin_amdgcn_exp2f(t1.w));
                    } else {
                    if constexpr (F8) { v0 = acc[ai][bj][m][0] * ACC8_SCALE + bv[bj][0]; v1 = acc[ai][bj][m][1] * ACC8_SCALE + bv[bj][1]; }
                    else { v0 = acc[ai][bj][m][0] + bv[bj][0]; v1 = acc[ai][bj][m][1] + bv[bj][1]; }
                    if (isg) { v0.x = sigmoidf_(v0.x); v0.y = sigmoidf_(v0.y); v0.z = sigmoidf_(v0.z); v0.w = sigmoidf_(v0.w);
                               v1.x = sigmoidf_(v1.x); v1.y = sigmoidf_(v1.y); v1.z = sigmoidf_(v1.z); v1.w = sigmoidf_(v1.w); }
                    }
#if GATE_U8
                    if (isg) { const unsigned lo = pk4u8(v0.x, v0.y, v0.z, v0.w), hi = pk4u8(v1.x, v1.y, v1.z, v1.w); if (bj == 0) { g8.x = lo; g8.y = hi; } else { g8.z = lo; g8.w = hi; } }
                    else { v4u w; w.x = pk2(v0.x, v0.y); w.y = pk2(v0.z, v0.w); w.z = pk2(v1.x, v1.y); w.w = pk2(v1.z, v1.w); *(v4u*)(rowp + bj * 128) = w; }
#else
                    v4u w; w.x = pk2(v0.x, v0.y); w.y = pk2(v0.z, v0.w); w.z = pk2(v1.x, v1.y); w.w = pk2(v1.z, v1.w);
                    if (isg) *(v4u*)(GF + (((gtile * 16 + (ai * 4 + m) * 2 + bj) * 512) + wl) * 8) = w;
                    else *(v4u*)(rowp + bj * 128) = w;
#endif
                }
#if GATE_U8
                if (isg) __builtin_nontemporal_store(g8, (v4u*)((unsigned char*)GF + ((gtile * 8 + (ai * 4 + m)) * 512 + wl) * 16));
#endif
            }
    }
};
typedef EpiPT<false> EpiP;
struct OffOrder { pg8::StaticOrder S; int n0, a0, a1; int i0 = 0, ni = 1 << 30;
    DI bool next(int i, pg8::Unit& u) const { if (i >= ni) return false; const bool ok = S.next(i + i0, u); u.pn = u.pn < n0 ? a0 + u.pn : a1 + (u.pn - n0); return ok; } };
struct EpiV8 {
    static constexpr bool PERM = false; static constexpr bool CHAIN = false; static constexpr bool PREFETCH = false;
    unsigned char* V8; LAS unsigned char* EX;
    DI void operator()(const f32x4 (&acc)[2][2][4][2], const pg8::Unit& u, int wr, int wc, int fr, int fq) const {
        int fr_ = fr, fq_ = fq; asm volatile("" : "+v"(fr_), "+v"(fq_));
        const int lane_ = fq_ * 16 + fr_, wv_ = wr * 4 + wc;
        LAS unsigned char* st = EX + wv_ * 1024;
#pragma unroll
        for (int ai = 0; ai < 2; ++ai)
#pragma unroll
            for (int bj = 0; bj < 2; ++bj) {
                const size_t blk = ((size_t)(u.pm * 4 + wr + 2 * ai) * 4 + ((u.pn - 12) * 2 + bj)) * 8192 + (size_t)wc * 2048;
#pragma unroll
                for (int jj = 0; jj < 2; ++jj) {
#pragma unroll
                    for (int mm = 0; mm < 2; ++mm)
#pragma unroll
                        for (int n = 0; n < 2; ++n) { const f32x4 v = acc[ai][bj][2 * jj + mm][n];
                            *(LAS unsigned*)(st + ((n * 16 + fr_) + 32 * (fq_ & 1)) * 16 + 4 * (mm * 2 + (fq_ >> 1))) = pk4f8(v.x, v.y, v.z, v.w); }
                    LDS_WAIT();
                    const v4u o = *(const LAS v4u*)(st + lane_ * 16);
                    *(v4u*)(V8 + blk + jj * 1024 + lane_ * 16) = o;
                    LDS_WAIT();
                }
            }
    }
};
struct EpiPlain {
    static constexpr bool PERM = true; static constexpr bool CHAIN = false; static constexpr bool PREFETCH = false;
    bf16* O; int ldc;
    DI void operator()(const f32x4 (&acc)[2][2][4][2], const pg8::Unit& u, int wr, int wc, int fr, int fq) const {
        const int row0 = u.pm * 256 + wr * 64 + fr, col0 = u.pn * 256 + wc * 32 + 8 * fq;
#pragma unroll
        for (int ai = 0; ai < 2; ++ai)
#pragma unroll
            for (int m = 0; m < 4; ++m) { bf16* rowp = O + (size_t)(row0 + ai * 128 + m * 16) * ldc + col0;
#pragma unroll
                for (int bj = 0; bj < 2; ++bj) { const f32x4 v0 = acc[ai][bj][m][0], v1 = acc[ai][bj][m][1];
                    v4u w; w.x = pk2(v0.x, v0.y); w.y = pk2(v0.z, v0.w); w.z = pk2(v1.x, v1.y); w.w = pk2(v1.z, v1.w);
                    *(v4u*)(rowp + bj * 128) = w; } }
    }
};

DI void p2_norm_rows(const Args& a, int vcu, int G, int wave, int lane) {
    unsigned char* ws = a.ws; bf16* P = (bf16*)(ws + WS_P);
    const int gw = vcu * 8 + wave, NGW = G * 8;
    float gda[16], gmx[8], gmk[8];
    { const float* gsrc = (lane < 32 ? a.in[I_DAQN] : a.in[I_DAKN]) + 16 * (lane & 3);
#pragma unroll
      for (int i = 0; i < 16; ++i) gda[i] = gsrc[i];
#pragma unroll
      for (int i = 0; i < 8; ++i) { gmx[i] = a.in[I_MXQN][8 * (lane & 15) + i]; gmk[i] = a.in[I_MXKN][8 * (lane & 15) + i]; } }
    const float sc_da = lane < 32 ? 0.125f * LOG2E : 1.f;
    const float sc_mx = 0.08838834764831845f * LOG2E;
    for (int m = gw; m < T; m += NGW) {
        { v4u* p = (v4u*)(P + (size_t)m * PW + P_DAQ + 16 * lane); v4u w0 = p[0], w1 = p[1];
          float f[16]; f[0] = bflo(w0.x); f[1] = bfhi(w0.x); f[2] = bflo(w0.y); f[3] = bfhi(w0.y); f[4] = bflo(w0.z); f[5] = bfhi(w0.z); f[6] = bflo(w0.w); f[7] = bfhi(w0.w);
          f[8] = bflo(w1.x); f[9] = bfhi(w1.x); f[10] = bflo(w1.y); f[11] = bfhi(w1.y); f[12] = bflo(w1.z); f[13] = bfhi(w1.z); f[14] = bflo(w1.w); f[15] = bfhi(w1.w);
          float ss = 0.f;
#pragma unroll
          for (int i = 0; i < 16; ++i) ss += f[i] * f[i];
          ss += __shfl_xor(ss, 1); ss += __shfl_xor(ss, 2);
          const float r = rsqrtf(ss * (1.f / 64.f) + EPS) * sc_da;
#pragma unroll
          for (int i = 0; i < 16; ++i) f[i] = f[i] * r * gda[i];
          w0.x = pk2(f[0], f[1]); w0.y = pk2(f[2], f[3]); w0.z = pk2(f[4], f[5]); w0.w = pk2(f[6], f[7]);
          w1.x = pk2(f[8], f[9]); w1.y = pk2(f[10], f[11]); w1.z = pk2(f[12], f[13]); w1.w = pk2(f[14], f[15]);
          p[0] = w0; p[1] = w1; }
        { v4u* p = (v4u*)(P + (size_t)m * PW + P_MXQ + 8 * lane); v4u w0 = p[0];
          float f[8]; f[0] = bflo(w0.x); f[1] = bfhi(w0.x); f[2] = bflo(w0.y); f[3] = bfhi(w0.y); f[4] = bflo(w0.z); f[5] = bfhi(w0.z); f[6] = bflo(w0.w); f[7] = bfhi(w0.w);
          float ss = 0.f;
#pragma unroll
          for (int i = 0; i < 8; ++i) ss += f[i] * f[i];
          ss = sum16(ss);
          const float r = rsqrtf(ss * (1.f / 128.f) + EPS) * sc_mx;
#pragma unroll
          for (int i = 0; i < 8; ++i) f[i] = f[i] * r * gmx[i];
          w0.x = pk2(f[0], f[1]); w0.y = pk2(f[2], f[3]); w0.z = pk2(f[4], f[5]); w0.w = pk2(f[6], f[7]);
          p[0] = w0; }
    }
}

constexpr int LMS = 65;
constexpr int PREP_GC = 0, PREP_BETA = 256, PREP_QS = 1024, PREP_KS = PREP_QS + 64 * 272, PREP_LM = PREP_KS + 64 * 272, PREP_TM = PREP_LM + 64 * LMS * 4, PREP_RHS = PREP_TM + 4 * 16 * 17 * 4 + 64, PREP_END = PREP_RHS + 64 * 256 * 4;
static_assert(PREP_RHS % 16 == 0, "prep LDS alignment");
static_assert(PREP_END <= RING_BYTES, "prep LDS");
struct PrepPre { float g, be; v4u xin[11]; };
DI void prep_prefetch(const Args& a, int ck, int tid, int wave, PrepPre& pp) {
    unsigned char* ws = a.ws; const bf16* P = (const bf16*)(ws + WS_P);
    const int lane = tid & 63, n = ck & 127, h = (ck >> 7) & 3, b = ck >> 9;
    const size_t t0 = (size_t)b * SEQ + (size_t)n * 64;
    if (wave == 0) { pp.g = ((const float*)(ws + WS_G))[(t0 + lane) * 4 + h]; pp.be = ((const float*)(ws + WS_BETA))[(t0 + lane) * 4 + h]; }
    if (wave < 6) {
        const int part = wave >> 1, rg = (tid >> 4) & 7, cg = tid & 15, i0 = rg * 8;
        const int ch0 = part * 512 + h * 128 + cg * 8;
        const bf16* xp = P + ((long)b * SEQ + n * 64 + i0 - 3) * PW + ch0;
        asm volatile("" : "+v"(xp));
#pragma unroll
        for (int jj = 0; jj < 11; ++jj) { const int s = n * 64 + i0 - 3 + jj;
            pp.xin[jj] = (s >= 0) ? *(const GAS v4u*)(xp + (long)jj * PW) : (v4u){0u, 0u, 0u, 0u}; }
    }
}
template <int PROBE_SKIP = 0>
DI void dn_prep_unit(const Args& a, LAS unsigned char* lds, int ck, int ck_next, PrepPre& pp, int wave) {
    const int tid = fresh_tid(), lane = tid & 63;
    unsigned char* ws = a.ws; const bf16* P = (const bf16*)(ws + WS_P);
    const int n = ck & 127, h = (ck >> 7) & 3, b = ck >> 9;
    const size_t t0 = (size_t)b * SEQ + (size_t)n * 64;
    LAS float* gc = (LAS float*)(lds + PREP_GC); LAS float* bet = (LAS float*)(lds + PREP_BETA);
    LAS float* Lm = (LAS float*)(lds + PREP_LM); LAS float* RHS = (LAS float*)(lds + PREP_RHS);
    if (wave == 0) {
        float v = pp.g;
#pragma unroll
        for (int o = 1; o < 64; o <<= 1) { const float u = __shfl_up(v, o); if (lane >= o) v += u; }
        gc[lane] = v; bet[lane] = pp.be;
    }
    __syncthreads();
    if (wave < 6) {
        const int part = wave >> 1, rg = (tid >> 4) & 7, cg = tid & 15, i0 = rg * 8;
        const int ch0 = part * 512 + h * 128 + cg * 8;
        float w[4][8];
#pragma unroll
        for (int j = 0; j < 4; ++j) { const f32x4* p = (const f32x4*)(a.in[I_CONV] + j * 1536 + ch0); const f32x4 w0 = p[0], w1 = p[1];
            w[j][0] = w0.x; w[j][1] = w0.y; w[j][2] = w0.z; w[j][3] = w0.w; w[j][4] = w1.x; w[j][5] = w1.y; w[j][6] = w1.z; w[j][7] = w1.w; }
        v4u xin[11];
#pragma unroll
        for (int jj = 0; jj < 11; ++jj) xin[jj] = pp.xin[jj];
        float o[8][8];
#pragma unroll
        for (int ri = 0; ri < 8; ++ri) {
            float acc[8];
#pragma unroll
            for (int c = 0; c < 8; ++c) acc[c] = 0.f;
#pragma unroll
            for (int j = 0; j < 4; ++j) { const v4u x = xin[ri + j];
                acc[0] += w[j][0] * bflo(x.x); acc[1] += w[j][1] * bfhi(x.x); acc[2] += w[j][2] * bflo(x.y); acc[3] += w[j][3] * bfhi(x.y);
                acc[4] += w[j][4] * bflo(x.z); acc[5] += w[j][5] * bfhi(x.z); acc[6] += w[j][6] * bflo(x.w); acc[7] += w[j][7] * bfhi(x.w); }
            float ss = 0.f;
#pragma unroll
            for (int c = 0; c < 8; ++c) { const float s_ = acc[c] * sigmoidf_(acc[c]); o[ri][c] = s_; ss += s_ * s_; }
            ss = sum16(ss);
            const float nrm = part == 0 ? rsqrtf(ss + EPS) * 0.08838834764831845f : part == 1 ? rsqrtf(ss + EPS) : 1.f;
#pragma unroll
            for (int c = 0; c < 8; ++c) o[ri][c] *= nrm;
        }
        bf16* qdp = (bf16*)(ws + WS_QD) + (size_t)ck * 8192 + (size_t)(((i0 >> 5) * 8 + (cg >> 1)) * 64 + (i0 & 31) + 32 * (cg & 1)) * 8;
        asm volatile("" : "+v"(qdp));
#pragma unroll
        for (int ri = 0; ri < 8; ++ri) {
            const int row = i0 + ri; const float g_ = gc[row], be = bet[row];
            if (part == 0) {
                v4u wq; wq.x = pk2(o[ri][0], o[ri][1]); wq.y = pk2(o[ri][2], o[ri][3]); wq.z = pk2(o[ri][4], o[ri][5]); wq.w = pk2(o[ri][6], o[ri][7]);
                *(LAS v4u*)(lds + PREP_QS + row * 272 + cg * 16) = wq;
                const float eg = fast_exp(g_);
                v4u wd; wd.x = pk2(o[ri][0] * eg, o[ri][1] * eg); wd.y = pk2(o[ri][2] * eg, o[ri][3] * eg); wd.z = pk2(o[ri][4] * eg, o[ri][5] * eg); wd.w = pk2(o[ri][6] * eg, o[ri][7] * eg);
                *(GAS v4u*)(qdp + ri * 8) = wd;
            } else if (part == 1) {
                v4u wq; wq.x = pk2(o[ri][0], o[ri][1]); wq.y = pk2(o[ri][2], o[ri][3]); wq.z = pk2(o[ri][4], o[ri][5]); wq.w = pk2(o[ri][6], o[ri][7]);
                *(LAS v4u*)(lds + PREP_KS + row * 272 + cg * 16) = wq;
                const float f = be * fast_exp(g_);
                LAS f32x4* r4 = (LAS f32x4*)(RHS + row * 256 + 128 + cg * 8);
                r4[0] = (f32x4){o[ri][0] * f, o[ri][1] * f, o[ri][2] * f, o[ri][3] * f}; r4[1] = (f32x4){o[ri][4] * f, o[ri][5] * f, o[ri][6] * f, o[ri][7] * f};
            } else {
                LAS f32x4* r4 = (LAS f32x4*)(RHS + row * 256 + cg * 8);
                r4[0] = (f32x4){o[ri][0] * be, o[ri][1] * be, o[ri][2] * be, o[ri][3] * be}; r4[1] = (f32x4){o[ri][4] * be, o[ri][5] * be, o[ri][6] * be, o[ri][7] * be};
            }
        }
    }
    __syncthreads();
    if (ck_next < NCHUNK) prep_prefetch(a, ck_next, tid, wave, pp);
    {
        const int sel = wave >> 2, it = (wave >> 1) & 1, jt = wave & 1, r = lane & 31, hh = lane >> 5;
        const LAS unsigned char* Ab = lds + (sel ? PREP_QS : PREP_KS) + (32 * it + r) * 272 + hh * 16;
        const LAS unsigned char* Bb = lds + PREP_KS + (32 * jt + r) * 272 + hh * 16;
        f32x16 acc = {};
#pragma unroll
        for (int s = 0; s < 8; ++s) { const bf16x8 av = *(const LAS bf16x8*)(Ab + s * 32), bv = *(const LAS bf16x8*)(Bb + s * 32);
            acc = __builtin_amdgcn_mfma_f32_32x32x16_bf16(av, bv, acc, 0, 0, 0); }
        const int col = 32 * jt + r; const float gcol = gc[col];
        bf16* QKB = (bf16*)(ws + WS_QK) + (size_t)ck * 4096;
#pragma unroll
        for (int i = 0; i < 16; ++i) { const int row = 32 * it + crow(i, hh);
            const float dec = fast_exp(col <= row ? gc[row] - gcol : 0.f);
            if (sel == 0) Lm[row * LMS + col] = (col < row) ? acc[i] * dec * bet[row] : 0.f;
            else QKB[(((row >> 5) * 4 + (col >> 4)) * 64 + (row & 31) + 32 * ((col >> 3) & 1)) * 8 + (col & 7)] = (bf16)f2bf((col <= row) ? acc[i] * dec : 0.f); }
    }
    __syncthreads();
    LAS float* Tm = (LAS float*)(lds + PREP_TM);
    if (wave == 0) {
        const int blk = lane >> 4, c = lane & 15;
        const LAS float* Db = Lm + (16 * blk) * LMS + 16 * blk;
        float t[16];
#pragma unroll
        for (int r = 0; r < 16; ++r) { float acc = (r == c) ? 1.f : 0.f;
#pragma unroll
            for (int jj = 0; jj < r; ++jj) acc -= Db[r * LMS + jj] * t[jj];
            t[r] = acc; }
#pragma unroll
        for (int r = 0; r < 16; ++r) Tm[(blk * 16 + r) * 17 + c] = t[r];
    } else if (wave >= 4) {
        const int q = tid - 256, kd = q & 127, half = q >> 7;
        const float gl = gc[63];
        bf16* KDT = (bf16*)(ws + WS_KDT) + (size_t)ck * 8192;
#pragma unroll
        for (int c8 = 0; c8 < 4; ++c8) { float f[8];
#pragma unroll
            for (int jj = 0; jj < 8; ++jj) { const int c = 32 * half + 8 * c8 + jj; f[jj] = bf2f(*(const LAS bf16*)(lds + PREP_KS + c * 272 + kd * 2)) * fast_exp(gl - gc[c]); }
            v4u w; w.x = pk2(f[0], f[1]); w.y = pk2(f[2], f[3]); w.z = pk2(f[4], f[5]); w.w = pk2(f[6], f[7]);
            *(v4u*)(KDT + (size_t)((((kd >> 5) * 4 + 2 * half + (c8 >> 1)) * 64) + (kd & 31) + 32 * (c8 & 1)) * 8) = w; }
        if (q == 0) ((float*)(ws + WS_EGL))[ck] = fast_exp(gl);
    }
    __syncthreads();
    if (PROBE_SKIP != 1) {
        const int lr = lane & 15, lq = lane >> 4;
#pragma unroll
        for (int tt = 0; tt < 2; ++tt) {
            const int ct = wave * 2 + tt;
            f32x4 X[4];
#pragma unroll
            for (int b = 0; b < 4; ++b) {
                f32x4 acc;
#pragma unroll
                for (int rg = 0; rg < 4; ++rg) acc[rg] = RHS[(16 * b + 4 * lq + rg) * 256 + ct * 16 + lr];
#pragma unroll
                for (int jb = 0; jb < b; ++jb)
#pragma unroll
                    for (int rg = 0; rg < 4; ++rg) acc = __builtin_amdgcn_mfma_f32_16x16x4f32(-Lm[(16 * b + lr) * LMS + 16 * jb + 4 * lq + rg], X[jb][rg], acc, 0, 0, 0);
                f32x4 xb = {0.f, 0.f, 0.f, 0.f};
#pragma unroll
                for (int rg = 0; rg < 4; ++rg) xb = __builtin_amdgcn_mfma_f32_16x16x4f32(Tm[(b * 16 + lr) * 17 + 4 * lq + rg], acc[rg], xb, 0, 0, 0);
                X[b] = xb;
            }
#pragma unroll
            for (int b = 0; b < 4; ++b)
#pragma unroll
                for (int rg = 0; rg < 4; ++rg) RHS[(16 * b + 4 * lq + rg) * 256 + ct * 16 + lr] = X[b][rg];
        }
    }
    __syncthreads();
    {
        const int row = tid >> 3, seg = tid & 7;
        const LAS f32x4* s4 = (const LAS f32x4*)(RHS + row * 256 + seg * 32);
        const float sg = seg < 4 ? 1.f : -1.f;
        bf16* dst = (bf16*)(ws + (seg < 4 ? WS_U : WS_NW)) + (size_t)ck * 8192;
        const int ctr = row >> 5, rr = row & 31;
#pragma unroll
        for (int q = 0; q < 4; ++q) { const f32x4 x0 = s4[2 * q] * sg, x1 = s4[2 * q + 1] * sg;
            v4u w; w.x = pk2(x0.x, x0.y); w.y = pk2(x0.z, x0.w); w.z = pk2(x1.x, x1.y); w.w = pk2(x1.z, x1.w);
            const int fi = seg < 4 ? ((ctr * 4 + seg) * 2 + (q >> 1)) : (ctr * 8 + (seg - 4) * 2 + (q >> 1));
            *(v4u*)(dst + (size_t)(fi * 64 + rr + 32 * (q & 1)) * 8) = w; }
    }
    __syncthreads();
}

DI void p2_v8_tiles(const Args& a, LAS unsigned char* lds, int vcu, int G, int tid) {
    unsigned char* ws = a.ws; const bf16* P = (const bf16*)(ws + WS_P);
    const int row = tid >> 3, seg = tid & 7;
    const int nt = tid >> 7, jj = (tid >> 6) & 1, ln = tid & 63, n = ln & 31, hh = ln >> 5, c = nt * 32 + n;
    v4u w0, w1;
    if (vcu < BATCH * 128 * 4) { const int b = vcu >> 9, j = (vcu >> 2) & 127, h = vcu & 3; const bf16* src = P + ((size_t)b * SEQ + j * 64 + row) * PW + P_DAV + h * 128 + seg * 16; w0 = *(const v4u*)src; w1 = *(const v4u*)(src + 8); }
    for (int u = vcu; u < BATCH * 128 * 4; u += G) {
        *(LAS v4u*)(lds + row * 272 + seg * 32) = w0; *(LAS v4u*)(lds + row * 272 + seg * 32 + 16) = w1;
        __syncthreads();
        { const int un = u + G; if (un < BATCH * 128 * 4) { const int b = un >> 9, j = (un >> 2) & 127, h = un & 3; const bf16* src = P + ((size_t)b * SEQ + j * 64 + row) * PW + P_DAV + h * 128 + seg * 16; w0 = *(const v4u*)src; w1 = *(const v4u*)(src + 8); } }
        float f[16];
#pragma unroll
        for (int i = 0; i < 16; ++i) f[i] = bf2f(*(const LAS bf16*)(lds + (32 * jj + crow(i, hh)) * 272 + c * 2));
        v4u o; o.x = pk4f8(f[0], f[1], f[2], f[3]); o.y = pk4f8(f[4], f[5], f[6], f[7]); o.z = pk4f8(f[8], f[9], f[10], f[11]); o.w = pk4f8(f[12], f[13], f[14], f[15]);
        *(v4u*)(ws + WS_V8 + (size_t)u * 8192 + tid * 16) = o;
        __syncthreads();
    }
}
constexpr int SCAN_ST = 0, SCAN_VN = 2 * 32 * 272, SCAN_OS = SCAN_VN + 2 * 32 * 144, SCAN_END = SCAN_OS + 8 * 32 * 80;
#ifndef SCAN_DEPTH2
#define SCAN_DEPTH2 1
#endif
struct ScanFrag { bf16x8 a0[8]; bf16x8 a1[4]; bf16x8 a3[4]; float egl; };
struct ScanA0 { bf16x8 a0[8]; };
struct ScanR { bf16x8 a1[4]; bf16x8 a3[4]; float egl; };
template <bool LO>
DI void dn_scan_role(const Args& a, LAS unsigned char* lds, int j, int wave, int lane, const int pmode) {
    unsigned char* ws = a.ws;
    const int grp = wave >> 2, w4 = wave & 3, task = 2 * j + grp, bh = task >> 2, vs = task & 3, b = bh >> 2, h = bh & 3;
    const int r = lane & 31, hh = lane >> 5;
    LAS unsigned char* ST = lds + SCAN_ST + grp * (32 * 272); LAS unsigned char* VN = lds + SCAN_VN + grp * (32 * 144); LAS unsigned char* OS = lds + SCAN_OS + wave * (32 * 80);
    const bf16* A0 = (const bf16*)(ws + (LO ? WS_NW : WS_QD)); const bf16* U = (const bf16*)(ws + WS_U);
    const bf16* KDT = (const bf16*)(ws + WS_KDT); const bf16* QKB = (const bf16*)(ws + WS_QK); const float* EGL = (const float*)(ws + WS_EGL);
    bf16* ODN = (bf16*)(ws + WS_ODN);
    bf16x8 bI[2];
#pragma unroll
    for (int s = 0; s < 2; ++s)
#pragma unroll
        for (int jj = 0; jj < 8; ++jj) bI[s][jj] = (16 * s + 8 * hh + jj == r) ? (short)0x3F80 : (short)0;
    f32x16 sacc = {};
    const int ct = w4 & 1;
#define SCAN_LDA(F, n_) do { const int n__ = (n_) < SEQ / 64 ? (n_) : SEQ / 64 - 1; const size_t ck_ = (size_t)(bh * 128 + n__); \
        _Pragma("unroll") for (int s = 0; s < 8; ++s) F.a0[s] = *(const bf16x8*)(A0 + ck_ * 8192 + (size_t)((ct * 8 + s) * 64 + lane) * 8); \
        if constexpr (LO) { _Pragma("unroll") for (int s = 0; s < 2; ++s) F.a1[s] = *(const bf16x8*)(U + ck_ * 8192 + (size_t)(((ct * 4 + vs) * 2 + s) * 64 + lane) * 8); } } while (0)
#define SCAN_LDR(F, n_) do { const int n__ = (n_) < SEQ / 64 ? (n_) : SEQ / 64 - 1; const size_t ck_ = (size_t)(bh * 128 + n__); \
        if constexpr (!LO) { _Pragma("unroll") for (int s = 0; s < 4; ++s) F.a1[s] = *(const bf16x8*)(QKB + ck_ * 4096 + (size_t)((ct * 4 + s) * 64 + lane) * 8); } \
        _Pragma("unroll") for (int s = 0; s < 4; ++s) F.a3[s] = *(const bf16x8*)(KDT + ck_ * 8192 + (size_t)((w4 * 4 + s) * 64 + lane) * 8); \
        F.egl = EGL[ck_]; } while (0)
#define SCAN_STEP(F, n_) do { const size_t t0_ = (size_t)b * SEQ + (size_t)(n_) * 64; \
        _Pragma("unroll") for (int g = 0; g < 4; ++g) { v2u w; w.x = pk2(sacc[4 * g], sacc[4 * g + 1]); w.y = pk2(sacc[4 * g + 2], sacc[4 * g + 3]); \
            *(LAS v2u*)(ST + r * 272 + (32 * w4 + 8 * g + 4 * hh) * 2) = w; } \
        LDS_WAIT(); __builtin_amdgcn_s_barrier(); \
        f32x16 acc = {}, acc2 = {}; \
        if constexpr (LO) { acc = __builtin_amdgcn_mfma_f32_32x32x16_bf16(F.a1[0], bI[0], acc, 0, 0, 0); acc2 = __builtin_amdgcn_mfma_f32_32x32x16_bf16(F.a1[1], bI[1], acc2, 0, 0, 0); } \
        _Pragma("unroll") for (int s = 0; s < 8; s += 2) { const bf16x8 b0 = *(const LAS bf16x8*)(ST + r * 272 + (16 * s + 8 * hh) * 2), b1 = *(const LAS bf16x8*)(ST + r * 272 + (16 * s + 16 + 8 * hh) * 2); \
            acc = __builtin_amdgcn_mfma_f32_32x32x16_bf16(F.a0[s], b0, acc, 0, 0, 0); acc2 = __builtin_amdgcn_mfma_f32_32x32x16_bf16(F.a0[s + 1], b1, acc2, 0, 0, 0); } \
        __builtin_amdgcn_sched_barrier(0); if (!(pmode & 2)) SCAN_LDA(F, (n_) + 2); __builtin_amdgcn_sched_barrier(0);        \
        _Pragma("unroll") for (int i = 0; i < 16; i += 2) { f32x2_t_ t_ = {acc[i], acc[i + 1]}, u_ = {acc2[i], acc2[i + 1]}; t_ = t_ + u_; acc[i] = t_.x; acc[i + 1] = t_.y; } \
        if constexpr (LO) { _Pragma("unroll") for (int g = 0; g < 4; ++g) { v2u w; w.x = pk2(acc[4 * g], acc[4 * g + 1]); w.y = pk2(acc[4 * g + 2], acc[4 * g + 3]); \
            *(LAS v2u*)(VN + r * 144 + (32 * ct + 8 * g + 4 * hh) * 2) = w; } } \
        LDS_WAIT(); __builtin_amdgcn_s_barrier(); \
        bf16x8 bv[4]; _Pragma("unroll") for (int s = 0; s < 4; ++s) bv[s] = *(const LAS bf16x8*)(VN + r * 144 + (16 * s + 8 * hh) * 2); \
        _Pragma("unroll") for (int i = 0; i < 16; i += 2) { f32x2_t_ t_ = {sacc[i], sacc[i + 1]}; t_ = t_ * F.egl; sacc[i] = t_.x; sacc[i + 1] = t_.y; } \
        _Pragma("unroll") for (int s = 0; s < 4; ++s) sacc = __builtin_amdgcn_mfma_f32_32x32x16_bf16(F.a3[s], bv[s], sacc, 0, 0, 0); \
        if constexpr (!LO) { _Pragma("unroll") for (int s = 0; s < 4; ++s) acc = __builtin_amdgcn_mfma_f32_32x32x16_bf16(F.a1[s], bv[s], acc, 0, 0, 0); } \
        __builtin_amdgcn_sched_barrier(0); if (!(pmode & 2)) SCAN_LDR(F, (n_) + 2); __builtin_amdgcn_sched_barrier(0); \
        if (!LO && !(pmode & 1)) {                                           \
            _Pragma("unroll") for (int i = 0; i < 16; i += 2) { const unsigned w_ = pk2(acc[i], acc[i + 1]);        \
                *(LAS unsigned short*)(OS + crow(i, hh) * 80 + r * 2) = (unsigned short)w_; *(LAS unsigned short*)(OS + crow(i + 1, hh) * 80 + r * 2) = (unsigned short)(w_ >> 16); } \
            LDS_WAIT(); \
            _Pragma("unroll") for (int q = 0; q < 2; ++q) { const int row_ = (lane >> 2) + 16 * q, ch_ = lane & 3; \
                const v4u v_ = *(const LAS v4u*)(OS + row_ * 80 + ch_ * 16); *(v4u*)(ODN + (t0_ + 32 * ct + row_) * 512 + h * 128 + vs * 32 + ch_ * 8) = v_; } \
            LDS_WAIT(); } \
    } while (0)
    ScanFrag FA, FB;
    SCAN_LDA(FA, 0); SCAN_LDR(FA, 0); SCAN_LDA(FB, 1); SCAN_LDR(FB, 1);
    for (int n = 0; n < SEQ / 64; n += 2) {
        SCAN_STEP(FA, n);
        SCAN_STEP(FB, n + 1);
    }
#define SCAN_IT(a_, b_, c_, d_, e_) do {} while (0)
#undef SCAN_IT
#undef SCAN_LDA
#undef SCAN_LDR
#undef SCAN_STEP
    __syncthreads();
}
DI void dn_scan(const Args& a, LAS unsigned char* lds, int j, int wave, int lane, const int pmode = 0) {
    if ((wave & 3) < 2) dn_scan_role<true>(a, lds, j, wave, lane, pmode); else dn_scan_role<false>(a, lds, j, wave, lane, pmode);
}

constexpr int MX_K = 0, MX_V = 65536;
#ifndef MX_BOUNDREF
#define MX_BOUNDREF 1
#endif
DI void mx_unit(const Args& a, LAS unsigned char* lds, int bh, int qb, int tid, int wave, int lane) {
    unsigned char* ws = a.ws; const int b = bh >> 2, h = bh & 3;
    const bf16* MKV = (const bf16*)(ws + WS_MKV) + (size_t)b * NMEM * 1024 + h * 128;
    float gk[8];
#pragma unroll
    for (int i = 0; i < 8; ++i) gk[i] = a.in[I_MXKN][8 * (tid & 15) + i];
#pragma unroll
    for (int i = 0; i < 8; ++i) { const int q = tid + 512 * i, row = q >> 4, ch = q & 15;
        v4u kv = *(const v4u*)(MKV + (size_t)row * 1024 + ch * 8); const v4u vv = *(const v4u*)(MKV + (size_t)row * 1024 + 512 + ch * 8);
        float f[8]; f[0] = bflo(kv.x); f[1] = bfhi(kv.x); f[2] = bflo(kv.y); f[3] = bfhi(kv.y); f[4] = bflo(kv.z); f[5] = bfhi(kv.z); f[6] = bflo(kv.w); f[7] = bfhi(kv.w);
        float ss = 0.f;
#pragma unroll
        for (int jx = 0; jx < 8; ++jx) ss += f[jx] * f[jx];
        ss = sum16(ss);
        const float rn = rsqrtf(ss * (1.f / 128.f) + EPS);
        kv.x = pk2(f[0] * rn * gk[0], f[1] * rn * gk[1]); kv.y = pk2(f[2] * rn * gk[2], f[3] * rn * gk[3]); kv.z = pk2(f[4] * rn * gk[4], f[5] * rn * gk[5]); kv.w = pk2(f[6] * rn * gk[6], f[7] * rn * gk[7]);
        *(LAS v4u*)(lds + MX_K + row * 256 + ((ch ^ (row & 7)) * 16)) = kv; *(LAS v4u*)(lds + MX_V + row * 256 + ch * 16) = vv; }
    const int r = lane & 31, hh = lane >> 5;
    const size_t qrow = (size_t)b * SEQ + (size_t)qb * 256 + wave * 32;
    const bf16* Q = (const bf16*)(ws + WS_P) + (qrow + r) * PW + P_MXQ + h * 128;
    bf16x8 qf[8];
#pragma unroll
    for (int s = 0; s < 8; ++s) qf[s] = *(const bf16x8*)(Q + 16 * s + 8 * hh);
    __syncthreads();
#if MX_BOUNDREF
    float mx;
    { float ss = 0.f;
#pragma unroll
      for (int s = 0; s < 8; ++s)
#pragma unroll
          for (int jx = 0; jx < 8; ++jx) { const float f = bf2f((bf16)qf[s][jx]); ss += f * f; }
      ss += __shfl_xor(ss, 32);
      float gm = 0.f;
#pragma unroll
      for (int i = 0; i < 8; ++i) gm = fmaxf(gm, fabsf(gk[i]));
#pragma unroll
      for (int o = 1; o < 16; o <<= 1) gm = fmaxf(gm, __shfl_xor(gm, o));
      mx = sqrtf(ss) * gm * (11.313708498984761f * 1.01f) + 0.01f; }
#else
    float mx = -INFINITY;
#pragma unroll 1
    for (int kt = 0; kt < 8; ++kt) { f32x16 acc = {}; const int row = 32 * kt + r;
#pragma unroll
        for (int s = 0; s < 8; ++s) { const bf16x8 kf = *(const LAS bf16x8*)(lds + MX_K + row * 256 + (((2 * s + hh) ^ (row & 7)) * 16));
            acc = __builtin_amdgcn_mfma_f32_32x32x16_bf16(kf, qf[s], acc, 0, 0, 0); }
#pragma unroll
        for (int i = 0; i < 16; ++i) mx = fmaxf(mx, acc[i]); }
    mx = fmaxf(mx, __shfl_xor(mx, 32));
#endif
    float sum = 0.f;
    f32x16 o[4] = {};
    const int g16 = lane >> 4, i16 = lane & 15, qq = i16 >> 2, pp = i16 & 3;
    const LAS unsigned char* vb = lds + MX_V + (4 * hh + qq) * 256 + (16 * (g16 & 1) + 4 * pp) * 2;
#pragma unroll 1
    for (int kt = 0; kt < 8; ++kt) { f32x16 st = {}; const int row = 32 * kt + r;
#pragma unroll
        for (int s = 0; s < 8; ++s) { const bf16x8 kf = *(const LAS bf16x8*)(lds + MX_K + row * 256 + (((2 * s + hh) ^ (row & 7)) * 16));
            st = __builtin_amdgcn_mfma_f32_32x32x16_bf16(kf, qf[s], st, 0, 0, 0); }
#pragma unroll
        for (int i = 0; i < 16; ++i) { const float p = __builtin_amdgcn_exp2f(st[i] - mx); st[i] = p; sum += p; }
#pragma unroll
        for (int s2 = 0; s2 < 2; ++s2) {
            v4u pw; pw.x = pk2(st[8 * s2 + 0], st[8 * s2 + 1]); pw.y = pk2(st[8 * s2 + 2], st[8 * s2 + 3]); pw.z = pk2(st[8 * s2 + 4], st[8 * s2 + 5]); pw.w = pk2(st[8 * s2 + 6], st[8 * s2 + 7]);
            const bf16x8 pa = __builtin_bit_cast(bf16x8, pw);
#pragma unroll
            for (int dt = 0; dt < 4; ++dt) {
                const LAS unsigned char* vp = vb + (32 * kt + 16 * s2) * 256 + dt * 64;
                const s16x4 lo = __builtin_bit_cast(s16x4, __builtin_amdgcn_ds_read_tr16_b64_v4i16((LAS s16x4*)vp));
                const s16x4 hi = __builtin_bit_cast(s16x4, __builtin_amdgcn_ds_read_tr16_b64_v4i16((LAS s16x4*)(vp + 8 * 256)));
                const bf16x8 vf = {lo[0], lo[1], lo[2], lo[3], hi[0], hi[1], hi[2], hi[3]};
                o[dt] = __builtin_amdgcn_mfma_f32_32x32x16_bf16(pa, vf, o[dt], 0, 0, 0);
            }
        }
    }
    sum += __shfl_xor(sum, 32);
    LAS float* wsc = (LAS float*)(lds + LWSC_OFF + wave * 256);
    if (hh == 0) wsc[r] = __builtin_amdgcn_rcpf(sum);
    LDS_WAIT();
    bf16* O = (bf16*)(ws + WS_OMX) + qrow * 512 + h * 128;
    __syncthreads();
    { LAS unsigned char* stg = lds + MX_K + wave * (32 * 272);
#pragma unroll
      for (int i = 0; i < 16; ++i) { const int qr_ = crow(i, hh); const float rl = wsc[qr_];
#pragma unroll
          for (int dt = 0; dt < 4; dt += 2) { const unsigned w_ = pk2(o[dt][i] * rl, o[dt + 1][i] * rl);
              *(LAS unsigned short*)(stg + qr_ * 272 + (dt * 32 + r) * 2) = (unsigned short)w_; *(LAS unsigned short*)(stg + qr_ * 272 + ((dt + 1) * 32 + r) * 2) = (unsigned short)(w_ >> 16); } }
      LDS_WAIT();
#pragma unroll
      for (int q = 0; q < 8; ++q) { const int c_ = lane + 64 * q, row_ = c_ >> 4, ch_ = c_ & 15;
          const v4u v_ = *(const LAS v4u*)(stg + row_ * 272 + ch_ * 16); *(v4u*)(O + (size_t)row_ * 512 + ch_ * 8) = v_; }
      LDS_WAIT(); }
    __syncthreads();
}

DI void p4_norm_rows(const Args& a, int vcu, int G, int wave, int lane) {
    unsigned char* ws = a.ws; const int gw = vcu * 8 + wave, NGW = G * 8;
    const float* lp = a.in[I_LAM];
    const float l1 = wave_sum(lp[lane] * lp[64 + lane]), l2 = wave_sum(lp[128 + lane] * lp[192 + lane]);
    const float lam_init = 0.2f, lam = expf(l1) - expf(l2) + lam_init;
    float gdn[8], gda[8];
#pragma unroll
    for (int i = 0; i < 8; ++i) { gdn[i] = a.in[I_DNON][8 * (lane & 15) + i]; gda[i] = a.in[I_SUBLN][8 * (lane & 15) + i] * (1.f - lam_init); }
    const bf16* P = (const bf16*)(ws + WS_P);
    for (int m0 = gw; m0 < T; m0 += 4 * NGW) {
        v4u lw0[4], lz0[4], lw1[4], lw2[4];
#pragma unroll
        for (int q = 0; q < 4; ++q) { const size_t m = (size_t)(m0 + q * NGW);
            lw0[q] = *(const v4u*)((const bf16*)(ws + WS_ODN) + m * 512 + 8 * lane); lz0[q] = *(const v4u*)(P + m * PW + P_DNZ + 8 * lane);
            lw1[q] = *(const v4u*)((const bf16*)(ws + WS_O1) + m * 512 + 8 * lane); lw2[q] = *(const v4u*)((const bf16*)(ws + WS_O2) + m * 512 + 8 * lane); }
#pragma unroll
        for (int q = 0; q < 4; ++q) { const size_t m = (size_t)(m0 + q * NGW);
        { const v4u w0 = lw0[q], z0 = lz0[q];
          float f[8], z[8]; f[0] = bflo(w0.x); f[1] = bfhi(w0.x); f[2] = bflo(w0.y); f[3] = bfhi(w0.y); f[4] = bflo(w0.z); f[5] = bfhi(w0.z); f[6] = bflo(w0.w); f[7] = bfhi(w0.w);
          z[0] = bflo(z0.x); z[1] = bfhi(z0.x); z[2] = bflo(z0.y); z[3] = bfhi(z0.y); z[4] = bflo(z0.z); z[5] = bfhi(z0.z); z[6] = bflo(z0.w); z[7] = bfhi(z0.w);
          float ss = 0.f;
#pragma unroll
          for (int i = 0; i < 8; ++i) ss += f[i] * f[i];
          ss = sum16(ss);
          const float r = rsqrtf(ss * (1.f / 128.f) + EPS);
#pragma unroll
          for (int i = 0; i < 8; ++i) f[i] = f[i] * r * gdn[i] * (z[i] * sigmoidf_(z[i]));
          v4u o; o.x = pk2(f[0], f[1]); o.y = pk2(f[2], f[3]); o.z = pk2(f[4], f[5]); o.w = pk2(f[6], f[7]);
          *(v4u*)((bf16*)(ws + WS_ODNF) + m * 512 + 8 * lane) = o; }
        { const v4u w1 = lw1[q], w2 = lw2[q];
          float f[8]; f[0] = bflo(w1.x) - lam * bflo(w2.x); f[1] = bfhi(w1.x) - lam * bfhi(w2.x); f[2] = bflo(w1.y) - lam * bflo(w2.y); f[3] = bfhi(w1.y) - lam * bfhi(w2.y);
          f[4] = bflo(w1.z) - lam * bflo(w2.z); f[5] = bfhi(w1.z) - lam * bfhi(w2.z); f[6] = bflo(w1.w) - lam * bflo(w2.w); f[7] = bfhi(w1.w) - lam * bfhi(w2.w);
          float ss = 0.f;
#pragma unroll
          for (int i = 0; i < 8; ++i) ss += f[i] * f[i];
          ss = sum16(ss);
          const float r = rsqrtf(ss * (1.f / 128.f) + EPS);
#pragma unroll
          for (int i = 0; i < 8; ++i) f[i] = f[i] * r * gda[i];
          v4u o; o.x = pk2(f[0], f[1]); o.y = pk2(f[2], f[3]); o.z = pk2(f[4], f[5]); o.w = pk2(f[6], f[7]);
          *(v4u*)((bf16*)(ws + WS_ODAF) + m * 512 + 8 * lane) = o; }
        }
    }
}

struct BranchOrder {
    pg8::StaticOrder so; long a1, a2;
    DI bool next(int i, pg8::Unit& u) const {
        const int tl = i / 3, r = i - 3 * tl;
        if (!so.tile((long)tl * so.G + so.c, u.pm, u.pn)) return false;
        u.aoff = r == 0 ? 0 : (r == 1 ? a1 : a2); u.boff = (long)r * 1024 * 512 * 2; u.tag = r; return true;
    }
};
#ifndef MERGE_CHAIN
#define MERGE_CHAIN 1
#endif
#ifndef MERGE_PK
#define MERGE_PK 1
#endif
#if MERGE_CHAIN && GATE_U8
struct EpiMerge {
    static constexpr bool PERM = true; static constexpr bool CHAIN = true; static constexpr bool PREFETCH = false;
    bf16* MRG; const bf16* GF; bf16* MF;
    DI static float gc(unsigned w, int b) { return fmaxf((float)((w >> (8 * b)) & 0xffu), 0.5f); }
    DI bool chain(f32x4 (&acc)[2][2][4][2], const pg8::Unit& u, int wr, int wc, int fr, int fq) const {
        int fr_ = fr, fq_ = fq; asm volatile("" : "+v"(fr_), "+v"(fq_));
        const int r = u.tag;
        const int wl = (wr * 4 + wc) * 64 + fq_ * 16 + fr_;
        const unsigned char* gfp = (const unsigned char*)GF + (((size_t)(r * 128 + u.pm) * 4 + u.pn) * 8 * 512 + wl) * 16;
        if (r < 2) {
#pragma unroll
            for (int ai = 0; ai < 2; ++ai) {
                v4u qa[4], qb[4];
#pragma unroll
                for (int m = 0; m < 4; ++m) { qa[m] = __builtin_nontemporal_load((const v4u*)(gfp + (size_t)(ai * 4 + m) * 8192)); qb[m] = __builtin_nontemporal_load((const v4u*)(gfp + (size_t)(ai * 4 + m) * 8192 + (size_t)128 * 4 * 65536)); }
#pragma unroll
                for (int m = 0; m < 4; ++m)
#pragma unroll
                    for (int bj = 0; bj < 2; ++bj) { const unsigned a0 = bj == 0 ? qa[m].x : qa[m].z, a1 = bj == 0 ? qa[m].y : qa[m].w, b0 = bj == 0 ? qb[m].x : qb[m].z, b1 = bj == 0 ? qb[m].y : qb[m].w;
#if MERGE_PK
#define MRG_PAIR(DST, AW, BW, K) { f32x2_t_ ga_, gb_; ga_.x = gc(AW, K); ga_.y = gc(AW, K + 1); gb_.x = gc(BW, K + 1); gb_.y = gc(BW, K); \
                            const float R_ = __builtin_amdgcn_rcpf(gb_.x * gb_.y); DST = DST * ((ga_ * gb_) * R_); }
                        f32x2_t_ c0 = acc[ai][bj][m][0].xy, c1 = acc[ai][bj][m][0].zw, c2 = acc[ai][bj][m][1].xy, c3 = acc[ai][bj][m][1].zw;
                        MRG_PAIR(c0, a0, b0, 0) MRG_PAIR(c1, a0, b0, 2) MRG_PAIR(c2, a1, b1, 0) MRG_PAIR(c3, a1, b1, 2)
                        acc[ai][bj][m][0].xy = c0; acc[ai][bj][m][0].zw = c1; acc[ai][bj][m][1].xy = c2; acc[ai][bj][m][1].zw = c3; }
#undef MRG_PAIR
#else
                        f32x4 s0, s1;
                        s0.x = gc(a0, 0) * __builtin_amdgcn_rcpf(gc(b0, 0)); s0.y = gc(a0, 1) * __builtin_amdgcn_rcpf(gc(b0, 1)); s0.z = gc(a0, 2) * __builtin_amdgcn_rcpf(gc(b0, 2)); s0.w = gc(a0, 3) * __builtin_amdgcn_rcpf(gc(b0, 3));
                        s1.x = gc(a1, 0) * __builtin_amdgcn_rcpf(gc(b1, 0)); s1.y = gc(a1, 1) * __builtin_amdgcn_rcpf(gc(b1, 1)); s1.z = gc(a1, 2) * __builtin_amdgcn_rcpf(gc(b1, 2)); s1.w = gc(a1, 3) * __builtin_amdgcn_rcpf(gc(b1, 3));
                        acc[ai][bj][m][0] *= s0; acc[ai][bj][m][1] *= s1; }
#endif
            }
            return true;
        }
        const int row0 = u.pm * 256 + wr * 64 + fr_, col0 = u.pn * 256 + wc * 32 + 8 * fq_;
#pragma unroll
        for (int ai = 0; ai < 2; ++ai) {
            v4u qa[4];
#pragma unroll
            for (int m = 0; m < 4; ++m) qa[m] = __builtin_nontemporal_load((const v4u*)(gfp + (size_t)(ai * 4 + m) * 8192));
#pragma unroll
            for (int m = 0; m < 4; ++m)
#pragma unroll
                for (int bj = 0; bj < 2; ++bj) { const unsigned a0 = bj == 0 ? qa[m].x : qa[m].z, a1 = bj == 0 ? qa[m].y : qa[m].w;
                    const f32x4 v0 = acc[ai][bj][m][0], v1 = acc[ai][bj][m][1];
#if MERGE_PK
                    f32x2_t_ g0_, g1_, g2_, g3_; g0_.x = gc(a0, 0); g0_.y = gc(a0, 1); g1_.x = gc(a0, 2); g1_.y = gc(a0, 3); g2_.x = gc(a1, 0); g2_.y = gc(a1, 1); g3_.x = gc(a1, 2); g3_.y = gc(a1, 3);
                    const f32x2_t_ p0_ = v0.xy * g0_, p1_ = v0.zw * g1_, p2_ = v1.xy * g2_, p3_ = v1.zw * g3_;
                    v4u w; w.x = pk2(p0_.x, p0_.y); w.y = pk2(p1_.x, p1_.y); w.z = pk2(p2_.x, p2_.y); w.w = pk2(p3_.x, p3_.y);
#else
                    v4u w; w.x = pk2(v0.x * gc(a0, 0), v0.y * gc(a0, 1)); w.y = pk2(v0.z * gc(a0, 2), v0.w * gc(a0, 3)); w.z = pk2(v1.x * gc(a1, 0), v1.y * gc(a1, 1)); w.w = pk2(v1.z * gc(a1, 2), v1.w * gc(a1, 3));
#endif
                    *(v4u*)(MRG + (size_t)(row0 + ai * 128 + m * 16) * 1024 + col0 + bj * 128) = w; }
        }
        return false;
    }
};
#else
struct EpiMerge {
    static constexpr bool PERM = true; static constexpr bool CHAIN = false; static constexpr bool PREFETCH = false;
    bf16* MRG; const bf16* GF; bf16* MF;
    DI void operator()(const f32x4 (&acc)[2][2][4][2], const pg8::Unit& u, int wr, int wc, int fr, int fq) const {
        const int row0 = u.pm * 256 + wr * 64 + fr, col0 = u.pn * 256 + wc * 32 + 8 * fq; const int r = u.tag;
        const int wl = (wr * 4 + wc) * 64 + fq * 16 + fr;
#if GATE_U8
        const unsigned char* gfp = (const unsigned char*)GF + (((size_t)(r * 128 + u.pm) * 4 + u.pn) * 8 * 512 + wl) * 16;
#else
        const bf16* gfp = GF + (((size_t)(r * 128 + u.pm) * 4 + u.pn) * 16 * 512 + wl) * 8;
#endif
        bf16* mfp = MF + (((size_t)u.pm * 4 + u.pn) * 16 * 512 + wl) * 8;
#pragma unroll
        for (int ai = 0; ai < 2; ++ai) {
#if GATE_U8
            v4u gq[4], ow[4][2];
#pragma unroll
            for (int m = 0; m < 4; ++m) { gq[m] = *(const v4u*)(gfp + (size_t)(ai * 4 + m) * 8192);
#pragma unroll
                for (int bj = 0; bj < 2; ++bj) { const int f = (ai * 4 + m) * 2 + bj; ow[m][bj] = (r > 0) ? *(const v4u*)(mfp + (size_t)f * 4096) : (v4u){0u, 0u, 0u, 0u}; } }
#else
            v4u gw[4][2], ow[4][2];
#pragma unroll
            for (int m = 0; m < 4; ++m)
#pragma unroll
                for (int bj = 0; bj < 2; ++bj) { const int f = (ai * 4 + m) * 2 + bj;
                    gw[m][bj] = *(const v4u*)(gfp + (size_t)f * 4096);
                    ow[m][bj] = (r > 0) ? *(const v4u*)(mfp + (size_t)f * 4096) : (v4u){0u, 0u, 0u, 0u}; }
#endif
#pragma unroll
            for (int m = 0; m < 4; ++m)
#pragma unroll
                for (int bj = 0; bj < 2; ++bj) { const size_t row = (size_t)(row0 + ai * 128 + m * 16); const int col = col0 + bj * 128; const int f = (ai * 4 + m) * 2 + bj;
                    const v4u o = ow[m][bj];
                    f32x4 v0 = acc[ai][bj][m][0], v1 = acc[ai][bj][m][1];
#if GATE_U8
                    const unsigned ga = bj == 0 ? gq[m].x : gq[m].z, gb = bj == 0 ? gq[m].y : gq[m].w;
                    v0.x = v0.x * (float)(ga & 0xffu) + bflo(o.x); v0.y = v0.y * (float)((ga >> 8) & 0xffu) + bfhi(o.x); v0.z = v0.z * (float)((ga >> 16) & 0xffu) + bflo(o.y); v0.w = v0.w * (float)(ga >> 24) + bfhi(o.y);
                    v1.x = v1.x * (float)(gb & 0xffu) + bflo(o.z); v1.y = v1.y * (float)((gb >> 8) & 0xffu) + bfhi(o.z); v1.z = v1.z * (float)((gb >> 16) & 0xffu) + bflo(o.w); v1.w = v1.w * (float)(gb >> 24) + bfhi(o.w);
#else
                    const v4u g = gw[m][bj];
                    v0.x = v0.x * bflo(g.x) + bflo(o.x); v0.y = v0.y * bfhi(g.x) + bfhi(o.x); v0.z = v0.z * bflo(g.y) + bflo(o.y); v0.w = v0.w * bfhi(g.y) + bfhi(o.y);
                    v1.x = v1.x * bflo(g.z) + bflo(o.z); v1.y = v1.y * bfhi(g.z) + bfhi(o.z); v1.z = v1.z * bflo(g.w) + bflo(o.w); v1.w = v1.w * bfhi(g.w) + bfhi(o.w);
#endif
                    v4u w; w.x = pk2(v0.x, v0.y); w.y = pk2(v0.z, v0.w); w.z = pk2(v1.x, v1.y); w.w = pk2(v1.z, v1.w);
                    if (r < 2) *(v4u*)(mfp + (size_t)f * 4096) = w;
                    else *(v4u*)(MRG + row * 1024 + col) = w; }
        }
    }
};
#endif
#ifndef ROUTER_FUSED
#define ROUTER_FUSED 0
#endif
struct EpiResF32 {
    static constexpr bool PERM = false; static constexpr bool CHAIN = false; static constexpr bool PREFETCH = false;
    float* C; const float* X; unsigned char* H2; const float* fn;
    DI void operator()(const f32x4 (&acc)[2][2][4][2], const pg8::Unit& u, int wr, int wc, int fr, int fq) const {
        const int row0 = u.pm * 256 + wr * 64 + fr, col0 = u.pn * 256 + wc * 32 + 4 * fq;
#pragma unroll
        for (int ai = 0; ai < 2; ++ai) {
            f32x4 xv[4][2][2];
#pragma unroll
            for (int m = 0; m < 4; ++m) { const size_t ro = (size_t)(row0 + ai * 128 + m * 16) * 1024 + col0;
#pragma unroll
                for (int bj = 0; bj < 2; ++bj)
#pragma unroll
                    for (int n = 0; n < 2; ++n) xv[m][bj][n] = *(const f32x4*)(X + ro + bj * 128 + n * 16); }
#pragma unroll
            for (int m = 0; m < 4; ++m) { const size_t ro = (size_t)(row0 + ai * 128 + m * 16) * 1024 + col0;
#pragma unroll
                for (int bj = 0; bj < 2; ++bj)
#pragma unroll
                    for (int n = 0; n < 2; ++n) { const f32x4 v = acc[ai][bj][m][n] + xv[m][bj][n]; *(f32x4*)(C + ro + bj * 128 + n * 16) = v;
#if ROUTER_FUSED
                        const f32x4 g = *(const f32x4*)(fn + col0 + bj * 128 + n * 16) * A8_SCALE;
                        *(unsigned*)(H2 + ro + bj * 128 + n * 16) = pk4f8(v.x * g.x, v.y * g.y, v.z * g.z, v.w * g.w);
#endif
                    } }
        }
    }
};

#ifndef X1_BF16
#define X1_BF16 1
#endif
struct EpiResB {
    static constexpr bool PERM = true; static constexpr bool CHAIN = false; static constexpr bool PREFETCH = false;
    bf16* C; const float* X;
    DI void prefetch(const pg8::Unit& u, int wr, int wc, int fr, int fq, unsigned& d0, unsigned& d1, unsigned& d2, unsigned& d3) const {
        const float* p = X + (size_t)(u.pm * 256 + wr * 64 + fr + fq * 16) * 1024 + u.pn * 256 + wc * 32;
        asm volatile("global_load_dword %0, %1, off" : "=v"(d0) : "v"(p) : "memory");
        asm volatile("global_load_dword %0, %1, off" : "=v"(d1) : "v"(p + 128) : "memory");
        asm volatile("global_load_dword %0, %1, off" : "=v"(d2) : "v"(p + 128 * 1024) : "memory");
        asm volatile("global_load_dword %0, %1, off" : "=v"(d3) : "v"(p + 128 * 1024 + 128) : "memory");
    }
    DI void operator()(const f32x4 (&acc)[2][2][4][2], const pg8::Unit& u, int wr, int wc, int fr, int fq) const {
        int fr_ = fr, fq_ = fq; asm volatile("" : "+v"(fr_), "+v"(fq_));
        const int row0 = u.pm * 256 + wr * 64 + fr_, col0 = u.pn * 256 + wc * 32 + 8 * fq_;
#pragma unroll
        for (int ai = 0; ai < 2; ++ai) {
            f32x4 xv[4][2][2];
#pragma unroll
            for (int m = 0; m < 4; ++m) { const float* xp = X + (size_t)(row0 + ai * 128 + m * 16) * 1024 + col0;
#pragma unroll
                for (int bj = 0; bj < 2; ++bj) { xv[m][bj][0] = __builtin_nontemporal_load((const f32x4*)(xp + bj * 128)); xv[m][bj][1] = __builtin_nontemporal_load((const f32x4*)(xp + bj * 128 + 4)); } }
#pragma unroll
            for (int m = 0; m < 4; ++m) { bf16* cp = C + (size_t)(row0 + ai * 128 + m * 16) * 1024 + col0;
#pragma unroll
                for (int bj = 0; bj < 2; ++bj) { const f32x4 v0 = acc[ai][bj][m][0] + xv[m][bj][0], v1 = acc[ai][bj][m][1] + xv[m][bj][1];
                    v4u w; w.x = pk2(v0.x, v0.y); w.y = pk2(v0.z, v0.w); w.z = pk2(v1.x, v1.y); w.w = pk2(v1.z, v1.w);
                    *(v4u*)(cp + bj * 128) = w; } }
        }
    }
};
DI void bf8_to_f(const v4u w, float (&f)[8]) { f[0] = bflo(w.x); f[1] = bfhi(w.x); f[2] = bflo(w.y); f[3] = bfhi(w.y); f[4] = bflo(w.z); f[5] = bfhi(w.z); f[6] = bflo(w.w); f[7] = bfhi(w.w); }

#ifndef ROUTER_SPLIT3
#define ROUTER_SPLIT3 1
#endif
#if ROUTER_SPLIT3 && X1_BF16
constexpr int RT_WP = 1040, RT_WH = 0, RT_WM = 33280, RT_WL = 66560, RT_LG = 102400;
#else
constexpr int RT_W = 0, RT_LG = 65536;
#endif
#if X1_BF16
DI void p5_rows(const Args& a, int vcu, int G, int wave, int lane) {
    unsigned char* ws = a.ws; const int gw = vcu * 8 + wave, NGW = G * 8;
    const bf16* X1B = (const bf16*)(ws + WS_X1B);
    {
        float gv[16];
#pragma unroll
        for (int j = 0; j < 4; ++j) { const f32x4 g = ((const f32x4*)(a.in[I_FNORM] + 16 * lane))[j]; gv[4 * j] = g.x; gv[4 * j + 1] = g.y; gv[4 * j + 2] = g.z; gv[4 * j + 3] = g.w; }
        unsigned char* H2 = ws + WS_H;
        for (int m0 = gw; m0 < T; m0 += 4 * NGW) {
            v4u xw[4][2];
#pragma unroll
            for (int q = 0; q < 4; ++q) { const v4u* xr = (const v4u*)(X1B + (size_t)(m0 + q * NGW) * D + 16 * lane); xw[q][0] = xr[0]; xw[q][1] = xr[1]; }
#pragma unroll
            for (int q = 0; q < 4; ++q) {
                float f[16]; { float t[8]; bf8_to_f(xw[q][0], t); _Pragma("unroll") for (int i = 0; i < 8; ++i) f[i] = t[i]; bf8_to_f(xw[q][1], t); _Pragma("unroll") for (int i = 0; i < 8; ++i) f[8 + i] = t[i]; }
                float ss = 0.f;
#pragma unroll
                for (int i = 0; i < 16; ++i) ss += f[i] * f[i];
                const float rstd = rsqrtf(wave_sum(ss) * (1.f / D) + EPS) * A8_SCALE;
#pragma unroll
                for (int i = 0; i < 16; ++i) f[i] = f[i] * rstd * gv[i];
                v4u o; o.x = pk4f8(f[0], f[1], f[2], f[3]); o.y = pk4f8(f[4], f[5], f[6], f[7]); o.z = pk4f8(f[8], f[9], f[10], f[11]); o.w = pk4f8(f[12], f[13], f[14], f[15]);
                *(v4u*)(H2 + (size_t)(m0 + q * NGW) * D + 16 * lane) = o; }
        }
    }
}
#endif
DI void p5_router(const Args& a, LAS unsigned char* lds, int vcu, int G, int tid, int wave, int lane, int cw_cnt) {
    unsigned char* ws = a.ws; const int gw = vcu * 8 + wave, NGW = G * 8;
    const float* X1 = a.out;
#if X1_BF16
    const bf16* X1B = (const bf16*)(ws + WS_X1B);
    const bool rows_first = (__builtin_amdgcn_readfirstlane((int)blockIdx.x) & 1) == 0;
    if (rows_first) p5_rows(a, vcu, G, wave, lane);
#elif !ROUTER_FUSED
    {
        f32x4 gv[4];
#pragma unroll
        for (int j = 0; j < 4; ++j) gv[j] = ((const f32x4*)a.in[I_FNORM])[lane + 64 * j];
#if MOE_FP8
        unsigned char* H2 = ws + WS_H;
        for (int m = gw; m < T; m += NGW) {
            const f32x4* xr = (const f32x4*)(X1 + (size_t)m * D) + lane;
            f32x4 v[4]; float ss = 0.f;
#pragma unroll
            for (int j = 0; j < 4; ++j) { v[j] = xr[64 * j]; ss += (v[j].x * v[j].x + v[j].y * v[j].y) + (v[j].z * v[j].z + v[j].w * v[j].w); }
            const float rstd = rsqrtf(wave_sum(ss) * (1.f / D) + EPS) * A8_SCALE;
            unsigned* o4 = (unsigned*)(H2 + (size_t)m * D) + lane;
#pragma unroll
            for (int j = 0; j < 4; ++j) { v[j] = v[j] * rstd * gv[j]; o4[64 * j] = pk4f8(v[j].x, v[j].y, v[j].z, v[j].w); }
        }
#else
        bf16* H2 = (bf16*)(ws + WS_H);
        for (int m = gw; m < T; m += NGW) {
            const f32x4* xr = (const f32x4*)(X1 + (size_t)m * D) + lane;
            f32x4 v[4]; float ss = 0.f;
#pragma unroll
            for (int j = 0; j < 4; ++j) { v[j] = xr[64 * j]; ss += (v[j].x * v[j].x + v[j].y * v[j].y) + (v[j].z * v[j].z + v[j].w * v[j].w); }
            const float rstd = rsqrtf(wave_sum(ss) * (1.f / D) + EPS);
            unsigned long long* o8 = (unsigned long long*)(H2 + (size_t)m * D) + lane;
#pragma unroll
            for (int j = 0; j < 4; ++j) { v[j] = v[j] * rstd * gv[j]; o8[64 * j] = (unsigned long long)pk2(v[j].x, v[j].y) | ((unsigned long long)pk2(v[j].z, v[j].w) << 32); }
        }
#endif
    }
#endif
    LAS int* hist = (LAS int*)(lds + LCNT_OFF);
    if (tid < 32) hist[tid] = 0;
    const int r = lane & 31, hh = lane >> 5;
    for (int tb = vcu; tb < T / 128; tb += G) {
        const int tok0 = tb * 128 + wave * 32;
        f32x16 acc = {}; float ssq = 0.f;
        for (int kh = 0; kh < 2; ++kh) {
#if ROUTER_SPLIT3 && X1_BF16
            __syncthreads();
#pragma unroll
            for (int i = 0; i < 8; ++i) { const int q = tid + 512 * i, k = q >> 3, e4 = (q & 7) * 4;
                const float gk = a.in[I_FNORM][kh * 512 + k]; const f32x4 w = *(const f32x4*)(a.in[I_WR] + (size_t)(kh * 512 + k) * 32 + e4) * gk;
#pragma unroll
                for (int c = 0; c < 4; ++c) { const float v = w[c];
                    const unsigned h_ = f2bf(v); const float r1 = v - __builtin_bit_cast(float, h_ << 16);
                    const unsigned m_ = f2bf(r1); const float r2 = r1 - __builtin_bit_cast(float, m_ << 16);
                    const unsigned l_ = f2bf(r2);
                    LAS unsigned char* wp_ = lds + (e4 + c) * RT_WP + k * 2;
                    *(LAS unsigned short*)(wp_ + RT_WH) = (unsigned short)h_; *(LAS unsigned short*)(wp_ + RT_WM) = (unsigned short)m_; *(LAS unsigned short*)(wp_ + RT_WL) = (unsigned short)l_; } }
            __syncthreads();
            if (wave < 4) {
                const bf16* xp = X1B + (size_t)(tok0 + r) * D + kh * 512 + 8 * hh;
                const LAS unsigned char* bp_ = lds + r * RT_WP + 16 * hh;
                for (int s8 = 0; s8 < 32; s8 += 8) { v4u xq[8];
#pragma unroll
                  for (int u = 0; u < 8; ++u) xq[u] = *(const v4u*)(xp + 16 * (s8 + u));
#pragma unroll
                  for (int u = 0; u < 8; ++u) { const v4u xw = xq[u]; const bf16x8 av = __builtin_bit_cast(bf16x8, xw);
                    const LAS unsigned char* bq_ = bp_ + 32 * (s8 + u);
                    acc = __builtin_amdgcn_mfma_f32_32x32x16_bf16(av, *(const LAS bf16x8*)(bq_ + RT_WL), acc, 0, 0, 0);
                    acc = __builtin_amdgcn_mfma_f32_32x32x16_bf16(av, *(const LAS bf16x8*)(bq_ + RT_WM), acc, 0, 0, 0);
                    acc = __builtin_amdgcn_mfma_f32_32x32x16_bf16(av, *(const LAS bf16x8*)(bq_ + RT_WH), acc, 0, 0, 0);
                    float t[8]; bf8_to_f(xw, t);
                    ssq += (t[0] * t[0] + t[1] * t[1]) + (t[2] * t[2] + t[3] * t[3]) + ((t[4] * t[4] + t[5] * t[5]) + (t[6] * t[6] + t[7] * t[7])); }
                }
            }
        }
#else
            __syncthreads();
#pragma unroll
            for (int i = 0; i < 8; ++i) { const int q = tid + 512 * i, k = q >> 3, e4 = (q & 7) * 4;
                const float gk = a.in[I_FNORM][kh * 512 + k]; f32x4 w = *(const f32x4*)(a.in[I_WR] + (size_t)(kh * 512 + k) * 32 + e4);
                *(LAS f32x4*)(lds + RT_W + (k * 32 + e4) * 4) = w * gk; }
            __syncthreads();
            if (wave < 4) {
#if X1_BF16
                const bf16* xp = X1B + (size_t)(tok0 + r) * D + kh * 512 + 4 * hh;
                for (int i8 = 0; i8 < 64; i8 += 8) { v2u xq[8];
#pragma unroll
                  for (int u = 0; u < 8; ++u) xq[u] = *(const v2u*)(xp + 8 * (i8 + u));
#pragma unroll
                  for (int u = 0; u < 8; ++u) { const int i = i8 + u; const v2u xw = xq[u]; f32x4 xv; xv.x = bflo(xw.x); xv.y = bfhi(xw.x); xv.z = bflo(xw.y); xv.w = bfhi(xw.y);
#else
                const float* xp = X1 + (size_t)(tok0 + r) * D + kh * 512 + 4 * hh;
                for (int i = 0; i < 64; ++i) { const f32x4 xv = *(const f32x4*)(xp + 8 * i);
#endif
                    ssq += (xv.x * xv.x + xv.y * xv.y) + (xv.z * xv.z + xv.w * xv.w);
                    const LAS float* wp = (const LAS float*)(lds + RT_W) + (8 * i + 4 * hh) * 32 + r;
                    acc = __builtin_amdgcn_mfma_f32_32x32x2f32(xv.x, wp[0], acc, 0, 0, 0);
                    acc = __builtin_amdgcn_mfma_f32_32x32x2f32(xv.y, wp[32], acc, 0, 0, 0);
                    acc = __builtin_amdgcn_mfma_f32_32x32x2f32(xv.z, wp[64], acc, 0, 0, 0);
                    acc = __builtin_amdgcn_mfma_f32_32x32x2f32(xv.w, wp[96], acc, 0, 0, 0); }
#if X1_BF16
                }
#endif
            }
        }
#endif
        if (wave < 4) {
            ssq += __shfl_xor(ssq, 32);
            LAS float* wsc = (LAS float*)(lds + LWSC_OFF + wave * 256);
            if (hh == 0) { const float rs_ = rsqrtf(ssq * (1.f / D) + EPS); wsc[r] = rs_;
#if ROUTER_FUSED
                ((float*)(ws + WS_RSTD))[tok0 + r] = rs_;
#endif
            }
            LDS_WAIT();
            LAS float* LG = (LAS float*)(lds + RT_LG + wave * (32 * 33 * 4));
            const float br = a.in[I_BR][r];
#pragma unroll
            for (int i = 0; i < 16; ++i) { const int tk = crow(i, hh); LG[tk * 33 + r] = acc[i] * wsc[tk] + br; }
            LDS_WAIT();
            if (lane < 32) {
                const LAS float* row = LG + lane * 33;
                float best[4]; int bi[4];
                unsigned taken = 0u;
#pragma unroll
                for (int k = 0; k < 4; ++k) { float bv = -INFINITY; int be = 0;
                    for (int e = 0; e < 32; ++e) { const float v = row[e]; const bool ok = !((taken >> e) & 1u) && v > bv; bv = ok ? v : bv; be = ok ? e : be; }
                    best[k] = bv; bi[k] = be; taken |= 1u << be; }
                const float e0 = 1.f, e1 = expf(best[1] - best[0]), e2 = expf(best[2] - best[0]), e3 = expf(best[3] - best[0]);
                const float inv = 1.f / (e0 + e1 + e2 + e3);
                int* TE = (int*)(ws + WS_TOKE) + (size_t)(tok0 + lane) * 4; float* TW = (float*)(ws + WS_TOKW) + (size_t)(tok0 + lane) * 4;
                TE[0] = bi[0]; TE[1] = bi[1]; TE[2] = bi[2]; TE[3] = bi[3];
                TW[0] = e0 * inv; TW[1] = e1 * inv; TW[2] = e2 * inv; TW[3] = e3 * inv;
                lds_add(&hist[bi[0]], 1); lds_add(&hist[bi[1]], 1); lds_add(&hist[bi[2]], 1); lds_add(&hist[bi[3]], 1);
            }
        }
    }
    __syncthreads();
    if (tid < 32) atomicAdd((unsigned*)(ws + WS_CTL) + cw_cnt + tid, (unsigned)hist[tid]);
#if X1_BF16
    if (!rows_first) p5_rows(a, vcu, G, wave, lane);
#endif
}

DI void moe_table(const Args& a, LAS unsigned char* lds, int tid) {
    LAS int* cnt = (LAS int*)(lds + LCNT_OFF); LAS int* base = cnt + 32; LAS int* misc = cnt + 64; LAS int* tab = (LAS int*)(lds + LTAB_OFF);
    __syncthreads();
    if (tid < 32) cnt[tid] = (int)__hip_atomic_load((unsigned*)(a.ws + WS_CTL) + CW_CNT + tid, RLX_AGENT);
    __syncthreads();
    if (tid == 0) { int ti = 0; for (int e = 0; e < 32; ++e) { base[e] = ti * 256; const int nt = (cnt[e] + 255) >> 8; for (int q = 0; q < nt; ++q) tab[ti + q] = e; ti += nt; } misc[0] = ti; }
    __syncthreads();
}
DI void p6_slots(const Args& a, LAS unsigned char* lds, int vcu, int G, int tid, int wave, int lane, int cw_cur) {
    unsigned char* ws = a.ws;
    LAS int* cnt = (LAS int*)(lds + LCNT_OFF); LAS int* base = cnt + 32;
    LAS int* lh = (LAS int*)(lds + 0); LAS int* wb = lh + 32; LAS int* pslot = lh + 64;
    moe_table(a, lds, tid);
    int* SD = (int*)(ws + WS_SDST); float* SW = (float*)(ws + WS_SW);
    for (int e = vcu; e < 32; e += G) { const int lo = base[e] + cnt[e], hi = base[e] + (((cnt[e] + 255) >> 8) << 8); for (int s = lo + tid; s < hi; s += 512) { SD[s] = -1; ((float*)(ws + WS_SR))[s] = 0.f; } }
    const int* TE = (const int*)(ws + WS_TOKE); const float* TW = (const float*)(ws + WS_TOKW);
    const bf16* H2 = (const bf16*)(ws + WS_H); bf16* XS = (bf16*)(ws + WS_XS);
    for (int tb = vcu; tb < T / 128; tb += G) {
        __syncthreads();
        if (tid < 32) lh[tid] = 0;
        __syncthreads();
        const int pair = tb * 512 + tid; const int e = TE[pair];
        const int rank = lds_add(&lh[e], 1);
        __syncthreads();
        if (tid < 32) wb[tid] = (int)atomicAdd((unsigned*)(ws + WS_CTL) + cw_cur + tid, (unsigned)lh[tid]);
        __syncthreads();
        const int slot = base[e] + wb[e] + rank;
        SD[slot] = pair; SW[slot] = TW[pair]; ((int*)(ws + WS_TSLOT))[pair] = slot;
#if ROUTER_FUSED
        ((float*)(ws + WS_SR))[slot] = ((const float*)(ws + WS_RSTD))[pair >> 2] * ACC8_SCALE;
#endif
    }
    __syncthreads();
}

#ifndef MOE_P10_LIFO
#define MOE_P10_LIFO 1
#endif
#ifndef MOE_XCD_RANGE
#define MOE_XCD_RANGE 1
#endif
struct MoeOrder {
    const LAS int* tab; int ntiles, npn, G, c; long bstride;
    DI bool next(int i, pg8::Unit& u) const {
#if MOE_XCD_RANGE
        const int x_ = c & 7, j_ = c >> 3, rpr_ = (G >> 3) / npn, nt8_ = (ntiles + 7) >> 3, loc_ = i * rpr_ + j_ / npn;
#if MOE_P10_LIFO
        const int nloc_ = min(nt8_, ntiles - x_ * nt8_);
        if (loc_ >= nloc_) return false;
        const int rt = x_ * nt8_ + (npn == 4 ? nloc_ - 1 - loc_ : loc_), within = (j_ % npn) << 3;
#else
        const int rt = x_ * nt8_ + loc_, within = (j_ % npn) << 3;
        if (loc_ >= nt8_ || rt >= ntiles) return false;
#endif
#else
        const long L = (long)i * G + c; const int per = 8 * npn; const int grp = (int)(L / per), within = (int)(L % per);
        const int rt = grp * 8 + (within & 7);
        if (rt >= ntiles) return false;
#endif
        const int e = __builtin_amdgcn_readfirstlane(tab[rt]);
        u.pm = rt; u.pn = within >> 3; u.aoff = 0; u.boff = (long)e * bstride; u.tag = e; return true;
    }
};
#ifndef SWIGLU_PK
#define SWIGLU_PK 1
#endif
struct EpiSwiGLU {
    static constexpr bool PERM = true; static constexpr bool CHAIN = false; static constexpr bool PREFETCH = false;
    static constexpr float OSC = MOE_FP8 ? A8_SCALE : 1.f;
    bf16* ACT; const float* bgu; int skip; const float* SR;
    DI void operator()(const f32x4 (&acc)[2][2][4][2], const pg8::Unit& u, int wr, int wc, int fr, int fq) const {
        if (skip == 1) { f32x4 s_ = {0.f, 0.f, 0.f, 0.f}; _Pragma("unroll") for (int a_ = 0; a_ < 2; ++a_) _Pragma("unroll") for (int b_ = 0; b_ < 2; ++b_) _Pragma("unroll") for (int m_ = 0; m_ < 4; ++m_) _Pragma("unroll") for (int n_ = 0; n_ < 2; ++n_) s_ += acc[a_][b_][m_][n_]; if (s_.x + s_.y + s_.z + s_.w == 123.456f) ACT[0] = 0; return; }
        int fr_ = fr, fq_ = fq; asm volatile("" : "+v"(fr_), "+v"(fq_));
        const int row0 = u.pm * 256 + wr * 64 + fr_, j0 = u.pn * 128 + wc * 32 + 8 * fq_;
        const float* bp = bgu + (size_t)u.tag * 2048 + j0;
        const f32x4 bg0 = *(const f32x4*)(bp), bg1 = *(const f32x4*)(bp + 4), bu0 = *(const f32x4*)(bp + 1024), bu1 = *(const f32x4*)(bp + 1028);
        const f32x4 bu0s = bu0 * OSC + OSC, bu1s = bu1 * OSC + OSC; (void)bu0s; (void)bu1s;
#if MOE_FP8 && !ROUTER_FUSED && SWIGLU_PK
        constexpr float CG = -1.702f * LOG2E, ICG = 1.f / CG;
        const f32x4 bg0c = bg0 * CG, bg1c = bg1 * CG, bu0c = bu0s * ICG, bu1c = bu1s * ICG;
#define SWG_PAIR(AG, AU, BG, BU, OUT) { f32x2_t_ g_ = (AG) * (ACC8_SCALE * CG) + (BG), u_ = (AU) * (ACC8_SCALE * OSC * ICG) + (BU); \
            g_.x = __builtin_amdgcn_fmed3f(g_.x, 7.f * CG, 60.f); g_.y = __builtin_amdgcn_fmed3f(g_.y, 7.f * CG, 60.f);        \
            u_.x = __builtin_amdgcn_fmed3f(u_.x, 8.f * OSC * ICG, -6.f * OSC * ICG); u_.y = __builtin_amdgcn_fmed3f(u_.y, 8.f * OSC * ICG, -6.f * OSC * ICG); \
            f32x2_t_ e_; e_.x = __builtin_amdgcn_exp2f(g_.x); e_.y = __builtin_amdgcn_exp2f(g_.y); e_ = e_ + 1.f; \
            const float R_ = __builtin_amdgcn_rcpf(e_.x * e_.y); const f32x2_t_ es_ = {e_.y, e_.x}; OUT = ((u_ * g_) * es_) * R_; }
#pragma unroll
        for (int ai = 0; ai < 2; ++ai)
#pragma unroll
            for (int m = 0; m < 4; ++m) {
                const f32x4 G0 = acc[ai][0][m][0], G1 = acc[ai][0][m][1], U0 = acc[ai][1][m][0], U1 = acc[ai][1][m][1];
                f32x2_t_ o0, o1, o2, o3;
                SWG_PAIR(G0.xy, U0.xy, bg0c.xy, bu0c.xy, o0) SWG_PAIR(G0.zw, U0.zw, bg0c.zw, bu0c.zw, o1)
                SWG_PAIR(G1.xy, U1.xy, bg1c.xy, bu1c.xy, o2) SWG_PAIR(G1.zw, U1.zw, bg1c.zw, bu1c.zw, o3)
                v2u w; w.x = pk4f8(o0.x, o0.y, o1.x, o1.y); w.y = pk4f8(o2.x, o2.y, o3.x, o3.y);
                if (skip != 2 || w.x == 0x12345678u) *(v2u*)((unsigned char*)ACT + (size_t)(row0 + ai * 128 + m * 16) * 1024 + j0) = w; }
#undef SWG_PAIR
#else
#pragma unroll
        for (int ai = 0; ai < 2; ++ai)
#pragma unroll
            for (int m = 0; m < 4; ++m) {
#if MOE_FP8 && ROUTER_FUSED
                const float rs_ = SR[row0 + ai * 128 + m * 16];
                f32x4 g0 = acc[ai][0][m][0] * rs_ + bg0, g1 = acc[ai][0][m][1] * rs_ + bg1, u0 = acc[ai][1][m][0] * rs_ + bu0, u1 = acc[ai][1][m][1] * rs_ + bu1;
#elif MOE_FP8
                f32x4 g0 = acc[ai][0][m][0] * ACC8_SCALE + bg0, g1 = acc[ai][0][m][1] * ACC8_SCALE + bg1, u0 = acc[ai][1][m][0] * (ACC8_SCALE * OSC) + bu0s, u1 = acc[ai][1][m][1] * (ACC8_SCALE * OSC) + bu1s;
#else
                f32x4 g0 = acc[ai][0][m][0] + bg0, g1 = acc[ai][0][m][1] + bg1, u0 = acc[ai][1][m][0] + bu0, u1 = acc[ai][1][m][1] + bu1;
#endif
                float o[8];
#pragma unroll
#if MOE_FP8 && !ROUTER_FUSED
                for (int q = 0; q < 4; ++q) { float g = fminf(g0[q], 7.f), up = __builtin_amdgcn_fmed3f(u0[q], -6.f * OSC, 8.f * OSC); o[q] = up * g * __builtin_amdgcn_rcpf(1.f + __builtin_amdgcn_exp2f(g * (-1.702f * LOG2E)));
                    g = fminf(g1[q], 7.f); up = __builtin_amdgcn_fmed3f(u1[q], -6.f * OSC, 8.f * OSC); o[4 + q] = up * g * __builtin_amdgcn_rcpf(1.f + __builtin_amdgcn_exp2f(g * (-1.702f * LOG2E))); }
#else
                for (int q = 0; q < 4; ++q) { float g = fminf(g0[q], 7.f), up = fminf(fmaxf(u0[q], -7.f), 7.f); o[q] = (up * OSC + OSC) * g * sigmoidf_(1.702f * g);
                    g = fminf(g1[q], 7.f); up = fminf(fmaxf(u1[q], -7.f), 7.f); o[4 + q] = (up * OSC + OSC) * g * sigmoidf_(1.702f * g); }
#endif
#if MOE_FP8
                v2u w; w.x = pk4f8(o[0], o[1], o[2], o[3]); w.y = pk4f8(o[4], o[5], o[6], o[7]);
                if (skip != 2 || w.x == 0x12345678u) *(v2u*)((unsigned char*)ACT + (size_t)(row0 + ai * 128 + m * 16) * 1024 + j0) = w; }
#else
                v4u w; w.x = pk2(o[0], o[1]); w.y = pk2(o[2], o[3]); w.z = pk2(o[4], o[5]); w.w = pk2(o[6], o[7]);
                if (skip != 2 || w.x == 0x12345678u) *(v4u*)(ACT + (size_t)(row0 + ai * 128 + m * 16) * 1024 + j0) = w; }
#endif
#endif
    }
};
#ifndef Y_FP8
#define Y_FP8 1
#endif
constexpr float Y8_SCALE = 16.f;
DI float clamp8(float v) { return __builtin_amdgcn_fmed3f(v, -448.f, 448.f); }
struct EpiDown {
    static constexpr bool PERM = true; static constexpr bool CHAIN = false; static constexpr bool PREFETCH = false;
    bf16* Y2; const float* bd; const int* SD; const float* SW;
    DI void operator()(const f32x4 (&acc)[2][2][4][2], const pg8::Unit& u, int wr, int wc, int fr, int fq) const {
        int fr_ = fr, fq_ = fq; asm volatile("" : "+v"(fr_), "+v"(fq_));
        const int row0 = u.pm * 256 + wr * 64 + fr_, col0 = u.pn * 256 + wc * 32 + 8 * fq_;
        const float* bp = bd + (size_t)u.tag * 1024 + col0;
        f32x4 bv[2][2];
#pragma unroll
        for (int bj = 0; bj < 2; ++bj)
#pragma unroll
            for (int n = 0; n < 2; ++n) bv[bj][n] = *(const f32x4*)(bp + bj * 128 + 4 * n);
        float sws[2][4];
#pragma unroll
        for (int ai = 0; ai < 2; ++ai)
#pragma unroll
            for (int m = 0; m < 4; ++m) sws[ai][m] = SW[row0 + ai * 128 + m * 16];
#pragma unroll
        for (int ai = 0; ai < 2; ++ai)
#pragma unroll
            for (int m = 0; m < 4; ++m) {
#if Y_FP8
                const float sw = sws[ai][m] * Y8_SCALE; unsigned char* rowp = (unsigned char*)Y2 + (size_t)(row0 + ai * 128 + m * 16) * 1024 + col0;
#else
                const float sw = sws[ai][m]; bf16* rowp = Y2 + (size_t)(row0 + ai * 128 + m * 16) * 1024 + col0;
#endif
#pragma unroll
                for (int bj = 0; bj < 2; ++bj) {
#if MOE_FP8 && SWIGLU_PK
                    const f32x4 a0_ = acc[ai][bj][m][0], a1_ = acc[ai][bj][m][1];
                    const f32x2_t_ p0_ = (a0_.xy * ACC8_SCALE + bv[bj][0].xy) * sw, p1_ = (a0_.zw * ACC8_SCALE + bv[bj][0].zw) * sw, p2_ = (a1_.xy * ACC8_SCALE + bv[bj][1].xy) * sw, p3_ = (a1_.zw * ACC8_SCALE + bv[bj][1].zw) * sw;
                    f32x4 v0, v1; v0.xy = p0_; v0.zw = p1_; v1.xy = p2_; v1.zw = p3_;
#elif MOE_FP8
                    const f32x4 v0 = (acc[ai][bj][m][0] * ACC8_SCALE + bv[bj][0]) * sw, v1 = (acc[ai][bj][m][1] * ACC8_SCALE + bv[bj][1]) * sw;
#else
                    const f32x4 v0 = (acc[ai][bj][m][0] + bv[bj][0]) * sw, v1 = (acc[ai][bj][m][1] + bv[bj][1]) * sw;
#endif
#if Y_FP8
                    v2u w; w.x = pk4f8(clamp8(v0.x), clamp8(v0.y), clamp8(v0.z), clamp8(v0.w)); w.y = pk4f8(clamp8(v1.x), clamp8(v1.y), clamp8(v1.z), clamp8(v1.w));
                    *(v2u*)(rowp + bj * 128) = w; } }
#else
                    v4u w; w.x = pk2(v0.x, v0.y); w.y = pk2(v0.z, v0.w); w.z = pk2(v1.x, v1.y); w.w = pk2(v1.z, v1.w);
                    *(v4u*)(rowp + bj * 128) = w; } }
#endif
    }
};

#if X1_BF16 && Y_FP8
DI void p9_combine(const Args& a, int vcu, int G, int wave, int lane) {
    unsigned char* ws = a.ws; const int gw = vcu * 8 + wave, NGW = G * 8;
    const unsigned char* Y2 = ws + WS_XS; constexpr float IS = 1.f / Y8_SCALE;
    for (int m0 = gw; m0 < T; m0 += 4 * NGW) {
        int ts[4][4]; v4u xw[4][2], yw[4][4];
#pragma unroll
        for (int q = 0; q < 4; ++q) { const size_t m = (size_t)(m0 + q * NGW); const int* tp = (const int*)(ws + WS_TSLOT) + m * 4; ts[q][0] = tp[0]; ts[q][1] = tp[1]; ts[q][2] = tp[2]; ts[q][3] = tp[3];
            const v4u* xp = (const v4u*)((const bf16*)(ws + WS_X1B) + m * D + 16 * lane); xw[q][0] = xp[0]; xw[q][1] = xp[1]; }
#pragma unroll
        for (int q = 0; q < 4; ++q)
#pragma unroll
            for (int k = 0; k < 4; ++k) yw[q][k] = *(const v4u*)(Y2 + (size_t)ts[q][k] * 1024 + 16 * lane);
#pragma unroll
        for (int q = 0; q < 4; ++q) {
            float o[16]; { float t[8]; bf8_to_f(xw[q][0], t); _Pragma("unroll") for (int i = 0; i < 8; ++i) o[i] = t[i]; bf8_to_f(xw[q][1], t); _Pragma("unroll") for (int i = 0; i < 8; ++i) o[8 + i] = t[i]; }
#pragma unroll
            for (int k = 0; k < 4; ++k) { const v4u w = yw[q][k]; f32x2_t_ c;
                c = __builtin_amdgcn_cvt_pk_f32_fp8((int)w.x, false); o[0] += c.x * IS; o[1] += c.y * IS; c = __builtin_amdgcn_cvt_pk_f32_fp8((int)w.x, true); o[2] += c.x * IS; o[3] += c.y * IS;
                c = __builtin_amdgcn_cvt_pk_f32_fp8((int)w.y, false); o[4] += c.x * IS; o[5] += c.y * IS; c = __builtin_amdgcn_cvt_pk_f32_fp8((int)w.y, true); o[6] += c.x * IS; o[7] += c.y * IS;
                c = __builtin_amdgcn_cvt_pk_f32_fp8((int)w.z, false); o[8] += c.x * IS; o[9] += c.y * IS; c = __builtin_amdgcn_cvt_pk_f32_fp8((int)w.z, true); o[10] += c.x * IS; o[11] += c.y * IS;
                c = __builtin_amdgcn_cvt_pk_f32_fp8((int)w.w, false); o[12] += c.x * IS; o[13] += c.y * IS; c = __builtin_amdgcn_cvt_pk_f32_fp8((int)w.w, true); o[14] += c.x * IS; o[15] += c.y * IS; }
            f32x4* op = (f32x4*)(a.out + (size_t)(m0 + q * NGW) * D + 16 * lane);
            op[0] = (f32x4){o[0], o[1], o[2], o[3]}; op[1] = (f32x4){o[4], o[5], o[6], o[7]}; op[2] = (f32x4){o[8], o[9], o[10], o[11]}; op[3] = (f32x4){o[12], o[13], o[14], o[15]};
        }
    }
}
#else
DI void p9_combine(const Args& a, int vcu, int G, int wave, int lane) {
    unsigned char* ws = a.ws; const int gw = vcu * 8 + wave, NGW = G * 8;
    const bf16* Y2 = (const bf16*)(ws + WS_XS);
    for (int m = gw; m < T; m += NGW) {
        f32x4* op = (f32x4*)(a.out + (size_t)m * D + 16 * lane);
#if X1_BF16
        f32x4 o0, o1, o2, o3; { const v4u* xp = (const v4u*)((const bf16*)(ws + WS_X1B) + (size_t)m * D + 16 * lane); const v4u w0 = xp[0], w1 = xp[1];
            o0.x = bflo(w0.x); o0.y = bfhi(w0.x); o0.z = bflo(w0.y); o0.w = bfhi(w0.y); o1.x = bflo(w0.z); o1.y = bfhi(w0.z); o1.z = bflo(w0.w); o1.w = bfhi(w0.w);
            o2.x = bflo(w1.x); o2.y = bfhi(w1.x); o2.z = bflo(w1.y); o2.w = bfhi(w1.y); o3.x = bflo(w1.z); o3.y = bfhi(w1.z); o3.z = bflo(w1.w); o3.w = bfhi(w1.w); }
#else
        f32x4 o0 = op[0], o1 = op[1], o2 = op[2], o3 = op[3];
#endif
        int ts[4]; { const int* tp = (const int*)(ws + WS_TSLOT) + (size_t)m * 4; ts[0] = tp[0]; ts[1] = tp[1]; ts[2] = tp[2]; ts[3] = tp[3]; }
#pragma unroll
#if Y_FP8
        for (int k = 0; k < 4; ++k) { const v4u w = *(const v4u*)((const unsigned char*)Y2 + (size_t)ts[k] * 1024 + 16 * lane); constexpr float IS = 1.f / Y8_SCALE;
            f32x2_t_ a;
            a = __builtin_amdgcn_cvt_pk_f32_fp8((int)w.x, false); o0.x += a.x * IS; o0.y += a.y * IS; a = __builtin_amdgcn_cvt_pk_f32_fp8((int)w.x, true); o0.z += a.x * IS; o0.w += a.y * IS;
            a = __builtin_amdgcn_cvt_pk_f32_fp8((int)w.y, false); o1.x += a.x * IS; o1.y += a.y * IS; a = __builtin_amdgcn_cvt_pk_f32_fp8((int)w.y, true); o1.z += a.x * IS; o1.w += a.y * IS;
            a = __builtin_amdgcn_cvt_pk_f32_fp8((int)w.z, false); o2.x += a.x * IS; o2.y += a.y * IS; a = __builtin_amdgcn_cvt_pk_f32_fp8((int)w.z, true); o2.z += a.x * IS; o2.w += a.y * IS;
            a = __builtin_amdgcn_cvt_pk_f32_fp8((int)w.w, false); o3.x += a.x * IS; o3.y += a.y * IS; a = __builtin_amdgcn_cvt_pk_f32_fp8((int)w.w, true); o3.z += a.x * IS; o3.w += a.y * IS; }
#else
        for (int k = 0; k < 4; ++k) { const v4u* yp = (const v4u*)(Y2 + (size_t)ts[k] * 1024 + 16 * lane); const v4u w0 = yp[0], w1 = yp[1];
            o0.x += bflo(w0.x); o0.y += bfhi(w0.x); o0.z += bflo(w0.y); o0.w += bfhi(w0.y); o1.x += bflo(w0.z); o1.y += bfhi(w0.z); o1.z += bflo(w0.w); o1.w += bfhi(w0.w);
            o2.x += bflo(w1.x); o2.y += bfhi(w1.x); o2.z += bflo(w1.y); o2.w += bfhi(w1.y); o3.x += bflo(w1.z); o3.y += bfhi(w1.z); o3.z += bflo(w1.w); o3.w += bfhi(w1.w); }
#endif
        op[0] = o0; op[1] = o1; op[2] = o2; op[3] = o3;
    }
}
#endif
constexpr int NPHASE = 12;
#ifndef V8_FROM_P1
#define V8_FROM_P1 1
#endif
#ifndef P1_SPLIT
#define P1_SPLIT 1
#endif
constexpr int N_ATT_ITEMS = 1024, N_MX_ITEMS = 512, N_SCAN_WG = 32, N_TR_WG = 64;
DI void stagger(int bx, int step_ticks) {
#ifdef STAGGER
    const unsigned long long t0 = __builtin_amdgcn_s_memrealtime(); const unsigned long long d = (unsigned long long)(((bx >> 3) & 7) * step_ticks);
    while (__builtin_amdgcn_s_memrealtime() - t0 < d) __builtin_amdgcn_s_sleep(8);
#endif
}
typedef const Args __attribute__((address_space(4))) CArgs;
#if defined(__HIP_DEVICE_COMPILE__)
DI CArgs* fresh_args() { unsigned long long v = (unsigned long long)__builtin_amdgcn_kernarg_segment_ptr(); asm volatile("" : "+s"(v)); return (CArgs*)v; }
#else
__device__ CArgs* fresh_args();
#endif
DI Args load_args() { CArgs* p = fresh_args(); Args a;
#pragma unroll
    for (int i = 0; i < 27; ++i) a.in[i] = p->in[i];
    a.out = p->out; a.ws = p->ws; a.ph_lo = p->ph_lo; a.ph_hi = p->ph_hi; a.li = p->li; a.pad = 0; return a; }
#ifndef MK_N_LAUNCHES
#define MK_N_LAUNCHES 1
#endif
__global__ void __launch_bounds__(512, 2) mk_fwd(Args args_unused) {
    extern __shared__ __attribute__((aligned(16))) unsigned char lds_raw[];
    LAS unsigned char* lds = (LAS unsigned char*)lds_raw;
    volatile LAS unsigned* MISC = (volatile LAS unsigned*)(lds + MISC_OFF);
    for (int u = threadIdx.x; u < (LDS_BYTES - LDSCTL_OFF) / 4; u += 512) ((LAS unsigned*)(lds + LDSCTL_OFF))[u] = 0u;
    __syncthreads();
    { const Args A0 = load_args(); (void)xcd_barrier_post((unsigned*)(A0.ws + WS_CTL) + CW_BAR, MISC + 8); }
#ifdef ONLY_PHASE
#define IN(k) ((k) == ONLY_PHASE)
#elif MK_N_LAUNCHES == 1
#define IN(k) true
#else
#define IN(k) (fresh_args()->ph_lo <= (k) && (k) < fresh_args()->ph_hi)
#endif
#define FRESH() const Args A_ = load_args(); unsigned char* const ws = A_.ws; (void)ws; const int tid_ = fresh_tid(), lane_ = tid_ & 63, wave_ = __builtin_amdgcn_readfirstlane(tid_ >> 6); (void)lane_; (void)wave_; \
    const int G = gridDim.x, bx = blockIdx.x, vcu = (G % 8 == 0) ? (bx % 8) * (G / 8) + bx / 8 : bx; (void)vcu
#ifndef REPEAT_PHASE
#define REPEAT_PHASE -1
#endif
#define NREP(k) ((k) == REPEAT_PHASE ? 2 : 1)
#define GBAR() do { XcdBarrier b_; b_.bar = (unsigned*)(fresh_args()->ws + WS_CTL) + CW_BAR; b_.x = xb_xcc_id(); b_.st = MISC + 8; xcd_barrier(b_); } while (0)
#define SEAM(k) do { if (IN(k) && IN((k) + 1)) { XcdBarrier b_; b_.bar = (unsigned*)(fresh_args()->ws + WS_CTL) + CW_BAR; b_.x = xb_xcc_id(); b_.st = MISC + 8; xcd_barrier(b_); } } while (0)

    if (IN(0)) _Pragma("unroll") for (int rep_ = 0; rep_ < NREP(0); ++rep_) { if (rep_) GBAR(); FRESH();
#ifdef PROBE_P0
        p0_prologue(A_, lds, vcu, G, wave_, lane_, rep_ == 0 ? PROBE_P0 : 0); }
#else
        p0_prologue(A_, lds, vcu, G, wave_, lane_); }
#endif
    SEAM(0);
    if (IN(1)) _Pragma("unroll") for (int rep_ = 0; rep_ < NREP(1); ++rep_) { if (rep_) GBAR();
        FRESH();
        const int cls_ = P1_SPLIT ? (__builtin_amdgcn_readfirstlane((int)blockIdx.x) & 3) : 0;
#define P1_F8_PART(I0, NI) {   \
          pg8::Gemm g{(const bf16*)(ws + WS_H8), (const bf16*)(ws + WS_WIN8), 512, 512, 512, nullptr, 0}; \
          OffOrder S; S.S.init(T, (12 + (P1_FA1 - P1_FA0)) * 256, G, bx); S.n0 = P1_FA1 - P1_FA0; S.a0 = P1_FA0; S.a1 = 16; S.i0 = (I0); S.ni = (NI); \
          EpiPT<true> E{(bf16*)(ws + WS_P), A_.in[I_BGATE], 0, (bf16*)(ws + WS_GF), (LAS float*)(lds + 128 * 1024), A_.in[I_DAQN], A_.in[I_DAKN], A_.in[I_MXQN], ws + WS_Q8, ws + WS_K8}; \
          pg8::gemm_phase<EpiPT<true>, OffOrder, false, true>(lds, g, S, E, tid_); }
#define P1_BF_PART(I0, NI) { \
          pg8::Gemm g{(const bf16*)(ws + WS_H), (const bf16*)(ws + WS_WIN), 1024, 1024, 1024, nullptr, 0}; \
          OffOrder S; S.S.init(T, 14 * 256, G, bx); S.n0 = 12; S.a0 = 0; S.a1 = 14; S.i0 = (I0); S.ni = (NI);        \
          EpiP E{(bf16*)(ws + WS_P), A_.in[I_BGATE], 0, (bf16*)(ws + WS_GF), (LAS float*)(lds + 128 * 1024), A_.in[I_DAQN], A_.in[I_DAKN], A_.in[I_MXQN], ws + WS_Q8, ws + WS_K8}; \
          pg8::gemm_phase<EpiP, OffOrder>(lds, g, S, E, tid_); }
#define P1_V_PART() {   \
          pg8::Gemm g{(const bf16*)(ws + WS_H), (const bf16*)(ws + WS_WIN), 1024, 1024, 1024, nullptr, 0}; \
          OffOrder S; S.S.init(T, 2 * 256, G, bx); S.n0 = 2; S.a0 = 12; S.a1 = 14; \
          EpiV8 E{ws + WS_V8, lds + 128 * 1024}; \
          pg8::gemm_phase<EpiV8, OffOrder, false, false, true>(lds, g, S, E, tid_); }
        if (!(cls_ & 1)) P1_V_PART()
        const int f8a_ = cls_ == 1 ? 1000 : cls_ == 3 ? 3 : 0;
        const int bfa_ = cls_ == 2 ? 4 : 1000;
        if (f8a_ > 0) P1_F8_PART(0, f8a_)
        P1_BF_PART(0, bfa_)
        if (f8a_ < 1000) P1_F8_PART(f8a_, 1000)
        if (bfa_ < 1000) P1_BF_PART(bfa_, 1000)
        if (cls_ & 1) P1_V_PART()
#undef P1_V_PART
#undef P1_F8_PART
#undef P1_BF_PART
    }
    SEAM(1);
    if (IN(2)) _Pragma("unroll") for (int rep_ = 0; rep_ < NREP(2); ++rep_) { if (rep_) GBAR();
        FRESH();
#ifndef NO_PREP
        { PrepPre pp; if (vcu < NCHUNK) prep_prefetch(A_, vcu, tid_, wave_, pp);
          for (int ck = vcu; ck < NCHUNK; ck += G) dn_prep_unit<0>(A_, lds, ck, ck + G, pp, wave_); }
#if ATTN_FP8PV && !V8_FROM_P1
        { FRESH(); p2_v8_tiles(A_, lds, vcu, G, tid_); }
#endif
#endif
#if !defined(NO_NORM) && !NORM_IN_EPI
        if (rep_ == 0) p2_norm_rows(A_, vcu, G, wave_, lane_);
#endif
    }
    SEAM(2);
    if (IN(3)) _Pragma("unroll") for (int rep_ = 0; rep_ < NREP(3); ++rep_) { if (rep_) GBAR();
#ifndef NO_SCAN
        if (blockIdx.x >= N_SCAN_WG && blockIdx.x < N_SCAN_WG + N_TR_WG) { FRESH(); moe_transposes(A_, lds, bx - N_SCAN_WG, N_TR_WG, wave_, lane_); p3_small_copies(A_, lds, bx - N_SCAN_WG, N_TR_WG, wave_, lane_); __syncthreads(); }
        if (blockIdx.x >= N_SCAN_WG + N_TR_WG && blockIdx.x < N_SCAN_WG + N_TR_WG + 16) { FRESH();
            pg8::Gemm g{(const bf16*)(ws + WS_MEMN), (const bf16*)(ws + WS_WMKV), 1024, 1024, 1024, nullptr, 0}; pg8::StaticOrder S; S.init(BATCH * NMEM, 1024, 16, bx - (N_SCAN_WG + N_TR_WG));
            EpiPlain E{(bf16*)(ws + WS_MKV), 1024};
            pg8::gemm_phase<EpiPlain, pg8::StaticOrder>(lds, g, S, E, tid_);
            asm volatile("s_waitcnt vmcnt(0)" ::: "memory"); __syncthreads();
            if (tid_ == 0) { __builtin_amdgcn_fence(__ATOMIC_RELEASE, "agent"); asm volatile("s_waitcnt vmcnt(0)" ::: "memory"); __hip_atomic_fetch_add((unsigned*)(ws + WS_CTL) + CW_MKV + 1024 * rep_, 1u, RLX_AGENT); }
            __syncthreads(); }
#ifdef PROBE_ATT
        if (rep_ == 1)
#endif
        if (blockIdx.x < N_SCAN_WG) { FRESH(); dn_scan(A_, lds, bx, wave_, lane_); }
#ifdef PROBE_SCAN_ALONE
        GBAR();
#endif
#ifdef PROBE_SCAN_TWICE
        if (blockIdx.x < N_SCAN_WG) { FRESH(); dn_scan(A_, lds, bx, wave_, lane_, PROBE_SCAN_TWICE >> 1); }
#endif
#endif
#ifndef NO_ATT
        for (;;) {
            CArgs* ap = fresh_args(); unsigned char* ws = ap->ws; const int tid_ = fresh_tid();
            if (tid_ == 0) MISC[16] = __hip_atomic_fetch_add((unsigned*)(ws + WS_CTL) + CW_QHEAD + 1024 * rep_, 1u, RLX_AGENT);
            __syncthreads();
            const int item = __builtin_amdgcn_readfirstlane((int)MISC[16]);
            __syncthreads();
            if (item >= N_ATT_ITEMS) break;
            const int qb = 31 - (item >> 5), rest = item & 31, b = rest >> 3, h = (rest >> 1) & 3, map = rest & 1;
            const attn_body::bf16* Pb = (const attn_body::bf16*)(ws + WS_P) + (size_t)b * SEQ * PW;
            attn_body::bf16* Ob = (attn_body::bf16*)(ws + (map ? WS_O2 : WS_O1)) + (size_t)b * SEQ * 512 + h * 128;
            float kb_; { float g_ = __builtin_fabsf(ap->in[I_DAKN][tid_ & 63]);
#pragma unroll
                for (int o_ = 1; o_ < 64; o_ <<= 1) g_ = __builtin_fmaxf(g_, __shfl_xor(g_, o_));
                kb_ = __builtin_bit_cast(float, __builtin_amdgcn_readfirstlane(__builtin_bit_cast(int, 8.f * g_))); }
            attn_body::attn_unit<8, false>(qb, Pb + P_DAQ + h * 128 + map * 64, Pb + P_DAK + h * 128 + map * 64, Pb + P_DAV + h * 128, Ob, ap->in[I_REL], h, (char*)lds_raw, tid_, kb_, ws + WS_V8 + ((size_t)(b * 128) * 4 + h) * 8192, ws + WS_Q8 + (size_t)b * SEQ * 512 + (h * 2 + map) * 64, ws + WS_K8 + ((size_t)(b * 128) * 8 + (h * 2 + map)) * 4096);
        }
#endif
#ifndef NO_MX
        { FRESH();
          if (tid_ == 0) { unsigned sp = 0; while (__hip_atomic_load((unsigned*)(ws + WS_CTL) + CW_MKV + 1024 * rep_, RLX_AGENT) < 16u) { __builtin_amdgcn_s_sleep(2); if (++sp > (1u << 22)) break; }
              __builtin_amdgcn_fence(__ATOMIC_ACQUIRE, "agent"); asm volatile("s_waitcnt vmcnt(0)" ::: "memory"); }
          __syncthreads(); }
        for (;;) {
            FRESH();
            if (tid_ == 0) MISC[16] = __hip_atomic_fetch_add((unsigned*)(ws + WS_CTL) + CW_QHEAD + 16 + 1024 * rep_, 1u, RLX_AGENT);
            __syncthreads();
            const int idx = __builtin_amdgcn_readfirstlane((int)MISC[16]);
            __syncthreads();
            if (idx >= N_MX_ITEMS) break;
            mx_unit(A_, lds, idx >> 5, idx & 31, tid_, wave_, lane_);
        }
#endif
    }
    SEAM(3);
    if (IN(4)) _Pragma("unroll") for (int rep_ = 0; rep_ < NREP(4); ++rep_) { if (rep_) GBAR(); FRESH(); p4_norm_rows(A_, vcu, G, wave_, lane_); }
    SEAM(4);
    if (IN(5)) _Pragma("unroll") for (int rep_ = 0; rep_ < NREP(5); ++rep_) { if (rep_) GBAR();
        FRESH();
        pg8::Gemm g{(const bf16*)(ws + WS_ODNF), (const bf16*)(ws + WS_WB), 512, 512, 512, nullptr, 0};
        BranchOrder S; S.so.init(T, 1024, G, bx); S.a1 = (long)(WS_ODAF - WS_ODNF); S.a2 = (long)(WS_OMX - WS_ODNF);
        EpiMerge E{(bf16*)(ws + WS_MRG), (const bf16*)(ws + WS_GF), (bf16*)(ws + WS_MF)};
        pg8::gemm_phase<EpiMerge, BranchOrder>(lds, g, S, E, tid_);
    }
    SEAM(5);
    if (IN(6)) _Pragma("unroll") for (int rep_ = 0; rep_ < NREP(6); ++rep_) { if (rep_) GBAR();
        FRESH();
        pg8::Gemm g{(const bf16*)(ws + WS_MRG), (const bf16*)(ws + WS_WOUT), 1024, 1024, 1024, nullptr, 0}; pg8::StaticOrder S; S.init(T, 1024, G, bx);
#if X1_BF16
        EpiResB E{(bf16*)(ws + WS_X1B), A_.in[I_X]};
        pg8::gemm_phase<EpiResB, pg8::StaticOrder>(lds, g, S, E, tid_);
#else
        EpiResF32 E{A_.out, A_.in[I_X], ws + WS_H, A_.in[I_FNORM]};
        pg8::gemm_phase<EpiResF32, pg8::StaticOrder>(lds, g, S, E, tid_);
#endif
    }
    SEAM(6);
    if (IN(7)) _Pragma("unroll") for (int rep_ = 0; rep_ < NREP(7); ++rep_) { if (rep_) GBAR(); FRESH(); p5_router(A_, lds, vcu, G, tid_, wave_, lane_, CW_CNT + 256 * rep_); }
    SEAM(7);
    if (IN(8)) _Pragma("unroll") for (int rep_ = 0; rep_ < NREP(8); ++rep_) { if (rep_) GBAR(); FRESH(); p6_slots(A_, lds, vcu, G, tid_, wave_, lane_, CW_CUR + 256 * rep_); }
    SEAM(8);
    if (IN(9)) _Pragma("unroll") for (int rep_ = 0; rep_ < NREP(9); ++rep_) { if (rep_) GBAR();
        FRESH();
        moe_table(A_, lds, tid_);
#if MOE_FP8
        pg8::Gemm g{(const bf16*)(ws + WS_H), (const bf16*)(ws + WS_WGU), 512, 512, 512, (const int*)(ws + WS_SDST), 0};
        MoeOrder S{(const LAS int*)(lds + LTAB_OFF), ((const LAS int*)(lds + LCNT_OFF))[64], 8, G, bx, (long)2048 * 1024};
#else
        pg8::Gemm g{(const bf16*)(ws + WS_H), (const bf16*)(ws + WS_WGU), 1024, 1024, 1024, (const int*)(ws + WS_SDST), 0};
        MoeOrder S{(const LAS int*)(lds + LTAB_OFF), ((const LAS int*)(lds + LCNT_OFF))[64], 8, G, bx, (long)2048 * 1024 * 2};
#endif
#ifdef PROBE_NOEPI
        EpiSwiGLU E{(bf16*)(ws + WS_ACT), A_.in[I_BGU], (REPEAT_PHASE == 9 && rep_ == 0) ? PROBE_NOEPI : 0, (const float*)(ws + WS_SR)};
#else
        EpiSwiGLU E{(bf16*)(ws + WS_ACT), A_.in[I_BGU], 0, (const float*)(ws + WS_SR)};
#endif
        pg8::gemm_phase<EpiSwiGLU, MoeOrder, true, MOE_FP8 != 0>(lds, g, S, E, tid_);
    }
    SEAM(9);
    if (IN(10)) _Pragma("unroll") for (int rep_ = 0; rep_ < NREP(10); ++rep_) { if (rep_) GBAR();
        FRESH();
        moe_table(A_, lds, tid_);
#if MOE_FP8
        pg8::Gemm g{(const bf16*)(ws + WS_ACT), (const bf16*)(ws + WS_WD), 512, 512, 512, nullptr, 0};
        MoeOrder S{(const LAS int*)(lds + LTAB_OFF), ((const LAS int*)(lds + LCNT_OFF))[64], 4, G, bx, (long)1024 * 1024};
#else
        pg8::Gemm g{(const bf16*)(ws + WS_ACT), (const bf16*)(ws + WS_WD), 1024, 1024, 1024, nullptr, 0};
        MoeOrder S{(const LAS int*)(lds + LTAB_OFF), ((const LAS int*)(lds + LCNT_OFF))[64], 4, G, bx, (long)1024 * 1024 * 2};
#endif
        EpiDown E{(bf16*)(ws + WS_XS), A_.in[I_BD], (const int*)(ws + WS_SDST), (const float*)(ws + WS_SW)};
        pg8::gemm_phase<EpiDown, MoeOrder, false, MOE_FP8 != 0>(lds, g, S, E, tid_);
    }
    SEAM(10);
    if (IN(11)) {
        FRESH();
#ifdef PROBE_P11
        p9_combine_probe(A_, vcu, G, wave_, lane_); GBAR();
#endif
        p9_combine(A_, vcu, G, wave_, lane_);
        if (bx == 0 && tid_ == 0) { if (__hip_atomic_load((unsigned*)(ws + WS_CTL) + CW_BAR + XB_TMO, RLX_AGENT) != 0u) A_.out[0] = __builtin_nanf(""); }
    }
#undef IN
#undef SEAM
#undef FRESH
}

extern "C" void kernel_launch(void* const* d_in, const int* in_sizes, int n_in, void* d_out, int out_size, void* d_ws, size_t ws_size, hipStream_t stream) {
    static int grid = 0;
    if (grid == 0) {
        if (n_in != 27 || in_sizes[0] != T * D || out_size != T * D || ws_size < WS_END) {
            fprintf(stderr, "kernel_launch: unexpected shapes (n_in %d, in0 %d, out %d, ws %zu < %zu); nothing launched\n", n_in, n_in > 0 ? in_sizes[0] : -1, out_size, ws_size, (size_t)WS_END); grid = -1; return; }
        int dev = 0, cus = 0, per_cu = 0;
        if (hipGetDevice(&dev) != hipSuccess || hipDeviceGetAttribute(&cus, hipDeviceAttributeMultiprocessorCount, dev) != hipSuccess) { grid = -1; return; }
        if (hipFuncSetAttribute((const void*)mk_fwd, hipFuncAttributeMaxDynamicSharedMemorySize, LDS_BYTES) != hipSuccess) { fprintf(stderr, "kernel_launch: hipFuncSetAttribute failed\n"); grid = -1; return; }
        if (hipOccupancyMaxActiveBlocksPerMultiprocessor(&per_cu, (const void*)mk_fwd, 512, LDS_BYTES) != hipSuccess || per_cu < 1)
            fprintf(stderr, "kernel_launch: note: occupancy query reports %d workgroups per CU\n", per_cu);
        (void)hipGetLastError();
        grid = cus;
        if (grid > 256) grid = 256;
    }
    if (grid < 0) return;
    if (hipMemsetAsync((char*)d_ws + WS_CTL, 0, CTL_ZERO_BYTES, stream) != hipSuccess) return;
    Args a{};
    for (int i = 0; i < 27; ++i) a.in[i] = (const float*)d_in[i];
    a.out = (float*)d_out; a.ws = (unsigned char*)d_ws;
#if MK_N_LAUNCHES == 1
    a.ph_lo = 0; a.ph_hi = NPHASE; a.li = 0; a.pad = 0;
    hipLaunchKernelGGL(mk_fwd, dim3(grid), dim3(512), LDS_BYTES, stream, a);
#else
    for (int p = 0; p < NPHASE; ++p) { a.ph_lo = p; a.ph_hi = p + 1; a.li = 0; a.pad = 0; hipLaunchKernelGGL(mk_fwd, dim3(grid), dim3(512), LDS_BYTES, stream, a); }
#endif
}
```
